# Optimizing an MI355X kernel written in HIP

```python
import math
import jax, jax.numpy as jnp
from jax import lax
import numpy as np

D_MODEL = 2048
BATCH = 4
SEQ = 4096
DEPTH = 1

POOL_WIDTH = D_MODEL // 2
POOL_WINDOWS = (2, 4, 8, 16)
POOL_GROUPS = len(POOL_WINDOWS)
POOL_GROUP_DIM = POOL_WIDTH // POOL_GROUPS
SSM_WIDTH = D_MODEL // 2
SSM_GROUP_DIM = 16
SSM_GROUPS = SSM_WIDTH // SSM_GROUP_DIM
SSM_STATE = 64
DT_MIN = 1e-3
DT_MAX = 1e-1
LAMBDA_RE_MAX = -1e-4
IN_WIDTH = POOL_WIDTH + SSM_WIDTH + 2 * D_MODEL
N_EXPERTS = 32
TOP_K = 4
D_EXPERT = D_MODEL
SWIGLU_ALPHA = 1.702
SWIGLU_LIMIT = 7.0
MOE_BLOCK = 256
N_ADA = 6
RMS_EPS = 1e-6

kernel_name = "pool_s5_gated_moe_adaln_block"


def rms_norm(x, g):
    xf = x.astype(jnp.float32)
    y = xf * lax.rsqrt(jnp.mean(xf * xf, axis=-1, keepdims=True) + RMS_EPS)
    return y * g.astype(jnp.float32)


def modulate(h, shift, scale):
    return h * (1.0 + scale[:, None, :]) + shift[:, None, :]


def pool_mixer(u, pool_w, pool_scale):
    b, s, _ = u.shape
    uf = u.astype(jnp.float32).reshape(b, s, POOL_GROUPS, POOL_GROUP_DIM)
    cs = jnp.cumsum(uf, axis=1)
    pos = jnp.arange(1, s + 1, dtype=jnp.float32)
    outs = []
    for g, w in enumerate(POOL_WINDOWS):
        c_g = cs[:, :, g]
        lower = jnp.pad(c_g[:, : s - w], ((0, 0), (w, 0), (0, 0)))
        count = jnp.minimum(pos, float(w))[None, :, None]
        outs.append((c_g - lower) / count - uf[:, :, g])
    pooled = jnp.stack(outs, axis=2)
    mixed = jnp.einsum('bsgc,gcd->bsgd', pooled, pool_w.astype(jnp.float32))
    return mixed.reshape(b, s, POOL_WIDTH) * pool_scale.astype(jnp.float32)


def _complex_linear_combine(left, right):
    a1r, a1i, b1r, b1i = left
    a2r, a2i, b2r, b2i = right
    ar = a2r * a1r - a2i * a1i
    ai = a2r * a1i + a2i * a1r
    br = a2r * b1r - a2i * b1i + b2r
    bi = a2r * b1i + a2i * b1r + b2i
    return (ar, ai, br, bi)


def s5_mixer(u, lam_re, lam_im, log_dt, b_re, b_im, c_re, c_im, d_skip):
    b, s, _ = u.shape
    f32 = jnp.float32
    uf = u.astype(f32).reshape(b, s, SSM_GROUPS, SSM_GROUP_DIM)
    dt = jnp.exp(log_dt.astype(f32))[:, None]
    lre = jnp.minimum(lam_re.astype(f32), LAMBDA_RE_MAX)
    lim = lam_im.astype(f32)
    mag = jnp.exp(lre * dt)
    ang = lim * dt
    ab_re = mag * jnp.cos(ang)
    ab_im = mag * jnp.sin(ang)
    den = lre * lre + lim * lim
    nr = ab_re - 1.0
    ni = ab_im
    f_re = (nr * lre + ni * lim) / den
    f_im = (ni * lre - nr * lim) / den
    br_, bi_ = b_re.astype(f32), b_im.astype(f32)
    bb_re = f_re[..., None] * br_ - f_im[..., None] * bi_
    bb_im = f_re[..., None] * bi_ + f_im[..., None] * br_
    bu_re = jnp.einsum('bsgh,gph->bsgp', uf, bb_re)
    bu_im = jnp.einsum('bsgh,gph->bsgp', uf, bb_im)
    a_re = jnp.broadcast_to(ab_re[None, None], (1, s, SSM_GROUPS, SSM_STATE))
    a_im = jnp.broadcast_to(ab_im[None, None], (1, s, SSM_GROUPS, SSM_STATE))
    _, _, xr, xi = lax.associative_scan(_complex_linear_combine, (a_re, a_im, bu_re, bu_im), axis=1)
    y = (jnp.einsum('bsgp,ghp->bsgh', xr, c_re.astype(f32))
         - jnp.einsum('bsgp,ghp->bsgh', xi, c_im.astype(f32)))
    y = y + d_skip.astype(f32).reshape(SSM_GROUPS, SSM_GROUP_DIM) * uf
    return y.reshape(b, s, SSM_WIDTH)


def hybrid_mixer(h, w_in, pool_w, pool_scale, w_pool_out, lam_re, lam_im, log_dt,
                 b_re, b_im, c_re, c_im, d_skip, w_glu, b_glu, w_out):
    z = h @ w_in
    u_pool, u_ssm, g_pool, g_ssm = jnp.split(
        z, [POOL_WIDTH, POOL_WIDTH + SSM_WIDTH, POOL_WIDTH + SSM_WIDTH + D_MODEL], axis=-1)
    y_pool = pool_mixer(u_pool, pool_w, pool_scale) @ w_pool_out
    y_s = jax.nn.gelu(s5_mixer(u_ssm, lam_re, lam_im, log_dt, b_re, b_im, c_re, c_im, d_skip))
    glu = y_s @ w_glu + b_glu
    glu_a, glu_b = jnp.split(glu, 2, axis=-1)
    y_ssm = glu_a * jax.nn.sigmoid(glu_b)
    merged = jax.nn.sigmoid(g_pool) * y_pool + jax.nn.sigmoid(g_ssm) * y_ssm
    return merged @ w_out


def moe_ffn(h, w_router, b_router, w1, b1, w2, b2):
    b, s, d = h.shape
    t = b * s
    hf = h.reshape(t, d)
    logits = hf.astype(jnp.float32) @ w_router.astype(jnp.float32) + b_router.astype(jnp.float32)
    top_val, top_idx = lax.top_k(logits, TOP_K)
    weights = jax.nn.softmax(top_val, axis=-1)
    n_assign = t * TOP_K
    flat_e = top_idx.reshape(-1).astype(jnp.int32)
    flat_t = jnp.repeat(jnp.arange(t, dtype=jnp.int32), TOP_K)
    flat_w = weights.reshape(-1)
    order = jnp.argsort(flat_e)
    se = flat_e[order]
    counts = jnp.zeros((N_EXPERTS,), jnp.int32).at[flat_e].add(1)
    starts = jnp.cumsum(counts) - counts
    pcounts = (counts + MOE_BLOCK - 1) // MOE_BLOCK * MOE_BLOCK
    pends = jnp.cumsum(pcounts)
    pstarts = pends - pcounts
    rank = jnp.arange(n_assign, dtype=jnp.int32) - starts[se]
    dest = pstarts[se] + rank
    n_blocks = -(-(n_assign + N_EXPERTS * (MOE_BLOCK - 1)) // MOE_BLOCK)
    n_pad = n_blocks * MOE_BLOCK
    buf_tok = jnp.zeros((n_pad,), jnp.int32).at[dest].set(flat_t[order])
    buf_w = jnp.zeros((n_pad,), jnp.float32).at[dest].set(flat_w[order])
    block_starts = jnp.arange(n_blocks, dtype=jnp.int32) * MOE_BLOCK
    block_e = jnp.minimum(jnp.searchsorted(pends, block_starts, side='right'), N_EXPERTS - 1)

    def run_block(args):
        tok, wgt, e = args
        xb = hf[tok]
        gu = xb @ w1[e] + b1[e]
        x_glu = jnp.minimum(gu[:, :D_EXPERT], SWIGLU_LIMIT)
        x_lin = jnp.clip(gu[:, D_EXPERT:], -SWIGLU_LIMIT, SWIGLU_LIMIT)
        act = x_glu * jax.nn.sigmoid(SWIGLU_ALPHA * x_glu) * (x_lin + 1.0)
        y = act @ w2[e] + b2[e]
        return y * wgt[:, None].astype(y.dtype)

    ys = lax.map(run_block, (buf_tok.reshape(n_blocks, MOE_BLOCK),
                             buf_w.reshape(n_blocks, MOE_BLOCK), block_e))
    out = jnp.zeros((t, d), ys.dtype).at[buf_tok].add(ys.reshape(n_pad, d))
    return out.reshape(b, s, d)


def setup_inputs(seed: int = 0) -> dict:
    key = jax.random.key(seed)
    ks = jax.random.split(key, 32)
    f32 = jnp.float32

    def nrm(k, shape, scale):
        return jax.random.normal(k, shape, f32) * scale

    L, D, G, P, H = DEPTH, D_MODEL, SSM_GROUPS, SSM_STATE, SSM_GROUP_DIM
    E, F = N_EXPERTS, D_EXPERT
    lam_im = (math.pi * jnp.arange(P, dtype=f32))[None, None, :] + nrm(ks[10], (L, G, P), 0.01)
    log_dt = jax.random.uniform(ks[11], (L, G), f32, math.log(DT_MIN), math.log(DT_MAX))
    return {
        "x": nrm(ks[0], (BATCH, SEQ, D), 1.0),
        "c": nrm(ks[1], (BATCH, D), 1.0),
        "ada_w": nrm(ks[2], (L, D, N_ADA * D), 0.3 * D ** -0.5),
        "ada_b": nrm(ks[3], (L, N_ADA * D), 0.02),
        "norm1_g": 1.0 + nrm(ks[4], (L, D), 0.02),
        "w_in": nrm(ks[5], (L, D, IN_WIDTH), D ** -0.5),
        "pool_w": nrm(ks[6], (L, POOL_GROUPS, POOL_GROUP_DIM, POOL_GROUP_DIM), POOL_GROUP_DIM ** -0.5),
        "pool_scale": 1.0 + nrm(ks[7], (L, POOL_WIDTH), 0.1),
        "w_pool_out": nrm(ks[8], (L, POOL_WIDTH, D), POOL_WIDTH ** -0.5),
        "ssm_lam_re": -0.5 + nrm(ks[9], (L, G, P), 0.01),
        "ssm_lam_im": lam_im,
        "ssm_log_dt": log_dt,
        "ssm_b_re": nrm(ks[12], (L, G, P, H), (2.0 * H) ** -0.5),
        "ssm_b_im": nrm(ks[13], (L, G, P, H), (2.0 * H) ** -0.5),
        "ssm_c_re": nrm(ks[14], (L, G, H, P), (2.0 * P) ** -0.5),
        "ssm_c_im": nrm(ks[15], (L, G, H, P), (2.0 * P) ** -0.5),
        "ssm_d": nrm(ks[16], (L, SSM_WIDTH), 1.0),
        "w_glu": nrm(ks[17], (L, SSM_WIDTH, 2 * D), SSM_WIDTH ** -0.5),
        "b_glu": nrm(ks[18], (L, 2 * D), 0.01),
        "w_out": nrm(ks[19], (L, D, D), D ** -0.5),
        "norm2_g": 1.0 + nrm(ks[20], (L, D), 0.02),
        "w_router": nrm(ks[21], (L, D, E), D ** -0.5),
        "b_router": nrm(ks[22], (L, E), 0.01),
        "w1": nrm(ks[23], (L, E, D, 2 * F), D ** -0.5),
        "b1": nrm(ks[24], (L, E, 2 * F), 0.01),
        "w2": nrm(ks[25], (L, E, F, D), F ** -0.5),
        "b2": nrm(ks[26], (L, E, D), 0.01),
        "final_ada_w": nrm(ks[27], (D, 2 * D), 0.3 * D ** -0.5),
        "final_ada_b": nrm(ks[28], (2 * D,), 0.02),
        "final_norm_g": 1.0 + nrm(ks[29], (D,), 0.02),
    }


def reference(x, c, ada_w, ada_b, norm1_g, w_in, pool_w, pool_scale, w_pool_out,
              ssm_lam_re, ssm_lam_im, ssm_log_dt, ssm_b_re, ssm_b_im, ssm_c_re, ssm_c_im, ssm_d,
              w_glu, b_glu, w_out, norm2_g, w_router, b_router, w1, b1, w2, b2,
              final_ada_w, final_ada_b, final_norm_g):
    c_act = jax.nn.silu(c.astype(jnp.float32))
    for l in range(DEPTH):
        mod = c_act @ ada_w[l] + ada_b[l]
        sh_m, sc_m, gt_m, sh_f, sc_f, gt_f = jnp.split(mod, N_ADA, axis=-1)
        h = modulate(rms_norm(x, norm1_g[l]), sh_m, sc_m)
        mix = hybrid_mixer(h, w_in[l], pool_w[l], pool_scale[l], w_pool_out[l],
                           ssm_lam_re[l], ssm_lam_im[l], ssm_log_dt[l], ssm_b_re[l], ssm_b_im[l],
                           ssm_c_re[l], ssm_c_im[l], ssm_d[l], w_glu[l], b_glu[l], w_out[l])
        x = x + (gt_m[:, None, :] * mix).astype(x.dtype)
        h2 = modulate(rms_norm(x, norm2_g[l]), sh_f, sc_f)
        ffn = moe_ffn(h2, w_router[l], b_router[l], w1[l], b1[l], w2[l], b2[l])
        x = x + (gt_f[:, None, :] * ffn).astype(x.dtype)
    fmod = c_act @ final_ada_w + final_ada_b
    sh_o, sc_o = jnp.split(fmod, 2, axis=-1)
    y = modulate(rms_norm(x, final_norm_g), sh_o, sc_o)
    return y.astype(x.dtype)
```

```cpp
#include <hip/hip_runtime.h>
#include <cstdio>
#include <cstdint>

namespace pg8 {
#define PG8_LAS __attribute__((address_space(3)))
typedef unsigned short bf16_t;
typedef short bf16x8 __attribute__((ext_vector_type(8)));
typedef float f32x4 __attribute__((ext_vector_type(4)));
typedef float f32x2 __attribute__((ext_vector_type(2)));
typedef unsigned u32x4 __attribute__((ext_vector_type(4)));
constexpr int BM = 256, BK = 64, HALF = 128, HTB = HALF * BK * 2, STAGE_BYTES = 8 * HTB, NXCD = 8, WGM = 8;

__host__ __device__ __forceinline__ int lds_byte(int r, int c) { const int st = (r >> 4) * 2 + (c >> 5), rr = r & 15, cc = c & 31, ob = rr * 64 + cc * 2; return st * 1024 + (ob ^ (((ob >> 9) & 1) << 5)); }
__host__ __device__ __forceinline__ void stage_rc(int b, int& R, int& C) { const int st = b / 1024, sb = b % 1024, swz = sb ^ (((sb >> 9) & 1) << 5); R = (st >> 1) * 16 + swz / 64; C = (st & 1) * 32 + (swz % 64) / 2; }
__host__ __device__ __forceinline__ int perm32(int rho) { const int n = rho >> 4, i = rho & 15; return 8 * (i >> 2) + 4 * n + (i & 3); }

struct Unit { int pm, pn, e, rb, nvalid; };

__device__ __forceinline__ unsigned cvt_pk_bf16(float lo, float hi) { unsigned r; asm volatile("v_cvt_pk_bf16_f32 %0, %1, %2" : "=v"(r) : "v"(lo), "v"(hi)); return r; }
__device__ __forceinline__ float bf_lo(unsigned w) { return __uint_as_float(w << 16); }
__device__ __forceinline__ float bf_hi(unsigned w) { return __uint_as_float(w & 0xffff0000u); }
__device__ __forceinline__ float sigmoidf_(float x) { return __builtin_amdgcn_rcpf(1.0f + __builtin_amdgcn_exp2f(-1.44269504089f * x)); }
__device__ __forceinline__ float gelu_tanh_(float x) { const float u = 0.7978845608f * (x + 0.044715f * x * x * x); return x * __builtin_amdgcn_rcpf(1.0f + __builtin_amdgcn_exp2f(-2.88539008178f * u)); }

template <class Epi, class Sched, bool GATHER>
__device__ __forceinline__ void gemm_phase(PG8_LAS unsigned char* lds, const int lda, const int ldb, const int K, const Sched& S, const Epi& E) {
    const int tid = threadIdx.x, wid = __builtin_amdgcn_readfirstlane(tid >> 6), lane = tid & 63, wr = wid >> 2, wc = wid & 3, fr = lane & 15, fq = lane >> 4;
    const int nt = K / BK;
    unsigned voffA[2], voffB[2], colA[2]; int rowA[2];
#pragma unroll
    for (int i = 0; i < 2; ++i) { int R, C; stage_rc(tid * 16 + i * 8192, R, C); const int Rb = Epi::PERM ? ((R & ~31) + perm32(R & 31)) : R;
        rowA[i] = R; colA[i] = (unsigned)C * 2u; voffA[i] = (unsigned)(R * lda + C) * 2u; voffB[i] = (unsigned)(Rb * ldb + C) * 2u; }
    const size_t kstep = (size_t)(BK * 2);
    const size_t hstepA = GATHER ? (size_t)0 : (size_t)HALF * lda * 2;
    const size_t hstepB = (size_t)HALF * ldb * 2;
    const unsigned ldsw = (unsigned)wid * 1024u;
    const int aoff = lds_byte(wr * 64 + fr, fq * 8), boff = lds_byte(wc * 32 + fr, fq * 8);
#define PG8_SA(b, h) (((b) * 2 + (h)) * HTB)
#define PG8_SB(b, h) ((4 + (b) * 2 + (h)) * HTB)
#define PG8_STAGE2(bufoff, gbase, o0, o1) do { \
        __builtin_amdgcn_global_load_lds((const unsigned*)((const char*)(gbase) + (o0)), (PG8_LAS unsigned*)(lds + (bufoff) + ldsw), 16, 0, 0); \
        __builtin_amdgcn_global_load_lds((const unsigned*)((const char*)(gbase) + (o1)), (PG8_LAS unsigned*)(lds + (bufoff) + ldsw + 8192), 16, 0, 0); } while (0)
#define PG8_STAGE_B(bufoff, gbase) PG8_STAGE2(bufoff, gbase, voffB[0], voffB[1])
#define PG8_LDA(dst, b, h) do { _Pragma("unroll") for (int m = 0; m < 4; ++m) _Pragma("unroll") for (int k = 0; k < 2; ++k) dst[m][k] = *(const PG8_LAS bf16x8*)(lds + PG8_SA(b, h) + aoff + m * 2048 + k * 1024); } while (0)
#define PG8_LDB(dst, b, h) do { _Pragma("unroll") for (int n = 0; n < 2; ++n) _Pragma("unroll") for (int k = 0; k < 2; ++k) dst[n][k] = *(const PG8_LAS bf16x8*)(lds + PG8_SB(b, h) + boff + n * 2048 + k * 1024); } while (0)
#define PG8_MMA(ai, bj, At, Bt) do { __builtin_amdgcn_s_setprio(1); _Pragma("unroll") for (int m = 0; m < 4; ++m) _Pragma("unroll") for (int n = 0; n < 2; ++n) _Pragma("unroll") for (int k = 0; k < 2; ++k) \
        acc[ai][bj][m][n] = __builtin_amdgcn_mfma_f32_16x16x32_bf16(Bt[n][k], At[m][k], acc[ai][bj][m][n], 0, 0, 0); __builtin_amdgcn_s_setprio(0); } while (0)
#define PG8_WAIT_V(n) asm volatile("s_waitcnt vmcnt(" #n ")" ::: "memory")
#define PG8_WAIT_L(n) asm volatile("s_waitcnt lgkmcnt(" #n ")" ::: "memory")
#define PG8_BAR __builtin_amdgcn_s_barrier()
#define PG8_SCHED __builtin_amdgcn_sched_barrier(0)
    Unit cur, nxt; int ui = 0;
    if (!S.next(0, cur)) return;
    f32x4 acc[2][2][4][2];
#pragma unroll
    for (int a = 0; a < 2; ++a)
#pragma unroll
        for (int b = 0; b < 2; ++b)
#pragma unroll
            for (int m = 0; m < 4; ++m)
#pragma unroll
                for (int n = 0; n < 2; ++n) acc[a][b][m][n] = (f32x4){0.f, 0.f, 0.f, 0.f};
    bf16x8 At[4][2], B0[2][2], B1[2][2];
    const char* cA = S.a_ptr(cur); const char* cB = S.b_ptr(cur);
    unsigned gcur[2][2], gnxt[2][2];
#pragma unroll
    for (int h = 0; h < 2; ++h)
#pragma unroll
        for (int i = 0; i < 2; ++i) { if constexpr (GATHER) gcur[h][i] = S.a_rowoff(cur, h * HALF + rowA[i]) + colA[i]; else gcur[h][i] = voffA[i]; gnxt[h][i] = gcur[h][i]; }
    PG8_STAGE_B(PG8_SB(0, 0), cB); PG8_STAGE_B(PG8_SB(0, 1), cB + hstepB); PG8_STAGE2(PG8_SA(0, 0), cA, gcur[0][0], gcur[0][1]); PG8_STAGE2(PG8_SA(0, 1), cA + hstepA, gcur[1][0], gcur[1][1]);
    if (wr == 1) PG8_BAR;
    PG8_WAIT_V(2); PG8_BAR;
    PG8_STAGE_B(PG8_SB(1, 0), cB + kstep); PG8_STAGE2(PG8_SA(1, 0), cA + kstep, gcur[0][0], gcur[0][1]); PG8_STAGE_B(PG8_SB(1, 1), cB + hstepB + kstep);
    PG8_WAIT_V(6); PG8_BAR;
    for (;;) {
        const bool has_next = S.next(ui + 1, nxt);
        const char* nA = has_next ? S.a_ptr(nxt) : cA; const char* nB = has_next ? S.b_ptr(nxt) : cB;
#pragma unroll 1
        for (int t = 0; t < nt; t += 2) {
            const bool last = (t == nt - 2);
            const char* a1 = cA + (size_t)(t + 1) * kstep;
            const char* a2 = last ? nA : cA + (size_t)(t + 2) * kstep; const char* b2 = last ? nB : cB + (size_t)(t + 2) * kstep;
            const char* a3 = a2 + kstep; const char* b3 = b2 + kstep;
            if constexpr (GATHER) {
                if (last && has_next) {
#pragma unroll
                    for (int h = 0; h < 2; ++h)
#pragma unroll
                        for (int i = 0; i < 2; ++i) gnxt[h][i] = S.a_rowoff(nxt, h * HALF + rowA[i]) + colA[i];
                    asm volatile("" : "+v"(gnxt[0][0]), "+v"(gnxt[0][1]), "+v"(gnxt[1][0]), "+v"(gnxt[1][1]));
                }
            }
            unsigned o2[2][2];
#pragma unroll
            for (int h = 0; h < 2; ++h)
#pragma unroll
                for (int i = 0; i < 2; ++i) { if constexpr (GATHER) o2[h][i] = last ? gnxt[h][i] : gcur[h][i]; else o2[h][i] = voffA[i]; }
            PG8_LDB(B0, 0, 0); PG8_LDB(B1, 0, 1); PG8_SCHED; PG8_LDA(At, 0, 0); PG8_STAGE2(PG8_SA(1, 1), a1 + hstepA, gcur[1][0], gcur[1][1]);
            PG8_WAIT_V(8); PG8_WAIT_L(0); PG8_BAR; PG8_MMA(0, 0, At, B0); PG8_MMA(0, 1, At, B1); PG8_BAR; PG8_SCHED;
            PG8_LDA(At, 0, 1); PG8_STAGE_B(PG8_SB(0, 0), b2); PG8_STAGE_B(PG8_SB(0, 1), b2 + hstepB); PG8_STAGE2(PG8_SA(0, 0), a2, o2[0][0], o2[0][1]);
            PG8_WAIT_V(8); PG8_WAIT_L(0); PG8_BAR; PG8_MMA(1, 0, At, B0); PG8_MMA(1, 1, At, B1); PG8_BAR; PG8_SCHED;
            PG8_LDB(B0, 1, 0); PG8_LDB(B1, 1, 1); PG8_SCHED; PG8_LDA(At, 1, 0); PG8_STAGE2(PG8_SA(0, 1), a2 + hstepA, o2[1][0], o2[1][1]);
            PG8_WAIT_V(8); PG8_WAIT_L(0); PG8_BAR; PG8_MMA(0, 0, At, B0); PG8_MMA(0, 1, At, B1); PG8_BAR; PG8_SCHED;
            PG8_LDA(At, 1, 1); PG8_STAGE_B(PG8_SB(1, 0), b3); PG8_STAGE_B(PG8_SB(1, 1), b3 + hstepB); PG8_STAGE2(PG8_SA(1, 0), a3, o2[0][0], o2[0][1]);
            PG8_WAIT_V(8); PG8_WAIT_L(0); PG8_BAR; PG8_MMA(1, 0, At, B0); PG8_MMA(1, 1, At, B1); PG8_BAR; PG8_SCHED;
        }
        if (wr == 0) PG8_BAR;
        E(acc, cur, wr, wc, fr, fq);
        if (!has_next) break;
#pragma unroll
        for (int a = 0; a < 2; ++a)
#pragma unroll
            for (int b = 0; b < 2; ++b)
#pragma unroll
                for (int m = 0; m < 4; ++m)
#pragma unroll
                    for (int n = 0; n < 2; ++n) acc[a][b][m][n] = (f32x4){0.f, 0.f, 0.f, 0.f};
        cur = nxt; cA = nA; cB = nB; ++ui;
#pragma unroll
        for (int h = 0; h < 2; ++h)
#pragma unroll
            for (int i = 0; i < 2; ++i) gcur[h][i] = gnxt[h][i];
        if (wr == 1) PG8_BAR;
    }
    PG8_WAIT_V(0);
    PG8_BAR;
#undef PG8_SA
#undef PG8_SB
#undef PG8_STAGE2
#undef PG8_STAGE_B
#undef PG8_LDA
#undef PG8_LDB
#undef PG8_MMA
#undef PG8_WAIT_V
#undef PG8_WAIT_L
#undef PG8_BAR
#undef PG8_SCHED
}
}

constexpr int NWAVES = 8;
#ifndef MK_N_LAUNCHES
#define MK_N_LAUNCHES 12
#endif
constexpr int NPH = 12;
constexpr int N_LAUNCHES = MK_N_LAUNCHES;

constexpr int BATCH = 4, SEQ = 4096, D = 2048, T = BATCH * SEQ;
constexpr int PW = 1024, SW = 1024, INW = PW + SW + 2 * D;
constexpr int NE = 32, TOPK = 4, FE = 2048;
constexpr int SG = 64, SP = 64, SH = 16, CL = 16, NCH = SEQ / CL;
constexpr int UGK = CL * SH + 2 * SP;
constexpr int LCAP = T;
constexpr int MAXBLK = 288;
constexpr float RMS_EPS = 1e-6f;

constexpr size_t MiB = 1u << 20;
constexpr size_t WS_CTL = 0, CTL_ZERO_BYTES = 1 * MiB;
constexpr size_t WS_MOD = 1 * MiB;
constexpr size_t WS_FMOD = WS_MOD + 196608, WS_AL = WS_MOD + 262144;
constexpr size_t WS_WIN = 2 * MiB, WS_POOLW = 26 * MiB, WS_WPO = 27 * MiB, WS_WGLU = 31 * MiB, WS_WOUT = 39 * MiB, WS_WEND = 47 * MiB, WS_TG = 55 * MiB;
constexpr size_t WS_W1 = 68 * MiB, WS_W2 = 580 * MiB;
constexpr size_t WS_XN = 836 * MiB, WS_UP = 900 * MiB, WS_UG = 932 * MiB, WS_SGP = 980 * MiB, WS_SGS = 1044 * MiB, WS_PL = 1108 * MiB, WS_PM = 1140 * MiB, WS_E = 1172 * MiB;
constexpr size_t WS_YPG = 1204 * MiB, WS_YS = 1268 * MiB, WS_MG = 1300 * MiB, WS_X1 = 1364 * MiB, WS_LTOK = 1492 * MiB, WS_LWT = 1494 * MiB, WS_TSLOT = 1496 * MiB;
constexpr size_t WS_ACT = 1498 * MiB, WS_YE = 1786 * MiB, WS_END = 2074 * MiB;
static_assert(WS_TG + (size_t)SG * 256 * UGK * 2 <= WS_W1 && WS_UG + (size_t)SG * 1024 * UGK * 2 <= WS_SGP && WS_ACT + (size_t)MAXBLK * 256 * FE * 2 <= WS_YE, "d_ws map");
constexpr int CW_TMO = 0, CW_CODE = 1, CW_CNT = 64, CW_BAR = 4096;

constexpr int RING_OFF = 0, RING_BYTES = 131072;
constexpr int LDSCTL_OFF = RING_BYTES, MISC_OFF = LDSCTL_OFF + 320;
constexpr int LDS_BYTES = 147456;

#define GAS __attribute__((address_space(1)))
#define LAS __attribute__((address_space(3)))
typedef unsigned short bf16;
typedef unsigned v4u __attribute__((ext_vector_type(4)));
typedef unsigned v2u __attribute__((ext_vector_type(2)));
typedef float f32x4 __attribute__((ext_vector_type(4)));
typedef float f32x16 __attribute__((ext_vector_type(16)));
typedef GAS unsigned gu32;
#define RLX_AGENT __ATOMIC_RELAXED, __HIP_MEMORY_SCOPE_AGENT
#define LDS_WAIT() asm volatile("s_waitcnt lgkmcnt(0)" ::: "memory")
#define VM_WAIT() asm volatile("s_waitcnt vmcnt(0)" ::: "memory")
using pg8::cvt_pk_bf16; using pg8::bf_lo; using pg8::bf_hi; using pg8::sigmoidf_; using pg8::gelu_tanh_;

#define XB_TMO      128
#define XB_XCNT(j)  (256  + 64 * (j))
#define XB_XSUB(j)  (1280 + 64 * (j))
#define XB_XGEN(j)  (2304 + 64 * (j))
#define XB_TOP      3328
#define XB_TOPGEN   3392
#define XCD_BAR_WORDS 3456
#define XB_SPIN_CAP (1u << 18)

__device__ __forceinline__ unsigned xb_ld(unsigned* p)              { return __hip_atomic_load(p, __ATOMIC_RELAXED, __HIP_MEMORY_SCOPE_AGENT); }
__device__ __forceinline__ unsigned xb_add(unsigned* p, unsigned v) { return __hip_atomic_fetch_add(p, v, __ATOMIC_RELAXED, __HIP_MEMORY_SCOPE_AGENT); }
__device__ __forceinline__ unsigned xb_xcc_id() { return (unsigned)__builtin_amdgcn_s_getreg((3 << 11) | 20) & 0xFu; }
#define XB_SPIN(cond, bar) do { unsigned _sp = 0; while (cond) { __builtin_amdgcn_s_sleep(1); \
    if ((++_sp & 255u) == 0u) { if (xb_ld(&(bar)[XB_TMO])) break; if (_sp > XB_SPIN_CAP) { atomicAdd(&(bar)[XB_TMO], 1u); break; } } } } while (0)

struct XcdBarrier { unsigned* bar; unsigned x; volatile LAS unsigned* st; };

__device__ __forceinline__ XcdBarrier xcd_barrier_post(unsigned* bar, volatile LAS unsigned* st) {
    XcdBarrier b; b.bar = bar; b.x = xb_xcc_id(); b.st = st;
    if (threadIdx.x == 0) (void)xb_add(&bar[XB_XCNT(b.x)], 1u);
    return b;
}
__device__ __forceinline__ void xcd_barrier_complete(unsigned* bar, unsigned x, unsigned& nloc, unsigned& nx) {
    const unsigned G = gridDim.x * gridDim.y * gridDim.z;
    unsigned sum, cnt, mine, sp = 0u;
    for (;;) {
        sum = 0u; cnt = 0u; mine = 0u;
#pragma unroll
        for (unsigned j = 0; j < 16; ++j) { const unsigned c = xb_ld(&bar[XB_XCNT(j)]); sum += c; cnt += (c > 0u) ? 1u : 0u; mine = (j == x) ? c : mine; }
        if (sum == G) break;
        __builtin_amdgcn_s_sleep(1);
        if ((++sp & 255u) == 0u) { if (xb_ld(&bar[XB_TMO])) break; if (sp > XB_SPIN_CAP) { atomicAdd(&bar[XB_TMO], 1u); break; } }
    }
    nloc = mine > 0u ? mine : 1u; nx = cnt > 0u ? cnt : 1u;
}
__device__ __forceinline__ void xcd_barrier(const XcdBarrier& b) {
    asm volatile("s_waitcnt vmcnt(0)" ::: "memory");
    __syncthreads();
    if (threadIdx.x == 0) {
        unsigned* bar = b.bar;
        __builtin_amdgcn_s_waitcnt(0);
        unsigned nloc = b.st[0], nx = b.st[1];
        if (nloc == 0u) { xcd_barrier_complete(bar, b.x, nloc, nx); b.st[0] = nloc; b.st[1] = nx; }
        const unsigned old = xb_add(&bar[XB_XSUB(b.x)], 1u);
        const unsigned gen = old / nloc;
        if (old + 1u == (gen + 1u) * nloc) {
            __builtin_amdgcn_fence(__ATOMIC_RELEASE, "agent");
            asm volatile("s_waitcnt vmcnt(0)" ::: "memory");
            const unsigned og = xb_add(&bar[XB_TOP], 1u);
            const unsigned tg = og / nx;
            if (og + 1u == (tg + 1u) * nx) xb_add(&bar[XB_TOPGEN], 1u);
            else XB_SPIN(xb_ld(&bar[XB_TOPGEN]) == tg, bar);
            __builtin_amdgcn_fence(__ATOMIC_ACQUIRE, "agent");
            xb_add(&bar[XB_XGEN(b.x)], 1u);
            asm volatile("s_waitcnt vmcnt(0)" ::: "memory");
        } else {
            XB_SPIN(xb_ld(&bar[XB_XGEN(b.x)]) == gen, bar);
            __builtin_amdgcn_fence(__ATOMIC_ACQUIRE, "agent");
            asm volatile("s_waitcnt vmcnt(0)" ::: "memory");
        }
    }
    __syncthreads();
}

using pg8::Unit;
struct SchedDense {
    const char* A; const char* Bt; size_t astep, bstep; int nM, nN, nwg, G, c;
    __device__ __forceinline__ void init(const void* A_, const void* Bt_, int M, int N, int lda, int ldb, int G_, int c_) { A = (const char*)A_; Bt = (const char*)Bt_; astep = (size_t)256 * lda * 2; bstep = (size_t)256 * ldb * 2; nM = M / 256; nN = N / 256; nwg = nM * nN; G = G_; c = c_; }
    __device__ __forceinline__ bool next(int i, Unit& u) const {
        const long L = (long)i * G + c; if (L >= nwg) return false;
        int wgid = (int)L; { const int q = nwg / pg8::NXCD, r = nwg % pg8::NXCD, xcd = wgid % pg8::NXCD, off = wgid / pg8::NXCD; wgid = (xcd < r ? xcd * (q + 1) : r * (q + 1) + (xcd - r) * q) + off; }
        const int nig = pg8::WGM * nN, gid = wgid / nig, fm = gid * pg8::WGM, gsz = (nM - fm) < pg8::WGM ? (nM - fm) : pg8::WGM;
        u.pm = fm + ((wgid % nig) % gsz); u.pn = (wgid % nig) / gsz; u.e = 0; u.rb = 0; u.nvalid = 256; return true;
    }
    __device__ __forceinline__ const char* a_ptr(const Unit& u) const { return A + (size_t)u.pm * astep; }
    __device__ __forceinline__ const char* b_ptr(const Unit& u) const { return Bt + (size_t)u.pn * bstep; }
    __device__ __forceinline__ unsigned a_rowoff(const Unit&, int) const { return 0u; }
};
struct SchedGrouped {
    const char* A; const char* Bt; size_t astep, agstride, bgstride; int nPM, nunits, G, c;
    __device__ __forceinline__ void init(const void* A_, const void* Bt_, int lda, size_t agstride_, size_t bgstride_, int nPM_, int ngroups, int G_, int c_) { A = (const char*)A_; Bt = (const char*)Bt_; astep = (size_t)256 * lda * 2; agstride = agstride_; bgstride = bgstride_; nPM = nPM_; nunits = nPM_ * ngroups; G = G_; c = c_; }
    __device__ __forceinline__ bool next(int i, Unit& u) const { const int L = i * G + c; if (L >= nunits) return false; u.e = L / nPM; u.pm = L % nPM; u.pn = 0; u.rb = 0; u.nvalid = 256; return true; }
    __device__ __forceinline__ const char* a_ptr(const Unit& u) const { return A + (size_t)u.e * agstride + (size_t)u.pm * astep; }
    __device__ __forceinline__ const char* b_ptr(const Unit& u) const { return Bt + (size_t)u.e * bgstride; }
    __device__ __forceinline__ unsigned a_rowoff(const Unit&, int) const { return 0u; }
};
struct SchedMoe {
    const char* A; const char* Bt; size_t astep, bstep_e, bstep_n; int nN, G, c; volatile LAS unsigned* M; const int* ltok; bool gather;
    __device__ __forceinline__ bool next(int i, Unit& u) const {
        const int L = i * G + c; const int total = (int)M[176]; if (L >= total) return false;
        int e = 0;
#pragma unroll 1
        for (int j = 1; j < NE; ++j) e += (L >= (int)M[32 + j]) ? 1 : 0;
        e = __builtin_amdgcn_readfirstlane(e);
        const int w = L - (int)M[32 + e], pb = (int)M[80 + e], nb = (int)M[80 + e + 1] - pb, cnt = (int)M[128 + e];
        int rb = w % nb, pn = w / nb;
        rb = __builtin_amdgcn_readfirstlane(rb); pn = __builtin_amdgcn_readfirstlane(pn);
        u.e = e; u.rb = rb; u.pn = pn; u.pm = __builtin_amdgcn_readfirstlane(pb + rb); const int nv = cnt - rb * 256; u.nvalid = __builtin_amdgcn_readfirstlane(nv < 256 ? nv : 256); return true;
    }
    __device__ __forceinline__ const char* a_ptr(const Unit& u) const { return gather ? A : A + (size_t)u.pm * astep; }
    __device__ __forceinline__ const char* b_ptr(const Unit& u) const { return Bt + (size_t)u.e * bstep_e + (size_t)u.pn * bstep_n; }
    __device__ __forceinline__ unsigned a_rowoff(const Unit& u, int r) const { const int idx = (r < u.nvalid) ? (u.rb * 256 + r) : 0; const int tok = ltok[(size_t)u.e * LCAP + idx]; return (unsigned)tok * (unsigned)(D * 2); }
};

using pg8::f32x2; using pg8::u32x4;
#define EPI_ARGS const f32x4 (&acc)[2][2][4][2], const Unit& u, int wr, int wc, int fr, int fq
struct EpiZ { static constexpr bool PERM = true; bf16 *UP, *UG, *SGP, *SGS;
    __device__ __forceinline__ void operator()(EPI_ARGS) const {
        const int pn = u.pn, region = pn < 4 ? 0 : (pn < 8 ? 1 : (pn < 16 ? 2 : 3));
#pragma unroll
        for (int ai = 0; ai < 2; ++ai)
#pragma unroll
            for (int m = 0; m < 4; ++m) { const int row = u.pm * 256 + ai * 128 + wr * 64 + m * 16 + fr;
#pragma unroll
                for (int bj = 0; bj < 2; ++bj) { const int lc = bj * 128 + wc * 32 + 8 * fq; f32x4 v0 = acc[ai][bj][m][0], v1 = acc[ai][bj][m][1];
                    if (region >= 2) {
#pragma unroll
                        for (int j = 0; j < 4; ++j) { v0[j] = sigmoidf_(v0[j]); v1[j] = sigmoidf_(v1[j]); } }
                    u32x4 w; w.x = cvt_pk_bf16(v0[0], v0[1]); w.y = cvt_pk_bf16(v0[2], v0[3]); w.z = cvt_pk_bf16(v1[0], v1[1]); w.w = cvt_pk_bf16(v1[2], v1[3]);
                    bf16* dst;
                    if (region == 0) dst = UP + (size_t)row * PW + pn * 256 + lc;
                    else if (region == 1) { const int j = (pn - 4) * 256 + lc, g = j >> 4, h0 = j & 15, b = row >> 12, tp = row & 4095, c = tp >> 4, s = tp & 15; dst = UG + ((size_t)(g * 1024 + b * 256 + c) * UGK + s * 16 + h0); }
                    else if (region == 2) dst = SGP + (size_t)row * D + (pn - 8) * 256 + lc;
                    else dst = SGS + (size_t)row * D + (pn - 16) * 256 + lc;
                    *(u32x4*)dst = w; } }
    }
};
struct EpiS1 { static constexpr bool PERM = false; float* E;
    __device__ __forceinline__ void operator()(EPI_ARGS) const {
#pragma unroll
        for (int ai = 0; ai < 2; ++ai)
#pragma unroll
            for (int m = 0; m < 4; ++m) { const int row = u.pm * 256 + ai * 128 + wr * 64 + m * 16 + fr; float* rp = E + ((size_t)u.e * 1024 + row) * 128 + wc * 32 + 4 * fq;
#pragma unroll
                for (int n = 0; n < 2; ++n) *(f32x4*)(rp + n * 16) = acc[ai][0][m][n]; }
    }
};
struct EpiPmix { static constexpr bool PERM = true; bf16* PM; const float* scale;
    __device__ __forceinline__ void operator()(EPI_ARGS) const {
#pragma unroll
        for (int bj = 0; bj < 2; ++bj) { const int col = u.e * 256 + bj * 128 + wc * 32 + 8 * fq; const f32x4 s0 = *(const f32x4*)(scale + col), s1 = *(const f32x4*)(scale + col + 4);
#pragma unroll
            for (int ai = 0; ai < 2; ++ai)
#pragma unroll
                for (int m = 0; m < 4; ++m) { const int row = u.pm * 256 + ai * 128 + wr * 64 + m * 16 + fr; const f32x4 v0 = acc[ai][bj][m][0] * s0, v1 = acc[ai][bj][m][1] * s1;
                    u32x4 w; w.x = cvt_pk_bf16(v0[0], v0[1]); w.y = cvt_pk_bf16(v0[2], v0[3]); w.z = cvt_pk_bf16(v1[0], v1[1]); w.w = cvt_pk_bf16(v1[2], v1[3]);
                    *(u32x4*)(PM + (size_t)row * PW + col) = w; } }
    }
};
struct EpiS3 { static constexpr bool PERM = true; bf16* YS;
    __device__ __forceinline__ void operator()(EPI_ARGS) const {
#pragma unroll
        for (int ai = 0; ai < 2; ++ai)
#pragma unroll
            for (int m = 0; m < 4; ++m) { const int r = u.pm * 256 + ai * 128 + wr * 64 + m * 16 + fr, b = r >> 8, c = r & 255;
#pragma unroll
                for (int bj = 0; bj < 2; ++bj) { const int lc = bj * 128 + wc * 32 + 8 * fq, t = lc >> 4, h0 = lc & 15; f32x4 v0 = acc[ai][bj][m][0], v1 = acc[ai][bj][m][1];
#pragma unroll
                    for (int j = 0; j < 4; ++j) { v0[j] = gelu_tanh_(v0[j]); v1[j] = gelu_tanh_(v1[j]); }
                    u32x4 w; w.x = cvt_pk_bf16(v0[0], v0[1]); w.y = cvt_pk_bf16(v0[2], v0[3]); w.z = cvt_pk_bf16(v1[0], v1[1]); w.w = cvt_pk_bf16(v1[2], v1[3]);
                    *(u32x4*)(YS + (size_t)(b * SEQ + c * CL + t) * SW + u.e * 16 + h0) = w; } }
    }
};
struct EpiYpool { static constexpr bool PERM = true; bf16* YPG; const bf16* SGP;
    __device__ __forceinline__ void operator()(EPI_ARGS) const {
#pragma unroll
        for (int ai = 0; ai < 2; ++ai)
#pragma unroll
            for (int m = 0; m < 4; ++m) { const int row = u.pm * 256 + ai * 128 + wr * 64 + m * 16 + fr;
#pragma unroll
                for (int bj = 0; bj < 2; ++bj) { const size_t off = (size_t)row * D + u.pn * 256 + bj * 128 + wc * 32 + 8 * fq; const u32x4 g = *(const u32x4*)(SGP + off);
                    const f32x4 v0 = acc[ai][bj][m][0], v1 = acc[ai][bj][m][1];
                    u32x4 w; w.x = cvt_pk_bf16(v0[0] * bf_lo(g.x), v0[1] * bf_hi(g.x)); w.y = cvt_pk_bf16(v0[2] * bf_lo(g.y), v0[3] * bf_hi(g.y));
                    w.z = cvt_pk_bf16(v1[0] * bf_lo(g.z), v1[1] * bf_hi(g.z)); w.w = cvt_pk_bf16(v1[2] * bf_lo(g.w), v1[3] * bf_hi(g.w));
                    *(u32x4*)(YPG + off) = w; } }
    }
};
struct EpiGlu { static constexpr bool PERM = true; bf16* MG; const bf16 *YPG, *SGS; const float* bglu;
    __device__ __forceinline__ void operator()(EPI_ARGS) const {
        const int j0 = u.pn * 128 + wc * 32 + 8 * fq;
        const f32x4 ba0 = *(const f32x4*)(bglu + j0), ba1 = *(const f32x4*)(bglu + j0 + 4), bb0 = *(const f32x4*)(bglu + D + j0), bb1 = *(const f32x4*)(bglu + D + j0 + 4);
#pragma unroll
        for (int ai = 0; ai < 2; ++ai)
#pragma unroll
            for (int m = 0; m < 4; ++m) { const int row = u.pm * 256 + ai * 128 + wr * 64 + m * 16 + fr; const size_t off = (size_t)row * D + j0;
                const u32x4 yp = *(const u32x4*)(YPG + off), gs = *(const u32x4*)(SGS + off);
                const f32x4 a0 = acc[ai][0][m][0] + ba0, a1 = acc[ai][0][m][1] + ba1, b0 = acc[ai][1][m][0] + bb0, b1 = acc[ai][1][m][1] + bb1;
                float o[8];
#pragma unroll
                for (int j = 0; j < 4; ++j) { o[j] = a0[j] * sigmoidf_(b0[j]); o[4 + j] = a1[j] * sigmoidf_(b1[j]); }
                u32x4 w; w.x = cvt_pk_bf16(bf_lo(yp.x) + bf_lo(gs.x) * o[0], bf_hi(yp.x) + bf_hi(gs.x) * o[1]); w.y = cvt_pk_bf16(bf_lo(yp.y) + bf_lo(gs.y) * o[2], bf_hi(yp.y) + bf_hi(gs.y) * o[3]);
                w.z = cvt_pk_bf16(bf_lo(yp.z) + bf_lo(gs.z) * o[4], bf_hi(yp.z) + bf_hi(gs.z) * o[5]); w.w = cvt_pk_bf16(bf_lo(yp.w) + bf_lo(gs.w) * o[6], bf_hi(yp.w) + bf_hi(gs.w) * o[7]);
                *(u32x4*)(MG + off) = w; }
    }
};
struct EpiOut { static constexpr bool PERM = false; float* X1; const float* x; const float* mod;
    __device__ __forceinline__ void operator()(EPI_ARGS) const {
        const int b = (u.pm * 256) >> 12; const float* gt = mod + (size_t)b * 6 * D + 2 * D;
#pragma unroll
        for (int bj = 0; bj < 2; ++bj)
#pragma unroll
            for (int n = 0; n < 2; ++n) { const int col = u.pn * 256 + bj * 128 + wc * 32 + n * 16 + 4 * fq; const f32x4 g = *(const f32x4*)(gt + col);
#pragma unroll
                for (int ai = 0; ai < 2; ++ai)
#pragma unroll
                    for (int m = 0; m < 4; ++m) { const int row = u.pm * 256 + ai * 128 + wr * 64 + m * 16 + fr; const size_t off = (size_t)row * D + col;
                        *(f32x4*)(X1 + off) = *(const f32x4*)(x + off) + g * acc[ai][bj][m][n]; } }
    }
};
struct EpiMoe1 { static constexpr bool PERM = true; bf16* ACT; const float* b1;
    __device__ __forceinline__ void operator()(EPI_ARGS) const {
        const int j0 = u.pn * 128 + wc * 32 + 8 * fq; const float* bb = b1 + (size_t)u.e * 2 * FE;
        const f32x4 ba0 = *(const f32x4*)(bb + j0), ba1 = *(const f32x4*)(bb + j0 + 4), bl0 = *(const f32x4*)(bb + FE + j0), bl1 = *(const f32x4*)(bb + FE + j0 + 4);
#pragma unroll
        for (int ai = 0; ai < 2; ++ai)
#pragma unroll
            for (int m = 0; m < 4; ++m) { const int row = u.pm * 256 + ai * 128 + wr * 64 + m * 16 + fr;
                const f32x4 a0 = acc[ai][0][m][0] + ba0, a1 = acc[ai][0][m][1] + ba1, l0 = acc[ai][1][m][0] + bl0, l1 = acc[ai][1][m][1] + bl1;
                float o[8];
#pragma unroll
                for (int j = 0; j < 4; ++j) { const float g0 = fminf(a0[j], 7.0f), g1 = fminf(a1[j], 7.0f), x0 = fminf(fmaxf(l0[j], -7.0f), 7.0f), x1 = fminf(fmaxf(l1[j], -7.0f), 7.0f);
                    o[j] = g0 * sigmoidf_(1.702f * g0) * (x0 + 1.0f); o[4 + j] = g1 * sigmoidf_(1.702f * g1) * (x1 + 1.0f); }
                u32x4 w; w.x = cvt_pk_bf16(o[0], o[1]); w.y = cvt_pk_bf16(o[2], o[3]); w.z = cvt_pk_bf16(o[4], o[5]); w.w = cvt_pk_bf16(o[6], o[7]);
                *(u32x4*)(ACT + (size_t)row * FE + j0) = w; }
    }
};
struct EpiMoe2 { static constexpr bool PERM = true; bf16* YE; const float* b2; const float* lwt;
    __device__ __forceinline__ void operator()(EPI_ARGS) const {
        const float* bb = b2 + (size_t)u.e * D;
#pragma unroll
        for (int ai = 0; ai < 2; ++ai)
#pragma unroll
            for (int m = 0; m < 4; ++m) { const int r = ai * 128 + wr * 64 + m * 16 + fr; const float wg = (r < u.nvalid) ? lwt[(size_t)u.e * LCAP + u.rb * 256 + r] : 0.0f;
#pragma unroll
                for (int bj = 0; bj < 2; ++bj) { const int col = u.pn * 256 + bj * 128 + wc * 32 + 8 * fq; const f32x4 c0 = *(const f32x4*)(bb + col), c1 = *(const f32x4*)(bb + col + 4);
                    const f32x4 v0 = (acc[ai][bj][m][0] + c0) * wg, v1 = (acc[ai][bj][m][1] + c1) * wg;
                    u32x4 w; w.x = cvt_pk_bf16(v0[0], v0[1]); w.y = cvt_pk_bf16(v0[2], v0[3]); w.z = cvt_pk_bf16(v1[0], v1[1]); w.w = cvt_pk_bf16(v1[2], v1[3]);
                    *(u32x4*)(YE + ((size_t)u.pm * 256 + r) * D + col) = w; } }
    }
};

__device__ __forceinline__ float wave_sum(float v) {
#pragma unroll
    for (int o = 1; o < 64; o <<= 1) v += __shfl_xor(v, o);
    return v;
}
__device__ __forceinline__ void tr_item(const float* __restrict__ W, int K, int N, bf16* WT, int item, int lane, int mode) {
    const int nblk = N >> 6, kb = item / nblk, nb = item - kb * nblk, k0 = kb * 64, n = nb * 64 + lane;
    int drow = n;
    if (mode) { const int half = N >> 1, hi = n >= half ? 1 : 0, nn = n - hi * half; drow = (nn >> 7) * 256 + hi * 128 + (nn & 127); }
    const float* src = W + (size_t)k0 * N + n;
    float v[64];
#pragma unroll
    for (int i = 0; i < 64; ++i) v[i] = src[(size_t)i * N];
    bf16* dst = WT + (size_t)drow * K + k0;
#pragma unroll
    for (int j = 0; j < 8; ++j) { v4u o; o.x = cvt_pk_bf16(v[8 * j], v[8 * j + 1]); o.y = cvt_pk_bf16(v[8 * j + 2], v[8 * j + 3]); o.z = cvt_pk_bf16(v[8 * j + 4], v[8 * j + 5]); o.w = cvt_pk_bf16(v[8 * j + 6], v[8 * j + 7]);
        *(v4u*)(dst + 8 * j) = o; }
}

struct Args { const void* in[30]; float* out; unsigned char* ws; int ph_lo, ph_hi, li, pad; };

__global__ void __launch_bounds__(NWAVES * 64, 2) fwd_kernel(Args args) {
    extern __shared__ __attribute__((aligned(16))) unsigned char lds_raw[];
    LAS unsigned char* lds = (LAS unsigned char*)lds_raw;
    volatile LAS unsigned* MISC = (volatile LAS unsigned*)(lds + MISC_OFF);
    const int tid = threadIdx.x, lane = tid & 63, wave = __builtin_amdgcn_readfirstlane(tid >> 6);
    const int G = gridDim.x; const int bx = blockIdx.x; const int vcu = (G % 8 == 0) ? (bx % 8) * (G / 8) + bx / 8 : bx;
    unsigned char* ws = args.ws;
    gu32* ctl = (gu32*)(ws + WS_CTL);
    const float* x = (const float*)args.in[0]; const float* cin = (const float*)args.in[1]; const float* ada_w = (const float*)args.in[2]; const float* ada_b = (const float*)args.in[3];
    const float* norm1_g = (const float*)args.in[4]; const float* w_in = (const float*)args.in[5]; const float* pool_w = (const float*)args.in[6]; const float* pool_scale = (const float*)args.in[7];
    const float* w_pool_out = (const float*)args.in[8]; const float* lam_re = (const float*)args.in[9]; const float* lam_im = (const float*)args.in[10]; const float* log_dt = (const float*)args.in[11];
    const float* sb_re = (const float*)args.in[12]; const float* sb_im = (const float*)args.in[13]; const float* sc_re = (const float*)args.in[14]; const float* sc_im = (const float*)args.in[15];
    const float* ssm_d = (const float*)args.in[16]; const float* w_glu = (const float*)args.in[17]; const float* b_glu = (const float*)args.in[18]; const float* w_out = (const float*)args.in[19];
    const float* norm2_g = (const float*)args.in[20]; const float* w_router = (const float*)args.in[21]; const float* b_router = (const float*)args.in[22]; const float* w1 = (const float*)args.in[23];
    const float* b1 = (const float*)args.in[24]; const float* w2 = (const float*)args.in[25]; const float* b2 = (const float*)args.in[26]; const float* fada_w = (const float*)args.in[27];
    const float* fada_b = (const float*)args.in[28]; const float* fnorm_g = (const float*)args.in[29];
    float* out = args.out;
    float* MOD = (float*)(ws + WS_MOD); float* FMOD = (float*)(ws + WS_FMOD); float* AL = (float*)(ws + WS_AL);
    bf16* WinT = (bf16*)(ws + WS_WIN); bf16* PoolWT = (bf16*)(ws + WS_POOLW); bf16* WpoT = (bf16*)(ws + WS_WPO); bf16* WgluT = (bf16*)(ws + WS_WGLU); bf16* WoutT = (bf16*)(ws + WS_WOUT);
    bf16* WendT = (bf16*)(ws + WS_WEND); bf16* TG = (bf16*)(ws + WS_TG); bf16* W1T = (bf16*)(ws + WS_W1); bf16* W2T = (bf16*)(ws + WS_W2);
    bf16* XN = (bf16*)(ws + WS_XN); bf16* UP = (bf16*)(ws + WS_UP); bf16* UG = (bf16*)(ws + WS_UG); bf16* SGP = (bf16*)(ws + WS_SGP); bf16* SGS = (bf16*)(ws + WS_SGS);
    bf16* PL = (bf16*)(ws + WS_PL); bf16* PM = (bf16*)(ws + WS_PM); float* EB = (float*)(ws + WS_E); bf16* YPG = (bf16*)(ws + WS_YPG); bf16* YS = (bf16*)(ws + WS_YS);
    bf16* MG = (bf16*)(ws + WS_MG); float* X1 = (float*)(ws + WS_X1); int* LTOK = (int*)(ws + WS_LTOK); float* LWT = (float*)(ws + WS_LWT); int* TSLOT = (int*)(ws + WS_TSLOT);
    bf16* ACT = (bf16*)(ws + WS_ACT); bf16* YE = (bf16*)(ws + WS_YE);

    for (int u = tid; u < (LDS_BYTES - LDSCTL_OFF) / 4; u += NWAVES * 64) ((LAS unsigned*)(lds + LDSCTL_OFF))[u] = 0u;
    __syncthreads();
    XcdBarrier bar; bar.bar = (unsigned*)(ctl + CW_BAR); bar.x = 0; bar.st = nullptr;
    if (N_LAUNCHES == 1) bar = xcd_barrier_post((unsigned*)(ctl + CW_BAR), MISC + 8);
#define GRID_BAR() do { if (N_LAUNCHES == 1) xcd_barrier(bar); } while (0)
    const int lo = args.ph_lo, hi = args.ph_hi;
#ifndef PHSEL
#define PHSEL -1
#endif
#define IN(k) (PHSEL < 0 ? (lo <= (k) && (k) < hi) : ((k) == PHSEL))
#define BOTH(k) (IN(k) && IN((k) + 1))
    const int gw = vcu * NWAVES + wave, NGW = G * NWAVES;

    if (IN(0)) {
        LAS float* CA = (LAS float*)(lds + RING_OFF);
        LAS float* RED = (LAS float*)(lds + RING_OFF + 32768);
        for (int i = tid; i < BATCH * D; i += NWAVES * 64) { const float c = cin[i]; CA[i] = c * sigmoidf_(c); }
        __syncthreads();
        for (int cb = vcu; cb < (6 * D + 2 * D) / 64; cb += G) {
            const int col0 = cb * 64; const float* W; int N, cc; const float* bias; float* dst; int dld;
            if (col0 < 6 * D) { W = ada_w; N = 6 * D; cc = col0; bias = ada_b; dst = MOD; dld = 6 * D; } else { W = fada_w; N = 2 * D; cc = col0 - 6 * D; bias = fada_b; dst = FMOD; dld = 2 * D; }
            const int c4 = lane & 15, kr = lane >> 4;
            f32x4 a0 = {0.f, 0.f, 0.f, 0.f}, a1 = a0, a2 = a0, a3 = a0;
            const float* wp = W + (size_t)(256 * wave + kr) * N + cc + 4 * c4;
#pragma unroll 16
            for (int kk = 0; kk < 64; ++kk) { const f32x4 v = *(const f32x4*)(wp + (size_t)kk * 4 * N); const int k = 256 * wave + kk * 4 + kr;
                a0 += v * CA[k]; a1 += v * CA[D + k]; a2 += v * CA[2 * D + k]; a3 += v * CA[3 * D + k]; }
#pragma unroll
            for (int j = 0; j < 4; ++j) { a0[j] += __shfl_xor(a0[j], 16); a0[j] += __shfl_xor(a0[j], 32); a1[j] += __shfl_xor(a1[j], 16); a1[j] += __shfl_xor(a1[j], 32);
                a2[j] += __shfl_xor(a2[j], 16); a2[j] += __shfl_xor(a2[j], 32); a3[j] += __shfl_xor(a3[j], 16); a3[j] += __shfl_xor(a3[j], 32); }
            if (kr == 0) {
#pragma unroll
                for (int j = 0; j < 4; ++j) { RED[(wave * 4 + 0) * 64 + 4 * c4 + j] = a0[j]; RED[(wave * 4 + 1) * 64 + 4 * c4 + j] = a1[j]; RED[(wave * 4 + 2) * 64 + 4 * c4 + j] = a2[j]; RED[(wave * 4 + 3) * 64 + 4 * c4 + j] = a3[j]; } }
            __syncthreads();
            if (tid < 256) { const int b = tid >> 6, c = tid & 63; float s = bias[cc + c];
#pragma unroll
                for (int w = 0; w < 8; ++w) s += RED[(w * 4 + b) * 64 + c];
                dst[(size_t)b * dld + cc + c] = s; }
            __syncthreads();
        }
        if (BOTH(0)) GRID_BAR();
    }

    if (IN(1)) {
        {
            LAS float* AP = (LAS float*)(lds + RING_OFF);
            LAS float* BBm = (LAS float*)(lds + RING_OFF + 16384);
            LAS float* CCm = (LAS float*)(lds + RING_OFF + 32768);
            LAS float* MT = (LAS float*)(lds + RING_OFF + 49152);
            for (int it = vcu; it < SG * 4; it += G) {
                const int g = it >> 2, part = it & 3;
                if (tid < 64) { const int p = tid; const float dt = expf(log_dt[g]); const float lre = fminf(lam_re[g * SP + p], -1e-4f), lim = lam_im[g * SP + p];
                    for (int k = 0; k <= 16; ++k) { const float mag = expf(lre * dt * (float)k), ang = lim * dt * (float)k; AP[(k * 64 + p) * 2] = mag * cosf(ang); AP[(k * 64 + p) * 2 + 1] = mag * sinf(ang); }
                    const float mag = expf(lre * dt), ang = lim * dt; const float abr = mag * cosf(ang), abi = mag * sinf(ang);
                    const float den = lre * lre + lim * lim, nr = abr - 1.0f, ni = abi; const float fr_ = (nr * lre + ni * lim) / den, fi_ = (ni * lre - nr * lim) / den;
                    for (int h = 0; h < SH; ++h) { const float br = sb_re[((size_t)g * SP + p) * SH + h], bi = sb_im[((size_t)g * SP + p) * SH + h]; BBm[(p * 16 + h) * 2] = fr_ * br - fi_ * bi; BBm[(p * 16 + h) * 2 + 1] = fr_ * bi + fi_ * br; }
                    for (int h = 0; h < SH; ++h) { CCm[(h * 64 + p) * 2] = sc_re[((size_t)g * SH + h) * SP + p]; CCm[(h * 64 + p) * 2 + 1] = sc_im[((size_t)g * SH + h) * SP + p]; }
                    if (part == 0) { AL[(g * SP + p) * 2] = AP[(16 * 64 + p) * 2]; AL[(g * SP + p) * 2 + 1] = AP[(16 * 64 + p) * 2 + 1]; }
                }
                __syncthreads();
                for (int idx = tid; idx < 4096; idx += NWAVES * 64) { const int k = idx >> 8, hp = (idx >> 4) & 15, h = idx & 15; float s = 0.f;
                    for (int p = 0; p < SP; ++p) { const float ar = AP[(k * 64 + p) * 2], ai = AP[(k * 64 + p) * 2 + 1], cr = CCm[(hp * 64 + p) * 2], ci = CCm[(hp * 64 + p) * 2 + 1];
                        const float car = cr * ar - ci * ai, cai = cr * ai + ci * ar; s += car * BBm[(p * 16 + h) * 2] - cai * BBm[(p * 16 + h) * 2 + 1]; }
                    if (k == 0 && h == hp) s += ssm_d[g * SH + hp];
                    MT[idx] = s; }
                __syncthreads();
                for (int vi = tid; vi < 64 * (UGK / 8); vi += NWAVES * 64) { const int nl = vi / (UGK / 8), kv = vi - nl * (UGK / 8), n = part * 64 + nl, t = n >> 4, hp = n & 15, k0 = kv * 8; float val[8];
#pragma unroll
                    for (int j = 0; j < 8; ++j) { const int k = k0 + j;
                        if (k < 256) { const int s = k >> 4, h = k & 15; val[j] = (s <= t) ? MT[((t - s) << 8) + (hp << 4) + h] : 0.f; }
                        else { const int comp = k - 256, p = comp & 63; const float ar = AP[((t + 1) * 64 + p) * 2], ai = AP[((t + 1) * 64 + p) * 2 + 1], cr = CCm[(hp * 64 + p) * 2], ci = CCm[(hp * 64 + p) * 2 + 1];
                            val[j] = comp < 64 ? (cr * ar - ci * ai) : -(cr * ai + ci * ar); } }
                    v4u o; o.x = cvt_pk_bf16(val[0], val[1]); o.y = cvt_pk_bf16(val[2], val[3]); o.z = cvt_pk_bf16(val[4], val[5]); o.w = cvt_pk_bf16(val[6], val[7]);
                    *(v4u*)(TG + ((size_t)g * 256 + n) * UGK + k0) = o; }
                for (int vi = tid; vi < 64 * 32; vi += NWAVES * 64) { const int nl = vi >> 5, kv = vi & 31, n = part * 64 + nl, k0 = kv * 8; float val[8];
#pragma unroll
                    for (int j = 0; j < 8; ++j) { const int k = k0 + j, s = k >> 4, h = k & 15;
                        if (n < 128) { const int p = n & 63; const float ar = AP[((15 - s) * 64 + p) * 2], ai = AP[((15 - s) * 64 + p) * 2 + 1], br = BBm[(p * 16 + h) * 2], bi = BBm[(p * 16 + h) * 2 + 1];
                            val[j] = n < 64 ? (ar * br - ai * bi) : (ar * bi + ai * br); } else val[j] = 0.f; }
                    v4u o; o.x = cvt_pk_bf16(val[0], val[1]); o.y = cvt_pk_bf16(val[2], val[3]); o.z = cvt_pk_bf16(val[4], val[5]); o.w = cvt_pk_bf16(val[6], val[7]);
                    *(v4u*)(WendT + ((size_t)g * 256 + n) * 256 + k0) = o; }
                __syncthreads();
            }
        }
        for (int row = gw; row < T; row += NGW) {
            const int b = row >> 12; const float* xr = x + (size_t)row * D + 4 * lane; const float* mb = MOD + (size_t)b * 6 * D;
            f32x4 v[8]; float ss = 0.f;
#pragma unroll
            for (int j = 0; j < 8; ++j) { v[j] = *(const f32x4*)(xr + 256 * j); ss += v[j][0] * v[j][0] + v[j][1] * v[j][1] + v[j][2] * v[j][2] + v[j][3] * v[j][3]; }
            const float rstd = 1.0f / sqrtf(wave_sum(ss) * (1.0f / D) + RMS_EPS);
#pragma unroll
            for (int j = 0; j < 8; ++j) { const int k = 4 * lane + 256 * j; const f32x4 g = *(const f32x4*)(norm1_g + k), sh = *(const f32x4*)(mb + k), sc = *(const f32x4*)(mb + D + k);
                const f32x4 h = v[j] * rstd * g * (sc + 1.0f) + sh; v2u o; o.x = cvt_pk_bf16(h[0], h[1]); o.y = cvt_pk_bf16(h[2], h[3]); *(v2u*)(XN + (size_t)row * D + k) = o; }
        }
        {
            constexpr int I_IN = (D / 64) * (INW / 64), I_PW = 4 * 16, I_PO = (PW / 64) * (D / 64), I_GL = (SW / 64) * (2 * D / 64), I_OUT = (D / 64) * (D / 64);
            constexpr int I_W1E = (D / 64) * (2 * FE / 64), I_W2E = (FE / 64) * (D / 64), I_W1 = NE * I_W1E, I_W2 = NE * I_W2E;
            constexpr int NITEMS = I_IN + I_PW + I_PO + I_GL + I_OUT + I_W1 + I_W2;
            for (int it = gw; it < NITEMS; it += NGW) {
                int r = it;
                if (r < I_IN) { tr_item(w_in, D, INW, WinT, r, lane, 0); continue; } r -= I_IN;
                if (r < I_PW) { const int q = r >> 4; tr_item(pool_w + (size_t)q * 65536, 256, 256, PoolWT + (size_t)q * 65536, r & 15, lane, 0); continue; } r -= I_PW;
                if (r < I_PO) { tr_item(w_pool_out, PW, D, WpoT, r, lane, 0); continue; } r -= I_PO;
                if (r < I_GL) { tr_item(w_glu, SW, 2 * D, WgluT, r, lane, 1); continue; } r -= I_GL;
                if (r < I_OUT) { tr_item(w_out, D, D, WoutT, r, lane, 0); continue; } r -= I_OUT;
                if (r < I_W1) { const int e = r / I_W1E; tr_item(w1 + (size_t)e * D * 2 * FE, D, 2 * FE, W1T + (size_t)e * D * 2 * FE, r - e * I_W1E, lane, 1); continue; } r -= I_W1;
                { const int e = r / I_W2E; tr_item(w2 + (size_t)e * FE * D, FE, D, W2T + (size_t)e * FE * D, r - e * I_W2E, lane, 0); }
            }
        }
        if (BOTH(1)) GRID_BAR();
    }

    if (IN(2)) {
        SchedDense S; S.init(XN, WinT, T, INW, D, D, G, bx);
        EpiZ E{UP, UG, SGP, SGS};
        pg8::gemm_phase<EpiZ, SchedDense, false>(lds + RING_OFF, D, D, D, S, E);
        if (BOTH(2)) GRID_BAR();
    }

    if (IN(3)) {
        for (int it = gw; it < BATCH * 128 * 4; it += NGW) {
            const int gq = it & 3, tb = (it >> 2) & 127, b = it >> 9, w = 2 << gq, oct = lane & 31, th = lane >> 5, t0 = tb * 32 + th * 16;
            const bf16* up = UP + (size_t)b * SEQ * PW + gq * 256 + oct * 8; bf16* pl = PL + (size_t)b * SEQ * PW + gq * 256 + oct * 8;
            float Sx[8];
#pragma unroll
            for (int j = 0; j < 8; ++j) Sx[j] = 0.f;
            for (int jj = w - 1; jj >= 1; --jj) { const int tp = t0 - jj; if (tp >= 0) { const v4u q = *(const v4u*)(up + (size_t)tp * PW);
                Sx[0] += bf_lo(q.x); Sx[1] += bf_hi(q.x); Sx[2] += bf_lo(q.y); Sx[3] += bf_hi(q.y); Sx[4] += bf_lo(q.z); Sx[5] += bf_hi(q.z); Sx[6] += bf_lo(q.w); Sx[7] += bf_hi(q.w); } }
            for (int tt = 0; tt < 16; ++tt) { const int tp = t0 + tt; const v4u q = *(const v4u*)(up + (size_t)tp * PW);
                float uu[8] = {bf_lo(q.x), bf_hi(q.x), bf_lo(q.y), bf_hi(q.y), bf_lo(q.z), bf_hi(q.z), bf_lo(q.w), bf_hi(q.w)};
                const float cnt = (float)((tp + 1) < w ? (tp + 1) : w); float o[8];
#pragma unroll
                for (int j = 0; j < 8; ++j) { Sx[j] += uu[j]; o[j] = Sx[j] / cnt - uu[j]; }
                v4u ov; ov.x = cvt_pk_bf16(o[0], o[1]); ov.y = cvt_pk_bf16(o[2], o[3]); ov.z = cvt_pk_bf16(o[4], o[5]); ov.w = cvt_pk_bf16(o[6], o[7]);
                *(v4u*)(pl + (size_t)tp * PW) = ov;
                const int tq = tp - w + 1; if (tq >= 0) { const v4u q2 = *(const v4u*)(up + (size_t)tq * PW);
                    Sx[0] -= bf_lo(q2.x); Sx[1] -= bf_hi(q2.x); Sx[2] -= bf_lo(q2.y); Sx[3] -= bf_hi(q2.y); Sx[4] -= bf_lo(q2.z); Sx[5] -= bf_hi(q2.z); Sx[6] -= bf_lo(q2.w); Sx[7] -= bf_hi(q2.w); } }
        }
        __syncthreads();
        SchedGrouped S; S.init(UG, WendT, UGK, (size_t)1024 * UGK * 2, (size_t)256 * 256 * 2, 4, SG, G, vcu);
        EpiS1 E{EB};
        pg8::gemm_phase<EpiS1, SchedGrouped, false>(lds + RING_OFF, UGK, 256, 256, S, E);
        if (BOTH(3)) GRID_BAR();
    }

    if (IN(4)) {
        if (wave == 0) {
            for (int it = vcu; it < BATCH * SG; it += G) {
                const int b = it >> 6, g = it & 63, p = lane; const float ar = AL[(g * SP + p) * 2], ai = AL[(g * SP + p) * 2 + 1];
                float xr = 0.f, xi = 0.f; const size_t rb = (size_t)g * 1024 + b * 256;
#pragma unroll 8
                for (int c = 0; c < NCH; ++c) { const float er = EB[(rb + c) * 128 + p], ei = EB[(rb + c) * 128 + 64 + p];
                    UG[(rb + c) * UGK + 256 + p] = (bf16)(cvt_pk_bf16(xr, 0.f) & 0xffffu); UG[(rb + c) * UGK + 320 + p] = (bf16)(cvt_pk_bf16(xi, 0.f) & 0xffffu);
                    const float nr = ar * xr - ai * xi + er, ni = ar * xi + ai * xr + ei; xr = nr; xi = ni; }
            }
        }
        SchedGrouped S; S.init(PL, PoolWT, PW, (size_t)256 * 2, (size_t)256 * 256 * 2, T / 256, 4, G, vcu);
        EpiPmix E{PM, pool_scale};
        pg8::gemm_phase<EpiPmix, SchedGrouped, false>(lds + RING_OFF, PW, 256, 256, S, E);
        if (BOTH(4)) GRID_BAR();
    }

    if (IN(5)) {
        { SchedGrouped S; S.init(UG, TG, UGK, (size_t)1024 * UGK * 2, (size_t)256 * UGK * 2, 4, SG, G, vcu);
          EpiS3 E{YS};
          pg8::gemm_phase<EpiS3, SchedGrouped, false>(lds + RING_OFF, UGK, UGK, UGK, S, E); }
        { SchedDense S; S.init(PM, WpoT, T, D, PW, PW, G, bx);
          EpiYpool E{YPG, SGP};
          pg8::gemm_phase<EpiYpool, SchedDense, false>(lds + RING_OFF, PW, PW, PW, S, E); }
        if (BOTH(5)) GRID_BAR();
    }

    if (IN(6)) {
        SchedDense S; S.init(YS, WgluT, T, 2 * D, SW, SW, G, bx);
        EpiGlu E{MG, YPG, SGS, b_glu};
        pg8::gemm_phase<EpiGlu, SchedDense, false>(lds + RING_OFF, SW, SW, SW, S, E);
        if (BOTH(6)) GRID_BAR();
    }

    if (IN(7)) {
        SchedDense S; S.init(MG, WoutT, T, D, D, D, G, bx);
        EpiOut E{X1, x, MOD};
        pg8::gemm_phase<EpiOut, SchedDense, false>(lds + RING_OFF, D, D, D, S, E);
        if (BOTH(7)) GRID_BAR();
    }

    if (IN(8)) {
        LAS float* HT = (LAS float*)(lds + RING_OFF);
        LAS float* RED = (LAS float*)(lds + RING_OFF + 65792);
        LAS float* LG = (LAS float*)(lds + RING_OFF + 98560);
        LAS int* HIST = (LAS int*)(lds + RING_OFF + 102784);
        LAS int* BASE = (LAS int*)(lds + RING_OFF + 102912);
        for (int tile = vcu; tile < T / 32; tile += G) {
            const int R0 = tile * 32, b = R0 >> 12; const float* mb = MOD + (size_t)b * 6 * D;
            f32x4 v[4][8];
#pragma unroll
            for (int rr = 0; rr < 4; ++rr) { const int row = R0 + 4 * wave + rr; const float* xr = X1 + (size_t)row * D + 4 * lane; float ss = 0.f;
#pragma unroll
                for (int j = 0; j < 8; ++j) { v[rr][j] = *(const f32x4*)(xr + 256 * j); ss += v[rr][j][0] * v[rr][j][0] + v[rr][j][1] * v[rr][j][1] + v[rr][j][2] * v[rr][j][2] + v[rr][j][3] * v[rr][j][3]; }
                const float rstd = 1.0f / sqrtf(wave_sum(ss) * (1.0f / D) + RMS_EPS);
#pragma unroll
                for (int j = 0; j < 8; ++j) { const int k = 4 * lane + 256 * j; const f32x4 g = *(const f32x4*)(norm2_g + k), sh = *(const f32x4*)(mb + 3 * D + k), sc = *(const f32x4*)(mb + 4 * D + k);
                    v[rr][j] = v[rr][j] * rstd * g * (sc + 1.0f) + sh; v2u o; o.x = cvt_pk_bf16(v[rr][j][0], v[rr][j][1]); o.y = cvt_pk_bf16(v[rr][j][2], v[rr][j][3]); *(v2u*)(XN + (size_t)row * D + k) = o; } }
            if (tid < 32) HIST[tid] = 0;
            f32x16 lacc;
#pragma unroll
            for (int j = 0; j < 16; ++j) lacc[j] = 0.f;
#pragma unroll
            for (int q = 0; q < 4; ++q) {
                __syncthreads();
#pragma unroll
                for (int rr = 0; rr < 4; ++rr)
#pragma unroll
                    for (int jj = 0; jj < 2; ++jj) { const int lk = 4 * lane + 256 * jj; LAS float* hp = HT + (4 * wave + rr) * 513 + lk; const f32x4 q4 = v[rr][2 * q + jj]; hp[0] = q4[0]; hp[1] = q4[1]; hp[2] = q4[2]; hp[3] = q4[3]; }
                __syncthreads();
                const float* wrp = w_router + (size_t)(q * 512 + 64 * wave + (lane >> 5)) * NE + (lane & 31); const LAS float* ap = HT + (lane & 31) * 513 + 64 * wave + (lane >> 5);
#pragma unroll 8
                for (int s = 0; s < 32; ++s) lacc = __builtin_amdgcn_mfma_f32_32x32x2f32(ap[2 * s], wrp[(size_t)2 * s * NE], lacc, 0, 0, 0);
            }
#pragma unroll
            for (int rg = 0; rg < 16; ++rg) { const int i = (rg & 3) + 8 * (rg >> 2) + 4 * (lane >> 5); RED[(wave * 32 + i) * 32 + (lane & 31)] = lacc[rg]; }
            __syncthreads();
#pragma unroll
            for (int pp = 0; pp < 2; ++pp) { const int p = tid + pp * 512, i = p >> 5, j = p & 31; float s = b_router[j];
#pragma unroll
                for (int w = 0; w < 8; ++w) s += RED[(w * 32 + i) * 32 + j];
                LG[i * 33 + j] = s; }
            __syncthreads();
            int idx[4] = {0, 0, 0, 0}; float wv[4] = {0.f, 0.f, 0.f, 0.f}; int lrk[4] = {0, 0, 0, 0};
            if (tid < 32) {
                unsigned chosen = 0u; float val[4];
#pragma unroll
                for (int k = 0; k < 4; ++k) { float best = -3.0e38f; int bi = 0;
                    for (int j = 0; j < NE; ++j) { const float xv = LG[tid * 33 + j]; if (!((chosen >> j) & 1u) && xv > best) { best = xv; bi = j; } }
                    val[k] = best; idx[k] = bi; chosen |= 1u << bi; }
                float den = 0.f;
#pragma unroll
                for (int k = 0; k < 4; ++k) { wv[k] = expf(val[k] - val[0]); den += wv[k]; }
#pragma unroll
                for (int k = 0; k < 4; ++k) { wv[k] /= den; lrk[k] = atomicAdd((int*)&HIST[idx[k]], 1); }
            }
            __syncthreads();
            if (tid < 32) { const int c = HIST[tid]; BASE[tid] = c ? (int)__hip_atomic_fetch_add((unsigned*)(ctl + CW_CNT + tid), (unsigned)c, RLX_AGENT) : 0; }
            __syncthreads();
            if (tid < 32) { const int tok = R0 + tid;
#pragma unroll
                for (int k = 0; k < 4; ++k) { const int e = idx[k], rank = BASE[e] + lrk[k]; LTOK[(size_t)e * LCAP + rank] = tok; LWT[(size_t)e * LCAP + rank] = wv[k]; TSLOT[tok * 4 + k] = e * LCAP + rank; } }
            __syncthreads();
        }
        if (BOTH(8)) GRID_BAR();
    }

#define MOE_TABLES(nN_) do { __syncthreads(); if (tid == 0) { unsigned us = 0u, pb = 0u; for (int e = 0; e < NE; ++e) { const unsigned c = __hip_atomic_load(ctl + CW_CNT + e, RLX_AGENT); const unsigned nb = (c + 255u) >> 8; \
        MISC[32 + e] = us; MISC[80 + e] = pb; MISC[128 + e] = c; us += nb * (unsigned)(nN_); pb += nb; } MISC[32 + NE] = us; MISC[80 + NE] = pb; MISC[176] = us; } __syncthreads(); } while (0)

    if (IN(9)) {
        MOE_TABLES(2 * FE / 256);
        SchedMoe S; S.A = (const char*)XN; S.Bt = (const char*)W1T; S.astep = 0; S.bstep_e = (size_t)2 * FE * D * 2; S.bstep_n = (size_t)256 * D * 2; S.nN = 2 * FE / 256; S.G = G; S.c = vcu; S.M = MISC; S.ltok = LTOK; S.gather = true;
        EpiMoe1 E{ACT, b1};
        pg8::gemm_phase<EpiMoe1, SchedMoe, true>(lds + RING_OFF, D, D, D, S, E);
        if (BOTH(9)) GRID_BAR();
    }

    if (IN(10)) {
        MOE_TABLES(D / 256);
        SchedMoe S; S.A = (const char*)ACT; S.Bt = (const char*)W2T; S.astep = (size_t)256 * FE * 2; S.bstep_e = (size_t)D * FE * 2; S.bstep_n = (size_t)256 * FE * 2; S.nN = D / 256; S.G = G; S.c = vcu; S.M = MISC; S.ltok = LTOK; S.gather = false;
        EpiMoe2 E{YE, b2, LWT};
        pg8::gemm_phase<EpiMoe2, SchedMoe, false>(lds + RING_OFF, FE, FE, FE, S, E);
        if (BOTH(10)) GRID_BAR();
    }

    if (IN(11)) {
        MOE_TABLES(1);
        for (int row = gw; row < T; row += NGW) {
            const int b = row >> 12; const float* mb = MOD + (size_t)b * 6 * D; const float* fb = FMOD + (size_t)b * 2 * D;
            size_t prow[4];
#pragma unroll
            for (int k = 0; k < 4; ++k) { const int s = TSLOT[row * 4 + k]; const int e = s >> 14, rank = s & (LCAP - 1); prow[k] = ((size_t)MISC[80 + e] * 256 + rank) * D; }
            f32x4 v[8]; float ss = 0.f;
#pragma unroll
            for (int j = 0; j < 8; ++j) { const int k = 4 * lane + 256 * j; f32x4 f = {0.f, 0.f, 0.f, 0.f};
#pragma unroll
                for (int kk = 0; kk < 4; ++kk) { const v2u y = *(const v2u*)(YE + prow[kk] + k); f[0] += bf_lo(y.x); f[1] += bf_hi(y.x); f[2] += bf_lo(y.y); f[3] += bf_hi(y.y); }
                const f32x4 gt = *(const f32x4*)(mb + 5 * D + k); v[j] = *(const f32x4*)(X1 + (size_t)row * D + k) + gt * f;
                ss += v[j][0] * v[j][0] + v[j][1] * v[j][1] + v[j][2] * v[j][2] + v[j][3] * v[j][3]; }
            const float rstd = 1.0f / sqrtf(wave_sum(ss) * (1.0f / D) + RMS_EPS);
#pragma unroll
            for (int j = 0; j < 8; ++j) { const int k = 4 * lane + 256 * j; const f32x4 g = *(const f32x4*)(fnorm_g + k), sh = *(const f32x4*)(fb + k), sc = *(const f32x4*)(fb + D + k);
                *(f32x4*)(out + (size_t)row * D + k) = v[j] * rstd * g * (sc + 1.0f) + sh; }
        }
    }
#undef IN
#undef BOTH
}

extern "C" void kernel_launch(void* const* d_in, const int* in_sizes, int n_in, void* d_out, int out_size, void* d_ws, size_t ws_size, hipStream_t stream) {
    static int grid = 0;
    if (grid == 0) {
        if (n_in != 30 || out_size != T * D || ws_size < WS_END) { fprintf(stderr, "kernel_launch: unexpected shapes (n_in %d, out %d, ws %zu); nothing launched\n", n_in, out_size, ws_size); grid = -1; return; }
        int dev = 0, cus = 0, per_cu = 0;
        if (hipGetDevice(&dev) != hipSuccess || hipDeviceGetAttribute(&cus, hipDeviceAttributeMultiprocessorCount, dev) != hipSuccess) { grid = -1; return; }
        if (hipFuncSetAttribute((const void*)fwd_kernel, hipFuncAttributeMaxDynamicSharedMemorySize, LDS_BYTES) != hipSuccess) { fprintf(stderr, "kernel_launch: hipFuncSetAttribute failed\n"); grid = -1; return; }
        if (hipOccupancyMaxActiveBlocksPerMultiprocessor(&per_cu, (const void*)fwd_kernel, NWAVES * 64, LDS_BYTES) != hipSuccess || per_cu < 1)
            fprintf(stderr, "kernel_launch: note: occupancy query reports %d workgroups per CU\n", per_cu);
        (void)hipGetLastError();
        grid = cus;
    }
    if (grid < 0) return;
    if (hipMemsetAsync((char*)d_ws + WS_CTL, 0, CTL_ZERO_BYTES, stream) != hipSuccess) { fprintf(stderr, "kernel_launch: hipMemsetAsync failed\n"); return; }
    Args a{};
    for (int i = 0; i < 30; ++i) a.in[i] = d_in[i];
    a.out = (float*)d_out; a.ws = (unsigned char*)d_ws;
    for (int li = 0; li < N_LAUNCHES; ++li) {
        if (N_LAUNCHES == 1) { a.ph_lo = 0; a.ph_hi = NPH; } else { a.ph_lo = li; a.ph_hi = li + 1; }
        a.li = li; a.pad = 0;
        hipLaunchKernelGGL(fwd_kernel, dim3(grid), dim3(NWAVES * 64), LDS_BYTES, stream, a);
        const hipError_t le = hipPeekAtLastError();
        if (le != hipSuccess) { fprintf(stderr, "kernel_launch: launch %d failed: %s\n", li, hipGetErrorName(le)); break; }
    }
}
```

```cpp
#include <hip/hip_runtime.h>
#include <cstdio>
#include <cstdint>

namespace pg8 {
#define PG8_LAS __attribute__((address_space(3)))
typedef unsigned short bf16_t;
typedef short bf16x8 __attribute__((ext_vector_type(8)));
typedef float f32x4 __attribute__((ext_vector_type(4)));
typedef float f32x2 __attribute__((ext_vector_type(2)));
typedef unsigned u32x4 __attribute__((ext_vector_type(4)));
constexpr int BM = 256, BK = 64, HALF = 128, HTB = HALF * BK * 2, STAGE_BYTES = 8 * HTB, NXCD = 8, WGM = 8;

__host__ __device__ __forceinline__ int lds_byte(int r, int c) { const int st = (r >> 4) * 2 + (c >> 5), rr = r & 15, cc = c & 31, ob = rr * 64 + cc * 2; return st * 1024 + (ob ^ (((ob >> 9) & 1) << 5)); }
__host__ __device__ __forceinline__ void stage_rc(int b, int& R, int& C) { const int st = b / 1024, sb = b % 1024, swz = sb ^ (((sb >> 9) & 1) << 5); R = (st >> 1) * 16 + swz / 64; C = (st & 1) * 32 + (swz % 64) / 2; }
__host__ __device__ __forceinline__ int perm32(int rho) { const int n = rho >> 4, i = rho & 15; return 8 * (i >> 2) + 4 * n + (i & 3); }

struct Unit { int pm, pn, e, rb, nvalid; };

__device__ __forceinline__ unsigned cvt_pk_bf16(float lo, float hi) { unsigned r; asm volatile("v_cvt_pk_bf16_f32 %0, %1, %2" : "=v"(r) : "v"(lo), "v"(hi)); return r; }
__device__ __forceinline__ float bf_lo(unsigned w) { return __uint_as_float(w << 16); }
__device__ __forceinline__ float bf_hi(unsigned w) { return __uint_as_float(w & 0xffff0000u); }
__device__ __forceinline__ float sigmoidf_(float x) { return __builtin_amdgcn_rcpf(1.0f + __builtin_amdgcn_exp2f(-1.44269504089f * x)); }
__device__ __forceinline__ float gelu_tanh_(float x) { const float u = 0.7978845608f * (x + 0.044715f * x * x * x); return x * __builtin_amdgcn_rcpf(1.0f + __builtin_amdgcn_exp2f(-2.88539008178f * u)); }

template <class Epi, class Sched, bool GATHER>
__device__ __forceinline__ void gemm_phase(PG8_LAS unsigned char* lds, const int lda, const int ldb, const int K, const Sched& S, const Epi& E) {
    const int tid = threadIdx.x, wid = __builtin_amdgcn_readfirstlane(tid >> 6), lane = tid & 63, wr = wid >> 2, wc = wid & 3, fr = lane & 15, fq = lane >> 4;
    const int nt = K / BK;
    unsigned voffA[2], voffB[2], colA[2]; int rowA[2];
#pragma unroll
    for (int i = 0; i < 2; ++i) { int R, C; stage_rc(tid * 16 + i * 8192, R, C); const int Rb = Epi::PERM ? ((R & ~31) + perm32(R & 31)) : R;
        rowA[i] = R; colA[i] = (unsigned)C * 2u; voffA[i] = (unsigned)(R * lda + C) * 2u; voffB[i] = (unsigned)(Rb * ldb + C) * 2u; }
    const size_t kstep = (size_t)(BK * 2);
    const size_t hstepA = GATHER ? (size_t)0 : (size_t)HALF * lda * 2;
    const size_t hstepB = (size_t)HALF * ldb * 2;
    const unsigned ldsw = (unsigned)wid * 1024u;
    const int aoff = lds_byte(wr * 64 + fr, fq * 8), boff = lds_byte(wc * 32 + fr, fq * 8);
#define PG8_SA(b, h) (((b) * 2 + (h)) * HTB)
#define PG8_SB(b, h) ((4 + (b) * 2 + (h)) * HTB)
#define PG8_STAGE2(bufoff, gbase, o0, o1) do { \
        __builtin_amdgcn_global_load_lds((const unsigned*)((const char*)(gbase) + (o0)), (PG8_LAS unsigned*)(lds + (bufoff) + ldsw), 16, 0, 0); \
        __builtin_amdgcn_global_load_lds((const unsigned*)((const char*)(gbase) + (o1)), (PG8_LAS unsigned*)(lds + (bufoff) + ldsw + 8192), 16, 0, 0); } while (0)
#define PG8_STAGE_B(bufoff, gbase) PG8_STAGE2(bufoff, gbase, voffB[0], voffB[1])
#define PG8_LDA(dst, b, h) do { _Pragma("unroll") for (int m = 0; m < 4; ++m) _Pragma("unroll") for (int k = 0; k < 2; ++k) dst[m][k] = *(const PG8_LAS bf16x8*)(lds + PG8_SA(b, h) + aoff + m * 2048 + k * 1024); } while (0)
#define PG8_LDB(dst, b, h) do { _Pragma("unroll") for (int n = 0; n < 2; ++n) _Pragma("unroll") for (int k = 0; k < 2; ++k) dst[n][k] = *(const PG8_LAS bf16x8*)(lds + PG8_SB(b, h) + boff + n * 2048 + k * 1024); } while (0)
#define PG8_MMA(ai, bj, At, Bt) do { __builtin_amdgcn_s_setprio(1); _Pragma("unroll") for (int m = 0; m < 4; ++m) _Pragma("unroll") for (int n = 0; n < 2; ++n) _Pragma("unroll") for (int k = 0; k < 2; ++k) \
        acc[ai][bj][m][n] = __builtin_amdgcn_mfma_f32_16x16x32_bf16(Bt[n][k], At[m][k], acc[ai][bj][m][n], 0, 0, 0); __builtin_amdgcn_s_setprio(0); } while (0)
#define PG8_WAIT_V(n) asm volatile("s_waitcnt vmcnt(" #n ")" ::: "memory")
#define PG8_WAIT_L(n) asm volatile("s_waitcnt lgkmcnt(" #n ")" ::: "memory")
#define PG8_BAR __builtin_amdgcn_s_barrier()
#define PG8_SCHED __builtin_amdgcn_sched_barrier(0)
    Unit cur, nxt; int ui = 0;
    if (!S.next(0, cur)) return;
    f32x4 acc[2][2][4][2];
#pragma unroll
    for (int a = 0; a < 2; ++a)
#pragma unroll
        for (int b = 0; b < 2; ++b)
#pragma unroll
            for (int m = 0; m < 4; ++m)
#pragma unroll
                for (int n = 0; n < 2; ++n) acc[a][b][m][n] = (f32x4){0.f, 0.f, 0.f, 0.f};
    bf16x8 At[4][2], B0[2][2], B1[2][2];
    const char* cA = S.a_ptr(cur); const char* cB = S.b_ptr(cur);
    unsigned gcur[2][2], gnxt[2][2];
#pragma unroll
    for (int h = 0; h < 2; ++h)
#pragma unroll
        for (int i = 0; i < 2; ++i) { if constexpr (GATHER) gcur[h][i] = S.a_rowoff(cur, h * HALF + rowA[i]) + colA[i]; else gcur[h][i] = voffA[i]; gnxt[h][i] = gcur[h][i]; }
    PG8_STAGE_B(PG8_SB(0, 0), cB); PG8_STAGE_B(PG8_SB(0, 1), cB + hstepB); PG8_STAGE2(PG8_SA(0, 0), cA, gcur[0][0], gcur[0][1]); PG8_STAGE2(PG8_SA(0, 1), cA + hstepA, gcur[1][0], gcur[1][1]);
    if (wr == 1) PG8_BAR;
    PG8_WAIT_V(2); PG8_BAR;
    PG8_STAGE_B(PG8_SB(1, 0), cB + kstep); PG8_STAGE2(PG8_SA(1, 0), cA + kstep, gcur[0][0], gcur[0][1]); PG8_STAGE_B(PG8_SB(1, 1), cB + hstepB + kstep);
    PG8_WAIT_V(6); PG8_BAR;
    for (;;) {
        const bool has_next = S.next(ui + 1, nxt);
        const char* nA = has_next ? S.a_ptr(nxt) : cA; const char* nB = has_next ? S.b_ptr(nxt) : cB;
#pragma unroll 1
        for (int t = 0; t < nt; t += 2) {
            const bool last = (t == nt - 2);
            const char* a1 = cA + (size_t)(t + 1) * kstep;
            const char* a2 = last ? nA : cA + (size_t)(t + 2) * kstep; const char* b2 = last ? nB : cB + (size_t)(t + 2) * kstep;
            const char* a3 = a2 + kstep; const char* b3 = b2 + kstep;
            if constexpr (GATHER) {
                if (last && has_next) {
#pragma unroll
                    for (int h = 0; h < 2; ++h)
#pragma unroll
                        for (int i = 0; i < 2; ++i) gnxt[h][i] = S.a_rowoff(nxt, h * HALF + rowA[i]) + colA[i];
                    asm volatile("" : "+v"(gnxt[0][0]), "+v"(gnxt[0][1]), "+v"(gnxt[1][0]), "+v"(gnxt[1][1]));
                }
            }
            unsigned o2[2][2];
#pragma unroll
            for (int h = 0; h < 2; ++h)
#pragma unroll
                for (int i = 0; i < 2; ++i) { if constexpr (GATHER) o2[h][i] = last ? gnxt[h][i] : gcur[h][i]; else o2[h][i] = voffA[i]; }
            PG8_LDB(B0, 0, 0); PG8_LDB(B1, 0, 1); PG8_SCHED; PG8_LDA(At, 0, 0); PG8_STAGE2(PG8_SA(1, 1), a1 + hstepA, gcur[1][0], gcur[1][1]);
            PG8_WAIT_V(8); PG8_WAIT_L(0); PG8_BAR; PG8_MMA(0, 0, At, B0); PG8_MMA(0, 1, At, B1); PG8_BAR; PG8_SCHED;
            PG8_LDA(At, 0, 1); PG8_STAGE_B(PG8_SB(0, 0), b2); PG8_STAGE_B(PG8_SB(0, 1), b2 + hstepB); PG8_STAGE2(PG8_SA(0, 0), a2, o2[0][0], o2[0][1]);
            PG8_WAIT_V(8); PG8_WAIT_L(0); PG8_BAR; PG8_MMA(1, 0, At, B0); PG8_MMA(1, 1, At, B1); PG8_BAR; PG8_SCHED;
            PG8_LDB(B0, 1, 0); PG8_LDB(B1, 1, 1); PG8_SCHED; PG8_LDA(At, 1, 0); PG8_STAGE2(PG8_SA(0, 1), a2 + hstepA, o2[1][0], o2[1][1]);
            PG8_WAIT_V(8); PG8_WAIT_L(0); PG8_BAR; PG8_MMA(0, 0, At, B0); PG8_MMA(0, 1, At, B1); PG8_BAR; PG8_SCHED;
            PG8_LDA(At, 1, 1); PG8_STAGE_B(PG8_SB(1, 0), b3); PG8_STAGE_B(PG8_SB(1, 1), b3 + hstepB); PG8_STAGE2(PG8_SA(1, 0), a3, o2[0][0], o2[0][1]);
            PG8_WAIT_V(8); PG8_WAIT_L(0); PG8_BAR; PG8_MMA(1, 0, At, B0); PG8_MMA(1, 1, At, B1); PG8_BAR; PG8_SCHED;
        }
        if (wr == 0) PG8_BAR;
        E(acc, cur, wr, wc, fr, fq);
        if (!has_next) break;
#pragma unroll
        for (int a = 0; a < 2; ++a)
#pragma unroll
            for (int b = 0; b < 2; ++b)
#pragma unroll
                for (int m = 0; m < 4; ++m)
#pragma unroll
                    for (int n = 0; n < 2; ++n) acc[a][b][m][n] = (f32x4){0.f, 0.f, 0.f, 0.f};
        cur = nxt; cA = nA; cB = nB; ++ui;
#pragma unroll
        for (int h = 0; h < 2; ++h)
#pragma unroll
            for (int i = 0; i < 2; ++i) gcur[h][i] = gnxt[h][i];
        if (wr == 1) PG8_BAR;
    }
    PG8_WAIT_V(0);
    PG8_BAR;
#undef PG8_SA
#undef PG8_SB
#undef PG8_STAGE2
#undef PG8_STAGE_B
#undef PG8_LDA
#undef PG8_LDB
#undef PG8_MMA
#undef PG8_WAIT_V
#undef PG8_WAIT_L
#undef PG8_BAR
#undef PG8_SCHED
}
}

constexpr int NWAVES = 8;
#ifndef MK_N_LAUNCHES
#define MK_N_LAUNCHES 1
#endif
constexpr int NPH = 12;
constexpr int N_LAUNCHES = MK_N_LAUNCHES;

constexpr int BATCH = 4, SEQ = 4096, D = 2048, T = BATCH * SEQ;
constexpr int PW = 1024, SW = 1024, INW = PW + SW + 2 * D;
constexpr int NE = 32, TOPK = 4, FE = 2048;
constexpr int SG = 64, SP = 64, SH = 16, CL = 16, NCH = SEQ / CL;
constexpr int UGK = CL * SH + 2 * SP;
constexpr int LCAP = T;
constexpr int MAXBLK = 288;
constexpr float RMS_EPS = 1e-6f;

constexpr size_t MiB = 1u << 20;
constexpr size_t WS_CTL = 0, CTL_ZERO_BYTES = 1 * MiB;
constexpr size_t WS_MOD = 1 * MiB;
constexpr size_t WS_FMOD = WS_MOD + 196608, WS_AL = WS_MOD + 262144;
constexpr size_t WS_WIN = 2 * MiB, WS_POOLW = 26 * MiB, WS_WPO = 27 * MiB, WS_WGLU = 31 * MiB, WS_WOUT = 39 * MiB, WS_WEND = 47 * MiB, WS_TG = 55 * MiB;
constexpr size_t WS_W1 = 68 * MiB, WS_W2 = 580 * MiB;
constexpr size_t WS_XN = 836 * MiB, WS_UP = 900 * MiB, WS_UG = 932 * MiB, WS_SGP = 980 * MiB, WS_SGS = 1044 * MiB, WS_PL = 1108 * MiB, WS_PM = 1140 * MiB, WS_E = 1172 * MiB;
constexpr size_t WS_YPG = 1204 * MiB, WS_YS = 1268 * MiB, WS_MG = 1300 * MiB, WS_X1 = 1364 * MiB, WS_LTOK = 1492 * MiB, WS_LWT = 1494 * MiB, WS_TSLOT = 1496 * MiB;
constexpr size_t WS_ACT = 1498 * MiB, WS_YE = 1786 * MiB, WS_END = 2074 * MiB;
static_assert(WS_TG + (size_t)SG * 256 * UGK * 2 <= WS_W1 && WS_UG + (size_t)SG * 1024 * UGK * 2 <= WS_SGP && WS_ACT + (size_t)MAXBLK * 256 * FE * 2 <= WS_YE, "d_ws map");
constexpr int CW_TMO = 0, CW_CODE = 1, CW_CNT = 64, CW_BAR = 4096;

constexpr int RING_OFF = 0, RING_BYTES = 131072;
constexpr int LDSCTL_OFF = RING_BYTES, MISC_OFF = LDSCTL_OFF + 320;
constexpr int LDS_BYTES = 147456;

#define GAS __attribute__((address_space(1)))
#define LAS __attribute__((address_space(3)))
typedef unsigned short bf16;
typedef unsigned v4u __attribute__((ext_vector_type(4)));
typedef unsigned v2u __attribute__((ext_vector_type(2)));
typedef float f32x4 __attribute__((ext_vector_type(4)));
typedef float f32x16 __attribute__((ext_vector_type(16)));
typedef GAS unsigned gu32;
#define RLX_AGENT __ATOMIC_RELAXED, __HIP_MEMORY_SCOPE_AGENT
#define LDS_WAIT() asm volatile("s_waitcnt lgkmcnt(0)" ::: "memory")
#define VM_WAIT() asm volatile("s_waitcnt vmcnt(0)" ::: "memory")
using pg8::cvt_pk_bf16; using pg8::bf_lo; using pg8::bf_hi; using pg8::sigmoidf_; using pg8::gelu_tanh_;

#define XB_TMO      128
#define XB_XCNT(j)  (256  + 64 * (j))
#define XB_XSUB(j)  (1280 + 64 * (j))
#define XB_XGEN(j)  (2304 + 64 * (j))
#define XB_TOP      3328
#define XB_TOPGEN   3392
#define XCD_BAR_WORDS 3456
#define XB_SPIN_CAP (1u << 18)

__device__ __forceinline__ unsigned xb_ld(unsigned* p)              { return __hip_atomic_load(p, __ATOMIC_RELAXED, __HIP_MEMORY_SCOPE_AGENT); }
__device__ __forceinline__ unsigned xb_add(unsigned* p, unsigned v) { return __hip_atomic_fetch_add(p, v, __ATOMIC_RELAXED, __HIP_MEMORY_SCOPE_AGENT); }
__device__ __forceinline__ unsigned xb_xcc_id() { return (unsigned)__builtin_amdgcn_s_getreg((3 << 11) | 20) & 0xFu; }
#define XB_SPIN(cond, bar) do { unsigned _sp = 0; while (cond) { __builtin_amdgcn_s_sleep(1); \
    if ((++_sp & 255u) == 0u) { if (xb_ld(&(bar)[XB_TMO])) break; if (_sp > XB_SPIN_CAP) { atomicAdd(&(bar)[XB_TMO], 1u); break; } } } } while (0)

struct XcdBarrier { unsigned* bar; unsigned x; volatile LAS unsigned* st; };

__device__ __forceinline__ XcdBarrier xcd_barrier_post(unsigned* bar, volatile LAS unsigned* st) {
    XcdBarrier b; b.bar = bar; b.x = xb_xcc_id(); b.st = st;
    if (threadIdx.x == 0) (void)xb_add(&bar[XB_XCNT(b.x)], 1u);
    return b;
}
__device__ __forceinline__ void xcd_barrier_complete(unsigned* bar, unsigned x, unsigned& nloc, unsigned& nx) {
    const unsigned G = gridDim.x * gridDim.y * gridDim.z;
    unsigned sum, cnt, mine, sp = 0u;
    for (;;) {
        sum = 0u; cnt = 0u; mine = 0u;
#pragma unroll
        for (unsigned j = 0; j < 16; ++j) { const unsigned c = xb_ld(&bar[XB_XCNT(j)]); sum += c; cnt += (c > 0u) ? 1u : 0u; mine = (j == x) ? c : mine; }
        if (sum == G) break;
        __builtin_amdgcn_s_sleep(1);
        if ((++sp & 255u) == 0u) { if (xb_ld(&bar[XB_TMO])) break; if (sp > XB_SPIN_CAP) { atomicAdd(&bar[XB_TMO], 1u); break; } }
    }
    nloc = mine > 0u ? mine : 1u; nx = cnt > 0u ? cnt : 1u;
}
__device__ __forceinline__ void xcd_barrier(const XcdBarrier& b) {
    asm volatile("s_waitcnt vmcnt(0)" ::: "memory");
    __syncthreads();
    if (threadIdx.x == 0) {
        unsigned* bar = b.bar;
        __builtin_amdgcn_s_waitcnt(0);
        unsigned nloc = b.st[0], nx = b.st[1];
        if (nloc == 0u) { xcd_barrier_complete(bar, b.x, nloc, nx); b.st[0] = nloc; b.st[1] = nx; }
        const unsigned old = xb_add(&bar[XB_XSUB(b.x)], 1u);
        const unsigned gen = old / nloc;
        if (old + 1u == (gen + 1u) * nloc) {
            __builtin_amdgcn_fence(__ATOMIC_RELEASE, "agent");
            asm volatile("s_waitcnt vmcnt(0)" ::: "memory");
            const unsigned og = xb_add(&bar[XB_TOP], 1u);
            const unsigned tg = og / nx;
            if (og + 1u == (tg + 1u) * nx) xb_add(&bar[XB_TOPGEN], 1u);
            else XB_SPIN(xb_ld(&bar[XB_TOPGEN]) == tg, bar);
            __builtin_amdgcn_fence(__ATOMIC_ACQUIRE, "agent");
            xb_add(&bar[XB_XGEN(b.x)], 1u);
            asm volatile("s_waitcnt vmcnt(0)" ::: "memory");
        } else {
            XB_SPIN(xb_ld(&bar[XB_XGEN(b.x)]) == gen, bar);
            __builtin_amdgcn_fence(__ATOMIC_ACQUIRE, "agent");
            asm volatile("s_waitcnt vmcnt(0)" ::: "memory");
        }
    }
    __syncthreads();
}

using pg8::Unit;
struct SchedDense {
    const char* A; const char* Bt; size_t astep, bstep; int nM, nN, nwg, G, c;
    __device__ __forceinline__ void init(const void* A_, const void* Bt_, int M, int N, int lda, int ldb, int G_, int c_) { A = (const char*)A_; Bt = (const char*)Bt_; astep = (size_t)256 * lda * 2; bstep = (size_t)256 * ldb * 2; nM = M / 256; nN = N / 256; nwg = nM * nN; G = G_; c = c_; }
    __device__ __forceinline__ bool next(int i, Unit& u) const {
        const long L = (long)i * G + c; if (L >= nwg) return false;
        int wgid = (int)L; { const int q = nwg / pg8::NXCD, r = nwg % pg8::NXCD, xcd = wgid % pg8::NXCD, off = wgid / pg8::NXCD; wgid = (xcd < r ? xcd * (q + 1) : r * (q + 1) + (xcd - r) * q) + off; }
        const int nig = pg8::WGM * nN, gid = wgid / nig, fm = gid * pg8::WGM, gsz = (nM - fm) < pg8::WGM ? (nM - fm) : pg8::WGM;
        u.pm = fm + ((wgid % nig) % gsz); u.pn = (wgid % nig) / gsz; u.e = 0; u.rb = 0; u.nvalid = 256; return true;
    }
    __device__ __forceinline__ const char* a_ptr(const Unit& u) const { return A + (size_t)u.pm * astep; }
    __device__ __forceinline__ const char* b_ptr(const Unit& u) const { return Bt + (size_t)u.pn * bstep; }
    __device__ __forceinline__ unsigned a_rowoff(const Unit&, int) const { return 0u; }
};
struct SchedGrouped {
    const char* A; const char* Bt; size_t astep, agstride, bgstride; int nPM, nunits, G, c;
    __device__ __forceinline__ void init(const void* A_, const void* Bt_, int lda, size_t agstride_, size_t bgstride_, int nPM_, int ngroups, int G_, int c_) { A = (const char*)A_; Bt = (const char*)Bt_; astep = (size_t)256 * lda * 2; agstride = agstride_; bgstride = bgstride_; nPM = nPM_; nunits = nPM_ * ngroups; G = G_; c = c_; }
    __device__ __forceinline__ bool next(int i, Unit& u) const { const int L = i * G + c; if (L >= nunits) return false; u.e = L / nPM; u.pm = L % nPM; u.pn = 0; u.rb = 0; u.nvalid = 256; return true; }
    __device__ __forceinline__ const char* a_ptr(const Unit& u) const { return A + (size_t)u.e * agstride + (size_t)u.pm * astep; }
    __device__ __forceinline__ const char* b_ptr(const Unit& u) const { return Bt + (size_t)u.e * bgstride; }
    __device__ __forceinline__ unsigned a_rowoff(const Unit&, int) const { return 0u; }
};
struct SchedMoe {
    const char* A; const char* Bt; size_t astep, bstep_e, bstep_n; int nN, G, c; volatile LAS unsigned* M; const int* ltok; bool gather;
    __device__ __forceinline__ bool next(int i, Unit& u) const {
        const int L = i * G + c; const int total = (int)M[176]; if (L >= total) return false;
        int e = 0;
#pragma unroll 1
        for (int j = 1; j < NE; ++j) e += (L >= (int)M[32 + j]) ? 1 : 0;
        e = __builtin_amdgcn_readfirstlane(e);
        const int w = L - (int)M[32 + e], pb = (int)M[80 + e], nb = (int)M[80 + e + 1] - pb, cnt = (int)M[128 + e];
        int rb = w % nb, pn = w / nb;
        rb = __builtin_amdgcn_readfirstlane(rb); pn = __builtin_amdgcn_readfirstlane(pn);
        u.e = e; u.rb = rb; u.pn = pn; u.pm = __builtin_amdgcn_readfirstlane(pb + rb); const int nv = cnt - rb * 256; u.nvalid = __builtin_amdgcn_readfirstlane(nv < 256 ? nv : 256); return true;
    }
    __device__ __forceinline__ const char* a_ptr(const Unit& u) const { return gather ? A : A + (size_t)u.pm * astep; }
    __device__ __forceinline__ const char* b_ptr(const Unit& u) const { return Bt + (size_t)u.e * bstep_e + (size_t)u.pn * bstep_n; }
    __device__ __forceinline__ unsigned a_rowoff(const Unit& u, int r) const { const int idx = (r < u.nvalid) ? (u.rb * 256 + r) : 0; const int tok = ltok[(size_t)u.e * LCAP + idx]; return (unsigned)tok * (unsigned)(D * 2); }
};

using pg8::f32x2; using pg8::u32x4;
#define EPI_ARGS const f32x4 (&acc)[2][2][4][2], const Unit& u, int wr, int wc, int fr, int fq
struct EpiZ { static constexpr bool PERM = true; bf16 *UP, *UG, *SGP, *SGS;
    __device__ __forceinline__ void operator()(EPI_ARGS) const {
        const int pn = u.pn, region = pn < 4 ? 0 : (pn < 8 ? 1 : (pn < 16 ? 2 : 3));
#pragma unroll
        for (int ai = 0; ai < 2; ++ai)
#pragma unroll
            for (int m = 0; m < 4; ++m) { const int row = u.pm * 256 + ai * 128 + wr * 64 + m * 16 + fr;
#pragma unroll
                for (int bj = 0; bj < 2; ++bj) { const int lc = bj * 128 + wc * 32 + 8 * fq; f32x4 v0 = acc[ai][bj][m][0], v1 = acc[ai][bj][m][1];
                    if (region >= 2) {
#pragma unroll
                        for (int j = 0; j < 4; ++j) { v0[j] = sigmoidf_(v0[j]); v1[j] = sigmoidf_(v1[j]); } }
                    u32x4 w; w.x = cvt_pk_bf16(v0[0], v0[1]); w.y = cvt_pk_bf16(v0[2], v0[3]); w.z = cvt_pk_bf16(v1[0], v1[1]); w.w = cvt_pk_bf16(v1[2], v1[3]);
                    bf16* dst;
                    if (region == 0) dst = UP + (size_t)row * PW + pn * 256 + lc;
                    else if (region == 1) { const int j = (pn - 4) * 256 + lc, g = j >> 4, h0 = j & 15, b = row >> 12, tp = row & 4095, c = tp >> 4, s = tp & 15; dst = UG + ((size_t)(g * 1024 + b * 256 + c) * UGK + s * 16 + h0); }
                    else if (region == 2) dst = SGP + (size_t)row * D + (pn - 8) * 256 + lc;
                    else dst = SGS + (size_t)row * D + (pn - 16) * 256 + lc;
                    *(u32x4*)dst = w; } }
    }
};
struct EpiS1 { static constexpr bool PERM = false; float* E;
    __device__ __forceinline__ void operator()(EPI_ARGS) const {
#pragma unroll
        for (int ai = 0; ai < 2; ++ai)
#pragma unroll
            for (int m = 0; m < 4; ++m) { const int row = u.pm * 256 + ai * 128 + wr * 64 + m * 16 + fr; float* rp = E + ((size_t)u.e * 1024 + row) * 128 + wc * 32 + 4 * fq;
#pragma unroll
                for (int n = 0; n < 2; ++n) *(f32x4*)(rp + n * 16) = acc[ai][0][m][n]; }
    }
};
struct EpiPmix { static constexpr bool PERM = true; bf16* PM; const float* scale;
    __device__ __forceinline__ void operator()(EPI_ARGS) const {
#pragma unroll
        for (int bj = 0; bj < 2; ++bj) { const int col = u.e * 256 + bj * 128 + wc * 32 + 8 * fq; const f32x4 s0 = *(const f32x4*)(scale + col), s1 = *(const f32x4*)(scale + col + 4);
#pragma unroll
            for (int ai = 0; ai < 2; ++ai)
#pragma unroll
                for (int m = 0; m < 4; ++m) { const int row = u.pm * 256 + ai * 128 + wr * 64 + m * 16 + fr; const f32x4 v0 = acc[ai][bj][m][0] * s0, v1 = acc[ai][bj][m][1] * s1;
                    u32x4 w; w.x = cvt_pk_bf16(v0[0], v0[1]); w.y = cvt_pk_bf16(v0[2], v0[3]); w.z = cvt_pk_bf16(v1[0], v1[1]); w.w = cvt_pk_bf16(v1[2], v1[3]);
                    *(u32x4*)(PM + (size_t)row * PW + col) = w; } }
    }
};
struct EpiS3 { static constexpr bool PERM = true; bf16* YS;
    __device__ __forceinline__ void operator()(EPI_ARGS) const {
#pragma unroll
        for (int ai = 0; ai < 2; ++ai)
#pragma unroll
            for (int m = 0; m < 4; ++m) { const int r = u.pm * 256 + ai * 128 + wr * 64 + m * 16 + fr, b = r >> 8, c = r & 255;
#pragma unroll
                for (int bj = 0; bj < 2; ++bj) { const int lc = bj * 128 + wc * 32 + 8 * fq, t = lc >> 4, h0 = lc & 15; f32x4 v0 = acc[ai][bj][m][0], v1 = acc[ai][bj][m][1];
#pragma unroll
                    for (int j = 0; j < 4; ++j) { v0[j] = gelu_tanh_(v0[j]); v1[j] = gelu_tanh_(v1[j]); }
                    u32x4 w; w.x = cvt_pk_bf16(v0[0], v0[1]); w.y = cvt_pk_bf16(v0[2], v0[3]); w.z = cvt_pk_bf16(v1[0], v1[1]); w.w = cvt_pk_bf16(v1[2], v1[3]);
                    *(u32x4*)(YS + (size_t)(b * SEQ + c * CL + t) * SW + u.e * 16 + h0) = w; } }
    }
};
struct EpiYpool { static constexpr bool PERM = true; bf16* YPG; const bf16* SGP;
    __device__ __forceinline__ void operator()(EPI_ARGS) const {
#pragma unroll
        for (int ai = 0; ai < 2; ++ai)
#pragma unroll
            for (int m = 0; m < 4; ++m) { const int row = u.pm * 256 + ai * 128 + wr * 64 + m * 16 + fr;
#pragma unroll
                for (int bj = 0; bj < 2; ++bj) { const size_t off = (size_t)row * D + u.pn * 256 + bj * 128 + wc * 32 + 8 * fq; const u32x4 g = *(const u32x4*)(SGP + off);
                    const f32x4 v0 = acc[ai][bj][m][0], v1 = acc[ai][bj][m][1];
                    u32x4 w; w.x = cvt_pk_bf16(v0[0] * bf_lo(g.x), v0[1] * bf_hi(g.x)); w.y = cvt_pk_bf16(v0[2] * bf_lo(g.y), v0[3] * bf_hi(g.y));
                    w.z = cvt_pk_bf16(v1[0] * bf_lo(g.z), v1[1] * bf_hi(g.z)); w.w = cvt_pk_bf16(v1[2] * bf_lo(g.w), v1[3] * bf_hi(g.w));
                    *(u32x4*)(YPG + off) = w; } }
    }
};
struct EpiGlu { static constexpr bool PERM = true; bf16* MG; const bf16 *YPG, *SGS; const float* bglu;
    __device__ __forceinline__ void operator()(EPI_ARGS) const {
        const int j0 = u.pn * 128 + wc * 32 + 8 * fq;
        const f32x4 ba0 = *(const f32x4*)(bglu + j0), ba1 = *(const f32x4*)(bglu + j0 + 4), bb0 = *(const f32x4*)(bglu + D + j0), bb1 = *(const f32x4*)(bglu + D + j0 + 4);
#pragma unroll
        for (int ai = 0; ai < 2; ++ai)
#pragma unroll
            for (int m = 0; m < 4; ++m) { const int row = u.pm * 256 + ai * 128 + wr * 64 + m * 16 + fr; const size_t off = (size_t)row * D + j0;
                const u32x4 yp = *(const u32x4*)(YPG + off), gs = *(const u32x4*)(SGS + off);
                const f32x4 a0 = acc[ai][0][m][0] + ba0, a1 = acc[ai][0][m][1] + ba1, b0 = acc[ai][1][m][0] + bb0, b1 = acc[ai][1][m][1] + bb1;
                float o[8];
#pragma unroll
                for (int j = 0; j < 4; ++j) { o[j] = a0[j] * sigmoidf_(b0[j]); o[4 + j] = a1[j] * sigmoidf_(b1[j]); }
                u32x4 w; w.x = cvt_pk_bf16(bf_lo(yp.x) + bf_lo(gs.x) * o[0], bf_hi(yp.x) + bf_hi(gs.x) * o[1]); w.y = cvt_pk_bf16(bf_lo(yp.y) + bf_lo(gs.y) * o[2], bf_hi(yp.y) + bf_hi(gs.y) * o[3]);
                w.z = cvt_pk_bf16(bf_lo(yp.z) + bf_lo(gs.z) * o[4], bf_hi(yp.z) + bf_hi(gs.z) * o[5]); w.w = cvt_pk_bf16(bf_lo(yp.w) + bf_lo(gs.w) * o[6], bf_hi(yp.w) + bf_hi(gs.w) * o[7]);
                *(u32x4*)(MG + off) = w; }
    }
};
struct EpiOut { static constexpr bool PERM = false; float* X1; const float* x; const float* mod;
    __device__ __forceinline__ void operator()(EPI_ARGS) const {
        const int b = (u.pm * 256) >> 12; const float* gt = mod + (size_t)b * 6 * D + 2 * D;
#pragma unroll
        for (int bj = 0; bj < 2; ++bj)
#pragma unroll
            for (int n = 0; n < 2; ++n) { const int col = u.pn * 256 + bj * 128 + wc * 32 + n * 16 + 4 * fq; const f32x4 g = *(const f32x4*)(gt + col);
#pragma unroll
                for (int ai = 0; ai < 2; ++ai)
#pragma unroll
                    for (int m = 0; m < 4; ++m) { const int row = u.pm * 256 + ai * 128 + wr * 64 + m * 16 + fr; const size_t off = (size_t)row * D + col;
                        *(f32x4*)(X1 + off) = *(const f32x4*)(x + off) + g * acc[ai][bj][m][n]; } }
    }
};
struct EpiMoe1 { static constexpr bool PERM = true; bf16* ACT; const float* b1;
    __device__ __forceinline__ void operator()(EPI_ARGS) const {
        const int j0 = u.pn * 128 + wc * 32 + 8 * fq; const float* bb = b1 + (size_t)u.e * 2 * FE;
        const f32x4 ba0 = *(const f32x4*)(bb + j0), ba1 = *(const f32x4*)(bb + j0 + 4), bl0 = *(const f32x4*)(bb + FE + j0), bl1 = *(const f32x4*)(bb + FE + j0 + 4);
#pragma unroll
        for (int ai = 0; ai < 2; ++ai)
#pragma unroll
            for (int m = 0; m < 4; ++m) { const int row = u.pm * 256 + ai * 128 + wr * 64 + m * 16 + fr;
                const f32x4 a0 = acc[ai][0][m][0] + ba0, a1 = acc[ai][0][m][1] + ba1, l0 = acc[ai][1][m][0] + bl0, l1 = acc[ai][1][m][1] + bl1;
                float o[8];
#pragma unroll
                for (int j = 0; j < 4; ++j) { const float g0 = fminf(a0[j], 7.0f), g1 = fminf(a1[j], 7.0f), x0 = fminf(fmaxf(l0[j], -7.0f), 7.0f), x1 = fminf(fmaxf(l1[j], -7.0f), 7.0f);
                    o[j] = g0 * sigmoidf_(1.702f * g0) * (x0 + 1.0f); o[4 + j] = g1 * sigmoidf_(1.702f * g1) * (x1 + 1.0f); }
                u32x4 w; w.x = cvt_pk_bf16(o[0], o[1]); w.y = cvt_pk_bf16(o[2], o[3]); w.z = cvt_pk_bf16(o[4], o[5]); w.w = cvt_pk_bf16(o[6], o[7]);
                *(u32x4*)(ACT + (size_t)row * FE + j0) = w; }
    }
};
struct EpiMoe2 { static constexpr bool PERM = true; bf16* YE; const float* b2; const float* lwt;
    __device__ __forceinline__ void operator()(EPI_ARGS) const {
        const float* bb = b2 + (size_t)u.e * D;
#pragma unroll
        for (int ai = 0; ai < 2; ++ai)
#pragma unroll
            for (int m = 0; m < 4; ++m) { const int r = ai * 128 + wr * 64 + m * 16 + fr; const float wg = (r < u.nvalid) ? lwt[(size_t)u.e * LCAP + u.rb * 256 + r] : 0.0f;
#pragma unroll
                for (int bj = 0; bj < 2; ++bj) { const int col = u.pn * 256 + bj * 128 + wc * 32 + 8 * fq; const f32x4 c0 = *(const f32x4*)(bb + col), c1 = *(const f32x4*)(bb + col + 4);
                    const f32x4 v0 = (acc[ai][bj][m][0] + c0) * wg, v1 = (acc[ai][bj][m][1] + c1) * wg;
                    u32x4 w; w.x = cvt_pk_bf16(v0[0], v0[1]); w.y = cvt_pk_bf16(v0[2], v0[3]); w.z = cvt_pk_bf16(v1[0], v1[1]); w.w = cvt_pk_bf16(v1[2], v1[3]);
                    *(u32x4*)(YE + ((size_t)u.pm * 256 + r) * D + col) = w; } }
    }
};

__device__ __forceinline__ float wave_sum(float v) {
#pragma unroll
    for (int o = 1; o < 64; o <<= 1) v += __shfl_xor(v, o);
    return v;
}
__device__ __forceinline__ void tr_item(const float* __restrict__ W, int K, int N, bf16* WT, int item, int lane, int mode) {
    const int nblk = N >> 6, kb = item / nblk, nb = item - kb * nblk, k0 = kb * 64, n = nb * 64 + lane;
    int drow = n;
    if (mode) { const int half = N >> 1, hi = n >= half ? 1 : 0, nn = n - hi * half; drow = (nn >> 7) * 256 + hi * 128 + (nn & 127); }
    const float* src = W + (size_t)k0 * N + n;
    float v[64];
#pragma unroll
    for (int i = 0; i < 64; ++i) v[i] = src[(size_t)i * N];
    bf16* dst = WT + (size_t)drow * K + k0;
#pragma unroll
    for (int j = 0; j < 8; ++j) { v4u o; o.x = cvt_pk_bf16(v[8 * j], v[8 * j + 1]); o.y = cvt_pk_bf16(v[8 * j + 2], v[8 * j + 3]); o.z = cvt_pk_bf16(v[8 * j + 4], v[8 * j + 5]); o.w = cvt_pk_bf16(v[8 * j + 6], v[8 * j + 7]);
        *(v4u*)(dst + 8 * j) = o; }
}

struct Args { const void* in[30]; float* out; unsigned char* ws; int ph_lo, ph_hi, li, pad; };

__global__ void __launch_bounds__(NWAVES * 64, 2) fwd_kernel(Args args) {
    extern __shared__ __attribute__((aligned(16))) unsigned char lds_raw[];
    LAS unsigned char* lds = (LAS unsigned char*)lds_raw;
    volatile LAS unsigned* MISC = (volatile LAS unsigned*)(lds + MISC_OFF);
    const int tid = threadIdx.x, lane = tid & 63, wave = __builtin_amdgcn_readfirstlane(tid >> 6);
    const int G = gridDim.x; const int bx = blockIdx.x; const int vcu = (G % 8 == 0) ? (bx % 8) * (G / 8) + bx / 8 : bx;
    unsigned char* ws = args.ws;
    gu32* ctl = (gu32*)(ws + WS_CTL);
    const float* x = (const float*)args.in[0]; const float* cin = (const float*)args.in[1]; const float* ada_w = (const float*)args.in[2]; const float* ada_b = (const float*)args.in[3];
    const float* norm1_g = (const float*)args.in[4]; const float* w_in = (const float*)args.in[5]; const float* pool_w = (const float*)args.in[6]; const float* pool_scale = (const float*)args.in[7];
    const float* w_pool_out = (const float*)args.in[8]; const float* lam_re = (const float*)args.in[9]; const float* lam_im = (const float*)args.in[10]; const float* log_dt = (const float*)args.in[11];
    const float* sb_re = (const float*)args.in[12]; const float* sb_im = (const float*)args.in[13]; const float* sc_re = (const float*)args.in[14]; const float* sc_im = (const float*)args.in[15];
    const float* ssm_d = (const float*)args.in[16]; const float* w_glu = (const float*)args.in[17]; const float* b_glu = (const float*)args.in[18]; const float* w_out = (const float*)args.in[19];
    const float* norm2_g = (const float*)args.in[20]; const float* w_router = (const float*)args.in[21]; const float* b_router = (const float*)args.in[22]; const float* w1 = (const float*)args.in[23];
    const float* b1 = (const float*)args.in[24]; const float* w2 = (const float*)args.in[25]; const float* b2 = (const float*)args.in[26]; const float* fada_w = (const float*)args.in[27];
    const float* fada_b = (const float*)args.in[28]; const float* fnorm_g = (const float*)args.in[29];
    float* out = args.out;
    float* MOD = (float*)(ws + WS_MOD); float* FMOD = (float*)(ws + WS_FMOD); float* AL = (float*)(ws + WS_AL);
    bf16* WinT = (bf16*)(ws + WS_WIN); bf16* PoolWT = (bf16*)(ws + WS_POOLW); bf16* WpoT = (bf16*)(ws + WS_WPO); bf16* WgluT = (bf16*)(ws + WS_WGLU); bf16* WoutT = (bf16*)(ws + WS_WOUT);
    bf16* WendT = (bf16*)(ws + WS_WEND); bf16* TG = (bf16*)(ws + WS_TG); bf16* W1T = (bf16*)(ws + WS_W1); bf16* W2T = (bf16*)(ws + WS_W2);
    bf16* XN = (bf16*)(ws + WS_XN); bf16* UP = (bf16*)(ws + WS_UP); bf16* UG = (bf16*)(ws + WS_UG); bf16* SGP = (bf16*)(ws + WS_SGP); bf16* SGS = (bf16*)(ws + WS_SGS);
    bf16* PL = (bf16*)(ws + WS_PL); bf16* PM = (bf16*)(ws + WS_PM); float* EB = (float*)(ws + WS_E); bf16* YPG = (bf16*)(ws + WS_YPG); bf16* YS = (bf16*)(ws + WS_YS);
    bf16* MG = (bf16*)(ws + WS_MG); float* X1 = (float*)(ws + WS_X1); int* LTOK = (int*)(ws + WS_LTOK); float* LWT = (float*)(ws + WS_LWT); int* TSLOT = (int*)(ws + WS_TSLOT);
    bf16* ACT = (bf16*)(ws + WS_ACT); bf16* YE = (bf16*)(ws + WS_YE);

    for (int u = tid; u < (LDS_BYTES - LDSCTL_OFF) / 4; u += NWAVES * 64) ((LAS unsigned*)(lds + LDSCTL_OFF))[u] = 0u;
    __syncthreads();
    XcdBarrier bar; bar.bar = (unsigned*)(ctl + CW_BAR); bar.x = 0; bar.st = nullptr;
    if (N_LAUNCHES == 1) bar = xcd_barrier_post((unsigned*)(ctl + CW_BAR), MISC + 8);
#define GRID_BAR() do { if (N_LAUNCHES == 1) xcd_barrier(bar); } while (0)
    const int lo = args.ph_lo, hi = args.ph_hi;
#ifndef PHSEL
#define PHSEL -1
#endif
#define IN(k) (PHSEL < 0 ? (lo <= (k) && (k) < hi) : ((k) == PHSEL))
#define BOTH(k) (IN(k) && IN((k) + 1))
    const int gw = vcu * NWAVES + wave, NGW = G * NWAVES;

    if (IN(0)) {
        LAS float* CA = (LAS float*)(lds + RING_OFF);
        LAS float* RED = (LAS float*)(lds + RING_OFF + 32768);
        for (int i = tid; i < BATCH * D; i += NWAVES * 64) { const float c = cin[i]; CA[i] = c * sigmoidf_(c); }
        __syncthreads();
        for (int cb = vcu; cb < (6 * D + 2 * D) / 64; cb += G) {
            const int col0 = cb * 64; const float* W; int N, cc; const float* bias; float* dst; int dld;
            if (col0 < 6 * D) { W = ada_w; N = 6 * D; cc = col0; bias = ada_b; dst = MOD; dld = 6 * D; } else { W = fada_w; N = 2 * D; cc = col0 - 6 * D; bias = fada_b; dst = FMOD; dld = 2 * D; }
            const int c4 = lane & 15, kr = lane >> 4;
            f32x4 a0 = {0.f, 0.f, 0.f, 0.f}, a1 = a0, a2 = a0, a3 = a0;
            const float* wp = W + (size_t)(256 * wave + kr) * N + cc + 4 * c4;
#pragma unroll 16
            for (int kk = 0; kk < 64; ++kk) { const f32x4 v = *(const f32x4*)(wp + (size_t)kk * 4 * N); const int k = 256 * wave + kk * 4 + kr;
                a0 += v * CA[k]; a1 += v * CA[D + k]; a2 += v * CA[2 * D + k]; a3 += v * CA[3 * D + k]; }
#pragma unroll
            for (int j = 0; j < 4; ++j) { a0[j] += __shfl_xor(a0[j], 16); a0[j] += __shfl_xor(a0[j], 32); a1[j] += __shfl_xor(a1[j], 16); a1[j] += __shfl_xor(a1[j], 32);
                a2[j] += __shfl_xor(a2[j], 16); a2[j] += __shfl_xor(a2[j], 32); a3[j] += __shfl_xor(a3[j], 16); a3[j] += __shfl_xor(a3[j], 32); }
            if (kr == 0) {
#pragma unroll
                for (int j = 0; j < 4; ++j) { RED[(wave * 4 + 0) * 64 + 4 * c4 + j] = a0[j]; RED[(wave * 4 + 1) * 64 + 4 * c4 + j] = a1[j]; RED[(wave * 4 + 2) * 64 + 4 * c4 + j] = a2[j]; RED[(wave * 4 + 3) * 64 + 4 * c4 + j] = a3[j]; } }
            __syncthreads();
            if (tid < 256) { const int b = tid >> 6, c = tid & 63; float s = bias[cc + c];
#pragma unroll
                for (int w = 0; w < 8; ++w) s += RED[(w * 4 + b) * 64 + c];
                dst[(size_t)b * dld + cc + c] = s; }
            __syncthreads();
        }
        if (BOTH(0)) GRID_BAR();
    }

    if (IN(1)) {
        {
            LAS float* AP = (LAS float*)(lds + RING_OFF);
            LAS float* BBm = (LAS float*)(lds + RING_OFF + 16384);
            LAS float* CCm = (LAS float*)(lds + RING_OFF + 32768);
            LAS float* MT = (LAS float*)(lds + RING_OFF + 49152);
            for (int it = vcu; it < SG * 4; it += G) {
                const int g = it >> 2, part = it & 3;
                if (tid < 64) { const int p = tid; const float dt = expf(log_dt[g]); const float lre = fminf(lam_re[g * SP + p], -1e-4f), lim = lam_im[g * SP + p];
                    for (int k = 0; k <= 16; ++k) { const float mag = expf(lre * dt * (float)k), ang = lim * dt * (float)k; AP[(k * 64 + p) * 2] = mag * cosf(ang); AP[(k * 64 + p) * 2 + 1] = mag * sinf(ang); }
                    const float mag = expf(lre * dt), ang = lim * dt; const float abr = mag * cosf(ang), abi = mag * sinf(ang);
                    const float den = lre * lre + lim * lim, nr = abr - 1.0f, ni = abi; const float fr_ = (nr * lre + ni * lim) / den, fi_ = (ni * lre - nr * lim) / den;
                    for (int h = 0; h < SH; ++h) { const float br = sb_re[((size_t)g * SP + p) * SH + h], bi = sb_im[((size_t)g * SP + p) * SH + h]; BBm[(p * 16 + h) * 2] = fr_ * br - fi_ * bi; BBm[(p * 16 + h) * 2 + 1] = fr_ * bi + fi_ * br; }
                    for (int h = 0; h < SH; ++h) { CCm[(h * 64 + p) * 2] = sc_re[((size_t)g * SH + h) * SP + p]; CCm[(h * 64 + p) * 2 + 1] = sc_im[((size_t)g * SH + h) * SP + p]; }
                    if (part == 0) { AL[(g * SP + p) * 2] = AP[(16 * 64 + p) * 2]; AL[(g * SP + p) * 2 + 1] = AP[(16 * 64 + p) * 2 + 1]; }
                }
                __syncthreads();
                for (int idx = tid; idx < 4096; idx += NWAVES * 64) { const int k = idx >> 8, hp = (idx >> 4) & 15, h = idx & 15; float s = 0.f;
                    for (int p = 0; p < SP; ++p) { const float ar = AP[(k * 64 + p) * 2], ai = AP[(k * 64 + p) * 2 + 1], cr = CCm[(hp * 64 + p) * 2], ci = CCm[(hp * 64 + p) * 2 + 1];
                        const float car = cr * ar - ci * ai, cai = cr * ai + ci * ar; s += car * BBm[(p * 16 + h) * 2] - cai * BBm[(p * 16 + h) * 2 + 1]; }
                    if (k == 0 && h == hp) s += ssm_d[g * SH + hp];
                    MT[idx] = s; }
                __syncthreads();
                for (int vi = tid; vi < 64 * (UGK / 8); vi += NWAVES * 64) { const int nl = vi / (UGK / 8), kv = vi - nl * (UGK / 8), n = part * 64 + nl, t = n >> 4, hp = n & 15, k0 = kv * 8; float val[8];
#pragma unroll
                    for (int j = 0; j < 8; ++j) { const int k = k0 + j;
                        if (k < 256) { const int s = k >> 4, h = k & 15; val[j] = (s <= t) ? MT[((t - s) << 8) + (hp << 4) + h] : 0.f; }
                        else { const int comp = k - 256, p = comp & 63; const float ar = AP[((t + 1) * 64 + p) * 2], ai = AP[((t + 1) * 64 + p) * 2 + 1], cr = CCm[(hp * 64 + p) * 2], ci = CCm[(hp * 64 + p) * 2 + 1];
                            val[j] = comp < 64 ? (cr * ar - ci * ai) : -(cr * ai + ci * ar); } }
                    v4u o; o.x = cvt_pk_bf16(val[0], val[1]); o.y = cvt_pk_bf16(val[2], val[3]); o.z = cvt_pk_bf16(val[4], val[5]); o.w = cvt_pk_bf16(val[6], val[7]);
                    *(v4u*)(TG + ((size_t)g * 256 + n) * UGK + k0) = o; }
                for (int vi = tid; vi < 64 * 32; vi += NWAVES * 64) { const int nl = vi >> 5, kv = vi & 31, n = part * 64 + nl, k0 = kv * 8; float val[8];
#pragma unroll
                    for (int j = 0; j < 8; ++j) { const int k = k0 + j, s = k >> 4, h = k & 15;
                        if (n < 128) { const int p = n & 63; const float ar = AP[((15 - s) * 64 + p) * 2], ai = AP[((15 - s) * 64 + p) * 2 + 1], br = BBm[(p * 16 + h) * 2], bi = BBm[(p * 16 + h) * 2 + 1];
                            val[j] = n < 64 ? (ar * br - ai * bi) : (ar * bi + ai * br); } else val[j] = 0.f; }
                    v4u o; o.x = cvt_pk_bf16(val[0], val[1]); o.y = cvt_pk_bf16(val[2], val[3]); o.z = cvt_pk_bf16(val[4], val[5]); o.w = cvt_pk_bf16(val[6], val[7]);
                    *(v4u*)(WendT + ((size_t)g * 256 + n) * 256 + k0) = o; }
                __syncthreads();
            }
        }
        for (int row = gw; row < T; row += NGW) {
            const int b = row >> 12; const float* xr = x + (size_t)row * D + 4 * lane; const float* mb = MOD + (size_t)b * 6 * D;
            f32x4 v[8]; float ss = 0.f;
#pragma unroll
            for (int j = 0; j < 8; ++j) { v[j] = *(const f32x4*)(xr + 256 * j); ss += v[j][0] * v[j][0] + v[j][1] * v[j][1] + v[j][2] * v[j][2] + v[j][3] * v[j][3]; }
            const float rstd = 1.0f / sqrtf(wave_sum(ss) * (1.0f / D) + RMS_EPS);
#pragma unroll
            for (int j = 0; j < 8; ++j) { const int k = 4 * lane + 256 * j; const f32x4 g = *(const f32x4*)(norm1_g + k), sh = *(const f32x4*)(mb + k), sc = *(const f32x4*)(mb + D + k);
                const f32x4 h = v[j] * rstd * g * (sc + 1.0f) + sh; v2u o; o.x = cvt_pk_bf16(h[0], h[1]); o.y = cvt_pk_bf16(h[2], h[3]); *(v2u*)(XN + (size_t)row * D + k) = o; }
        }
        {
            constexpr int I_IN = (D / 64) * (INW / 64), I_PW = 4 * 16, I_PO = (PW / 64) * (D / 64), I_GL = (SW / 64) * (2 * D / 64), I_OUT = (D / 64) * (D / 64);
            constexpr int I_W1E = (D / 64) * (2 * FE / 64), I_W2E = (FE / 64) * (D / 64), I_W1 = NE * I_W1E, I_W2 = NE * I_W2E;
            constexpr int NITEMS = I_IN + I_PW + I_PO + I_GL + I_OUT + I_W1 + I_W2;
            for (int it = gw; it < NITEMS; it += NGW) {
                int r = it;
                if (r < I_IN) { tr_item(w_in, D, INW, WinT, r, lane, 0); continue; } r -= I_IN;
                if (r < I_PW) { const int q = r >> 4; tr_item(pool_w + (size_t)q * 65536, 256, 256, PoolWT + (size_t)q * 65536, r & 15, lane, 0); continue; } r -= I_PW;
                if (r < I_PO) { tr_item(w_pool_out, PW, D, WpoT, r, lane, 0); continue; } r -= I_PO;
                if (r < I_GL) { tr_item(w_glu, SW, 2 * D, WgluT, r, lane, 1); continue; } r -= I_GL;
                if (r < I_OUT) { tr_item(w_out, D, D, WoutT, r, lane, 0); continue; } r -= I_OUT;
                if (r < I_W1) { const int e = r / I_W1E; tr_item(w1 + (size_t)e * D * 2 * FE, D, 2 * FE, W1T + (size_t)e * D * 2 * FE, r - e * I_W1E, lane, 1); continue; } r -= I_W1;
                { const int e = r / I_W2E; tr_item(w2 + (size_t)e * FE * D, FE, D, W2T + (size_t)e * FE * D, r - e * I_W2E, lane, 0); }
            }
        }
        if (BOTH(1)) GRID_BAR();
    }

    if (IN(2)) {
        SchedDense S; S.init(XN, WinT, T, INW, D, D, G, bx);
        EpiZ E{UP, UG, SGP, SGS};
        pg8::gemm_phase<EpiZ, SchedDense, false>(lds + RING_OFF, D, D, D, S, E);
        if (BOTH(2)) GRID_BAR();
    }

    if (IN(3)) {
        for (int it = gw; it < BATCH * 128 * 4; it += NGW) {
            const int gq = it & 3, tb = (it >> 2) & 127, b = it >> 9, w = 2 << gq, oct = lane & 31, th = lane >> 5, t0 = tb * 32 + th * 16;
            const bf16* up = UP + (size_t)b * SEQ * PW + gq * 256 + oct * 8; bf16* pl = PL + (size_t)b * SEQ * PW + gq * 256 + oct * 8;
            float Sx[8];
#pragma unroll
            for (int j = 0; j < 8; ++j) Sx[j] = 0.f;
            for (int jj = w - 1; jj >= 1; --jj) { const int tp = t0 - jj; if (tp >= 0) { const v4u q = *(const v4u*)(up + (size_t)tp * PW);
                Sx[0] += bf_lo(q.x); Sx[1] += bf_hi(q.x); Sx[2] += bf_lo(q.y); Sx[3] += bf_hi(q.y); Sx[4] += bf_lo(q.z); Sx[5] += bf_hi(q.z); Sx[6] += bf_lo(q.w); Sx[7] += bf_hi(q.w); } }
            for (int tt = 0; tt < 16; ++tt) { const int tp = t0 + tt; const v4u q = *(const v4u*)(up + (size_t)tp * PW);
                float uu[8] = {bf_lo(q.x), bf_hi(q.x), bf_lo(q.y), bf_hi(q.y), bf_lo(q.z), bf_hi(q.z), bf_lo(q.w), bf_hi(q.w)};
                const float cnt = (float)((tp + 1) < w ? (tp + 1) : w); float o[8];
#pragma unroll
                for (int j = 0; j < 8; ++j) { Sx[j] += uu[j]; o[j] = Sx[j] / cnt - uu[j]; }
                v4u ov; ov.x = cvt_pk_bf16(o[0], o[1]); ov.y = cvt_pk_bf16(o[2], o[3]); ov.z = cvt_pk_bf16(o[4], o[5]); ov.w = cvt_pk_bf16(o[6], o[7]);
                *(v4u*)(pl + (size_t)tp * PW) = ov;
                const int tq = tp - w + 1; if (tq >= 0) { const v4u q2 = *(const v4u*)(up + (size_t)tq * PW);
                    Sx[0] -= bf_lo(q2.x); Sx[1] -= bf_hi(q2.x); Sx[2] -= bf_lo(q2.y); Sx[3] -= bf_hi(q2.y); Sx[4] -= bf_lo(q2.z); Sx[5] -= bf_hi(q2.z); Sx[6] -= bf_lo(q2.w); Sx[7] -= bf_hi(q2.w); } }
        }
        __syncthreads();
        SchedGrouped S; S.init(UG, WendT, UGK, (size_t)1024 * UGK * 2, (size_t)256 * 256 * 2, 4, SG, G, vcu);
        EpiS1 E{EB};
        pg8::gemm_phase<EpiS1, SchedGrouped, false>(lds + RING_OFF, UGK, 256, 256, S, E);
        if (BOTH(3)) GRID_BAR();
    }

    if (IN(4)) {
        if (wave == 0) {
            for (int it = vcu; it < BATCH * SG; it += G) {
                const int b = it >> 6, g = it & 63, p = lane; const float ar = AL[(g * SP + p) * 2], ai = AL[(g * SP + p) * 2 + 1];
                float xr = 0.f, xi = 0.f; const size_t rb = (size_t)g * 1024 + b * 256;
#pragma unroll 8
                for (int c = 0; c < NCH; ++c) { const float er = EB[(rb + c) * 128 + p], ei = EB[(rb + c) * 128 + 64 + p];
                    UG[(rb + c) * UGK + 256 + p] = (bf16)(cvt_pk_bf16(xr, 0.f) & 0xffffu); UG[(rb + c) * UGK + 320 + p] = (bf16)(cvt_pk_bf16(xi, 0.f) & 0xffffu);
                    const float nr = ar * xr - ai * xi + er, ni = ar * xi + ai * xr + ei; xr = nr; xi = ni; }
            }
        }
        SchedGrouped S; S.init(PL, PoolWT, PW, (size_t)256 * 2, (size_t)256 * 256 * 2, T / 256, 4, G, vcu);
        EpiPmix E{PM, pool_scale};
        pg8::gemm_phase<EpiPmix, SchedGrouped, false>(lds + RING_OFF, PW, 256, 256, S, E);
        if (BOTH(4)) GRID_BAR();
    }

    if (IN(5)) {
        { SchedGrouped S; S.init(UG, TG, UGK, (size_t)1024 * UGK * 2, (size_t)256 * UGK * 2, 4, SG, G, vcu);
          EpiS3 E{YS};
          pg8::gemm_phase<EpiS3, SchedGrouped, false>(lds + RING_OFF, UGK, UGK, UGK, S, E); }
        { SchedDense S; S.init(PM, WpoT, T, D, PW, PW, G, bx);
          EpiYpool E{YPG, SGP};
          pg8::gemm_phase<EpiYpool, SchedDense, false>(lds + RING_OFF, PW, PW, PW, S, E); }
        if (BOTH(5)) GRID_BAR();
    }

    if (IN(6)) {
        SchedDense S; S.init(YS, WgluT, T, 2 * D, SW, SW, G, bx);
        EpiGlu E{MG, YPG, SGS, b_glu};
        pg8::gemm_phase<EpiGlu, SchedDense, false>(lds + RING_OFF, SW, SW, SW, S, E);
        if (BOTH(6)) GRID_BAR();
    }

    if (IN(7)) {
        SchedDense S; S.init(MG, WoutT, T, D, D, D, G, bx);
        EpiOut E{X1, x, MOD};
        pg8::gemm_phase<EpiOut, SchedDense, false>(lds + RING_OFF, D, D, D, S, E);
        if (BOTH(7)) GRID_BAR();
    }

    if (IN(8)) {
        LAS float* HT = (LAS float*)(lds + RING_OFF);
        LAS float* RED = (LAS float*)(lds + RING_OFF + 65792);
        LAS float* LG = (LAS float*)(lds + RING_OFF + 98560);
        LAS int* HIST = (LAS int*)(lds + RING_OFF + 102784);
        LAS int* BASE = (LAS int*)(lds + RING_OFF + 102912);
        for (int tile = vcu; tile < T / 32; tile += G) {
            const int R0 = tile * 32, b = R0 >> 12; const float* mb = MOD + (size_t)b * 6 * D;
            f32x4 v[4][8];
#pragma unroll
            for (int rr = 0; rr < 4; ++rr) { const int row = R0 + 4 * wave + rr; const float* xr = X1 + (size_t)row * D + 4 * lane; float ss = 0.f;
#pragma unroll
                for (int j = 0; j < 8; ++j) { v[rr][j] = *(const f32x4*)(xr + 256 * j); ss += v[rr][j][0] * v[rr][j][0] + v[rr][j][1] * v[rr][j][1] + v[rr][j][2] * v[rr][j][2] + v[rr][j][3] * v[rr][j][3]; }
                const float rstd = 1.0f / sqrtf(wave_sum(ss) * (1.0f / D) + RMS_EPS);
#pragma unroll
                for (int j = 0; j < 8; ++j) { const int k = 4 * lane + 256 * j; const f32x4 g = *(const f32x4*)(norm2_g + k), sh = *(const f32x4*)(mb + 3 * D + k), sc = *(const f32x4*)(mb + 4 * D + k);
                    v[rr][j] = v[rr][j] * rstd * g * (sc + 1.0f) + sh; v2u o; o.x = cvt_pk_bf16(v[rr][j][0], v[rr][j][1]); o.y = cvt_pk_bf16(v[rr][j][2], v[rr][j][3]); *(v2u*)(XN + (size_t)row * D + k) = o; } }
            if (tid < 32) HIST[tid] = 0;
            f32x16 lacc;
#pragma unroll
            for (int j = 0; j < 16; ++j) lacc[j] = 0.f;
#pragma unroll
            for (int q = 0; q < 4; ++q) {
                __syncthreads();
#pragma unroll
                for (int rr = 0; rr < 4; ++rr)
#pragma unroll
                    for (int jj = 0; jj < 2; ++jj) { const int lk = 4 * lane + 256 * jj; LAS float* hp = HT + (4 * wave + rr) * 513 + lk; const f32x4 q4 = v[rr][2 * q + jj]; hp[0] = q4[0]; hp[1] = q4[1]; hp[2] = q4[2]; hp[3] = q4[3]; }
                __syncthreads();
                const float* wrp = w_router + (size_t)(q * 512 + 64 * wave + (lane >> 5)) * NE + (lane & 31); const LAS float* ap = HT + (lane & 31) * 513 + 64 * wave + (lane >> 5);
#pragma unroll 8
                for (int s = 0; s < 32; ++s) lacc = __builtin_amdgcn_mfma_f32_32x32x2f32(ap[2 * s], wrp[(size_t)2 * s * NE], lacc, 0, 0, 0);
            }
#pragma unroll
            for (int rg = 0; rg < 16; ++rg) { const int i = (rg & 3) + 8 * (rg >> 2) + 4 * (lane >> 5); RED[(wave * 32 + i) * 32 + (lane & 31)] = lacc[rg]; }
            __syncthreads();
#pragma unroll
            for (int pp = 0; pp < 2; ++pp) { const int p = tid + pp * 512, i = p >> 5, j = p & 31; float s = b_router[j];
#pragma unroll
                for (int w = 0; w < 8; ++w) s += RED[(w * 32 + i) * 32 + j];
                LG[i * 33 + j] = s; }
            __syncthreads();
            int idx[4] = {0, 0, 0, 0}; float wv[4] = {0.f, 0.f, 0.f, 0.f}; int lrk[4] = {0, 0, 0, 0};
            if (tid < 32) {
                unsigned chosen = 0u; float val[4];
#pragma unroll
                for (int k = 0; k < 4; ++k) { float best = -3.0e38f; int bi = 0;
                    for (int j = 0; j < NE; ++j) { const float xv = LG[tid * 33 + j]; if (!((chosen >> j) & 1u) && xv > best) { best = xv; bi = j; } }
                    val[k] = best; idx[k] = bi; chosen |= 1u << bi; }
                float den = 0.f;
#pragma unroll
                for (int k = 0; k < 4; ++k) { wv[k] = expf(val[k] - val[0]); den += wv[k]; }
#pragma unroll
                for (int k = 0; k < 4; ++k) { wv[k] /= den; lrk[k] = atomicAdd((int*)&HIST[idx[k]], 1); }
            }
            __syncthreads();
            if (tid < 32) { const int c = HIST[tid]; BASE[tid] = c ? (int)__hip_atomic_fetch_add((unsigned*)(ctl + CW_CNT + tid), (unsigned)c, RLX_AGENT) : 0; }
            __syncthreads();
            if (tid < 32) { const int tok = R0 + tid;
#pragma unroll
                for (int k = 0; k < 4; ++k) { const int e = idx[k], rank = BASE[e] + lrk[k]; LTOK[(size_t)e * LCAP + rank] = tok; LWT[(size_t)e * LCAP + rank] = wv[k]; TSLOT[tok * 4 + k] = e * LCAP + rank; } }
            __syncthreads();
        }
        if (BOTH(8)) GRID_BAR();
    }

#define MOE_TABLES(nN_) do { __syncthreads(); if (tid == 0) { unsigned us = 0u, pb = 0u; for (int e = 0; e < NE; ++e) { const unsigned c = __hip_atomic_load(ctl + CW_CNT + e, RLX_AGENT); const unsigned nb = (c + 255u) >> 8; \
        MISC[32 + e] = us; MISC[80 + e] = pb; MISC[128 + e] = c; us += nb * (unsigned)(nN_); pb += nb; } MISC[32 + NE] = us; MISC[80 + NE] = pb; MISC[176] = us; } __syncthreads(); } while (0)

    if (IN(9)) {
        MOE_TABLES(2 * FE / 256);
        SchedMoe S; S.A = (const char*)XN; S.Bt = (const char*)W1T; S.astep = 0; S.bstep_e = (size_t)2 * FE * D * 2; S.bstep_n = (size_t)256 * D * 2; S.nN = 2 * FE / 256; S.G = G; S.c = vcu; S.M = MISC; S.ltok = LTOK; S.gather = true;
        EpiMoe1 E{ACT, b1};
        pg8::gemm_phase<EpiMoe1, SchedMoe, true>(lds + RING_OFF, D, D, D, S, E);
        if (BOTH(9)) GRID_BAR();
    }

    if (IN(10)) {
        MOE_TABLES(D / 256);
        SchedMoe S; S.A = (const char*)ACT; S.Bt = (const char*)W2T; S.astep = (size_t)256 * FE * 2; S.bstep_e = (size_t)D * FE * 2; S.bstep_n = (size_t)256 * FE * 2; S.nN = D / 256; S.G = G; S.c = vcu; S.M = MISC; S.ltok = LTOK; S.gather = false;
        EpiMoe2 E{YE, b2, LWT};
        pg8::gemm_phase<EpiMoe2, SchedMoe, false>(lds + RING_OFF, FE, FE, FE, S, E);
        if (BOTH(10)) GRID_BAR();
    }

    if (IN(11)) {
        MOE_TABLES(1);
        for (int row = gw; row < T; row += NGW) {
            const int b = row >> 12; const float* mb = MOD + (size_t)b * 6 * D; const float* fb = FMOD + (size_t)b * 2 * D;
            size_t prow[4];
#pragma unroll
            for (int k = 0; k < 4; ++k) { const int s = TSLOT[row * 4 + k]; const int e = s >> 14, rank = s & (LCAP - 1); prow[k] = ((size_t)MISC[80 + e] * 256 + rank) * D; }
            f32x4 v[8]; float ss = 0.f;
#pragma unroll
            for (int j = 0; j < 8; ++j) { const int k = 4 * lane + 256 * j; f32x4 f = {0.f, 0.f, 0.f, 0.f};
#pragma unroll
                for (int kk = 0; kk < 4; ++kk) { const v2u y = *(const v2u*)(YE + prow[kk] + k); f[0] += bf_lo(y.x); f[1] += bf_hi(y.x); f[2] += bf_lo(y.y); f[3] += bf_hi(y.y); }
                const f32x4 gt = *(const f32x4*)(mb + 5 * D + k); v[j] = *(const f32x4*)(X1 + (size_t)row * D + k) + gt * f;
                ss += v[j][0] * v[j][0] + v[j][1] * v[j][1] + v[j][2] * v[j][2] + v[j][3] * v[j][3]; }
            const float rstd = 1.0f / sqrtf(wave_sum(ss) * (1.0f / D) + RMS_EPS);
#pragma unroll
            for (int j = 0; j < 8; ++j) { const int k = 4 * lane + 256 * j; const f32x4 g = *(const f32x4*)(fnorm_g + k), sh = *(const f32x4*)(fb + k), sc = *(const f32x4*)(fb + D + k);
                *(f32x4*)(out + (size_t)row * D + k) = v[j] * rstd * g * (sc + 1.0f) + sh; }
        }
    }
#undef IN
#undef BOTH
}

extern "C" void kernel_launch(void* const* d_in, const int* in_sizes, int n_in, void* d_out, int out_size, void* d_ws, size_t ws_size, hipStream_t stream) {
    static int grid = 0;
    if (grid == 0) {
        if (n_in != 30 || out_size != T * D || ws_size < WS_END) { fprintf(stderr, "kernel_launch: unexpected shapes (n_in %d, out %d, ws %zu); nothing launched\n", n_in, out_size, ws_size); grid = -1; return; }
        int dev = 0, cus = 0, per_cu = 0;
        if (hipGetDevice(&dev) != hipSuccess || hipDeviceGetAttribute(&cus, hipDeviceAttributeMultiprocessorCount, dev) != hipSuccess) { grid = -1; return; }
        if (hipFuncSetAttribute((const void*)fwd_kernel, hipFuncAttributeMaxDynamicSharedMemorySize, LDS_BYTES) != hipSuccess) { fprintf(stderr, "kernel_launch: hipFuncSetAttribute failed\n"); grid = -1; return; }
        if (hipOccupancyMaxActiveBlocksPerMultiprocessor(&per_cu, (const void*)fwd_kernel, NWAVES * 64, LDS_BYTES) != hipSuccess || per_cu < 1)
            fprintf(stderr, "kernel_launch: note: occupancy query reports %d workgroups per CU\n", per_cu);
        (void)hipGetLastError();
        grid = cus;
    }
    if (grid < 0) return;
    if (hipMemsetAsync((char*)d_ws + WS_CTL, 0, CTL_ZERO_BYTES, stream) != hipSuccess) { fprintf(stderr, "kernel_launch: hipMemsetAsync failed\n"); return; }
    Args a{};
    for (int i = 0; i < 30; ++i) a.in[i] = d_in[i];
    a.out = (float*)d_out; a.ws = (unsigned char*)d_ws;
    for (int li = 0; li < N_LAUNCHES; ++li) {
        if (N_LAUNCHES == 1) { a.ph_lo = 0; a.ph_hi = NPH; } else { a.ph_lo = li; a.ph_hi = li + 1; }
        a.li = li; a.pad = 0;
        hipLaunchKernelGGL(fwd_kernel, dim3(grid), dim3(NWAVES * 64), LDS_BYTES, stream, a);
        const hipError_t le = hipPeekAtLastError();
        if (le != hipSuccess) { fprintf(stderr, "kernel_launch: launch %d failed: %s\n", li, hipGetErrorName(le)); break; }
    }
}
```

```cpp
#include <hip/hip_runtime.h>
#include <cstdio>
#include <cstdint>

namespace pg8 {
#define PG8_LAS __attribute__((address_space(3)))
typedef unsigned short bf16_t;
typedef short bf16x8 __attribute__((ext_vector_type(8)));
typedef float f32x4 __attribute__((ext_vector_type(4)));
typedef float f32x2 __attribute__((ext_vector_type(2)));
typedef unsigned u32x4 __attribute__((ext_vector_type(4)));
constexpr int BM = 256, BK = 64, HALF = 128, HTB = HALF * BK * 2, STAGE_BYTES = 8 * HTB, NXCD = 8, WGM = 8;

__host__ __device__ __forceinline__ int lds_byte(int r, int c) { const int st = (r >> 4) * 2 + (c >> 5), rr = r & 15, cc = c & 31, ob = rr * 64 + cc * 2; return st * 1024 + (ob ^ (((ob >> 9) & 1) << 5)); }
__host__ __device__ __forceinline__ void stage_rc(int b, int& R, int& C) { const int st = b / 1024, sb = b % 1024, swz = sb ^ (((sb >> 9) & 1) << 5); R = (st >> 1) * 16 + swz / 64; C = (st & 1) * 32 + (swz % 64) / 2; }
__host__ __device__ __forceinline__ int perm32(int rho) { const int n = rho >> 4, i = rho & 15; return 8 * (i >> 2) + 4 * n + (i & 3); }

struct Unit { int pm, pn, e, rb, nvalid; };

__device__ __forceinline__ unsigned cvt_pk_bf16(float lo, float hi) { unsigned r; asm volatile("v_cvt_pk_bf16_f32 %0, %1, %2" : "=v"(r) : "v"(lo), "v"(hi)); return r; }
__device__ __forceinline__ float bf_lo(unsigned w) { return __uint_as_float(w << 16); }
__device__ __forceinline__ float bf_hi(unsigned w) { return __uint_as_float(w & 0xffff0000u); }
__device__ __forceinline__ float sigmoidf_(float x) { return __builtin_amdgcn_rcpf(1.0f + __builtin_amdgcn_exp2f(-1.44269504089f * x)); }
__device__ __forceinline__ float gelu_tanh_(float x) { const float u = 0.7978845608f * (x + 0.044715f * x * x * x); return x * __builtin_amdgcn_rcpf(1.0f + __builtin_amdgcn_exp2f(-2.88539008178f * u)); }

template <class Epi, class Sched, bool GATHER>
__device__ __forceinline__ void gemm_phase(PG8_LAS unsigned char* lds, const int lda, const int ldb, const int K, const Sched& S, const Epi& E) {
    const int tid = threadIdx.x, wid = __builtin_amdgcn_readfirstlane(tid >> 6), lane = tid & 63, wr = wid >> 2, wc = wid & 3, fr = lane & 15, fq = lane >> 4;
    const int nt = K / BK;
    unsigned voffA[2], voffB[2], colA[2]; int rowA[2];
#pragma unroll
    for (int i = 0; i < 2; ++i) { int R, C; stage_rc(tid * 16 + i * 8192, R, C); const int Rb = Epi::PERM ? ((R & ~31) + perm32(R & 31)) : R;
        rowA[i] = R; colA[i] = (unsigned)C * 2u; voffA[i] = (unsigned)(R * lda + C) * 2u; voffB[i] = (unsigned)(Rb * ldb + C) * 2u; }
    const size_t kstep = (size_t)(BK * 2);
    const size_t hstepA = GATHER ? (size_t)0 : (size_t)HALF * lda * 2;
    const size_t hstepB = (size_t)HALF * ldb * 2;
    const unsigned ldsw = (unsigned)wid * 1024u;
    const int aoff = lds_byte(wr * 64 + fr, fq * 8), boff = lds_byte(wc * 32 + fr, fq * 8);
#define PG8_SA(b, h) (((b) * 2 + (h)) * HTB)
#define PG8_SB(b, h) ((4 + (b) * 2 + (h)) * HTB)
#define PG8_STAGE2(bufoff, gbase, o0, o1) do { \
        __builtin_amdgcn_global_load_lds((const unsigned*)((const char*)(gbase) + (o0)), (PG8_LAS unsigned*)(lds + (bufoff) + ldsw), 16, 0, 0); \
        __builtin_amdgcn_global_load_lds((const unsigned*)((const char*)(gbase) + (o1)), (PG8_LAS unsigned*)(lds + (bufoff) + ldsw + 8192), 16, 0, 0); } while (0)
#define PG8_STAGE_B(bufoff, gbase) PG8_STAGE2(bufoff, gbase, voffB[0], voffB[1])
#define PG8_LDA(dst, b, h) do { _Pragma("unroll") for (int m = 0; m < 4; ++m) _Pragma("unroll") for (int k = 0; k < 2; ++k) dst[m][k] = *(const PG8_LAS bf16x8*)(lds + PG8_SA(b, h) + aoff + m * 2048 + k * 1024); } while (0)
#define PG8_LDB(dst, b, h) do { _Pragma("unroll") for (int n = 0; n < 2; ++n) _Pragma("unroll") for (int k = 0; k < 2; ++k) dst[n][k] = *(const PG8_LAS bf16x8*)(lds + PG8_SB(b, h) + boff + n * 2048 + k * 1024); } while (0)
#define PG8_MMA(ai, bj, At, Bt) do { __builtin_amdgcn_s_setprio(1); _Pragma("unroll") for (int m = 0; m < 4; ++m) _Pragma("unroll") for (int n = 0; n < 2; ++n) _Pragma("unroll") for (int k = 0; k < 2; ++k) \
        acc[ai][bj][m][n] = __builtin_amdgcn_mfma_f32_16x16x32_bf16(Bt[n][k], At[m][k], acc[ai][bj][m][n], 0, 0, 0); __builtin_amdgcn_s_setprio(0); } while (0)
#define PG8_WAIT_V(n) asm volatile("s_waitcnt vmcnt(" #n ")" ::: "memory")
#define PG8_WAIT_L(n) asm volatile("s_waitcnt lgkmcnt(" #n ")" ::: "memory")
#define PG8_BAR __builtin_amdgcn_s_barrier()
#define PG8_SCHED __builtin_amdgcn_sched_barrier(0)
    Unit cur, nxt; int ui = 0;
    if (!S.next(0, cur)) return;
    f32x4 acc[2][2][4][2];
#pragma unroll
    for (int a = 0; a < 2; ++a)
#pragma unroll
        for (int b = 0; b < 2; ++b)
#pragma unroll
            for (int m = 0; m < 4; ++m)
#pragma unroll
                for (int n = 0; n < 2; ++n) acc[a][b][m][n] = (f32x4){0.f, 0.f, 0.f, 0.f};
    bf16x8 At[4][2], B0[2][2], B1[2][2];
    const char* cA = S.a_ptr(cur); const char* cB = S.b_ptr(cur);
    unsigned gcur[2][2], gnxt[2][2];
#pragma unroll
    for (int h = 0; h < 2; ++h)
#pragma unroll
        for (int i = 0; i < 2; ++i) { if constexpr (GATHER) gcur[h][i] = S.a_rowoff(cur, h * HALF + rowA[i]) + colA[i]; else gcur[h][i] = voffA[i]; gnxt[h][i] = gcur[h][i]; }
    PG8_STAGE_B(PG8_SB(0, 0), cB); PG8_STAGE_B(PG8_SB(0, 1), cB + hstepB); PG8_STAGE2(PG8_SA(0, 0), cA, gcur[0][0], gcur[0][1]); PG8_STAGE2(PG8_SA(0, 1), cA + hstepA, gcur[1][0], gcur[1][1]);
    if (wr == 1) PG8_BAR;
    PG8_WAIT_V(2); PG8_BAR;
    PG8_STAGE_B(PG8_SB(1, 0), cB + kstep); PG8_STAGE2(PG8_SA(1, 0), cA + kstep, gcur[0][0], gcur[0][1]); PG8_STAGE_B(PG8_SB(1, 1), cB + hstepB + kstep);
    PG8_WAIT_V(6); PG8_BAR;
    for (;;) {
        const bool has_next = S.next(ui + 1, nxt);
        const char* nA = has_next ? S.a_ptr(nxt) : cA; const char* nB = has_next ? S.b_ptr(nxt) : cB;
#pragma unroll 1
        for (int t = 0; t < nt; t += 2) {
            const bool last = (t == nt - 2);
            const char* a1 = cA + (size_t)(t + 1) * kstep;
            const char* a2 = last ? nA : cA + (size_t)(t + 2) * kstep; const char* b2 = last ? nB : cB + (size_t)(t + 2) * kstep;
            const char* a3 = a2 + kstep; const char* b3 = b2 + kstep;
            if constexpr (GATHER) {
                if (last && has_next) {
#pragma unroll
                    for (int h = 0; h < 2; ++h)
#pragma unroll
                        for (int i = 0; i < 2; ++i) gnxt[h][i] = S.a_rowoff(nxt, h * HALF + rowA[i]) + colA[i];
                    asm volatile("" : "+v"(gnxt[0][0]), "+v"(gnxt[0][1]), "+v"(gnxt[1][0]), "+v"(gnxt[1][1]));
                }
            }
            unsigned o2[2][2];
#pragma unroll
            for (int h = 0; h < 2; ++h)
#pragma unroll
                for (int i = 0; i < 2; ++i) { if constexpr (GATHER) o2[h][i] = last ? gnxt[h][i] : gcur[h][i]; else o2[h][i] = voffA[i]; }
            PG8_LDB(B0, 0, 0); PG8_LDB(B1, 0, 1); PG8_SCHED; PG8_LDA(At, 0, 0); PG8_STAGE2(PG8_SA(1, 1), a1 + hstepA, gcur[1][0], gcur[1][1]);
            PG8_WAIT_V(8); PG8_WAIT_L(0); PG8_BAR; PG8_MMA(0, 0, At, B0); PG8_MMA(0, 1, At, B1); PG8_BAR; PG8_SCHED;
            PG8_LDA(At, 0, 1); PG8_STAGE_B(PG8_SB(0, 0), b2); PG8_STAGE_B(PG8_SB(0, 1), b2 + hstepB); PG8_STAGE2(PG8_SA(0, 0), a2, o2[0][0], o2[0][1]);
            PG8_WAIT_V(8); PG8_WAIT_L(0); PG8_BAR; PG8_MMA(1, 0, At, B0); PG8_MMA(1, 1, At, B1); PG8_BAR; PG8_SCHED;
            PG8_LDB(B0, 1, 0); PG8_LDB(B1, 1, 1); PG8_SCHED; PG8_LDA(At, 1, 0); PG8_STAGE2(PG8_SA(0, 1), a2 + hstepA, o2[1][0], o2[1][1]);
            PG8_WAIT_V(8); PG8_WAIT_L(0); PG8_BAR; PG8_MMA(0, 0, At, B0); PG8_MMA(0, 1, At, B1); PG8_BAR; PG8_SCHED;
            PG8_LDA(At, 1, 1); PG8_STAGE_B(PG8_SB(1, 0), b3); PG8_STAGE_B(PG8_SB(1, 1), b3 + hstepB); PG8_STAGE2(PG8_SA(1, 0), a3, o2[0][0], o2[0][1]);
            PG8_WAIT_V(8); PG8_WAIT_L(0); PG8_BAR; PG8_MMA(1, 0, At, B0); PG8_MMA(1, 1, At, B1); PG8_BAR; PG8_SCHED;
        }
        if (wr == 0) PG8_BAR;
        E(acc, cur, wr, wc, fr, fq);
        if (!has_next) break;
#pragma unroll
        for (int a = 0; a < 2; ++a)
#pragma unroll
            for (int b = 0; b < 2; ++b)
#pragma unroll
                for (int m = 0; m < 4; ++m)
#pragma unroll
                    for (int n = 0; n < 2; ++n) acc[a][b][m][n] = (f32x4){0.f, 0.f, 0.f, 0.f};
        cur = nxt; cA = nA; cB = nB; ++ui;
#pragma unroll
        for (int h = 0; h < 2; ++h)
#pragma unroll
            for (int i = 0; i < 2; ++i) gcur[h][i] = gnxt[h][i];
        if (wr == 1) PG8_BAR;
    }
    PG8_WAIT_V(0);
    PG8_BAR;
#undef PG8_SA
#undef PG8_SB
#undef PG8_STAGE2
#undef PG8_STAGE_B
#undef PG8_LDA
#undef PG8_LDB
#undef PG8_MMA
#undef PG8_WAIT_V
#undef PG8_WAIT_L
#undef PG8_BAR
#undef PG8_SCHED
}
}

constexpr int NWAVES = 8;
#ifndef MK_N_LAUNCHES
#define MK_N_LAUNCHES 1
#endif
constexpr int NPH = 12;
constexpr int N_LAUNCHES = MK_N_LAUNCHES;

constexpr int BATCH = 4, SEQ = 4096, D = 2048, T = BATCH * SEQ;
constexpr int PW = 1024, SW = 1024, INW = PW + SW + 2 * D;
constexpr int NE = 32, TOPK = 4, FE = 2048;
constexpr int SG = 64, SP = 64, SH = 16, CL = 16, NCH = SEQ / CL;
constexpr int UGK = CL * SH + 2 * SP;
constexpr int LCAP = T;
constexpr int MAXBLK = 288;
constexpr float RMS_EPS = 1e-6f;

constexpr size_t MiB = 1u << 20;
constexpr size_t WS_CTL = 0, CTL_ZERO_BYTES = 1 * MiB;
constexpr size_t WS_MOD = 1 * MiB;
constexpr size_t WS_FMOD = WS_MOD + 196608, WS_AL = WS_MOD + 262144;
constexpr size_t WS_WIN = 2 * MiB, WS_POOLW = 26 * MiB, WS_WPO = 27 * MiB, WS_WGLU = 31 * MiB, WS_WOUT = 39 * MiB, WS_WEND = 47 * MiB, WS_TG = 55 * MiB;
constexpr size_t WS_W1 = 68 * MiB, WS_W2 = 580 * MiB;
constexpr size_t WS_XN = 836 * MiB, WS_UP = 900 * MiB, WS_UG = 932 * MiB, WS_SGP = 980 * MiB, WS_SGS = 1044 * MiB, WS_PL = 1108 * MiB, WS_PM = 1140 * MiB, WS_E = 1172 * MiB;
constexpr size_t WS_YPG = 1204 * MiB, WS_YS = 1268 * MiB, WS_MG = 1300 * MiB, WS_X1 = 1364 * MiB, WS_LTOK = 1492 * MiB, WS_LWT = 1494 * MiB, WS_TSLOT = 1496 * MiB;
constexpr size_t WS_ACT = 1498 * MiB, WS_YE = 1786 * MiB, WS_END = 2074 * MiB;
static_assert(WS_TG + (size_t)SG * 256 * UGK * 2 <= WS_W1 && WS_UG + (size_t)SG * 1024 * UGK * 2 <= WS_SGP && WS_ACT + (size_t)MAXBLK * 256 * FE * 2 <= WS_YE, "d_ws map");
constexpr int CW_TMO = 0, CW_CODE = 1, CW_CNT = 64, CW_BAR = 4096;

constexpr int RING_OFF = 0, RING_BYTES = 131072;
constexpr int LDSCTL_OFF = RING_BYTES, MISC_OFF = LDSCTL_OFF + 320;
constexpr int LDS_BYTES = 147456;

#define GAS __attribute__((address_space(1)))
#define LAS __attribute__((address_space(3)))
typedef unsigned short bf16;
typedef unsigned v4u __attribute__((ext_vector_type(4)));
typedef unsigned v2u __attribute__((ext_vector_type(2)));
typedef float f32x4 __attribute__((ext_vector_type(4)));
typedef float f32x16 __attribute__((ext_vector_type(16)));
typedef GAS unsigned gu32;
#define RLX_AGENT __ATOMIC_RELAXED, __HIP_MEMORY_SCOPE_AGENT
#define LDS_WAIT() asm volatile("s_waitcnt lgkmcnt(0)" ::: "memory")
#define VM_WAIT() asm volatile("s_waitcnt vmcnt(0)" ::: "memory")
using pg8::cvt_pk_bf16; using pg8::bf_lo; using pg8::bf_hi; using pg8::sigmoidf_; using pg8::gelu_tanh_;

#define XB_TMO      128
#define XB_XCNT(j)  (256  + 64 * (j))
#define XB_XSUB(j)  (1280 + 64 * (j))
#define XB_XGEN(j)  (2304 + 64 * (j))
#define XB_TOP      3328
#define XB_TOPGEN   3392
#define XCD_BAR_WORDS 3456
#define XB_SPIN_CAP (1u << 18)

__device__ __forceinline__ unsigned xb_ld(unsigned* p)              { return __hip_atomic_load(p, __ATOMIC_RELAXED, __HIP_MEMORY_SCOPE_AGENT); }
__device__ __forceinline__ unsigned xb_add(unsigned* p, unsigned v) { return __hip_atomic_fetch_add(p, v, __ATOMIC_RELAXED, __HIP_MEMORY_SCOPE_AGENT); }
__device__ __forceinline__ unsigned xb_xcc_id() { return (unsigned)__builtin_amdgcn_s_getreg((3 << 11) | 20) & 0xFu; }
#define XB_SPIN(cond, bar) do { unsigned _sp = 0; while (cond) { __builtin_amdgcn_s_sleep(1); \
    if ((++_sp & 255u) == 0u) { if (xb_ld(&(bar)[XB_TMO])) break; if (_sp > XB_SPIN_CAP) { atomicAdd(&(bar)[XB_TMO], 1u); break; } } } } while (0)

struct XcdBarrier { unsigned* bar; unsigned x; volatile LAS unsigned* st; };

__device__ __forceinline__ XcdBarrier xcd_barrier_post(unsigned* bar, volatile LAS unsigned* st) {
    XcdBarrier b; b.bar = bar; b.x = xb_xcc_id(); b.st = st;
    if (threadIdx.x == 0) (void)xb_add(&bar[XB_XCNT(b.x)], 1u);
    return b;
}
__device__ __forceinline__ void xcd_barrier_complete(unsigned* bar, unsigned x, unsigned& nloc, unsigned& nx) {
    const unsigned G = gridDim.x * gridDim.y * gridDim.z;
    unsigned sum, cnt, mine, sp = 0u;
    for (;;) {
        sum = 0u; cnt = 0u; mine = 0u;
#pragma unroll
        for (unsigned j = 0; j < 16; ++j) { const unsigned c = xb_ld(&bar[XB_XCNT(j)]); sum += c; cnt += (c > 0u) ? 1u : 0u; mine = (j == x) ? c : mine; }
        if (sum == G) break;
        __builtin_amdgcn_s_sleep(1);
        if ((++sp & 255u) == 0u) { if (xb_ld(&bar[XB_TMO])) break; if (sp > XB_SPIN_CAP) { atomicAdd(&bar[XB_TMO], 1u); break; } }
    }
    nloc = mine > 0u ? mine : 1u; nx = cnt > 0u ? cnt : 1u;
}
__device__ __forceinline__ void xcd_barrier(const XcdBarrier& b) {
    asm volatile("s_waitcnt vmcnt(0)" ::: "memory");
    __syncthreads();
    if (threadIdx.x == 0) {
        unsigned* bar = b.bar;
        __builtin_amdgcn_s_waitcnt(0);
        unsigned nloc = b.st[0], nx = b.st[1];
        if (nloc == 0u) { xcd_barrier_complete(bar, b.x, nloc, nx); b.st[0] = nloc; b.st[1] = nx; }
        const unsigned old = xb_add(&bar[XB_XSUB(b.x)], 1u);
        const unsigned gen = old / nloc;
        if (old + 1u == (gen + 1u) * nloc) {
            __builtin_amdgcn_fence(__ATOMIC_RELEASE, "agent");
            asm volatile("s_waitcnt vmcnt(0)" ::: "memory");
            const unsigned og = xb_add(&bar[XB_TOP], 1u);
            const unsigned tg = og / nx;
            if (og + 1u == (tg + 1u) * nx) xb_add(&bar[XB_TOPGEN], 1u);
            else XB_SPIN(xb_ld(&bar[XB_TOPGEN]) == tg, bar);
            __builtin_amdgcn_fence(__ATOMIC_ACQUIRE, "agent");
            xb_add(&bar[XB_XGEN(b.x)], 1u);
            asm volatile("s_waitcnt vmcnt(0)" ::: "memory");
        } else {
            XB_SPIN(xb_ld(&bar[XB_XGEN(b.x)]) == gen, bar);
            __builtin_amdgcn_fence(__ATOMIC_ACQUIRE, "agent");
            asm volatile("s_waitcnt vmcnt(0)" ::: "memory");
        }
    }
    __syncthreads();
}

using pg8::Unit;
struct SchedDense {
    const char* A; const char* Bt; size_t astep, bstep; int nM, nN, nwg, G, c;
    __device__ __forceinline__ void init(const void* A_, const void* Bt_, int M, int N, int lda, int ldb, int G_, int c_) { A = (const char*)A_; Bt = (const char*)Bt_; astep = (size_t)256 * lda * 2; bstep = (size_t)256 * ldb * 2; nM = M / 256; nN = N / 256; nwg = nM * nN; G = G_; c = c_; }
    __device__ __forceinline__ bool next(int i, Unit& u) const {
        const long L = (long)i * G + c; if (L >= nwg) return false;
        int wgid = (int)L; { const int q = nwg / pg8::NXCD, r = nwg % pg8::NXCD, xcd = wgid % pg8::NXCD, off = wgid / pg8::NXCD; wgid = (xcd < r ? xcd * (q + 1) : r * (q + 1) + (xcd - r) * q) + off; }
        const int nig = pg8::WGM * nN, gid = wgid / nig, fm = gid * pg8::WGM, gsz = (nM - fm) < pg8::WGM ? (nM - fm) : pg8::WGM;
        u.pm = fm + ((wgid % nig) % gsz); u.pn = (wgid % nig) / gsz; u.e = 0; u.rb = 0; u.nvalid = 256; return true;
    }
    __device__ __forceinline__ const char* a_ptr(const Unit& u) const { return A + (size_t)u.pm * astep; }
    __device__ __forceinline__ const char* b_ptr(const Unit& u) const { return Bt + (size_t)u.pn * bstep; }
    __device__ __forceinline__ unsigned a_rowoff(const Unit&, int) const { return 0u; }
};
struct SchedGrouped {
    const char* A; const char* Bt; size_t astep, agstride, bgstride; int nPM, nunits, G, c;
    __device__ __forceinline__ void init(const void* A_, const void* Bt_, int lda, size_t agstride_, size_t bgstride_, int nPM_, int ngroups, int G_, int c_) { A = (const char*)A_; Bt = (const char*)Bt_; astep = (size_t)256 * lda * 2; agstride = agstride_; bgstride = bgstride_; nPM = nPM_; nunits = nPM_ * ngroups; G = G_; c = c_; }
    __device__ __forceinline__ bool next(int i, Unit& u) const { const int L = i * G + c; if (L >= nunits) return false; u.e = L / nPM; u.pm = L % nPM; u.pn = 0; u.rb = 0; u.nvalid = 256; return true; }
    __device__ __forceinline__ const char* a_ptr(const Unit& u) const { return A + (size_t)u.e * agstride + (size_t)u.pm * astep; }
    __device__ __forceinline__ const char* b_ptr(const Unit& u) const { return Bt + (size_t)u.e * bgstride; }
    __device__ __forceinline__ unsigned a_rowoff(const Unit&, int) const { return 0u; }
};
struct SchedMoe {
    const char* A; const char* Bt; size_t astep, bstep_e, bstep_n; int nN, G, c; volatile LAS unsigned* M; const int* ltok; bool gather;
    __device__ __forceinline__ bool next(int i, Unit& u) const {
        const int L = i * G + c; const int total = (int)M[176]; if (L >= total) return false;
        int e = 0;
#pragma unroll 1
        for (int j = 1; j < NE; ++j) e += (L >= (int)M[32 + j]) ? 1 : 0;
        e = __builtin_amdgcn_readfirstlane(e);
        const int w = L - (int)M[32 + e], pb = (int)M[80 + e], nb = (int)M[80 + e + 1] - pb, cnt = (int)M[128 + e];
        int rb = w % nb, pn = w / nb;
        rb = __builtin_amdgcn_readfirstlane(rb); pn = __builtin_amdgcn_readfirstlane(pn);
        u.e = e; u.rb = rb; u.pn = pn; u.pm = __builtin_amdgcn_readfirstlane(pb + rb); const int nv = cnt - rb * 256; u.nvalid = __builtin_amdgcn_readfirstlane(nv < 256 ? nv : 256); return true;
    }
    __device__ __forceinline__ const char* a_ptr(const Unit& u) const { return gather ? A : A + (size_t)u.pm * astep; }
    __device__ __forceinline__ const char* b_ptr(const Unit& u) const { return Bt + (size_t)u.e * bstep_e + (size_t)u.pn * bstep_n; }
    __device__ __forceinline__ unsigned a_rowoff(const Unit& u, int r) const { const int idx = (r < u.nvalid) ? (u.rb * 256 + r) : 0; const int tok = ltok[(size_t)u.e * LCAP + idx]; return (unsigned)tok * (unsigned)(D * 2); }
};

using pg8::f32x2; using pg8::u32x4;
#define EPI_ARGS const f32x4 (&acc)[2][2][4][2], const Unit& u, int wr, int wc, int fr, int fq
struct EpiZ { static constexpr bool PERM = true; bf16 *UP, *UG, *SGP, *SGS;
    __device__ __forceinline__ void operator()(EPI_ARGS) const {
        const int pn = u.pn, region = pn < 4 ? 0 : (pn < 8 ? 1 : (pn < 16 ? 2 : 3));
#pragma unroll
        for (int ai = 0; ai < 2; ++ai)
#pragma unroll
            for (int m = 0; m < 4; ++m) { const int row = u.pm * 256 + ai * 128 + wr * 64 + m * 16 + fr;
#pragma unroll
                for (int bj = 0; bj < 2; ++bj) { const int lc = bj * 128 + wc * 32 + 8 * fq; f32x4 v0 = acc[ai][bj][m][0], v1 = acc[ai][bj][m][1];
                    if (region >= 2) {
#pragma unroll
                        for (int j = 0; j < 4; ++j) { v0[j] = sigmoidf_(v0[j]); v1[j] = sigmoidf_(v1[j]); } }
                    u32x4 w; w.x = cvt_pk_bf16(v0[0], v0[1]); w.y = cvt_pk_bf16(v0[2], v0[3]); w.z = cvt_pk_bf16(v1[0], v1[1]); w.w = cvt_pk_bf16(v1[2], v1[3]);
                    bf16* dst;
                    if (region == 0) dst = UP + (size_t)row * PW + pn * 256 + lc;
                    else if (region == 1) { const int j = (pn - 4) * 256 + lc, g = j >> 4, h0 = j & 15, b = row >> 12, tp = row & 4095, c = tp >> 4, s = tp & 15; dst = UG + ((size_t)(g * 1024 + b * 256 + c) * UGK + s * 16 + h0); }
                    else if (region == 2) dst = SGP + (size_t)row * D + (pn - 8) * 256 + lc;
                    else dst = SGS + (size_t)row * D + (pn - 16) * 256 + lc;
                    *(u32x4*)dst = w; } }
    }
};
struct EpiS1 { static constexpr bool PERM = false; float* E;
    __device__ __forceinline__ void operator()(EPI_ARGS) const {
#pragma unroll
        for (int ai = 0; ai < 2; ++ai)
#pragma unroll
            for (int m = 0; m < 4; ++m) { const int row = u.pm * 256 + ai * 128 + wr * 64 + m * 16 + fr; float* rp = E + ((size_t)u.e * 1024 + row) * 128 + wc * 32 + 4 * fq;
#pragma unroll
                for (int n = 0; n < 2; ++n) *(f32x4*)(rp + n * 16) = acc[ai][0][m][n]; }
    }
};
struct EpiPmix { static constexpr bool PERM = true; bf16* PM; const float* scale;
    __device__ __forceinline__ void operator()(EPI_ARGS) const {
#pragma unroll
        for (int bj = 0; bj < 2; ++bj) { const int col = u.e * 256 + bj * 128 + wc * 32 + 8 * fq; const f32x4 s0 = *(const f32x4*)(scale + col), s1 = *(const f32x4*)(scale + col + 4);
#pragma unroll
            for (int ai = 0; ai < 2; ++ai)
#pragma unroll
                for (int m = 0; m < 4; ++m) { const int row = u.pm * 256 + ai * 128 + wr * 64 + m * 16 + fr; const f32x4 v0 = acc[ai][bj][m][0] * s0, v1 = acc[ai][bj][m][1] * s1;
                    u32x4 w; w.x = cvt_pk_bf16(v0[0], v0[1]); w.y = cvt_pk_bf16(v0[2], v0[3]); w.z = cvt_pk_bf16(v1[0], v1[1]); w.w = cvt_pk_bf16(v1[2], v1[3]);
                    *(u32x4*)(PM + (size_t)row * PW + col) = w; } }
    }
};
struct EpiS3 { static constexpr bool PERM = true; bf16* YS;
    __device__ __forceinline__ void operator()(EPI_ARGS) const {
#pragma unroll
        for (int ai = 0; ai < 2; ++ai)
#pragma unroll
            for (int m = 0; m < 4; ++m) { const int r = u.pm * 256 + ai * 128 + wr * 64 + m * 16 + fr, b = r >> 8, c = r & 255;
#pragma unroll
                for (int bj = 0; bj < 2; ++bj) { const int lc = bj * 128 + wc * 32 + 8 * fq, t = lc >> 4, h0 = lc & 15; f32x4 v0 = acc[ai][bj][m][0], v1 = acc[ai][bj][m][1];
#pragma unroll
                    for (int j = 0; j < 4; ++j) { v0[j] = gelu_tanh_(v0[j]); v1[j] = gelu_tanh_(v1[j]); }
                    u32x4 w; w.x = cvt_pk_bf16(v0[0], v0[1]); w.y = cvt_pk_bf16(v0[2], v0[3]); w.z = cvt_pk_bf16(v1[0], v1[1]); w.w = cvt_pk_bf16(v1[2], v1[3]);
                    *(u32x4*)(YS + (size_t)(b * SEQ + c * CL + t) * SW + u.e * 16 + h0) = w; } }
    }
};
struct EpiYpool { static constexpr bool PERM = true; bf16* YPG; const bf16* SGP;
    __device__ __forceinline__ void operator()(EPI_ARGS) const {
#pragma unroll
        for (int ai = 0; ai < 2; ++ai)
#pragma unroll
            for (int m = 0; m < 4; ++m) { const int row = u.pm * 256 + ai * 128 + wr * 64 + m * 16 + fr;
#pragma unroll
                for (int bj = 0; bj < 2; ++bj) { const size_t off = (size_t)row * D + u.pn * 256 + bj * 128 + wc * 32 + 8 * fq; const u32x4 g = *(const u32x4*)(SGP + off);
                    const f32x4 v0 = acc[ai][bj][m][0], v1 = acc[ai][bj][m][1];
                    u32x4 w; w.x = cvt_pk_bf16(v0[0] * bf_lo(g.x), v0[1] * bf_hi(g.x)); w.y = cvt_pk_bf16(v0[2] * bf_lo(g.y), v0[3] * bf_hi(g.y));
                    w.z = cvt_pk_bf16(v1[0] * bf_lo(g.z), v1[1] * bf_hi(g.z)); w.w = cvt_pk_bf16(v1[2] * bf_lo(g.w), v1[3] * bf_hi(g.w));
                    *(u32x4*)(YPG + off) = w; } }
    }
};
struct EpiGlu { static constexpr bool PERM = true; bf16* MG; const bf16 *YPG, *SGS; const float* bglu;
    __device__ __forceinline__ void operator()(EPI_ARGS) const {
        const int j0 = u.pn * 128 + wc * 32 + 8 * fq;
        const f32x4 ba0 = *(const f32x4*)(bglu + j0), ba1 = *(const f32x4*)(bglu + j0 + 4), bb0 = *(const f32x4*)(bglu + D + j0), bb1 = *(const f32x4*)(bglu + D + j0 + 4);
#pragma unroll
        for (int ai = 0; ai < 2; ++ai)
#pragma unroll
            for (int m = 0; m < 4; ++m) { const int row = u.pm * 256 + ai * 128 + wr * 64 + m * 16 + fr; const size_t off = (size_t)row * D + j0;
                const u32x4 yp = *(const u32x4*)(YPG + off), gs = *(const u32x4*)(SGS + off);
                const f32x4 a0 = acc[ai][0][m][0] + ba0, a1 = acc[ai][0][m][1] + ba1, b0 = acc[ai][1][m][0] + bb0, b1 = acc[ai][1][m][1] + bb1;
                float o[8];
#pragma unroll
                for (int j = 0; j < 4; ++j) { o[j] = a0[j] * sigmoidf_(b0[j]); o[4 + j] = a1[j] * sigmoidf_(b1[j]); }
                u32x4 w; w.x = cvt_pk_bf16(bf_lo(yp.x) + bf_lo(gs.x) * o[0], bf_hi(yp.x) + bf_hi(gs.x) * o[1]); w.y = cvt_pk_bf16(bf_lo(yp.y) + bf_lo(gs.y) * o[2], bf_hi(yp.y) + bf_hi(gs.y) * o[3]);
                w.z = cvt_pk_bf16(bf_lo(yp.z) + bf_lo(gs.z) * o[4], bf_hi(yp.z) + bf_hi(gs.z) * o[5]); w.w = cvt_pk_bf16(bf_lo(yp.w) + bf_lo(gs.w) * o[6], bf_hi(yp.w) + bf_hi(gs.w) * o[7]);
                *(u32x4*)(MG + off) = w; }
    }
};
struct EpiOut { static constexpr bool PERM = false; float* X1; const float* x; const float* mod;
    __device__ __forceinline__ void operator()(EPI_ARGS) const {
        const int b = (u.pm * 256) >> 12; const float* gt = mod + (size_t)b * 6 * D + 2 * D;
#pragma unroll
        for (int bj = 0; bj < 2; ++bj)
#pragma unroll
            for (int n = 0; n < 2; ++n) { const int col = u.pn * 256 + bj * 128 + wc * 32 + n * 16 + 4 * fq; const f32x4 g = *(const f32x4*)(gt + col);
#pragma unroll
                for (int ai = 0; ai < 2; ++ai)
#pragma unroll
                    for (int m = 0; m < 4; ++m) { const int row = u.pm * 256 + ai * 128 + wr * 64 + m * 16 + fr; const size_t off = (size_t)row * D + col;
                        *(f32x4*)(X1 + off) = *(const f32x4*)(x + off) + g * acc[ai][bj][m][n]; } }
    }
};
struct EpiMoe1 { static constexpr bool PERM = true; bf16* ACT; const float* b1;
    __device__ __forceinline__ void operator()(EPI_ARGS) const {
        const int j0 = u.pn * 128 + wc * 32 + 8 * fq; const float* bb = b1 + (size_t)u.e * 2 * FE;
        const f32x4 ba0 = *(const f32x4*)(bb + j0), ba1 = *(const f32x4*)(bb + j0 + 4), bl0 = *(const f32x4*)(bb + FE + j0), bl1 = *(const f32x4*)(bb + FE + j0 + 4);
#pragma unroll
        for (int ai = 0; ai < 2; ++ai)
#pragma unroll
            for (int m = 0; m < 4; ++m) { const int row = u.pm * 256 + ai * 128 + wr * 64 + m * 16 + fr;
                const f32x4 a0 = acc[ai][0][m][0] + ba0, a1 = acc[ai][0][m][1] + ba1, l0 = acc[ai][1][m][0] + bl0, l1 = acc[ai][1][m][1] + bl1;
                float o[8];
#pragma unroll
                for (int j = 0; j < 4; ++j) { const float g0 = fminf(a0[j], 7.0f), g1 = fminf(a1[j], 7.0f), x0 = fminf(fmaxf(l0[j], -7.0f), 7.0f), x1 = fminf(fmaxf(l1[j], -7.0f), 7.0f);
                    o[j] = g0 * sigmoidf_(1.702f * g0) * (x0 + 1.0f); o[4 + j] = g1 * sigmoidf_(1.702f * g1) * (x1 + 1.0f); }
                u32x4 w; w.x = cvt_pk_bf16(o[0], o[1]); w.y = cvt_pk_bf16(o[2], o[3]); w.z = cvt_pk_bf16(o[4], o[5]); w.w = cvt_pk_bf16(o[6], o[7]);
                *(u32x4*)(ACT + (size_t)row * FE + j0) = w; }
    }
};
struct EpiMoe2 { static constexpr bool PERM = true; bf16* YE; const float* b2; const float* lwt;
    __device__ __forceinline__ void operator()(EPI_ARGS) const {
        const float* bb = b2 + (size_t)u.e * D;
#pragma unroll
        for (int ai = 0; ai < 2; ++ai)
#pragma unroll
            for (int m = 0; m < 4; ++m) { const int r = ai * 128 + wr * 64 + m * 16 + fr; const float wg = (r < u.nvalid) ? lwt[(size_t)u.e * LCAP + u.rb * 256 + r] : 0.0f;
#pragma unroll
                for (int bj = 0; bj < 2; ++bj) { const int col = u.pn * 256 + bj * 128 + wc * 32 + 8 * fq; const f32x4 c0 = *(const f32x4*)(bb + col), c1 = *(const f32x4*)(bb + col + 4);
                    const f32x4 v0 = (acc[ai][bj][m][0] + c0) * wg, v1 = (acc[ai][bj][m][1] + c1) * wg;
                    u32x4 w; w.x = cvt_pk_bf16(v0[0], v0[1]); w.y = cvt_pk_bf16(v0[2], v0[3]); w.z = cvt_pk_bf16(v1[0], v1[1]); w.w = cvt_pk_bf16(v1[2], v1[3]);
                    *(u32x4*)(YE + ((size_t)u.pm * 256 + r) * D + col) = w; } }
    }
};

__device__ __forceinline__ float wave_sum(float v) {
#pragma unroll
    for (int o = 1; o < 64; o <<= 1) v += __shfl_xor(v, o);
    return v;
}
__device__ __forceinline__ void tr_item(const float* __restrict__ W, int K, int N, bf16* WT, int item, int lane, int mode) {
    const int nblk = N >> 6, kb = item / nblk, nb = item - kb * nblk, k0 = kb * 64, n = nb * 64 + lane;
    int drow = n;
    if (mode) { const int half = N >> 1, hi = n >= half ? 1 : 0, nn = n - hi * half; drow = (nn >> 7) * 256 + hi * 128 + (nn & 127); }
    const float* src = W + (size_t)k0 * N + n;
    float v[64];
#pragma unroll
    for (int i = 0; i < 64; ++i) v[i] = src[(size_t)i * N];
    bf16* dst = WT + (size_t)drow * K + k0;
#pragma unroll
    for (int j = 0; j < 8; ++j) { v4u o; o.x = cvt_pk_bf16(v[8 * j], v[8 * j + 1]); o.y = cvt_pk_bf16(v[8 * j + 2], v[8 * j + 3]); o.z = cvt_pk_bf16(v[8 * j + 4], v[8 * j + 5]); o.w = cvt_pk_bf16(v[8 * j + 6], v[8 * j + 7]);
        *(v4u*)(dst + 8 * j) = o; }
}

struct Args { const void* in[30]; float* out; unsigned char* ws; int ph_lo, ph_hi, li, pad; };

__global__ void __launch_bounds__(NWAVES * 64, 2) fwd_kernel(Args args) {
    extern __shared__ __attribute__((aligned(16))) unsigned char lds_raw[];
    LAS unsigned char* lds = (LAS unsigned char*)lds_raw;
    volatile LAS unsigned* MISC = (volatile LAS unsigned*)(lds + MISC_OFF);
    const int tid = threadIdx.x, lane = tid & 63, wave = __builtin_amdgcn_readfirstlane(tid >> 6);
    const int G = gridDim.x; const int bx = blockIdx.x; const int vcu = (G % 8 == 0) ? (bx % 8) * (G / 8) + bx / 8 : bx;
    unsigned char* ws = args.ws;
    gu32* ctl = (gu32*)(ws + WS_CTL);
    const float* x = (const float*)args.in[0]; const float* cin = (const float*)args.in[1]; const float* ada_w = (const float*)args.in[2]; const float* ada_b = (const float*)args.in[3];
    const float* norm1_g = (const float*)args.in[4]; const float* w_in = (const float*)args.in[5]; const float* pool_w = (const float*)args.in[6]; const float* pool_scale = (const float*)args.in[7];
    const float* w_pool_out = (const float*)args.in[8]; const float* lam_re = (const float*)args.in[9]; const float* lam_im = (const float*)args.in[10]; const float* log_dt = (const float*)args.in[11];
    const float* sb_re = (const float*)args.in[12]; const float* sb_im = (const float*)args.in[13]; const float* sc_re = (const float*)args.in[14]; const float* sc_im = (const float*)args.in[15];
    const float* ssm_d = (const float*)args.in[16]; const float* w_glu = (const float*)args.in[17]; const float* b_glu = (const float*)args.in[18]; const float* w_out = (const float*)args.in[19];
    const float* norm2_g = (const float*)args.in[20]; const float* w_router = (const float*)args.in[21]; const float* b_router = (const float*)args.in[22]; const float* w1 = (const float*)args.in[23];
    const float* b1 = (const float*)args.in[24]; const float* w2 = (const float*)args.in[25]; const float* b2 = (const float*)args.in[26]; const float* fada_w = (const float*)args.in[27];
    const float* fada_b = (const float*)args.in[28]; const float* fnorm_g = (const float*)args.in[29];
    float* out = args.out;
    float* MOD = (float*)(ws + WS_MOD); float* FMOD = (float*)(ws + WS_FMOD); float* AL = (float*)(ws + WS_AL);
    bf16* WinT = (bf16*)(ws + WS_WIN); bf16* PoolWT = (bf16*)(ws + WS_POOLW); bf16* WpoT = (bf16*)(ws + WS_WPO); bf16* WgluT = (bf16*)(ws + WS_WGLU); bf16* WoutT = (bf16*)(ws + WS_WOUT);
    bf16* WendT = (bf16*)(ws + WS_WEND); bf16* TG = (bf16*)(ws + WS_TG); bf16* W1T = (bf16*)(ws + WS_W1); bf16* W2T = (bf16*)(ws + WS_W2);
    bf16* XN = (bf16*)(ws + WS_XN); bf16* UP = (bf16*)(ws + WS_UP); bf16* UG = (bf16*)(ws + WS_UG); bf16* SGP = (bf16*)(ws + WS_SGP); bf16* SGS = (bf16*)(ws + WS_SGS);
    bf16* PL = (bf16*)(ws + WS_PL); bf16* PM = (bf16*)(ws + WS_PM); float* EB = (float*)(ws + WS_E); bf16* YPG = (bf16*)(ws + WS_YPG); bf16* YS = (bf16*)(ws + WS_YS);
    bf16* MG = (bf16*)(ws + WS_MG); float* X1 = (float*)(ws + WS_X1); int* LTOK = (int*)(ws + WS_LTOK); float* LWT = (float*)(ws + WS_LWT); int* TSLOT = (int*)(ws + WS_TSLOT);
    bf16* ACT = (bf16*)(ws + WS_ACT); bf16* YE = (bf16*)(ws + WS_YE);

    for (int u = tid; u < (LDS_BYTES - LDSCTL_OFF) / 4; u += NWAVES * 64) ((LAS unsigned*)(lds + LDSCTL_OFF))[u] = 0u;
    __syncthreads();
    XcdBarrier bar; bar.bar = (unsigned*)(ctl + CW_BAR); bar.x = 0; bar.st = nullptr;
    if (N_LAUNCHES == 1) bar = xcd_barrier_post((unsigned*)(ctl + CW_BAR), MISC + 8);
#define GRID_BAR() do { if (N_LAUNCHES == 1) xcd_barrier(bar); } while (0)
    const int lo = args.ph_lo, hi = args.ph_hi;
#ifndef PHSEL
#define PHSEL -1
#endif
#define IN(k) (PHSEL < 0 ? (lo <= (k) && (k) < hi) : ((k) == PHSEL))
#define BOTH(k) (IN(k) && IN((k) + 1))
#ifndef DUPSEL
#define DUPSEL -1
#endif
#define REP(k) ((DUPSEL == (k)) ? 2 : 1)
    const int gw = vcu * NWAVES + wave, NGW = G * NWAVES;

    if (IN(0)) for (int rep_ = 0; rep_ < REP(0); ++rep_) {
        LAS float* CA = (LAS float*)(lds + RING_OFF);
        LAS float* RED = (LAS float*)(lds + RING_OFF + 32768);
        for (int i = tid; i < BATCH * D; i += NWAVES * 64) { const float c = cin[i]; CA[i] = c * sigmoidf_(c); }
        __syncthreads();
        for (int cb = vcu; cb < (6 * D + 2 * D) / 64; cb += G) {
            const int col0 = cb * 64; const float* W; int N, cc; const float* bias; float* dst; int dld;
            if (col0 < 6 * D) { W = ada_w; N = 6 * D; cc = col0; bias = ada_b; dst = MOD; dld = 6 * D; } else { W = fada_w; N = 2 * D; cc = col0 - 6 * D; bias = fada_b; dst = FMOD; dld = 2 * D; }
            const int c4 = lane & 15, kr = lane >> 4;
            f32x4 a0 = {0.f, 0.f, 0.f, 0.f}, a1 = a0, a2 = a0, a3 = a0;
            const float* wp = W + (size_t)(256 * wave + kr) * N + cc + 4 * c4;
#pragma unroll 16
            for (int kk = 0; kk < 64; ++kk) { const f32x4 v = *(const f32x4*)(wp + (size_t)kk * 4 * N); const int k = 256 * wave + kk * 4 + kr;
                a0 += v * CA[k]; a1 += v * CA[D + k]; a2 += v * CA[2 * D + k]; a3 += v * CA[3 * D + k]; }
#pragma unroll
            for (int j = 0; j < 4; ++j) { a0[j] += __shfl_xor(a0[j], 16); a0[j] += __shfl_xor(a0[j], 32); a1[j] += __shfl_xor(a1[j], 16); a1[j] += __shfl_xor(a1[j], 32);
                a2[j] += __shfl_xor(a2[j], 16); a2[j] += __shfl_xor(a2[j], 32); a3[j] += __shfl_xor(a3[j], 16); a3[j] += __shfl_xor(a3[j], 32); }
            if (kr == 0) {
#pragma unroll
                for (int j = 0; j < 4; ++j) { RED[(wave * 4 + 0) * 64 + 4 * c4 + j] = a0[j]; RED[(wave * 4 + 1) * 64 + 4 * c4 + j] = a1[j]; RED[(wave * 4 + 2) * 64 + 4 * c4 + j] = a2[j]; RED[(wave * 4 + 3) * 64 + 4 * c4 + j] = a3[j]; } }
            __syncthreads();
            if (tid < 256) { const int b = tid >> 6, c = tid & 63; float s = bias[cc + c];
#pragma unroll
                for (int w = 0; w < 8; ++w) s += RED[(w * 4 + b) * 64 + c];
                dst[(size_t)b * dld + cc + c] = s; }
            __syncthreads();
        }
        if (BOTH(0)) GRID_BAR();
    }

    if (IN(1)) for (int rep_ = 0; rep_ < REP(1); ++rep_) {
        {
            LAS float* AP = (LAS float*)(lds + RING_OFF);
            LAS float* BBm = (LAS float*)(lds + RING_OFF + 16384);
            LAS float* CCm = (LAS float*)(lds + RING_OFF + 32768);
            LAS float* MT = (LAS float*)(lds + RING_OFF + 49152);
            for (int it = vcu; it < SG * 4; it += G) {
                const int g = it >> 2, part = it & 3;
                if (tid < 64) { const int p = tid; const float dt = expf(log_dt[g]); const float lre = fminf(lam_re[g * SP + p], -1e-4f), lim = lam_im[g * SP + p];
                    for (int k = 0; k <= 16; ++k) { const float mag = expf(lre * dt * (float)k), ang = lim * dt * (float)k; AP[(k * 64 + p) * 2] = mag * cosf(ang); AP[(k * 64 + p) * 2 + 1] = mag * sinf(ang); }
                    const float mag = expf(lre * dt), ang = lim * dt; const float abr = mag * cosf(ang), abi = mag * sinf(ang);
                    const float den = lre * lre + lim * lim, nr = abr - 1.0f, ni = abi; const float fr_ = (nr * lre + ni * lim) / den, fi_ = (ni * lre - nr * lim) / den;
                    for (int h = 0; h < SH; ++h) { const float br = sb_re[((size_t)g * SP + p) * SH + h], bi = sb_im[((size_t)g * SP + p) * SH + h]; BBm[(p * 16 + h) * 2] = fr_ * br - fi_ * bi; BBm[(p * 16 + h) * 2 + 1] = fr_ * bi + fi_ * br; }
                    for (int h = 0; h < SH; ++h) { CCm[(h * 64 + p) * 2] = sc_re[((size_t)g * SH + h) * SP + p]; CCm[(h * 64 + p) * 2 + 1] = sc_im[((size_t)g * SH + h) * SP + p]; }
                    if (part == 0) { AL[(g * SP + p) * 2] = AP[(16 * 64 + p) * 2]; AL[(g * SP + p) * 2 + 1] = AP[(16 * 64 + p) * 2 + 1]; }
                }
                __syncthreads();
                for (int idx = tid; idx < 4096; idx += NWAVES * 64) { const int k = idx >> 8, hp = (idx >> 4) & 15, h = idx & 15; float s = 0.f;
                    for (int p = 0; p < SP; ++p) { const float ar = AP[(k * 64 + p) * 2], ai = AP[(k * 64 + p) * 2 + 1], cr = CCm[(hp * 64 + p) * 2], ci = CCm[(hp * 64 + p) * 2 + 1];
                        const float car = cr * ar - ci * ai, cai = cr * ai + ci * ar; s += car * BBm[(p * 16 + h) * 2] - cai * BBm[(p * 16 + h) * 2 + 1]; }
                    if (k == 0 && h == hp) s += ssm_d[g * SH + hp];
                    MT[idx] = s; }
                __syncthreads();
                for (int vi = tid; vi < 64 * (UGK / 8); vi += NWAVES * 64) { const int nl = vi / (UGK / 8), kv = vi - nl * (UGK / 8), n = part * 64 + nl, t = n >> 4, hp = n & 15, k0 = kv * 8; float val[8];
#pragma unroll
                    for (int j = 0; j < 8; ++j) { const int k = k0 + j;
                        if (k < 256) { const int s = k >> 4, h = k & 15; val[j] = (s <= t) ? MT[((t - s) << 8) + (hp << 4) + h] : 0.f; }
                        else { const int comp = k - 256, p = comp & 63; const float ar = AP[((t + 1) * 64 + p) * 2], ai = AP[((t + 1) * 64 + p) * 2 + 1], cr = CCm[(hp * 64 + p) * 2], ci = CCm[(hp * 64 + p) * 2 + 1];
                            val[j] = comp < 64 ? (cr * ar - ci * ai) : -(cr * ai + ci * ar); } }
                    v4u o; o.x = cvt_pk_bf16(val[0], val[1]); o.y = cvt_pk_bf16(val[2], val[3]); o.z = cvt_pk_bf16(val[4], val[5]); o.w = cvt_pk_bf16(val[6], val[7]);
                    *(v4u*)(TG + ((size_t)g * 256 + n) * UGK + k0) = o; }
                for (int vi = tid; vi < 64 * 32; vi += NWAVES * 64) { const int nl = vi >> 5, kv = vi & 31, n = part * 64 + nl, k0 = kv * 8; float val[8];
#pragma unroll
                    for (int j = 0; j < 8; ++j) { const int k = k0 + j, s = k >> 4, h = k & 15;
                        if (n < 128) { const int p = n & 63; const float ar = AP[((15 - s) * 64 + p) * 2], ai = AP[((15 - s) * 64 + p) * 2 + 1], br = BBm[(p * 16 + h) * 2], bi = BBm[(p * 16 + h) * 2 + 1];
                            val[j] = n < 64 ? (ar * br - ai * bi) : (ar * bi + ai * br); } else val[j] = 0.f; }
                    v4u o; o.x = cvt_pk_bf16(val[0], val[1]); o.y = cvt_pk_bf16(val[2], val[3]); o.z = cvt_pk_bf16(val[4], val[5]); o.w = cvt_pk_bf16(val[6], val[7]);
                    *(v4u*)(WendT + ((size_t)g * 256 + n) * 256 + k0) = o; }
                __syncthreads();
            }
        }
        for (int row = gw; row < T; row += NGW) {
            const int b = row >> 12; const float* xr = x + (size_t)row * D + 4 * lane; const float* mb = MOD + (size_t)b * 6 * D;
            f32x4 v[8]; float ss = 0.f;
#pragma unroll
            for (int j = 0; j < 8; ++j) { v[j] = *(const f32x4*)(xr + 256 * j); ss += v[j][0] * v[j][0] + v[j][1] * v[j][1] + v[j][2] * v[j][2] + v[j][3] * v[j][3]; }
            const float rstd = 1.0f / sqrtf(wave_sum(ss) * (1.0f / D) + RMS_EPS);
#pragma unroll
            for (int j = 0; j < 8; ++j) { const int k = 4 * lane + 256 * j; const f32x4 g = *(const f32x4*)(norm1_g + k), sh = *(const f32x4*)(mb + k), sc = *(const f32x4*)(mb + D + k);
                const f32x4 h = v[j] * rstd * g * (sc + 1.0f) + sh; v2u o; o.x = cvt_pk_bf16(h[0], h[1]); o.y = cvt_pk_bf16(h[2], h[3]); *(v2u*)(XN + (size_t)row * D + k) = o; }
        }
        {
            constexpr int T_IN = (D / 64) * (INW / 256), T_PW = 4 * 4, T_PO = (PW / 64) * (D / 256), T_GL = (SW / 64) * (2 * D / 256), T_OUT = (D / 64) * (D / 256);
            constexpr int T_W1E = (D / 64) * (2 * FE / 256), T_W2E = (FE / 64) * (D / 256), T_W1 = NE * T_W1E, T_W2 = NE * T_W2E;
            constexpr int NTILES = T_IN + T_PW + T_PO + T_GL + T_OUT + T_W1 + T_W2;
            constexpr int TRB = 256 * 144;
#define TR_DECODE(it_, W_, WT_, K_, N_, mode_, k0_, n0_) do { int r_ = (it_); \
                if (r_ < T_IN) { W_ = w_in; WT_ = WinT; K_ = D; N_ = INW; mode_ = 0; } \
                else if ((r_ -= T_IN) < T_PW) { const int q_ = r_ >> 2; r_ &= 3; W_ = pool_w + (size_t)q_ * 65536; WT_ = PoolWT + (size_t)q_ * 65536; K_ = 256; N_ = 256; mode_ = 0; } \
                else if ((r_ -= T_PW) < T_PO) { W_ = w_pool_out; WT_ = WpoT; K_ = PW; N_ = D; mode_ = 0; } \
                else if ((r_ -= T_PO) < T_GL) { W_ = w_glu; WT_ = WgluT; K_ = SW; N_ = 2 * D; mode_ = 1; } \
                else if ((r_ -= T_GL) < T_OUT) { W_ = w_out; WT_ = WoutT; K_ = D; N_ = D; mode_ = 0; } \
                else if ((r_ -= T_OUT) < T_W1) { const int e_ = r_ / T_W1E; r_ -= e_ * T_W1E; W_ = w1 + (size_t)e_ * D * 2 * FE; WT_ = W1T + (size_t)e_ * D * 2 * FE; K_ = D; N_ = 2 * FE; mode_ = 1; } \
                else { r_ -= T_W1; const int e_ = r_ / T_W2E; r_ -= e_ * T_W2E; W_ = w2 + (size_t)e_ * FE * D; WT_ = W2T + (size_t)e_ * FE * D; K_ = FE; N_ = D; mode_ = 0; } \
                const int nblk_ = N_ >> 8; k0_ = (r_ / nblk_) * 64; n0_ = (r_ % nblk_) * 256; } while (0)
#define TR_LOAD(reg_, W_, N_, k0_, n0_) do { const float* p_ = W_ + (size_t)(k0_ + 8 * wave) * N_ + n0_ + 4 * lane; \
                _Pragma("unroll") for (int i_ = 0; i_ < 8; ++i_) reg_[i_] = *(const f32x4*)(p_ + (size_t)i_ * N_); } while (0)
#define TR_PUT(reg_, buf_) do { _Pragma("unroll") for (int j_ = 0; j_ < 4; ++j_) { v4u o_; o_.x = cvt_pk_bf16(reg_[0][j_], reg_[1][j_]); o_.y = cvt_pk_bf16(reg_[2][j_], reg_[3][j_]); \
                o_.z = cvt_pk_bf16(reg_[4][j_], reg_[5][j_]); o_.w = cvt_pk_bf16(reg_[6][j_], reg_[7][j_]); *(LAS v4u*)(lds + RING_OFF + (buf_) * TRB + (4 * lane + j_) * 144 + 16 * wave) = o_; } } while (0)
#define TR_FLUSH(buf_, WT_, K_, N_, mode_, k0_, n0_) do { _Pragma("unroll") for (int p_ = 0; p_ < 4; ++p_) { const int n_ = 64 * p_ + (tid >> 3), c_ = tid & 7; \
                const v4u q_ = *(const LAS v4u*)(lds + RING_OFF + (buf_) * TRB + n_ * 144 + 16 * c_); const int gn_ = n0_ + n_; int drow_ = gn_; \
                if (mode_) { const int half_ = N_ >> 1, hi_ = gn_ >= half_ ? 1 : 0, nn_ = gn_ - hi_ * half_; drow_ = (nn_ >> 7) * 256 + hi_ * 128 + (nn_ & 127); } \
                *(v4u*)(WT_ + (size_t)drow_ * K_ + k0_ + 8 * c_) = q_; } } while (0)
#define TR_BAR() do { LDS_WAIT(); __builtin_amdgcn_s_barrier(); asm volatile("" ::: "memory"); } while (0)
            int itA = vcu, itB = vcu + G;
            const float *WA = nullptr, *WB = nullptr; bf16 *TA = nullptr, *TB = nullptr; int KA = 0, NA = 0, mA = 0, kA = 0, nA = 0, KB = 0, NB = 0, mB = 0, kB = 0, nB = 0;
            f32x4 ra[8], rb[8];
            if (itA < NTILES) { TR_DECODE(itA, WA, TA, KA, NA, mA, kA, nA); TR_LOAD(ra, WA, NA, kA, nA); }
            if (itB < NTILES) { TR_DECODE(itB, WB, TB, KB, NB, mB, kB, nB); TR_LOAD(rb, WB, NB, kB, nB); }
            while (itA < NTILES) {
                TR_PUT(ra, 0);
                { bf16* dT = TA; const int dK = KA, dN = NA, dm = mA, dk = kA, dn = nA;
                  itA += 2 * G; if (itA < NTILES) { TR_DECODE(itA, WA, TA, KA, NA, mA, kA, nA); TR_LOAD(ra, WA, NA, kA, nA); }
                  TR_BAR();
                  TR_FLUSH(0, dT, dK, dN, dm, dk, dn); }
                if (itB >= NTILES) break;
                TR_PUT(rb, 1);
                { bf16* dT = TB; const int dK = KB, dN = NB, dm = mB, dk = kB, dn = nB;
                  itB += 2 * G; if (itB < NTILES) { TR_DECODE(itB, WB, TB, KB, NB, mB, kB, nB); TR_LOAD(rb, WB, NB, kB, nB); }
                  TR_BAR();
                  TR_FLUSH(1, dT, dK, dN, dm, dk, dn); }
            }
            __syncthreads();
#undef TR_DECODE
#undef TR_LOAD
#undef TR_PUT
#undef TR_FLUSH
#undef TR_BAR
        }
        if (BOTH(1)) GRID_BAR();
    }

    if (IN(2)) {
        SchedDense S; S.init(XN, WinT, T, INW, D, D, G, bx);
        EpiZ E{UP, UG, SGP, SGS};
        pg8::gemm_phase<EpiZ, SchedDense, false>(lds + RING_OFF, D, D, D, S, E);
        if (DUPSEL == 2) { pg8::gemm_phase<EpiZ, SchedDense, false>(lds + RING_OFF, D, D, D, S, E); }
        if (BOTH(2)) GRID_BAR();
    }

    if (IN(3)) for (int rep_ = 0; rep_ < REP(3); ++rep_) {
        for (int it = gw; it < BATCH * 128 * 4; it += NGW) {
            const int gq = it & 3, tb = (it >> 2) & 127, b = it >> 9, w = 2 << gq, oct = lane & 31, th = lane >> 5, t0 = tb * 32 + th * 16;
            const bf16* up = UP + (size_t)b * SEQ * PW + gq * 256 + oct * 8; bf16* pl = PL + (size_t)b * SEQ * PW + gq * 256 + oct * 8;
            float Sx[8];
#pragma unroll
            for (int j = 0; j < 8; ++j) Sx[j] = 0.f;
            for (int jj = w - 1; jj >= 1; --jj) { const int tp = t0 - jj; if (tp >= 0) { const v4u q = *(const v4u*)(up + (size_t)tp * PW);
                Sx[0] += bf_lo(q.x); Sx[1] += bf_hi(q.x); Sx[2] += bf_lo(q.y); Sx[3] += bf_hi(q.y); Sx[4] += bf_lo(q.z); Sx[5] += bf_hi(q.z); Sx[6] += bf_lo(q.w); Sx[7] += bf_hi(q.w); } }
            for (int tt = 0; tt < 16; ++tt) { const int tp = t0 + tt; const v4u q = *(const v4u*)(up + (size_t)tp * PW);
                float uu[8] = {bf_lo(q.x), bf_hi(q.x), bf_lo(q.y), bf_hi(q.y), bf_lo(q.z), bf_hi(q.z), bf_lo(q.w), bf_hi(q.w)};
                const float cnt = (float)((tp + 1) < w ? (tp + 1) : w); float o[8];
#pragma unroll
                for (int j = 0; j < 8; ++j) { Sx[j] += uu[j]; o[j] = Sx[j] / cnt - uu[j]; }
                v4u ov; ov.x = cvt_pk_bf16(o[0], o[1]); ov.y = cvt_pk_bf16(o[2], o[3]); ov.z = cvt_pk_bf16(o[4], o[5]); ov.w = cvt_pk_bf16(o[6], o[7]);
                *(v4u*)(pl + (size_t)tp * PW) = ov;
                const int tq = tp - w + 1; if (tq >= 0) { const v4u q2 = *(const v4u*)(up + (size_t)tq * PW);
                    Sx[0] -= bf_lo(q2.x); Sx[1] -= bf_hi(q2.x); Sx[2] -= bf_lo(q2.y); Sx[3] -= bf_hi(q2.y); Sx[4] -= bf_lo(q2.z); Sx[5] -= bf_hi(q2.z); Sx[6] -= bf_lo(q2.w); Sx[7] -= bf_hi(q2.w); } }
        }
        __syncthreads();
        SchedGrouped S; S.init(UG, WendT, UGK, (size_t)1024 * UGK * 2, (size_t)256 * 256 * 2, 4, SG, G, vcu);
        EpiS1 E{EB};
        pg8::gemm_phase<EpiS1, SchedGrouped, false>(lds + RING_OFF, UGK, 256, 256, S, E);
        if (BOTH(3)) GRID_BAR();
    }

    if (IN(4)) for (int rep_ = 0; rep_ < REP(4); ++rep_) {
        if (wave == 0) {
            for (int it = vcu; it < BATCH * SG; it += G) {
                const int b = it >> 6, g = it & 63, p = lane; const float ar = AL[(g * SP + p) * 2], ai = AL[(g * SP + p) * 2 + 1];
                float xr = 0.f, xi = 0.f; const size_t rb = (size_t)g * 1024 + b * 256;
#pragma unroll 8
                for (int c = 0; c < NCH; ++c) { const float er = EB[(rb + c) * 128 + p], ei = EB[(rb + c) * 128 + 64 + p];
                    UG[(rb + c) * UGK + 256 + p] = (bf16)(cvt_pk_bf16(xr, 0.f) & 0xffffu); UG[(rb + c) * UGK + 320 + p] = (bf16)(cvt_pk_bf16(xi, 0.f) & 0xffffu);
                    const float nr = ar * xr - ai * xi + er, ni = ar * xi + ai * xr + ei; xr = nr; xi = ni; }
            }
        }
        SchedGrouped S; S.init(PL, PoolWT, PW, (size_t)256 * 2, (size_t)256 * 256 * 2, T / 256, 4, G, vcu);
        EpiPmix E{PM, pool_scale};
        pg8::gemm_phase<EpiPmix, SchedGrouped, false>(lds + RING_OFF, PW, 256, 256, S, E);
        if (BOTH(4)) GRID_BAR();
    }

    if (IN(5)) for (int rep_ = 0; rep_ < REP(5); ++rep_) {
        { SchedGrouped S; S.init(UG, TG, UGK, (size_t)1024 * UGK * 2, (size_t)256 * UGK * 2, 4, SG, G, vcu);
          EpiS3 E{YS};
          pg8::gemm_phase<EpiS3, SchedGrouped, false>(lds + RING_OFF, UGK, UGK, UGK, S, E); }
        { SchedDense S; S.init(PM, WpoT, T, D, PW, PW, G, bx);
          EpiYpool E{YPG, SGP};
          pg8::gemm_phase<EpiYpool, SchedDense, false>(lds + RING_OFF, PW, PW, PW, S, E); }
        if (BOTH(5)) GRID_BAR();
    }

    if (IN(6)) {
        SchedDense S; S.init(YS, WgluT, T, 2 * D, SW, SW, G, bx);
        EpiGlu E{MG, YPG, SGS, b_glu};
        pg8::gemm_phase<EpiGlu, SchedDense, false>(lds + RING_OFF, SW, SW, SW, S, E);
        if (DUPSEL == 6) { pg8::gemm_phase<EpiGlu, SchedDense, false>(lds + RING_OFF, SW, SW, SW, S, E); }
        if (BOTH(6)) GRID_BAR();
    }

    if (IN(7)) {
        SchedDense S; S.init(MG, WoutT, T, D, D, D, G, bx);
        EpiOut E{X1, x, MOD};
        pg8::gemm_phase<EpiOut, SchedDense, false>(lds + RING_OFF, D, D, D, S, E);
        if (DUPSEL == 7) { pg8::gemm_phase<EpiOut, SchedDense, false>(lds + RING_OFF, D, D, D, S, E); }
        if (BOTH(7)) GRID_BAR();
    }

    if (IN(8)) for (int rep_ = 0; rep_ < REP(8); ++rep_) {
        LAS float* HT = (LAS float*)(lds + RING_OFF);
        LAS float* RED = (LAS float*)(lds + RING_OFF + 65792);
        LAS float* LG = (LAS float*)(lds + RING_OFF + 98560);
        LAS int* HIST = (LAS int*)(lds + RING_OFF + 102784);
        LAS int* BASE = (LAS int*)(lds + RING_OFF + 102912);
        for (int tile = vcu; tile < T / 32; tile += G) {
            const int R0 = tile * 32, b = R0 >> 12; const float* mb = MOD + (size_t)b * 6 * D;
            f32x4 v[4][8];
#pragma unroll
            for (int rr = 0; rr < 4; ++rr) { const int row = R0 + 4 * wave + rr; const float* xr = X1 + (size_t)row * D + 4 * lane; float ss = 0.f;
#pragma unroll
                for (int j = 0; j < 8; ++j) { v[rr][j] = *(const f32x4*)(xr + 256 * j); ss += v[rr][j][0] * v[rr][j][0] + v[rr][j][1] * v[rr][j][1] + v[rr][j][2] * v[rr][j][2] + v[rr][j][3] * v[rr][j][3]; }
                const float rstd = 1.0f / sqrtf(wave_sum(ss) * (1.0f / D) + RMS_EPS);
#pragma unroll
                for (int j = 0; j < 8; ++j) { const int k = 4 * lane + 256 * j; const f32x4 g = *(const f32x4*)(norm2_g + k), sh = *(const f32x4*)(mb + 3 * D + k), sc = *(const f32x4*)(mb + 4 * D + k);
                    v[rr][j] = v[rr][j] * rstd * g * (sc + 1.0f) + sh; v2u o; o.x = cvt_pk_bf16(v[rr][j][0], v[rr][j][1]); o.y = cvt_pk_bf16(v[rr][j][2], v[rr][j][3]); *(v2u*)(XN + (size_t)row * D + k) = o; } }
            if (tid < 32) HIST[tid] = 0;
            f32x16 lacc;
#pragma unroll
            for (int j = 0; j < 16; ++j) lacc[j] = 0.f;
#pragma unroll
            for (int q = 0; q < 4; ++q) {
                __syncthreads();
#pragma unroll
                for (int rr = 0; rr < 4; ++rr)
#pragma unroll
                    for (int jj = 0; jj < 2; ++jj) { const int lk = 4 * lane + 256 * jj; LAS float* hp = HT + (4 * wave + rr) * 513 + lk; const f32x4 q4 = v[rr][2 * q + jj]; hp[0] = q4[0]; hp[1] = q4[1]; hp[2] = q4[2]; hp[3] = q4[3]; }
                __syncthreads();
                const float* wrp = w_router + (size_t)(q * 512 + 64 * wave + (lane >> 5)) * NE + (lane & 31); const LAS float* ap = HT + (lane & 31) * 513 + 64 * wave + (lane >> 5);
#pragma unroll 8
                for (int s = 0; s < 32; ++s) lacc = __builtin_amdgcn_mfma_f32_32x32x2f32(ap[2 * s], wrp[(size_t)2 * s * NE], lacc, 0, 0, 0);
            }
#pragma unroll
            for (int rg = 0; rg < 16; ++rg) { const int i = (rg & 3) + 8 * (rg >> 2) + 4 * (lane >> 5); RED[(wave * 32 + i) * 32 + (lane & 31)] = lacc[rg]; }
            __syncthreads();
#pragma unroll
            for (int pp = 0; pp < 2; ++pp) { const int p = tid + pp * 512, i = p >> 5, j = p & 31; float s = b_router[j];
#pragma unroll
                for (int w = 0; w < 8; ++w) s += RED[(w * 32 + i) * 32 + j];
                LG[i * 33 + j] = s; }
            __syncthreads();
            int idx[4] = {0, 0, 0, 0}; float wv[4] = {0.f, 0.f, 0.f, 0.f}; int lrk[4] = {0, 0, 0, 0};
            if (tid < 32) {
                unsigned chosen = 0u; float val[4];
#pragma unroll
                for (int k = 0; k < 4; ++k) { float best = -3.0e38f; int bi = 0;
                    for (int j = 0; j < NE; ++j) { const float xv = LG[tid * 33 + j]; if (!((chosen >> j) & 1u) && xv > best) { best = xv; bi = j; } }
                    val[k] = best; idx[k] = bi; chosen |= 1u << bi; }
                float den = 0.f;
#pragma unroll
                for (int k = 0; k < 4; ++k) { wv[k] = expf(val[k] - val[0]); den += wv[k]; }
#pragma unroll
                for (int k = 0; k < 4; ++k) { wv[k] /= den; lrk[k] = atomicAdd((int*)&HIST[idx[k]], 1); }
            }
            __syncthreads();
            if (tid < 32) { const int c = HIST[tid]; BASE[tid] = c ? (int)__hip_atomic_fetch_add((unsigned*)(ctl + CW_CNT + tid), (unsigned)c, RLX_AGENT) : 0; }
            __syncthreads();
            if (tid < 32) { const int tok = R0 + tid;
#pragma unroll
                for (int k = 0; k < 4; ++k) { const int e = idx[k], rank = BASE[e] + lrk[k]; LTOK[(size_t)e * LCAP + rank] = tok; LWT[(size_t)e * LCAP + rank] = wv[k]; TSLOT[tok * 4 + k] = e * LCAP + rank; } }
            __syncthreads();
        }
        if (BOTH(8)) GRID_BAR();
    }

#define MOE_TABLES(nN_) do { __syncthreads(); if (tid == 0) { unsigned us = 0u, pb = 0u; for (int e = 0; e < NE; ++e) { const unsigned c = __hip_atomic_load(ctl + CW_CNT + e, RLX_AGENT); const unsigned nb = (c + 255u) >> 8; \
        MISC[32 + e] = us; MISC[80 + e] = pb; MISC[128 + e] = c; us += nb * (unsigned)(nN_); pb += nb; } MISC[32 + NE] = us; MISC[80 + NE] = pb; MISC[176] = us; } __syncthreads(); } while (0)

    if (IN(9)) {
        MOE_TABLES(2 * FE / 256);
        SchedMoe S; S.A = (const char*)XN; S.Bt = (const char*)W1T; S.astep = 0; S.bstep_e = (size_t)2 * FE * D * 2; S.bstep_n = (size_t)256 * D * 2; S.nN = 2 * FE / 256; S.G = G; S.c = vcu; S.M = MISC; S.ltok = LTOK; S.gather = true;
        EpiMoe1 E{ACT, b1};
        pg8::gemm_phase<EpiMoe1, SchedMoe, true>(lds + RING_OFF, D, D, D, S, E);
        if (DUPSEL == 9) { pg8::gemm_phase<EpiMoe1, SchedMoe, true>(lds + RING_OFF, D, D, D, S, E); }
        if (BOTH(9)) GRID_BAR();
    }

    if (IN(10)) {
        MOE_TABLES(D / 256);
        SchedMoe S; S.A = (const char*)ACT; S.Bt = (const char*)W2T; S.astep = (size_t)256 * FE * 2; S.bstep_e = (size_t)D * FE * 2; S.bstep_n = (size_t)256 * FE * 2; S.nN = D / 256; S.G = G; S.c = vcu; S.M = MISC; S.ltok = LTOK; S.gather = false;
        EpiMoe2 E{YE, b2, LWT};
        pg8::gemm_phase<EpiMoe2, SchedMoe, false>(lds + RING_OFF, FE, FE, FE, S, E);
        if (DUPSEL == 10) { pg8::gemm_phase<EpiMoe2, SchedMoe, false>(lds + RING_OFF, FE, FE, FE, S, E); }
        if (BOTH(10)) GRID_BAR();
    }

    if (IN(11)) for (int rep_ = 0; rep_ < REP(11); ++rep_) {
        MOE_TABLES(1);
        for (int row = gw; row < T; row += NGW) {
            const int b = row >> 12; const float* mb = MOD + (size_t)b * 6 * D; const float* fb = FMOD + (size_t)b * 2 * D;
            size_t prow[4];
#pragma unroll
            for (int k = 0; k < 4; ++k) { const int s = TSLOT[row * 4 + k]; const int e = s >> 14, rank = s & (LCAP - 1); prow[k] = ((size_t)MISC[80 + e] * 256 + rank) * D; }
            f32x4 v[8]; float ss = 0.f;
#pragma unroll
            for (int j = 0; j < 8; ++j) { const int k = 4 * lane + 256 * j; f32x4 f = {0.f, 0.f, 0.f, 0.f};
#pragma unroll
                for (int kk = 0; kk < 4; ++kk) { const v2u y = *(const v2u*)(YE + prow[kk] + k); f[0] += bf_lo(y.x); f[1] += bf_hi(y.x); f[2] += bf_lo(y.y); f[3] += bf_hi(y.y); }
                const f32x4 gt = *(const f32x4*)(mb + 5 * D + k); v[j] = *(const f32x4*)(X1 + (size_t)row * D + k) + gt * f;
                ss += v[j][0] * v[j][0] + v[j][1] * v[j][1] + v[j][2] * v[j][2] + v[j][3] * v[j][3]; }
            const float rstd = 1.0f / sqrtf(wave_sum(ss) * (1.0f / D) + RMS_EPS);
#pragma unroll
            for (int j = 0; j < 8; ++j) { const int k = 4 * lane + 256 * j; const f32x4 g = *(const f32x4*)(fnorm_g + k), sh = *(const f32x4*)(fb + k), sc = *(const f32x4*)(fb + D + k);
                *(f32x4*)(out + (size_t)row * D + k) = v[j] * rstd * g * (sc + 1.0f) + sh; }
        }
    }
#undef IN
#undef BOTH
}

extern "C" void kernel_launch(void* const* d_in, const int* in_sizes, int n_in, void* d_out, int out_size, void* d_ws, size_t ws_size, hipStream_t stream) {
    static int grid = 0;
    if (grid == 0) {
        if (n_in != 30 || out_size != T * D || ws_size < WS_END) { fprintf(stderr, "kernel_launch: unexpected shapes (n_in %d, out %d, ws %zu); nothing launched\n", n_in, out_size, ws_size); grid = -1; return; }
        int dev = 0, cus = 0, per_cu = 0;
        if (hipGetDevice(&dev) != hipSuccess || hipDeviceGetAttribute(&cus, hipDeviceAttributeMultiprocessorCount, dev) != hipSuccess) { grid = -1; return; }
        if (hipFuncSetAttribute((const void*)fwd_kernel, hipFuncAttributeMaxDynamicSharedMemorySize, LDS_BYTES) != hipSuccess) { fprintf(stderr, "kernel_launch: hipFuncSetAttribute failed\n"); grid = -1; return; }
        if (hipOccupancyMaxActiveBlocksPerMultiprocessor(&per_cu, (const void*)fwd_kernel, NWAVES * 64, LDS_BYTES) != hipSuccess || per_cu < 1)
            fprintf(stderr, "kernel_launch: note: occupancy query reports %d workgroups per CU\n", per_cu);
        (void)hipGetLastError();
        grid = cus;
    }
    if (grid < 0) return;
    if (hipMemsetAsync((char*)d_ws + WS_CTL, 0, CTL_ZERO_BYTES, stream) != hipSuccess) { fprintf(stderr, "kernel_launch: hipMemsetAsync failed\n"); return; }
    Args a{};
    for (int i = 0; i < 30; ++i) a.in[i] = d_in[i];
    a.out = (float*)d_out; a.ws = (unsigned char*)d_ws;
    for (int li = 0; li < N_LAUNCHES; ++li) {
        if (N_LAUNCHES == 1) { a.ph_lo = 0; a.ph_hi = NPH; } else { a.ph_lo = li; a.ph_hi = li + 1; }
        a.li = li; a.pad = 0;
        hipLaunchKernelGGL(fwd_kernel, dim3(grid), dim3(NWAVES * 64), LDS_BYTES, stream, a);
        const hipError_t le = hipPeekAtLastError();
        if (le != hipSuccess) { fprintf(stderr, "kernel_launch: launch %d failed: %s\n", li, hipGetErrorName(le)); break; }
    }
}
```

```cpp
#include <hip/hip_runtime.h>
#include <cstdio>
#include <cstdint>

namespace pg8 {
#define PG8_LAS __attribute__((address_space(3)))
typedef unsigned short bf16_t;
typedef short bf16x8 __attribute__((ext_vector_type(8)));
typedef float f32x4 __attribute__((ext_vector_type(4)));
typedef float f32x2 __attribute__((ext_vector_type(2)));
typedef unsigned u32x4 __attribute__((ext_vector_type(4)));
typedef int i32x4 __attribute__((ext_vector_type(4)));
typedef int i32x8 __attribute__((ext_vector_type(8)));
constexpr int BM = 256, BK = 64, HALF = 128, HTB = HALF * BK * 2, STAGE_BYTES = 8 * HTB, NXCD = 8, WGM = 8;

__host__ __device__ __forceinline__ int lds_byte(int r, int c) { const int st = (r >> 4) * 2 + (c >> 5), rr = r & 15, cc = c & 31, ob = rr * 64 + cc * 2; return st * 1024 + (ob ^ (((ob >> 9) & 1) << 5)); }
__host__ __device__ __forceinline__ void stage_rc(int b, int& R, int& C) { const int st = b / 1024, sb = b % 1024, swz = sb ^ (((sb >> 9) & 1) << 5); R = (st >> 1) * 16 + swz / 64; C = (st & 1) * 32 + (swz % 64) / 2; }
__host__ __device__ __forceinline__ int perm32(int rho) { const int n = rho >> 4, i = rho & 15; return 8 * (i >> 2) + 4 * n + (i & 3); }

struct Unit { int pm, pn, e, rb, nvalid; };

__device__ __forceinline__ unsigned cvt_pk_bf16(float lo, float hi) { unsigned r; asm volatile("v_cvt_pk_bf16_f32 %0, %1, %2" : "=v"(r) : "v"(lo), "v"(hi)); return r; }
__device__ __forceinline__ unsigned pk4_fp8(float a, float b, float c, float d) {
    a = __builtin_amdgcn_fmed3f(a, -448.f, 448.f); b = __builtin_amdgcn_fmed3f(b, -448.f, 448.f); c = __builtin_amdgcn_fmed3f(c, -448.f, 448.f); d = __builtin_amdgcn_fmed3f(d, -448.f, 448.f);
    int w = 0; w = __builtin_amdgcn_cvt_pk_fp8_f32(a, b, w, false); w = __builtin_amdgcn_cvt_pk_fp8_f32(c, d, w, true); return (unsigned)w; }
__device__ __forceinline__ float bf_lo(unsigned w) { return __uint_as_float(w << 16); }
__device__ __forceinline__ float bf_hi(unsigned w) { return __uint_as_float(w & 0xffff0000u); }
__device__ __forceinline__ float sigmoidf_(float x) { return __builtin_amdgcn_rcpf(1.0f + __builtin_amdgcn_exp2f(-1.44269504089f * x)); }
__device__ __forceinline__ float gelu_tanh_(float x) { const float u = 0.7978845608f * (x + 0.044715f * x * x * x); return x * __builtin_amdgcn_rcpf(1.0f + __builtin_amdgcn_exp2f(-2.88539008178f * u)); }

template <class Epi, class Sched, bool GATHER, int ESZ = 2>
__device__ __forceinline__ void gemm_phase(PG8_LAS unsigned char* lds, const int lda, const int ldb, const int K, const Sched& S, const Epi& E) {
    const int tid = threadIdx.x, wid = __builtin_amdgcn_readfirstlane(tid >> 6), lane = tid & 63, wr = wid >> 2, wc = wid & 3, fr = lane & 15, fq = lane >> 4;
    const int nt = (K * ESZ) / (BK * 2);
    unsigned voffA[2], voffB[2], colA[2]; int rowA[2];
#pragma unroll
    for (int i = 0; i < 2; ++i) { int R, C; stage_rc(tid * 16 + i * 8192, R, C); const int Rb = Epi::PERM ? ((R & ~31) + perm32(R & 31)) : R;
        rowA[i] = R; colA[i] = (unsigned)C * 2u; voffA[i] = (unsigned)(R * lda * ESZ + C * 2); voffB[i] = (unsigned)(Rb * ldb * ESZ + C * 2); }
    const size_t kstep = (size_t)(BK * 2);
    const size_t hstepA = GATHER ? (size_t)0 : (size_t)HALF * lda * ESZ;
    const size_t hstepB = (size_t)HALF * ldb * ESZ;
    const unsigned ldsw = (unsigned)wid * 1024u;
    const int aoff = lds_byte(wr * 64 + fr, fq * 8), boff = lds_byte(wc * 32 + fr, fq * 8);
#define PG8_SA(b, h) (((b) * 2 + (h)) * HTB)
#define PG8_SB(b, h) ((4 + (b) * 2 + (h)) * HTB)
#define PG8_STAGE2(bufoff, gbase, o0, o1) do { \
        __builtin_amdgcn_global_load_lds((const unsigned*)((const char*)(gbase) + (o0)), (PG8_LAS unsigned*)(lds + (bufoff) + ldsw), 16, 0, 0); \
        __builtin_amdgcn_global_load_lds((const unsigned*)((const char*)(gbase) + (o1)), (PG8_LAS unsigned*)(lds + (bufoff) + ldsw + 8192), 16, 0, 0); } while (0)
#define PG8_STAGE_B(bufoff, gbase) PG8_STAGE2(bufoff, gbase, voffB[0], voffB[1])
#define PG8_LDA(dst, b, h) do { if constexpr (ESZ == 2) { _Pragma("unroll") for (int m = 0; m < 4; ++m) _Pragma("unroll") for (int k = 0; k < 2; ++k) dst[m][k] = *(const PG8_LAS bf16x8*)(lds + PG8_SA(b, h) + aoff + m * 2048 + k * 1024); } \
        else { _Pragma("unroll") for (int m = 0; m < 4; ++m) { const i32x4 lo_ = *(const PG8_LAS i32x4*)(lds + PG8_SA(b, h) + aoff + m * 2048), hi_ = *(const PG8_LAS i32x4*)(lds + PG8_SA(b, h) + aoff + m * 2048 + 1024); dst##8[m] = __builtin_shufflevector(lo_, hi_, 0, 1, 2, 3, 4, 5, 6, 7); } } } while (0)
#define PG8_LDB(dst, b, h) do { if constexpr (ESZ == 2) { _Pragma("unroll") for (int n = 0; n < 2; ++n) _Pragma("unroll") for (int k = 0; k < 2; ++k) dst[n][k] = *(const PG8_LAS bf16x8*)(lds + PG8_SB(b, h) + boff + n * 2048 + k * 1024); } \
        else { _Pragma("unroll") for (int n = 0; n < 2; ++n) { const i32x4 lo_ = *(const PG8_LAS i32x4*)(lds + PG8_SB(b, h) + boff + n * 2048), hi_ = *(const PG8_LAS i32x4*)(lds + PG8_SB(b, h) + boff + n * 2048 + 1024); dst##8[n] = __builtin_shufflevector(lo_, hi_, 0, 1, 2, 3, 4, 5, 6, 7); } } } while (0)
#define PG8_MMA(ai, bj, At, Bt) do { __builtin_amdgcn_s_setprio(1); \
        if constexpr (ESZ == 2) { _Pragma("unroll") for (int m = 0; m < 4; ++m) _Pragma("unroll") for (int n = 0; n < 2; ++n) _Pragma("unroll") for (int k = 0; k < 2; ++k) \
            acc[ai][bj][m][n] = __builtin_amdgcn_mfma_f32_16x16x32_bf16(Bt[n][k], At[m][k], acc[ai][bj][m][n], 0, 0, 0); } \
        else {   \
            asm volatile("s_nop 3\n\t" \
                "v_mfma_f32_16x16x128_f8f6f4 %0, %8, %10, %0\n\t" "v_mfma_f32_16x16x128_f8f6f4 %1, %9, %10, %1\n\t" \
                "v_mfma_f32_16x16x128_f8f6f4 %2, %8, %11, %2\n\t" "v_mfma_f32_16x16x128_f8f6f4 %3, %9, %11, %3\n\t" \
                "v_mfma_f32_16x16x128_f8f6f4 %4, %8, %12, %4\n\t" "v_mfma_f32_16x16x128_f8f6f4 %5, %9, %12, %5\n\t" \
                "v_mfma_f32_16x16x128_f8f6f4 %6, %8, %13, %6\n\t" "v_mfma_f32_16x16x128_f8f6f4 %7, %9, %13, %7" \
                : "+v"(acc[ai][bj][0][0]), "+v"(acc[ai][bj][0][1]), "+v"(acc[ai][bj][1][0]), "+v"(acc[ai][bj][1][1]), "+v"(acc[ai][bj][2][0]), "+v"(acc[ai][bj][2][1]), "+v"(acc[ai][bj][3][0]), "+v"(acc[ai][bj][3][1]) \
                : "v"(Bt##8[0]), "v"(Bt##8[1]), "v"(At##8[0]), "v"(At##8[1]), "v"(At##8[2]), "v"(At##8[3])); } \
        __builtin_amdgcn_s_setprio(0); } while (0)
#define PG8_WAIT_V(n) asm volatile("s_waitcnt vmcnt(" #n ")" ::: "memory")
#define PG8_WAIT_L(n) asm volatile("s_waitcnt lgkmcnt(" #n ")" ::: "memory")
#define PG8_BAR __builtin_amdgcn_s_barrier()
#define PG8_SCHED __builtin_amdgcn_sched_barrier(0)
    Unit cur, nxt; int ui = 0;
    if (!S.next(0, cur)) return;
    f32x4 acc[2][2][4][2];
#pragma unroll
    for (int a = 0; a < 2; ++a)
#pragma unroll
        for (int b = 0; b < 2; ++b)
#pragma unroll
            for (int m = 0; m < 4; ++m)
#pragma unroll
                for (int n = 0; n < 2; ++n) acc[a][b][m][n] = (f32x4){0.f, 0.f, 0.f, 0.f};
    bf16x8 At[4][2], B0[2][2], B1[2][2]; i32x8 At8[4], B08[2], B18[2];
    const char* cA = S.a_ptr(cur); const char* cB = S.b_ptr(cur);
    unsigned gcur[2][2], gnxt[2][2];
#pragma unroll
    for (int h = 0; h < 2; ++h)
#pragma unroll
        for (int i = 0; i < 2; ++i) { if constexpr (GATHER) gcur[h][i] = S.a_rowoff(cur, h * HALF + rowA[i]) + colA[i]; else gcur[h][i] = voffA[i]; gnxt[h][i] = gcur[h][i]; }
    PG8_STAGE_B(PG8_SB(0, 0), cB); PG8_STAGE_B(PG8_SB(0, 1), cB + hstepB); PG8_STAGE2(PG8_SA(0, 0), cA, gcur[0][0], gcur[0][1]); PG8_STAGE2(PG8_SA(0, 1), cA + hstepA, gcur[1][0], gcur[1][1]);
    if (wr == 1) PG8_BAR;
    PG8_WAIT_V(2); PG8_BAR;
    PG8_STAGE_B(PG8_SB(1, 0), cB + kstep); PG8_STAGE2(PG8_SA(1, 0), cA + kstep, gcur[0][0], gcur[0][1]); PG8_STAGE_B(PG8_SB(1, 1), cB + hstepB + kstep);
    PG8_WAIT_V(6); PG8_BAR;
    for (;;) {
        const bool has_next = S.next(ui + 1, nxt);
        const char* nA = has_next ? S.a_ptr(nxt) : cA; const char* nB = has_next ? S.b_ptr(nxt) : cB;
#pragma unroll 1
        for (int t = 0; t < nt; t += 2) {
            const bool last = (t == nt - 2);
            const char* a1 = cA + (size_t)(t + 1) * kstep;
            const char* a2 = last ? nA : cA + (size_t)(t + 2) * kstep; const char* b2 = last ? nB : cB + (size_t)(t + 2) * kstep;
            const char* a3 = a2 + kstep; const char* b3 = b2 + kstep;
            if constexpr (GATHER) {
                if (last && has_next) {
#pragma unroll
                    for (int h = 0; h < 2; ++h)
#pragma unroll
                        for (int i = 0; i < 2; ++i) gnxt[h][i] = S.a_rowoff(nxt, h * HALF + rowA[i]) + colA[i];
                    asm volatile("" : "+v"(gnxt[0][0]), "+v"(gnxt[0][1]), "+v"(gnxt[1][0]), "+v"(gnxt[1][1]));
                }
            }
            unsigned o2[2][2];
#pragma unroll
            for (int h = 0; h < 2; ++h)
#pragma unroll
                for (int i = 0; i < 2; ++i) { if constexpr (GATHER) o2[h][i] = last ? gnxt[h][i] : gcur[h][i]; else o2[h][i] = voffA[i]; }
            PG8_LDB(B0, 0, 0); PG8_LDB(B1, 0, 1); PG8_SCHED; PG8_LDA(At, 0, 0); PG8_STAGE2(PG8_SA(1, 1), a1 + hstepA, gcur[1][0], gcur[1][1]);
            PG8_WAIT_V(8); PG8_WAIT_L(0); PG8_BAR; PG8_MMA(0, 0, At, B0); PG8_MMA(0, 1, At, B1); PG8_BAR; PG8_SCHED;
            PG8_LDA(At, 0, 1); PG8_STAGE_B(PG8_SB(0, 0), b2); PG8_STAGE_B(PG8_SB(0, 1), b2 + hstepB); PG8_STAGE2(PG8_SA(0, 0), a2, o2[0][0], o2[0][1]);
            PG8_WAIT_V(8); PG8_WAIT_L(0); PG8_BAR; PG8_MMA(1, 0, At, B0); PG8_MMA(1, 1, At, B1); PG8_BAR; PG8_SCHED;
            PG8_LDB(B0, 1, 0); PG8_LDB(B1, 1, 1); PG8_SCHED; PG8_LDA(At, 1, 0); PG8_STAGE2(PG8_SA(0, 1), a2 + hstepA, o2[1][0], o2[1][1]);
            PG8_WAIT_V(8); PG8_WAIT_L(0); PG8_BAR; PG8_MMA(0, 0, At, B0); PG8_MMA(0, 1, At, B1); PG8_BAR; PG8_SCHED;
            PG8_LDA(At, 1, 1); PG8_STAGE_B(PG8_SB(1, 0), b3); PG8_STAGE_B(PG8_SB(1, 1), b3 + hstepB); PG8_STAGE2(PG8_SA(1, 0), a3, o2[0][0], o2[0][1]);
            PG8_WAIT_V(8); PG8_WAIT_L(0); PG8_BAR; PG8_MMA(1, 0, At, B0); PG8_MMA(1, 1, At, B1); PG8_BAR; PG8_SCHED;
        }
        if (wr == 0) PG8_BAR;
        if constexpr (ESZ == 1) asm volatile("s_nop 15\n\ts_nop 15" ::: "memory");
        E(acc, cur, wr, wc, fr, fq);
        if (!has_next) break;
#pragma unroll
        for (int a = 0; a < 2; ++a)
#pragma unroll
            for (int b = 0; b < 2; ++b)
#pragma unroll
                for (int m = 0; m < 4; ++m)
#pragma unroll
                    for (int n = 0; n < 2; ++n) acc[a][b][m][n] = (f32x4){0.f, 0.f, 0.f, 0.f};
        cur = nxt; cA = nA; cB = nB; ++ui;
#pragma unroll
        for (int h = 0; h < 2; ++h)
#pragma unroll
            for (int i = 0; i < 2; ++i) gcur[h][i] = gnxt[h][i];
        if (wr == 1) PG8_BAR;
    }
    PG8_WAIT_V(0);
    PG8_BAR;
#undef PG8_SA
#undef PG8_SB
#undef PG8_STAGE2
#undef PG8_STAGE_B
#undef PG8_LDA
#undef PG8_LDB
#undef PG8_MMA
#undef PG8_WAIT_V
#undef PG8_WAIT_L
#undef PG8_BAR
#undef PG8_SCHED
}
}

constexpr int NWAVES = 8;
#ifndef MK_N_LAUNCHES
#define MK_N_LAUNCHES 1
#endif
constexpr int NPH = 12;
constexpr int N_LAUNCHES = MK_N_LAUNCHES;

constexpr int BATCH = 4, SEQ = 4096, D = 2048, T = BATCH * SEQ;
constexpr int PW = 1024, SW = 1024, INW = PW + SW + 2 * D;
constexpr int NE = 32, TOPK = 4, FE = 2048;
constexpr int SG = 64, SP = 64, SH = 16, CL = 16, NCH = SEQ / CL;
constexpr int UGK = CL * SH + 2 * SP;
constexpr int LCAP = T;
constexpr int MAXBLK = 288;
constexpr float RMS_EPS = 1e-6f;

constexpr size_t MiB = 1u << 20;
constexpr size_t WS_CTL = 0, CTL_ZERO_BYTES = 1 * MiB;
constexpr size_t WS_MOD = 1 * MiB;
constexpr size_t WS_FMOD = WS_MOD + 196608, WS_AL = WS_MOD + 262144;
constexpr size_t WS_WIN = 2 * MiB, WS_POOLW = 26 * MiB, WS_WPO = 27 * MiB, WS_WGLU = 31 * MiB, WS_WOUT = 39 * MiB, WS_WEND = 47 * MiB, WS_TG = 55 * MiB;
constexpr size_t WS_W1 = 68 * MiB, WS_W2 = 580 * MiB;
constexpr size_t WS_XN = 836 * MiB, WS_UP = 900 * MiB, WS_UG = 932 * MiB, WS_SGP = 980 * MiB, WS_SGS = 1044 * MiB, WS_PL = 1108 * MiB, WS_PM = 1140 * MiB, WS_E = 1172 * MiB;
constexpr size_t WS_YPG = 1204 * MiB, WS_YS = 1268 * MiB, WS_MG = 1300 * MiB, WS_X1 = 1364 * MiB, WS_LTOK = 1492 * MiB, WS_LWT = 1494 * MiB, WS_TSLOT = 1496 * MiB;
constexpr size_t WS_ACT = 1498 * MiB, WS_YE = 1786 * MiB, WS_END = 2074 * MiB;
static_assert(WS_TG + (size_t)SG * 256 * UGK * 2 <= WS_W1 && WS_UG + (size_t)SG * 1024 * UGK * 2 <= WS_SGP && WS_ACT + (size_t)MAXBLK * 256 * FE * 2 <= WS_YE, "d_ws map");
constexpr int CW_TMO = 0, CW_CODE = 1, CW_CNT = 64, CW_BAR = 4096;

constexpr int RING_OFF = 0, RING_BYTES = 131072;
constexpr int LDSCTL_OFF = RING_BYTES, MISC_OFF = LDSCTL_OFF + 320;
constexpr int LDS_BYTES = 147456;

#define GAS __attribute__((address_space(1)))
#define LAS __attribute__((address_space(3)))
typedef unsigned short bf16;
typedef unsigned v4u __attribute__((ext_vector_type(4)));
typedef unsigned v2u __attribute__((ext_vector_type(2)));
typedef float f32x4 __attribute__((ext_vector_type(4)));
typedef float f32x16 __attribute__((ext_vector_type(16)));
typedef GAS unsigned gu32;
#define RLX_AGENT __ATOMIC_RELAXED, __HIP_MEMORY_SCOPE_AGENT
#define LDS_WAIT() asm volatile("s_waitcnt lgkmcnt(0)" ::: "memory")
#define VM_WAIT() asm volatile("s_waitcnt vmcnt(0)" ::: "memory")
using pg8::cvt_pk_bf16; using pg8::pk4_fp8; using pg8::bf_lo; using pg8::bf_hi; using pg8::sigmoidf_; using pg8::gelu_tanh_;

#define XB_TMO      128
#define XB_XCNT(j)  (256  + 64 * (j))
#define XB_XSUB(j)  (1280 + 64 * (j))
#define XB_XGEN(j)  (2304 + 64 * (j))
#define XB_TOP      3328
#define XB_TOPGEN   3392
#define XCD_BAR_WORDS 3456
#define XB_SPIN_CAP (1u << 18)

__device__ __forceinline__ unsigned xb_ld(unsigned* p)              { return __hip_atomic_load(p, __ATOMIC_RELAXED, __HIP_MEMORY_SCOPE_AGENT); }
__device__ __forceinline__ unsigned xb_add(unsigned* p, unsigned v) { return __hip_atomic_fetch_add(p, v, __ATOMIC_RELAXED, __HIP_MEMORY_SCOPE_AGENT); }
__device__ __forceinline__ unsigned xb_xcc_id() { return (unsigned)__builtin_amdgcn_s_getreg((3 << 11) | 20) & 0xFu; }
#define XB_SPIN(cond, bar) do { unsigned _sp = 0; while (cond) { __builtin_amdgcn_s_sleep(1); \
    if ((++_sp & 255u) == 0u) { if (xb_ld(&(bar)[XB_TMO])) break; if (_sp > XB_SPIN_CAP) { atomicAdd(&(bar)[XB_TMO], 1u); break; } } } } while (0)

struct XcdBarrier { unsigned* bar; unsigned x; volatile LAS unsigned* st; };

__device__ __forceinline__ XcdBarrier xcd_barrier_post(unsigned* bar, volatile LAS unsigned* st) {
    XcdBarrier b; b.bar = bar; b.x = xb_xcc_id(); b.st = st;
    if (threadIdx.x == 0) (void)xb_add(&bar[XB_XCNT(b.x)], 1u);
    return b;
}
__device__ __forceinline__ void xcd_barrier_complete(unsigned* bar, unsigned x, unsigned& nloc, unsigned& nx) {
    const unsigned G = gridDim.x * gridDim.y * gridDim.z;
    unsigned sum, cnt, mine, sp = 0u;
    for (;;) {
        sum = 0u; cnt = 0u; mine = 0u;
#pragma unroll
        for (unsigned j = 0; j < 16; ++j) { const unsigned c = xb_ld(&bar[XB_XCNT(j)]); sum += c; cnt += (c > 0u) ? 1u : 0u; mine = (j == x) ? c : mine; }
        if (sum == G) break;
        __builtin_amdgcn_s_sleep(1);
        if ((++sp & 255u) == 0u) { if (xb_ld(&bar[XB_TMO])) break; if (sp > XB_SPIN_CAP) { atomicAdd(&bar[XB_TMO], 1u); break; } }
    }
    nloc = mine > 0u ? mine : 1u; nx = cnt > 0u ? cnt : 1u;
}
__device__ __forceinline__ void xcd_barrier(const XcdBarrier& b) {
    asm volatile("s_waitcnt vmcnt(0)" ::: "memory");
    __syncthreads();
    if (threadIdx.x == 0) {
        unsigned* bar = b.bar;
        __builtin_amdgcn_s_waitcnt(0);
        unsigned nloc = b.st[0], nx = b.st[1];
        if (nloc == 0u) { xcd_barrier_complete(bar, b.x, nloc, nx); b.st[0] = nloc; b.st[1] = nx; }
        const unsigned old = xb_add(&bar[XB_XSUB(b.x)], 1u);
        const unsigned gen = old / nloc;
        if (old + 1u == (gen + 1u) * nloc) {
            __builtin_amdgcn_fence(__ATOMIC_RELEASE, "agent");
            asm volatile("s_waitcnt vmcnt(0)" ::: "memory");
            const unsigned og = xb_add(&bar[XB_TOP], 1u);
            const unsigned tg = og / nx;
            if (og + 1u == (tg + 1u) * nx) xb_add(&bar[XB_TOPGEN], 1u);
            else XB_SPIN(xb_ld(&bar[XB_TOPGEN]) == tg, bar);
            __builtin_amdgcn_fence(__ATOMIC_ACQUIRE, "agent");
            xb_add(&bar[XB_XGEN(b.x)], 1u);
            asm volatile("s_waitcnt vmcnt(0)" ::: "memory");
        } else {
            XB_SPIN(xb_ld(&bar[XB_XGEN(b.x)]) == gen, bar);
            __builtin_amdgcn_fence(__ATOMIC_ACQUIRE, "agent");
            asm volatile("s_waitcnt vmcnt(0)" ::: "memory");
        }
    }
    __syncthreads();
}

using pg8::Unit;
struct SchedDense {
    const char* A; const char* Bt; size_t astep, bstep; int nM, nN, nwg, G, c;
    __device__ __forceinline__ void init(const void* A_, const void* Bt_, int M, int N, int lda, int ldb, int G_, int c_) { A = (const char*)A_; Bt = (const char*)Bt_; astep = (size_t)256 * lda * 2; bstep = (size_t)256 * ldb * 2; nM = M / 256; nN = N / 256; nwg = nM * nN; G = G_; c = c_; }
    __device__ __forceinline__ bool next(int i, Unit& u) const {
        const long L = (long)i * G + c; if (L >= nwg) return false;
        int wgid = (int)L; { const int q = nwg / pg8::NXCD, r = nwg % pg8::NXCD, xcd = wgid % pg8::NXCD, off = wgid / pg8::NXCD; wgid = (xcd < r ? xcd * (q + 1) : r * (q + 1) + (xcd - r) * q) + off; }
        const int nig = pg8::WGM * nN, gid = wgid / nig, fm = gid * pg8::WGM, gsz = (nM - fm) < pg8::WGM ? (nM - fm) : pg8::WGM;
        u.pm = fm + ((wgid % nig) % gsz); u.pn = (wgid % nig) / gsz; u.e = 0; u.rb = 0; u.nvalid = 256; return true;
    }
    __device__ __forceinline__ const char* a_ptr(const Unit& u) const { return A + (size_t)u.pm * astep; }
    __device__ __forceinline__ const char* b_ptr(const Unit& u) const { return Bt + (size_t)u.pn * bstep; }
    __device__ __forceinline__ unsigned a_rowoff(const Unit&, int) const { return 0u; }
};
struct SchedGrouped {
    const char* A; const char* Bt; size_t astep, agstride, bgstride; int nPM, nunits, G, c;
    __device__ __forceinline__ void init(const void* A_, const void* Bt_, int lda, size_t agstride_, size_t bgstride_, int nPM_, int ngroups, int G_, int c_) { A = (const char*)A_; Bt = (const char*)Bt_; astep = (size_t)256 * lda * 2; agstride = agstride_; bgstride = bgstride_; nPM = nPM_; nunits = nPM_ * ngroups; G = G_; c = c_; }
    __device__ __forceinline__ bool next(int i, Unit& u) const { const int L = i * G + c; if (L >= nunits) return false; u.e = L / nPM; u.pm = L % nPM; u.pn = 0; u.rb = 0; u.nvalid = 256; return true; }
    __device__ __forceinline__ const char* a_ptr(const Unit& u) const { return A + (size_t)u.e * agstride + (size_t)u.pm * astep; }
    __device__ __forceinline__ const char* b_ptr(const Unit& u) const { return Bt + (size_t)u.e * bgstride; }
    __device__ __forceinline__ unsigned a_rowoff(const Unit&, int) const { return 0u; }
};
struct SchedMoe {
    const char* A; const char* Bt; size_t astep, bstep_e, bstep_n; int nN, G, c; volatile LAS unsigned* M; const int* ltok; bool gather;
    __device__ __forceinline__ bool next(int i, Unit& u) const {
        const int L = i * G + c; const int total = (int)M[176]; if (L >= total) return false;
        int e = 0;
#pragma unroll 1
        for (int j = 1; j < NE; ++j) e += (L >= (int)M[32 + j]) ? 1 : 0;
        e = __builtin_amdgcn_readfirstlane(e);
        const int w = L - (int)M[32 + e], pb = (int)M[80 + e], nb = (int)M[80 + e + 1] - pb, cnt = (int)M[128 + e];
        int rb = w % nb, pn = w / nb;
        rb = __builtin_amdgcn_readfirstlane(rb); pn = __builtin_amdgcn_readfirstlane(pn);
        u.e = e; u.rb = rb; u.pn = pn; u.pm = __builtin_amdgcn_readfirstlane(pb + rb); const int nv = cnt - rb * 256; u.nvalid = __builtin_amdgcn_readfirstlane(nv < 256 ? nv : 256); return true;
    }
    __device__ __forceinline__ const char* a_ptr(const Unit& u) const { return gather ? A : A + (size_t)u.pm * astep; }
    __device__ __forceinline__ const char* b_ptr(const Unit& u) const { return Bt + (size_t)u.e * bstep_e + (size_t)u.pn * bstep_n; }
    __device__ __forceinline__ unsigned a_rowoff(const Unit& u, int r) const { const int idx = (r < u.nvalid) ? (u.rb * 256 + r) : 0; const int tok = ltok[(size_t)u.e * LCAP + idx]; return (unsigned)tok * (unsigned)D; }
};

using pg8::f32x2; using pg8::u32x4;
#define EPI_ARGS const f32x4 (&acc)[2][2][4][2], const Unit& u, int wr, int wc, int fr, int fq
struct EpiZ { static constexpr bool PERM = true; bf16 *UP, *UG, *SGP, *SGS;
    __device__ __forceinline__ void operator()(EPI_ARGS) const {
        const int pn = u.pn, region = pn < 4 ? 0 : (pn < 8 ? 1 : (pn < 16 ? 2 : 3));
#pragma unroll
        for (int ai = 0; ai < 2; ++ai)
#pragma unroll
            for (int m = 0; m < 4; ++m) { const int row = u.pm * 256 + ai * 128 + wr * 64 + m * 16 + fr;
#pragma unroll
                for (int bj = 0; bj < 2; ++bj) { const int lc = bj * 128 + wc * 32 + 8 * fq; f32x4 v0 = acc[ai][bj][m][0], v1 = acc[ai][bj][m][1];
                    if (region >= 2) {
#pragma unroll
                        for (int j = 0; j < 4; ++j) { v0[j] = sigmoidf_(v0[j]); v1[j] = sigmoidf_(v1[j]); } }
                    u32x4 w; w.x = cvt_pk_bf16(v0[0], v0[1]); w.y = cvt_pk_bf16(v0[2], v0[3]); w.z = cvt_pk_bf16(v1[0], v1[1]); w.w = cvt_pk_bf16(v1[2], v1[3]);
                    bf16* dst;
                    if (region == 0) dst = UP + (size_t)row * PW + pn * 256 + lc;
                    else if (region == 1) { const int j = (pn - 4) * 256 + lc, g = j >> 4, h0 = j & 15, b = row >> 12, tp = row & 4095, c = tp >> 4, s = tp & 15; dst = UG + ((size_t)(g * 1024 + b * 256 + c) * UGK + s * 16 + h0); }
                    else if (region == 2) dst = SGP + (size_t)row * D + (pn - 8) * 256 + lc;
                    else dst = SGS + (size_t)row * D + (pn - 16) * 256 + lc;
                    *(u32x4*)dst = w; } }
    }
};
struct EpiS1 { static constexpr bool PERM = false; float* E;
    __device__ __forceinline__ void operator()(EPI_ARGS) const {
#pragma unroll
        for (int ai = 0; ai < 2; ++ai)
#pragma unroll
            for (int m = 0; m < 4; ++m) { const int row = u.pm * 256 + ai * 128 + wr * 64 + m * 16 + fr; float* rp = E + ((size_t)u.e * 1024 + row) * 128 + wc * 32 + 4 * fq;
#pragma unroll
                for (int n = 0; n < 2; ++n) *(f32x4*)(rp + n * 16) = acc[ai][0][m][n]; }
    }
};
struct EpiPmix { static constexpr bool PERM = true; bf16* PM; const float* scale;
    __device__ __forceinline__ void operator()(EPI_ARGS) const {
#pragma unroll
        for (int bj = 0; bj < 2; ++bj) { const int col = u.e * 256 + bj * 128 + wc * 32 + 8 * fq; const f32x4 s0 = *(const f32x4*)(scale + col), s1 = *(const f32x4*)(scale + col + 4);
#pragma unroll
            for (int ai = 0; ai < 2; ++ai)
#pragma unroll
                for (int m = 0; m < 4; ++m) { const int row = u.pm * 256 + ai * 128 + wr * 64 + m * 16 + fr; const f32x4 v0 = acc[ai][bj][m][0] * s0, v1 = acc[ai][bj][m][1] * s1;
                    u32x4 w; w.x = cvt_pk_bf16(v0[0], v0[1]); w.y = cvt_pk_bf16(v0[2], v0[3]); w.z = cvt_pk_bf16(v1[0], v1[1]); w.w = cvt_pk_bf16(v1[2], v1[3]);
                    *(u32x4*)(PM + (size_t)row * PW + col) = w; } }
    }
};
struct EpiS3 { static constexpr bool PERM = true; bf16* YS;
    __device__ __forceinline__ void operator()(EPI_ARGS) const {
#pragma unroll
        for (int ai = 0; ai < 2; ++ai)
#pragma unroll
            for (int m = 0; m < 4; ++m) { const int r = u.pm * 256 + ai * 128 + wr * 64 + m * 16 + fr, b = r >> 8, c = r & 255;
#pragma unroll
                for (int bj = 0; bj < 2; ++bj) { const int lc = bj * 128 + wc * 32 + 8 * fq, t = lc >> 4, h0 = lc & 15; f32x4 v0 = acc[ai][bj][m][0], v1 = acc[ai][bj][m][1];
#pragma unroll
                    for (int j = 0; j < 4; ++j) { v0[j] = gelu_tanh_(v0[j]); v1[j] = gelu_tanh_(v1[j]); }
                    u32x4 w; w.x = cvt_pk_bf16(v0[0], v0[1]); w.y = cvt_pk_bf16(v0[2], v0[3]); w.z = cvt_pk_bf16(v1[0], v1[1]); w.w = cvt_pk_bf16(v1[2], v1[3]);
                    *(u32x4*)(YS + (size_t)(b * SEQ + c * CL + t) * SW + u.e * 16 + h0) = w; } }
    }
};
struct EpiYpool { static constexpr bool PERM = true; bf16* YPG; const bf16* SGP;
    __device__ __forceinline__ void operator()(EPI_ARGS) const {
#pragma unroll
        for (int ai = 0; ai < 2; ++ai)
#pragma unroll
            for (int m = 0; m < 4; ++m) { const int row = u.pm * 256 + ai * 128 + wr * 64 + m * 16 + fr;
#pragma unroll
                for (int bj = 0; bj < 2; ++bj) { const size_t off = (size_t)row * D + u.pn * 256 + bj * 128 + wc * 32 + 8 * fq; const u32x4 g = *(const u32x4*)(SGP + off);
                    const f32x4 v0 = acc[ai][bj][m][0], v1 = acc[ai][bj][m][1];
                    u32x4 w; w.x = cvt_pk_bf16(v0[0] * bf_lo(g.x), v0[1] * bf_hi(g.x)); w.y = cvt_pk_bf16(v0[2] * bf_lo(g.y), v0[3] * bf_hi(g.y));
                    w.z = cvt_pk_bf16(v1[0] * bf_lo(g.z), v1[1] * bf_hi(g.z)); w.w = cvt_pk_bf16(v1[2] * bf_lo(g.w), v1[3] * bf_hi(g.w));
                    *(u32x4*)(YPG + off) = w; } }
    }
};
struct EpiGlu { static constexpr bool PERM = true; bf16* MG; const bf16 *YPG, *SGS; const float* bglu;
    __device__ __forceinline__ void operator()(EPI_ARGS) const {
        const int j0 = u.pn * 128 + wc * 32 + 8 * fq;
        const f32x4 ba0 = *(const f32x4*)(bglu + j0), ba1 = *(const f32x4*)(bglu + j0 + 4), bb0 = *(const f32x4*)(bglu + D + j0), bb1 = *(const f32x4*)(bglu + D + j0 + 4);
#pragma unroll
        for (int ai = 0; ai < 2; ++ai)
#pragma unroll
            for (int m = 0; m < 4; ++m) { const int row = u.pm * 256 + ai * 128 + wr * 64 + m * 16 + fr; const size_t off = (size_t)row * D + j0;
                const u32x4 yp = *(const u32x4*)(YPG + off), gs = *(const u32x4*)(SGS + off);
                const f32x4 a0 = acc[ai][0][m][0] + ba0, a1 = acc[ai][0][m][1] + ba1, b0 = acc[ai][1][m][0] + bb0, b1 = acc[ai][1][m][1] + bb1;
                float o[8];
#pragma unroll
                for (int j = 0; j < 4; ++j) { o[j] = a0[j] * sigmoidf_(b0[j]); o[4 + j] = a1[j] * sigmoidf_(b1[j]); }
                u32x4 w; w.x = cvt_pk_bf16(bf_lo(yp.x) + bf_lo(gs.x) * o[0], bf_hi(yp.x) + bf_hi(gs.x) * o[1]); w.y = cvt_pk_bf16(bf_lo(yp.y) + bf_lo(gs.y) * o[2], bf_hi(yp.y) + bf_hi(gs.y) * o[3]);
                w.z = cvt_pk_bf16(bf_lo(yp.z) + bf_lo(gs.z) * o[4], bf_hi(yp.z) + bf_hi(gs.z) * o[5]); w.w = cvt_pk_bf16(bf_lo(yp.w) + bf_lo(gs.w) * o[6], bf_hi(yp.w) + bf_hi(gs.w) * o[7]);
                *(u32x4*)(MG + off) = w; }
    }
};
struct EpiOut { static constexpr bool PERM = false; float* X1; const float* x; const float* mod;
    __device__ __forceinline__ void operator()(EPI_ARGS) const {
        const int b = (u.pm * 256) >> 12; const float* gt = mod + (size_t)b * 6 * D + 2 * D;
#pragma unroll
        for (int bj = 0; bj < 2; ++bj)
#pragma unroll
            for (int n = 0; n < 2; ++n) { const int col = u.pn * 256 + bj * 128 + wc * 32 + n * 16 + 4 * fq; const f32x4 g = *(const f32x4*)(gt + col);
#pragma unroll
                for (int ai = 0; ai < 2; ++ai)
#pragma unroll
                    for (int m = 0; m < 4; ++m) { const int row = u.pm * 256 + ai * 128 + wr * 64 + m * 16 + fr; const size_t off = (size_t)row * D + col;
                        *(f32x4*)(X1 + off) = *(const f32x4*)(x + off) + g * acc[ai][bj][m][n]; } }
    }
};
struct EpiMoe1 { static constexpr bool PERM = true; unsigned char* ACT; const float* b1;
    __device__ __forceinline__ void operator()(EPI_ARGS) const {
        const int j0 = u.pn * 128 + wc * 32 + 8 * fq; const float* bb = b1 + (size_t)u.e * 2 * FE;
        const f32x4 ba0 = *(const f32x4*)(bb + j0), ba1 = *(const f32x4*)(bb + j0 + 4), bl0 = *(const f32x4*)(bb + FE + j0), bl1 = *(const f32x4*)(bb + FE + j0 + 4);
#pragma unroll
        for (int ai = 0; ai < 2; ++ai)
#pragma unroll
            for (int m = 0; m < 4; ++m) { const int row = u.pm * 256 + ai * 128 + wr * 64 + m * 16 + fr;
                const f32x4 a0 = acc[ai][0][m][0] * 0.03125f + ba0, a1 = acc[ai][0][m][1] * 0.03125f + ba1, l0 = acc[ai][1][m][0] * 0.03125f + bl0, l1 = acc[ai][1][m][1] * 0.03125f + bl1;
                float o[8];
#pragma unroll
                for (int j = 0; j < 4; ++j) { const float g0 = fminf(a0[j], 7.0f), g1 = fminf(a1[j], 7.0f), x0 = fminf(fmaxf(l0[j], -7.0f), 7.0f), x1 = fminf(fmaxf(l1[j], -7.0f), 7.0f);
                    o[j] = g0 * sigmoidf_(1.702f * g0) * (x0 + 1.0f); o[4 + j] = g1 * sigmoidf_(1.702f * g1) * (x1 + 1.0f); }
                v2u w; w.x = pk4_fp8(o[0], o[1], o[2], o[3]); w.y = pk4_fp8(o[4], o[5], o[6], o[7]);
                *(v2u*)(ACT + (size_t)row * FE + j0) = w; asm volatile("" ::: "memory"); }
    }
};
struct EpiMoe2 { static constexpr bool PERM = true; bf16* YE; const float* b2; const float* lwt;
    __device__ __forceinline__ void operator()(EPI_ARGS) const {
        const float* bb = b2 + (size_t)u.e * D;
#pragma unroll
        for (int ai = 0; ai < 2; ++ai)
#pragma unroll
            for (int m = 0; m < 4; ++m) { const int r = ai * 128 + wr * 64 + m * 16 + fr; const float wg = (r < u.nvalid) ? lwt[(size_t)u.e * LCAP + u.rb * 256 + r] : 0.0f;
#pragma unroll
                for (int bj = 0; bj < 2; ++bj) { const int col = u.pn * 256 + bj * 128 + wc * 32 + 8 * fq; const f32x4 c0 = *(const f32x4*)(bb + col), c1 = *(const f32x4*)(bb + col + 4);
                    const f32x4 v0 = (acc[ai][bj][m][0] * 0.03125f + c0) * wg, v1 = (acc[ai][bj][m][1] * 0.03125f + c1) * wg;
                    u32x4 w; w.x = cvt_pk_bf16(v0[0], v0[1]); w.y = cvt_pk_bf16(v0[2], v0[3]); w.z = cvt_pk_bf16(v1[0], v1[1]); w.w = cvt_pk_bf16(v1[2], v1[3]);
                    *(u32x4*)(YE + ((size_t)u.pm * 256 + r) * D + col) = w; }
                asm volatile("" ::: "memory"); }
    }
};

__device__ __forceinline__ float wave_sum(float v) {
#pragma unroll
    for (int o = 1; o < 64; o <<= 1) v += __shfl_xor(v, o);
    return v;
}
__device__ __forceinline__ void tr_item(const float* __restrict__ W, int K, int N, bf16* WT, int item, int lane, int mode) {
    const int nblk = N >> 6, kb = item / nblk, nb = item - kb * nblk, k0 = kb * 64, n = nb * 64 + lane;
    int drow = n;
    if (mode) { const int half = N >> 1, hi = n >= half ? 1 : 0, nn = n - hi * half; drow = (nn >> 7) * 256 + hi * 128 + (nn & 127); }
    const float* src = W + (size_t)k0 * N + n;
    float v[64];
#pragma unroll
    for (int i = 0; i < 64; ++i) v[i] = src[(size_t)i * N];
    bf16* dst = WT + (size_t)drow * K + k0;
#pragma unroll
    for (int j = 0; j < 8; ++j) { v4u o; o.x = cvt_pk_bf16(v[8 * j], v[8 * j + 1]); o.y = cvt_pk_bf16(v[8 * j + 2], v[8 * j + 3]); o.z = cvt_pk_bf16(v[8 * j + 4], v[8 * j + 5]); o.w = cvt_pk_bf16(v[8 * j + 6], v[8 * j + 7]);
        *(v4u*)(dst + 8 * j) = o; }
}

struct Args { const void* in[30]; float* out; unsigned char* ws; int ph_lo, ph_hi, li, pad; };

__global__ void __launch_bounds__(NWAVES * 64, 2) fwd_kernel(Args args) {
    extern __shared__ __attribute__((aligned(16))) unsigned char lds_raw[];
    LAS unsigned char* lds = (LAS unsigned char*)lds_raw;
    volatile LAS unsigned* MISC = (volatile LAS unsigned*)(lds + MISC_OFF);
    const int tid = threadIdx.x, lane = tid & 63, wave = __builtin_amdgcn_readfirstlane(tid >> 6);
    const int G = gridDim.x; const int bx = blockIdx.x; const int vcu = (G % 8 == 0) ? (bx % 8) * (G / 8) + bx / 8 : bx;
    unsigned char* ws = args.ws;
    gu32* ctl = (gu32*)(ws + WS_CTL);
    const float* x = (const float*)args.in[0]; const float* cin = (const float*)args.in[1]; const float* ada_w = (const float*)args.in[2]; const float* ada_b = (const float*)args.in[3];
    const float* norm1_g = (const float*)args.in[4]; const float* w_in = (const float*)args.in[5]; const float* pool_w = (const float*)args.in[6]; const float* pool_scale = (const float*)args.in[7];
    const float* w_pool_out = (const float*)args.in[8]; const float* lam_re = (const float*)args.in[9]; const float* lam_im = (const float*)args.in[10]; const float* log_dt = (const float*)args.in[11];
    const float* sb_re = (const float*)args.in[12]; const float* sb_im = (const float*)args.in[13]; const float* sc_re = (const float*)args.in[14]; const float* sc_im = (const float*)args.in[15];
    const float* ssm_d = (const float*)args.in[16]; const float* w_glu = (const float*)args.in[17]; const float* b_glu = (const float*)args.in[18]; const float* w_out = (const float*)args.in[19];
    const float* norm2_g = (const float*)args.in[20]; const float* w_router = (const float*)args.in[21]; const float* b_router = (const float*)args.in[22]; const float* w1 = (const float*)args.in[23];
    const float* b1 = (const float*)args.in[24]; const float* w2 = (const float*)args.in[25]; const float* b2 = (const float*)args.in[26]; const float* fada_w = (const float*)args.in[27];
    const float* fada_b = (const float*)args.in[28]; const float* fnorm_g = (const float*)args.in[29];
    float* out = args.out;
    float* MOD = (float*)(ws + WS_MOD); float* FMOD = (float*)(ws + WS_FMOD); float* AL = (float*)(ws + WS_AL);
    bf16* WinT = (bf16*)(ws + WS_WIN); bf16* PoolWT = (bf16*)(ws + WS_POOLW); bf16* WpoT = (bf16*)(ws + WS_WPO); bf16* WgluT = (bf16*)(ws + WS_WGLU); bf16* WoutT = (bf16*)(ws + WS_WOUT);
    bf16* WendT = (bf16*)(ws + WS_WEND); bf16* TG = (bf16*)(ws + WS_TG); unsigned char* W1T8 = ws + WS_W1; unsigned char* W2T8 = ws + WS_W2;
    bf16* XN = (bf16*)(ws + WS_XN); bf16* UP = (bf16*)(ws + WS_UP); bf16* UG = (bf16*)(ws + WS_UG); bf16* SGP = (bf16*)(ws + WS_SGP); bf16* SGS = (bf16*)(ws + WS_SGS);
    bf16* PL = (bf16*)(ws + WS_PL); bf16* PM = (bf16*)(ws + WS_PM); float* EB = (float*)(ws + WS_E); bf16* YPG = (bf16*)(ws + WS_YPG); bf16* YS = (bf16*)(ws + WS_YS);
    bf16* MG = (bf16*)(ws + WS_MG); float* X1 = (float*)(ws + WS_X1); int* LTOK = (int*)(ws + WS_LTOK); float* LWT = (float*)(ws + WS_LWT); int* TSLOT = (int*)(ws + WS_TSLOT);
    unsigned char* ACT8 = ws + WS_ACT; bf16* YE = (bf16*)(ws + WS_YE); unsigned char* XN8 = ws + WS_XN;

    for (int u = tid; u < (LDS_BYTES - LDSCTL_OFF) / 4; u += NWAVES * 64) ((LAS unsigned*)(lds + LDSCTL_OFF))[u] = 0u;
    __syncthreads();
    XcdBarrier bar; bar.bar = (unsigned*)(ctl + CW_BAR); bar.x = 0; bar.st = nullptr;
    if (N_LAUNCHES == 1) bar = xcd_barrier_post((unsigned*)(ctl + CW_BAR), MISC + 8);
#define GRID_BAR() do { if (N_LAUNCHES == 1) xcd_barrier(bar); } while (0)
    const int lo = args.ph_lo, hi = args.ph_hi;
#ifndef PHSEL
#define PHSEL -1
#endif
#define IN(k) (PHSEL < 0 ? (lo <= (k) && (k) < hi) : ((k) == PHSEL))
#define BOTH(k) (IN(k) && IN((k) + 1))
#ifndef DUPSEL
#define DUPSEL -1
#endif
#define REP(k) ((DUPSEL == (k)) ? 2 : 1)
    const int gw = vcu * NWAVES + wave, NGW = G * NWAVES;

    if (IN(0)) for (int rep_ = 0; rep_ < REP(0); ++rep_) {
        LAS float* CA = (LAS float*)(lds + RING_OFF);
        LAS float* RED = (LAS float*)(lds + RING_OFF + 32768);
        for (int i = tid; i < BATCH * D; i += NWAVES * 64) { const float c = cin[i]; CA[i] = c * sigmoidf_(c); }
        __syncthreads();
        for (int cb = vcu; cb < (6 * D + 2 * D) / 64; cb += G) {
            const int col0 = cb * 64; const float* W; int N, cc; const float* bias; float* dst; int dld;
            if (col0 < 6 * D) { W = ada_w; N = 6 * D; cc = col0; bias = ada_b; dst = MOD; dld = 6 * D; } else { W = fada_w; N = 2 * D; cc = col0 - 6 * D; bias = fada_b; dst = FMOD; dld = 2 * D; }
            const int c4 = lane & 15, kr = lane >> 4;
            f32x4 a0 = {0.f, 0.f, 0.f, 0.f}, a1 = a0, a2 = a0, a3 = a0;
            const float* wp = W + (size_t)(256 * wave + kr) * N + cc + 4 * c4;
#pragma unroll 16
            for (int kk = 0; kk < 64; ++kk) { const f32x4 v = *(const f32x4*)(wp + (size_t)kk * 4 * N); const int k = 256 * wave + kk * 4 + kr;
                a0 += v * CA[k]; a1 += v * CA[D + k]; a2 += v * CA[2 * D + k]; a3 += v * CA[3 * D + k]; }
#pragma unroll
            for (int j = 0; j < 4; ++j) { a0[j] += __shfl_xor(a0[j], 16); a0[j] += __shfl_xor(a0[j], 32); a1[j] += __shfl_xor(a1[j], 16); a1[j] += __shfl_xor(a1[j], 32);
                a2[j] += __shfl_xor(a2[j], 16); a2[j] += __shfl_xor(a2[j], 32); a3[j] += __shfl_xor(a3[j], 16); a3[j] += __shfl_xor(a3[j], 32); }
            if (kr == 0) {
#pragma unroll
                for (int j = 0; j < 4; ++j) { RED[(wave * 4 + 0) * 64 + 4 * c4 + j] = a0[j]; RED[(wave * 4 + 1) * 64 + 4 * c4 + j] = a1[j]; RED[(wave * 4 + 2) * 64 + 4 * c4 + j] = a2[j]; RED[(wave * 4 + 3) * 64 + 4 * c4 + j] = a3[j]; } }
            __syncthreads();
            if (tid < 256) { const int b = tid >> 6, c = tid & 63; float s = bias[cc + c];
#pragma unroll
                for (int w = 0; w < 8; ++w) s += RED[(w * 4 + b) * 64 + c];
                dst[(size_t)b * dld + cc + c] = s; }
            __syncthreads();
        }
        if (BOTH(0)) GRID_BAR();
    }

    if (IN(1)) for (int rep_ = 0; rep_ < REP(1); ++rep_) {
        {
            LAS float* AP = (LAS float*)(lds + RING_OFF);
            LAS float* BBm = (LAS float*)(lds + RING_OFF + 16384);
            LAS float* CCm = (LAS float*)(lds + RING_OFF + 32768);
            LAS float* MT = (LAS float*)(lds + RING_OFF + 49152);
            for (int it = vcu; it < SG * 4; it += G) {
                const int g = it >> 2, part = it & 3;
                if (tid < 64) { const int p = tid; const float dt = expf(log_dt[g]); const float lre = fminf(lam_re[g * SP + p], -1e-4f), lim = lam_im[g * SP + p];
                    for (int k = 0; k <= 16; ++k) { const float mag = expf(lre * dt * (float)k), ang = lim * dt * (float)k; AP[(k * 64 + p) * 2] = mag * cosf(ang); AP[(k * 64 + p) * 2 + 1] = mag * sinf(ang); }
                    const float mag = expf(lre * dt), ang = lim * dt; const float abr = mag * cosf(ang), abi = mag * sinf(ang);
                    const float den = lre * lre + lim * lim, nr = abr - 1.0f, ni = abi; const float fr_ = (nr * lre + ni * lim) / den, fi_ = (ni * lre - nr * lim) / den;
                    for (int h = 0; h < SH; ++h) { const float br = sb_re[((size_t)g * SP + p) * SH + h], bi = sb_im[((size_t)g * SP + p) * SH + h]; BBm[(p * 16 + h) * 2] = fr_ * br - fi_ * bi; BBm[(p * 16 + h) * 2 + 1] = fr_ * bi + fi_ * br; }
                    for (int h = 0; h < SH; ++h) { CCm[(h * 64 + p) * 2] = sc_re[((size_t)g * SH + h) * SP + p]; CCm[(h * 64 + p) * 2 + 1] = sc_im[((size_t)g * SH + h) * SP + p]; }
                    if (part == 0) { AL[(g * SP + p) * 2] = AP[(16 * 64 + p) * 2]; AL[(g * SP + p) * 2 + 1] = AP[(16 * 64 + p) * 2 + 1]; }
                }
                __syncthreads();
                for (int idx = tid; idx < 4096; idx += NWAVES * 64) { const int k = idx >> 8, hp = (idx >> 4) & 15, h = idx & 15; float s = 0.f;
                    for (int p = 0; p < SP; ++p) { const float ar = AP[(k * 64 + p) * 2], ai = AP[(k * 64 + p) * 2 + 1], cr = CCm[(hp * 64 + p) * 2], ci = CCm[(hp * 64 + p) * 2 + 1];
                        const float car = cr * ar - ci * ai, cai = cr * ai + ci * ar; s += car * BBm[(p * 16 + h) * 2] - cai * BBm[(p * 16 + h) * 2 + 1]; }
                    if (k == 0 && h == hp) s += ssm_d[g * SH + hp];
                    MT[idx] = s; }
                __syncthreads();
                for (int vi = tid; vi < 64 * (UGK / 8); vi += NWAVES * 64) { const int nl = vi / (UGK / 8), kv = vi - nl * (UGK / 8), n = part * 64 + nl, t = n >> 4, hp = n & 15, k0 = kv * 8; float val[8];
#pragma unroll
                    for (int j = 0; j < 8; ++j) { const int k = k0 + j;
                        if (k < 256) { const int s = k >> 4, h = k & 15; val[j] = (s <= t) ? MT[((t - s) << 8) + (hp << 4) + h] : 0.f; }
                        else { const int comp = k - 256, p = comp & 63; const float ar = AP[((t + 1) * 64 + p) * 2], ai = AP[((t + 1) * 64 + p) * 2 + 1], cr = CCm[(hp * 64 + p) * 2], ci = CCm[(hp * 64 + p) * 2 + 1];
                            val[j] = comp < 64 ? (cr * ar - ci * ai) : -(cr * ai + ci * ar); } }
                    v4u o; o.x = cvt_pk_bf16(val[0], val[1]); o.y = cvt_pk_bf16(val[2], val[3]); o.z = cvt_pk_bf16(val[4], val[5]); o.w = cvt_pk_bf16(val[6], val[7]);
                    *(v4u*)(TG + ((size_t)g * 256 + n) * UGK + k0) = o; }
                for (int vi = tid; vi < 64 * 32; vi += NWAVES * 64) { const int nl = vi >> 5, kv = vi & 31, n = part * 64 + nl, k0 = kv * 8; float val[8];
#pragma unroll
                    for (int j = 0; j < 8; ++j) { const int k = k0 + j, s = k >> 4, h = k & 15;
                        if (n < 128) { const int p = n & 63; const float ar = AP[((15 - s) * 64 + p) * 2], ai = AP[((15 - s) * 64 + p) * 2 + 1], br = BBm[(p * 16 + h) * 2], bi = BBm[(p * 16 + h) * 2 + 1];
                            val[j] = n < 64 ? (ar * br - ai * bi) : (ar * bi + ai * br); } else val[j] = 0.f; }
                    v4u o; o.x = cvt_pk_bf16(val[0], val[1]); o.y = cvt_pk_bf16(val[2], val[3]); o.z = cvt_pk_bf16(val[4], val[5]); o.w = cvt_pk_bf16(val[6], val[7]);
                    *(v4u*)(WendT + ((size_t)g * 256 + n) * 256 + k0) = o; }
                __syncthreads();
            }
        }
        for (int row = gw; row < T; row += NGW) {
            const int b = row >> 12; const float* xr = x + (size_t)row * D + 4 * lane; const float* mb = MOD + (size_t)b * 6 * D;
            f32x4 v[8]; float ss = 0.f;
#pragma unroll
            for (int j = 0; j < 8; ++j) { v[j] = *(const f32x4*)(xr + 256 * j); ss += v[j][0] * v[j][0] + v[j][1] * v[j][1] + v[j][2] * v[j][2] + v[j][3] * v[j][3]; }
            const float rstd = 1.0f / sqrtf(wave_sum(ss) * (1.0f / D) + RMS_EPS);
#pragma unroll
            for (int j = 0; j < 8; ++j) { const int k = 4 * lane + 256 * j; const f32x4 g = *(const f32x4*)(norm1_g + k), sh = *(const f32x4*)(mb + k), sc = *(const f32x4*)(mb + D + k);
                const f32x4 h = v[j] * rstd * g * (sc + 1.0f) + sh; v2u o; o.x = cvt_pk_bf16(h[0], h[1]); o.y = cvt_pk_bf16(h[2], h[3]); *(v2u*)(XN + (size_t)row * D + k) = o; }
        }
        {
            constexpr int T_IN = (D / 64) * (INW / 256), T_PW = 4 * 4, T_PO = (PW / 64) * (D / 256), T_GL = (SW / 64) * (2 * D / 256), T_OUT = (D / 64) * (D / 256);
            constexpr int NTILES = T_IN + T_PW + T_PO + T_GL + T_OUT;
            constexpr int TRB = 256 * 144;
#define TR_DECODE(it_, W_, WT_, K_, N_, mode_, k0_, n0_) do { int r_ = (it_); \
                if (r_ < T_IN) { W_ = w_in; WT_ = WinT; K_ = D; N_ = INW; mode_ = 0; } \
                else if ((r_ -= T_IN) < T_PW) { const int q_ = r_ >> 2; r_ &= 3; W_ = pool_w + (size_t)q_ * 65536; WT_ = PoolWT + (size_t)q_ * 65536; K_ = 256; N_ = 256; mode_ = 0; } \
                else if ((r_ -= T_PW) < T_PO) { W_ = w_pool_out; WT_ = WpoT; K_ = PW; N_ = D; mode_ = 0; } \
                else if ((r_ -= T_PO) < T_GL) { W_ = w_glu; WT_ = WgluT; K_ = SW; N_ = 2 * D; mode_ = 1; } \
                else { r_ -= T_GL; W_ = w_out; WT_ = WoutT; K_ = D; N_ = D; mode_ = 0; } \
                const int nblk_ = N_ >> 8; k0_ = (r_ / nblk_) * 64; n0_ = (r_ % nblk_) * 256; } while (0)
#define TR_LOAD(reg_, W_, N_, k0_, n0_) do { const float* p_ = W_ + (size_t)(k0_ + 8 * wave) * N_ + n0_ + 4 * lane; \
                _Pragma("unroll") for (int i_ = 0; i_ < 8; ++i_) reg_[i_] = *(const f32x4*)(p_ + (size_t)i_ * N_); } while (0)
#define TR_PUT(reg_, buf_) do { _Pragma("unroll") for (int j_ = 0; j_ < 4; ++j_) { v4u o_; o_.x = cvt_pk_bf16(reg_[0][j_], reg_[1][j_]); o_.y = cvt_pk_bf16(reg_[2][j_], reg_[3][j_]); \
                o_.z = cvt_pk_bf16(reg_[4][j_], reg_[5][j_]); o_.w = cvt_pk_bf16(reg_[6][j_], reg_[7][j_]); *(LAS v4u*)(lds + RING_OFF + (buf_) * TRB + (4 * lane + j_) * 144 + 16 * wave) = o_; } } while (0)
#define TR_FLUSH(buf_, WT_, K_, N_, mode_, k0_, n0_) do { _Pragma("unroll") for (int p_ = 0; p_ < 4; ++p_) { const int n_ = 64 * p_ + (tid >> 3), c_ = tid & 7; \
                const v4u q_ = *(const LAS v4u*)(lds + RING_OFF + (buf_) * TRB + n_ * 144 + 16 * c_); const int gn_ = n0_ + n_; int drow_ = gn_; \
                if (mode_) { const int half_ = N_ >> 1, hi_ = gn_ >= half_ ? 1 : 0, nn_ = gn_ - hi_ * half_; drow_ = (nn_ >> 7) * 256 + hi_ * 128 + (nn_ & 127); } \
                *(v4u*)(WT_ + (size_t)drow_ * K_ + k0_ + 8 * c_) = q_; } } while (0)
#define TR_BAR() do { LDS_WAIT(); __builtin_amdgcn_s_barrier(); asm volatile("" ::: "memory"); } while (0)
            int itA = vcu, itB = vcu + G;
            const float *WA = nullptr, *WB = nullptr; bf16 *TA = nullptr, *TB = nullptr; int KA = 0, NA = 0, mA = 0, kA = 0, nA = 0, KB = 0, NB = 0, mB = 0, kB = 0, nB = 0;
            f32x4 ra[8], rb[8];
            if (itA < NTILES) { TR_DECODE(itA, WA, TA, KA, NA, mA, kA, nA); TR_LOAD(ra, WA, NA, kA, nA); }
            if (itB < NTILES) { TR_DECODE(itB, WB, TB, KB, NB, mB, kB, nB); TR_LOAD(rb, WB, NB, kB, nB); }
            while (itA < NTILES) {
                TR_PUT(ra, 0);
                { bf16* dT = TA; const int dK = KA, dN = NA, dm = mA, dk = kA, dn = nA;
                  itA += 2 * G; if (itA < NTILES) { TR_DECODE(itA, WA, TA, KA, NA, mA, kA, nA); TR_LOAD(ra, WA, NA, kA, nA); }
                  TR_BAR();
                  TR_FLUSH(0, dT, dK, dN, dm, dk, dn); }
                if (itB >= NTILES) break;
                TR_PUT(rb, 1);
                { bf16* dT = TB; const int dK = KB, dN = NB, dm = mB, dk = kB, dn = nB;
                  itB += 2 * G; if (itB < NTILES) { TR_DECODE(itB, WB, TB, KB, NB, mB, kB, nB); TR_LOAD(rb, WB, NB, kB, nB); }
                  TR_BAR();
                  TR_FLUSH(1, dT, dK, dN, dm, dk, dn); }
            }
            __syncthreads();
            {
                constexpr int U_W1E = (D / 128) * (2 * FE / 256), U_W2E = (FE / 128) * (D / 256), U_W1 = NE * U_W1E, U_TOT = U_W1 + NE * U_W2E;
#define T8_DECODE(it_, W_, WT_, K_, N_, mode_, k0_, n0_) do { int r_ = (it_); \
                    if (r_ < U_W1) { const int e_ = r_ / U_W1E; r_ -= e_ * U_W1E; W_ = w1 + (size_t)e_ * D * 2 * FE; WT_ = W1T8 + (size_t)e_ * D * 2 * FE; K_ = D; N_ = 2 * FE; mode_ = 1; } \
                    else { r_ -= U_W1; const int e_ = r_ / U_W2E; r_ -= e_ * U_W2E; W_ = w2 + (size_t)e_ * FE * D; WT_ = W2T8 + (size_t)e_ * FE * D; K_ = FE; N_ = D; mode_ = 0; } \
                    const int nblk_ = N_ >> 8; k0_ = (r_ / nblk_) * 128; n0_ = (r_ % nblk_) * 256; } while (0)
#define T8_LOAD(reg_, W_, N_, k0_, n0_) do { const float* p_ = W_ + (size_t)(k0_ + 16 * wave) * N_ + n0_ + 4 * lane; \
                    _Pragma("unroll") for (int i_ = 0; i_ < 16; ++i_) reg_[i_] = *(const f32x4*)(p_ + (size_t)i_ * N_); } while (0)
#define T8_PUT(reg_, buf_) do { _Pragma("unroll") for (int j_ = 0; j_ < 4; ++j_) { v4u o_; o_.x = pk4_fp8(32.f * reg_[0][j_], 32.f * reg_[1][j_], 32.f * reg_[2][j_], 32.f * reg_[3][j_]); o_.y = pk4_fp8(32.f * reg_[4][j_], 32.f * reg_[5][j_], 32.f * reg_[6][j_], 32.f * reg_[7][j_]); \
                    o_.z = pk4_fp8(32.f * reg_[8][j_], 32.f * reg_[9][j_], 32.f * reg_[10][j_], 32.f * reg_[11][j_]); o_.w = pk4_fp8(32.f * reg_[12][j_], 32.f * reg_[13][j_], 32.f * reg_[14][j_], 32.f * reg_[15][j_]); \
                    *(LAS v4u*)(lds + RING_OFF + (buf_) * TRB + (4 * lane + j_) * 144 + 16 * wave) = o_; } } while (0)
#define T8_FLUSH(buf_, WT_, K_, N_, mode_, k0_, n0_) do { _Pragma("unroll") for (int p_ = 0; p_ < 4; ++p_) { const int n_ = 64 * p_ + (tid >> 3), c_ = tid & 7; \
                    const v4u q_ = *(const LAS v4u*)(lds + RING_OFF + (buf_) * TRB + n_ * 144 + 16 * c_); const int gn_ = n0_ + n_; int drow_ = gn_; \
                    if (mode_) { const int half_ = N_ >> 1, hi_ = gn_ >= half_ ? 1 : 0, nn_ = gn_ - hi_ * half_; drow_ = (nn_ >> 7) * 256 + hi_ * 128 + (nn_ & 127); } \
                    *(v4u*)(WT_ + (size_t)drow_ * K_ + k0_ + 16 * c_) = q_; } } while (0)
                int itA = vcu, itB = vcu + G;
                const float *WA = nullptr, *WB = nullptr; unsigned char *TA = nullptr, *TB = nullptr; int KA = 0, NA = 0, mA = 0, kA = 0, nA = 0, KB = 0, NB = 0, mB = 0, kB = 0, nB = 0;
                f32x4 ra[16], rb[16];
                if (itA < U_TOT) { T8_DECODE(itA, WA, TA, KA, NA, mA, kA, nA); T8_LOAD(ra, WA, NA, kA, nA); }
                if (itB < U_TOT) { T8_DECODE(itB, WB, TB, KB, NB, mB, kB, nB); T8_LOAD(rb, WB, NB, kB, nB); }
                while (itA < U_TOT) {
                    T8_PUT(ra, 0);
                    { unsigned char* dT = TA; const int dK = KA, dN = NA, dm = mA, dk = kA, dn = nA;
                      itA += 2 * G; if (itA < U_TOT) { T8_DECODE(itA, WA, TA, KA, NA, mA, kA, nA); T8_LOAD(ra, WA, NA, kA, nA); }
                      TR_BAR();
                      T8_FLUSH(0, dT, dK, dN, dm, dk, dn); }
                    if (itB >= U_TOT) break;
                    T8_PUT(rb, 1);
                    { unsigned char* dT = TB; const int dK = KB, dN = NB, dm = mB, dk = kB, dn = nB;
                      itB += 2 * G; if (itB < U_TOT) { T8_DECODE(itB, WB, TB, KB, NB, mB, kB, nB); T8_LOAD(rb, WB, NB, kB, nB); }
                      TR_BAR();
                      T8_FLUSH(1, dT, dK, dN, dm, dk, dn); }
                }
                __syncthreads();
#undef T8_DECODE
#undef T8_LOAD
#undef T8_PUT
#undef T8_FLUSH
            }
#undef TR_DECODE
#undef TR_LOAD
#undef TR_PUT
#undef TR_FLUSH
#undef TR_BAR
        }
        if (BOTH(1)) GRID_BAR();
    }

    if (IN(2)) {
        SchedDense S; S.init(XN, WinT, T, INW, D, D, G, bx);
        EpiZ E{UP, UG, SGP, SGS};
        pg8::gemm_phase<EpiZ, SchedDense, false>(lds + RING_OFF, D, D, D, S, E);
        if (DUPSEL == 2) { pg8::gemm_phase<EpiZ, SchedDense, false>(lds + RING_OFF, D, D, D, S, E); }
        if (BOTH(2)) GRID_BAR();
    }

    if (IN(3)) {
        for (int it = gw; it < BATCH * 128 * 4; it += NGW) {
            const int gq = it & 3, tb = (it >> 2) & 127, b = it >> 9, w = 2 << gq, oct = lane & 31, th = lane >> 5, t0 = tb * 32 + th * 16;
            const bf16* up = UP + (size_t)b * SEQ * PW + gq * 256 + oct * 8; bf16* pl = PL + (size_t)b * SEQ * PW + gq * 256 + oct * 8;
            float Sx[8];
#pragma unroll
            for (int j = 0; j < 8; ++j) Sx[j] = 0.f;
            for (int jj = w - 1; jj >= 1; --jj) { const int tp = t0 - jj; if (tp >= 0) { const v4u q = *(const v4u*)(up + (size_t)tp * PW);
                Sx[0] += bf_lo(q.x); Sx[1] += bf_hi(q.x); Sx[2] += bf_lo(q.y); Sx[3] += bf_hi(q.y); Sx[4] += bf_lo(q.z); Sx[5] += bf_hi(q.z); Sx[6] += bf_lo(q.w); Sx[7] += bf_hi(q.w); } }
            for (int tt = 0; tt < 16; ++tt) { const int tp = t0 + tt; const v4u q = *(const v4u*)(up + (size_t)tp * PW);
                float uu[8] = {bf_lo(q.x), bf_hi(q.x), bf_lo(q.y), bf_hi(q.y), bf_lo(q.z), bf_hi(q.z), bf_lo(q.w), bf_hi(q.w)};
                const float cnt = (float)((tp + 1) < w ? (tp + 1) : w); float o[8];
#pragma unroll
                for (int j = 0; j < 8; ++j) { Sx[j] += uu[j]; o[j] = Sx[j] / cnt - uu[j]; }
                v4u ov; ov.x = cvt_pk_bf16(o[0], o[1]); ov.y = cvt_pk_bf16(o[2], o[3]); ov.z = cvt_pk_bf16(o[4], o[5]); ov.w = cvt_pk_bf16(o[6], o[7]);
                *(v4u*)(pl + (size_t)tp * PW) = ov;
                const int tq = tp - w + 1; if (tq >= 0) { const v4u q2 = *(const v4u*)(up + (size_t)tq * PW);
                    Sx[0] -= bf_lo(q2.x); Sx[1] -= bf_hi(q2.x); Sx[2] -= bf_lo(q2.y); Sx[3] -= bf_hi(q2.y); Sx[4] -= bf_lo(q2.z); Sx[5] -= bf_hi(q2.z); Sx[6] -= bf_lo(q2.w); Sx[7] -= bf_hi(q2.w); } }
        }
        __syncthreads();
        SchedGrouped S; S.init(UG, WendT, UGK, (size_t)1024 * UGK * 2, (size_t)256 * 256 * 2, 4, SG, G, vcu);
        EpiS1 E{EB};
        pg8::gemm_phase<EpiS1, SchedGrouped, false>(lds + RING_OFF, UGK, 256, 256, S, E); if (DUPSEL == 3) { pg8::gemm_phase<EpiS1, SchedGrouped, false>(lds + RING_OFF, UGK, 256, 256, S, E); }
        if (BOTH(3)) GRID_BAR();
    }

    if (IN(4)) {
        if (wave == 0) {
            for (int it = vcu; it < BATCH * SG; it += G) {
                const int b = it >> 6, g = it & 63, p = lane; const float ar = AL[(g * SP + p) * 2], ai = AL[(g * SP + p) * 2 + 1];
                float xr = 0.f, xi = 0.f; const size_t rb = (size_t)g * 1024 + b * 256;
#pragma unroll 8
                for (int c = 0; c < NCH; ++c) { const float er = EB[(rb + c) * 128 + p], ei = EB[(rb + c) * 128 + 64 + p];
                    UG[(rb + c) * UGK + 256 + p] = (bf16)(cvt_pk_bf16(xr, 0.f) & 0xffffu); UG[(rb + c) * UGK + 320 + p] = (bf16)(cvt_pk_bf16(xi, 0.f) & 0xffffu);
                    const float nr = ar * xr - ai * xi + er, ni = ar * xi + ai * xr + ei; xr = nr; xi = ni; }
            }
        }
        SchedGrouped S; S.init(PL, PoolWT, PW, (size_t)256 * 2, (size_t)256 * 256 * 2, T / 256, 4, G, vcu);
        EpiPmix E{PM, pool_scale};
        pg8::gemm_phase<EpiPmix, SchedGrouped, false>(lds + RING_OFF, PW, 256, 256, S, E); if (DUPSEL == 4) { pg8::gemm_phase<EpiPmix, SchedGrouped, false>(lds + RING_OFF, PW, 256, 256, S, E); }
        if (BOTH(4)) GRID_BAR();
    }

    if (IN(5)) {
        { SchedGrouped S; S.init(UG, TG, UGK, (size_t)1024 * UGK * 2, (size_t)256 * UGK * 2, 4, SG, G, vcu);
          EpiS3 E{YS};
          pg8::gemm_phase<EpiS3, SchedGrouped, false>(lds + RING_OFF, UGK, UGK, UGK, S, E); if (DUPSEL == 5) { pg8::gemm_phase<EpiS3, SchedGrouped, false>(lds + RING_OFF, UGK, UGK, UGK, S, E); } }
        { SchedDense S; S.init(PM, WpoT, T, D, PW, PW, G, bx);
          EpiYpool E{YPG, SGP};
          pg8::gemm_phase<EpiYpool, SchedDense, false>(lds + RING_OFF, PW, PW, PW, S, E); if (DUPSEL == 5) { pg8::gemm_phase<EpiYpool, SchedDense, false>(lds + RING_OFF, PW, PW, PW, S, E); } }
        if (BOTH(5)) GRID_BAR();
    }

    if (IN(6)) {
        SchedDense S; S.init(YS, WgluT, T, 2 * D, SW, SW, G, bx);
        EpiGlu E{MG, YPG, SGS, b_glu};
        pg8::gemm_phase<EpiGlu, SchedDense, false>(lds + RING_OFF, SW, SW, SW, S, E);
        if (DUPSEL == 6) { pg8::gemm_phase<EpiGlu, SchedDense, false>(lds + RING_OFF, SW, SW, SW, S, E); }
        if (BOTH(6)) GRID_BAR();
    }

    if (IN(7)) {
        SchedDense S; S.init(MG, WoutT, T, D, D, D, G, bx);
        EpiOut E{X1, x, MOD};
        pg8::gemm_phase<EpiOut, SchedDense, false>(lds + RING_OFF, D, D, D, S, E);
        if (DUPSEL == 7) { pg8::gemm_phase<EpiOut, SchedDense, false>(lds + RING_OFF, D, D, D, S, E); }
        if (BOTH(7)) GRID_BAR();
    }

    if (IN(8)) for (int rep_ = 0; rep_ < REP(8); ++rep_) {
        LAS float* HT = (LAS float*)(lds + RING_OFF);
        LAS float* RED = (LAS float*)(lds + RING_OFF + 65792);
        LAS float* LG = (LAS float*)(lds + RING_OFF + 98560);
        LAS int* HIST = (LAS int*)(lds + RING_OFF + 102784);
        LAS int* BASE = (LAS int*)(lds + RING_OFF + 102912);
        for (int tile = vcu; tile < T / 32; tile += G) {
            const int R0 = tile * 32, b = R0 >> 12; const float* mb = MOD + (size_t)b * 6 * D;
            f32x4 v[4][8];
#pragma unroll
            for (int rr = 0; rr < 4; ++rr) { const int row = R0 + 4 * wave + rr; const float* xr = X1 + (size_t)row * D + 4 * lane; float ss = 0.f;
#pragma unroll
                for (int j = 0; j < 8; ++j) { v[rr][j] = *(const f32x4*)(xr + 256 * j); ss += v[rr][j][0] * v[rr][j][0] + v[rr][j][1] * v[rr][j][1] + v[rr][j][2] * v[rr][j][2] + v[rr][j][3] * v[rr][j][3]; }
                const float rstd = 1.0f / sqrtf(wave_sum(ss) * (1.0f / D) + RMS_EPS);
#pragma unroll
                for (int j = 0; j < 8; ++j) { const int k = 4 * lane + 256 * j; const f32x4 g = *(const f32x4*)(norm2_g + k), sh = *(const f32x4*)(mb + 3 * D + k), sc = *(const f32x4*)(mb + 4 * D + k);
                    v[rr][j] = v[rr][j] * rstd * g * (sc + 1.0f) + sh; *(unsigned*)(XN8 + (size_t)row * D + k) = pk4_fp8(v[rr][j][0], v[rr][j][1], v[rr][j][2], v[rr][j][3]); } }
            if (tid < 32) HIST[tid] = 0;
            f32x16 lacc;
#pragma unroll
            for (int j = 0; j < 16; ++j) lacc[j] = 0.f;
#pragma unroll
            for (int q = 0; q < 4; ++q) {
                __syncthreads();
#pragma unroll
                for (int rr = 0; rr < 4; ++rr)
#pragma unroll
                    for (int jj = 0; jj < 2; ++jj) { const int lk = 4 * lane + 256 * jj; LAS float* hp = HT + (4 * wave + rr) * 513 + lk; const f32x4 q4 = v[rr][2 * q + jj]; hp[0] = q4[0]; hp[1] = q4[1]; hp[2] = q4[2]; hp[3] = q4[3]; }
                __syncthreads();
                const float* wrp = w_router + (size_t)(q * 512 + 64 * wave + (lane >> 5)) * NE + (lane & 31); const LAS float* ap = HT + (lane & 31) * 513 + 64 * wave + (lane >> 5);
#pragma unroll 8
                for (int s = 0; s < 32; ++s) lacc = __builtin_amdgcn_mfma_f32_32x32x2f32(ap[2 * s], wrp[(size_t)2 * s * NE], lacc, 0, 0, 0);
            }
#pragma unroll
            for (int rg = 0; rg < 16; ++rg) { const int i = (rg & 3) + 8 * (rg >> 2) + 4 * (lane >> 5); RED[(wave * 32 + i) * 32 + (lane & 31)] = lacc[rg]; }
            __syncthreads();
#pragma unroll
            for (int pp = 0; pp < 2; ++pp) { const int p = tid + pp * 512, i = p >> 5, j = p & 31; float s = b_router[j];
#pragma unroll
                for (int w = 0; w < 8; ++w) s += RED[(w * 32 + i) * 32 + j];
                LG[i * 33 + j] = s; }
            __syncthreads();
            int idx[4] = {0, 0, 0, 0}; float wv[4] = {0.f, 0.f, 0.f, 0.f}; int lrk[4] = {0, 0, 0, 0};
            if (tid < 32) {
                unsigned chosen = 0u; float val[4];
#pragma unroll
                for (int k = 0; k < 4; ++k) { float best = -3.0e38f; int bi = 0;
                    for (int j = 0; j < NE; ++j) { const float xv = LG[tid * 33 + j]; if (!((chosen >> j) & 1u) && xv > best) { best = xv; bi = j; } }
                    val[k] = best; idx[k] = bi; chosen |= 1u << bi; }
                float den = 0.f;
#pragma unroll
                for (int k = 0; k < 4; ++k) { wv[k] = expf(val[k] - val[0]); den += wv[k]; }
#pragma unroll
                for (int k = 0; k < 4; ++k) { wv[k] /= den; lrk[k] = atomicAdd((int*)&HIST[idx[k]], 1); }
            }
            __syncthreads();
            if (tid < 32) { const int c = HIST[tid]; BASE[tid] = c ? (int)__hip_atomic_fetch_add((unsigned*)(ctl + CW_CNT + tid), (unsigned)c, RLX_AGENT) : 0; }
            __syncthreads();
            if (tid < 32) { const int tok = R0 + tid;
#pragma unroll
                for (int k = 0; k < 4; ++k) { const int e = idx[k], rank = BASE[e] + lrk[k]; LTOK[(size_t)e * LCAP + rank] = tok; LWT[(size_t)e * LCAP + rank] = wv[k]; TSLOT[tok * 4 + k] = e * LCAP + rank; } }
            __syncthreads();
        }
        if (BOTH(8)) GRID_BAR();
    }

#define MOE_TABLES(nN_) do { __syncthreads(); if (tid == 0) { unsigned us = 0u, pb = 0u; for (int e = 0; e < NE; ++e) { const unsigned c = __hip_atomic_load(ctl + CW_CNT + e, RLX_AGENT); const unsigned nb = (c + 255u) >> 8; \
        MISC[32 + e] = us; MISC[80 + e] = pb; MISC[128 + e] = c; us += nb * (unsigned)(nN_); pb += nb; } MISC[32 + NE] = us; MISC[80 + NE] = pb; MISC[176] = us; } __syncthreads(); } while (0)

    if (IN(9)) {
        MOE_TABLES(2 * FE / 256);
        SchedMoe S; S.A = (const char*)XN8; S.Bt = (const char*)W1T8; S.astep = 0; S.bstep_e = (size_t)2 * FE * D; S.bstep_n = (size_t)256 * D; S.nN = 2 * FE / 256; S.G = G; S.c = vcu; S.M = MISC; S.ltok = LTOK; S.gather = true;
        EpiMoe1 E{ACT8, b1};
        pg8::gemm_phase<EpiMoe1, SchedMoe, true, 1>(lds + RING_OFF, D, D, D, S, E);
        if (DUPSEL == 9) { pg8::gemm_phase<EpiMoe1, SchedMoe, true, 1>(lds + RING_OFF, D, D, D, S, E); }
        if (BOTH(9)) GRID_BAR();
    }

    if (IN(10)) {
        MOE_TABLES(D / 256);
        SchedMoe S; S.A = (const char*)ACT8; S.Bt = (const char*)W2T8; S.astep = (size_t)256 * FE; S.bstep_e = (size_t)D * FE; S.bstep_n = (size_t)256 * FE; S.nN = D / 256; S.G = G; S.c = vcu; S.M = MISC; S.ltok = LTOK; S.gather = false;
        EpiMoe2 E{YE, b2, LWT};
        pg8::gemm_phase<EpiMoe2, SchedMoe, false, 1>(lds + RING_OFF, FE, FE, FE, S, E);
        if (DUPSEL == 10) { pg8::gemm_phase<EpiMoe2, SchedMoe, false, 1>(lds + RING_OFF, FE, FE, FE, S, E); }
        if (BOTH(10)) GRID_BAR();
    }

    if (IN(11)) for (int rep_ = 0; rep_ < REP(11); ++rep_) {
        MOE_TABLES(1);
        for (int row = gw; row < T; row += NGW) {
            const int b = row >> 12; const float* mb = MOD + (size_t)b * 6 * D; const float* fb = FMOD + (size_t)b * 2 * D;
            size_t prow[4];
#pragma unroll
            for (int k = 0; k < 4; ++k) { const int s = TSLOT[row * 4 + k]; const int e = s >> 14, rank = s & (LCAP - 1); prow[k] = ((size_t)MISC[80 + e] * 256 + rank) * D; }
            f32x4 v[8]; float ss = 0.f;
#pragma unroll
            for (int j = 0; j < 8; ++j) { const int k = 4 * lane + 256 * j; f32x4 f = {0.f, 0.f, 0.f, 0.f};
#pragma unroll
                for (int kk = 0; kk < 4; ++kk) { const v2u y = *(const v2u*)(YE + prow[kk] + k); f[0] += bf_lo(y.x); f[1] += bf_hi(y.x); f[2] += bf_lo(y.y); f[3] += bf_hi(y.y); }
                const f32x4 gt = *(const f32x4*)(mb + 5 * D + k); v[j] = *(const f32x4*)(X1 + (size_t)row * D + k) + gt * f;
                ss += v[j][0] * v[j][0] + v[j][1] * v[j][1] + v[j][2] * v[j][2] + v[j][3] * v[j][3]; }
            const float rstd = 1.0f / sqrtf(wave_sum(ss) * (1.0f / D) + RMS_EPS);
#pragma unroll
            for (int j = 0; j < 8; ++j) { const int k = 4 * lane + 256 * j; const f32x4 g = *(const f32x4*)(fnorm_g + k), sh = *(const f32x4*)(fb + k), sc = *(const f32x4*)(fb + D + k);
                *(f32x4*)(out + (size_t)row * D + k) = v[j] * rstd * g * (sc + 1.0f) + sh; }
        }
    }
#undef IN
#undef BOTH
}

extern "C" void kernel_launch(void* const* d_in, const int* in_sizes, int n_in, void* d_out, int out_size, void* d_ws, size_t ws_size, hipStream_t stream) {
    static int grid = 0;
    if (grid == 0) {
        if (n_in != 30 || out_size != T * D || ws_size < WS_END) { fprintf(stderr, "kernel_launch: unexpected shapes (n_in %d, out %d, ws %zu); nothing launched\n", n_in, out_size, ws_size); grid = -1; return; }
        int dev = 0, cus = 0, per_cu = 0;
        if (hipGetDevice(&dev) != hipSuccess || hipDeviceGetAttribute(&cus, hipDeviceAttributeMultiprocessorCount, dev) != hipSuccess) { grid = -1; return; }
        if (hipFuncSetAttribute((const void*)fwd_kernel, hipFuncAttributeMaxDynamicSharedMemorySize, LDS_BYTES) != hipSuccess) { fprintf(stderr, "kernel_launch: hipFuncSetAttribute failed\n"); grid = -1; return; }
        if (hipOccupancyMaxActiveBlocksPerMultiprocessor(&per_cu, (const void*)fwd_kernel, NWAVES * 64, LDS_BYTES) != hipSuccess || per_cu < 1)
            fprintf(stderr, "kernel_launch: note: occupancy query reports %d workgroups per CU\n", per_cu);
        (void)hipGetLastError();
        grid = cus;
    }
    if (grid < 0) return;
    if (hipMemsetAsync((char*)d_ws + WS_CTL, 0, CTL_ZERO_BYTES, stream) != hipSuccess) { fprintf(stderr, "kernel_launch: hipMemsetAsync failed\n"); return; }
    Args a{};
    for (int i = 0; i < 30; ++i) a.in[i] = d_in[i];
    a.out = (float*)d_out; a.ws = (unsigned char*)d_ws;
    for (int li = 0; li < N_LAUNCHES; ++li) {
        if (N_LAUNCHES == 1) { a.ph_lo = 0; a.ph_hi = NPH; } else { a.ph_lo = li; a.ph_hi = li + 1; }
        a.li = li; a.pad = 0;
        hipLaunchKernelGGL(fwd_kernel, dim3(grid), dim3(NWAVES * 64), LDS_BYTES, stream, a);
        const hipError_t le = hipPeekAtLastError();
        if (le != hipSuccess) { fprintf(stderr, "kernel_launch: launch %d failed: %s\n", li, hipGetErrorName(le)); break; }
    }
}
```

```cpp
#include <hip/hip_runtime.h>
#include <cstdio>
#include <cstdint>

namespace pg8 {
#define PG8_LAS __attribute__((address_space(3)))
typedef unsigned short bf16_t;
typedef short bf16x8 __attribute__((ext_vector_type(8)));
typedef float f32x4 __attribute__((ext_vector_type(4)));
typedef float f32x2 __attribute__((ext_vector_type(2)));
typedef unsigned u32x4 __attribute__((ext_vector_type(4)));
typedef int i32x4 __attribute__((ext_vector_type(4)));
typedef int i32x8 __attribute__((ext_vector_type(8)));
constexpr int BM = 256, BK = 64, HALF = 128, HTB = HALF * BK * 2, STAGE_BYTES = 8 * HTB, NXCD = 8, WGM = 8;

__host__ __device__ __forceinline__ int lds_byte(int r, int c) { const int st = (r >> 4) * 2 + (c >> 5), rr = r & 15, cc = c & 31, ob = rr * 64 + cc * 2; return st * 1024 + (ob ^ (((ob >> 9) & 1) << 5)); }
__host__ __device__ __forceinline__ void stage_rc(int b, int& R, int& C) { const int st = b / 1024, sb = b % 1024, swz = sb ^ (((sb >> 9) & 1) << 5); R = (st >> 1) * 16 + swz / 64; C = (st & 1) * 32 + (swz % 64) / 2; }
__host__ __device__ __forceinline__ int perm32(int rho) { const int n = rho >> 4, i = rho & 15; return 8 * (i >> 2) + 4 * n + (i & 3); }

struct Unit { int pm, pn, e, rb, nvalid; };

__device__ __forceinline__ unsigned cvt_pk_bf16(float lo, float hi) { unsigned r; asm volatile("v_cvt_pk_bf16_f32 %0, %1, %2" : "=v"(r) : "v"(lo), "v"(hi)); return r; }
__device__ __forceinline__ unsigned pk4_fp8(float a, float b, float c, float d) {
    a = __builtin_amdgcn_fmed3f(a, -448.f, 448.f); b = __builtin_amdgcn_fmed3f(b, -448.f, 448.f); c = __builtin_amdgcn_fmed3f(c, -448.f, 448.f); d = __builtin_amdgcn_fmed3f(d, -448.f, 448.f);
    int w = 0; w = __builtin_amdgcn_cvt_pk_fp8_f32(a, b, w, false); w = __builtin_amdgcn_cvt_pk_fp8_f32(c, d, w, true); return (unsigned)w; }
__device__ __forceinline__ float bf_lo(unsigned w) { return __uint_as_float(w << 16); }
__device__ __forceinline__ float bf_hi(unsigned w) { return __uint_as_float(w & 0xffff0000u); }
__device__ __forceinline__ float sigmoidf_(float x) { return __builtin_amdgcn_rcpf(1.0f + __builtin_amdgcn_exp2f(-1.44269504089f * x)); }
__device__ __forceinline__ float gelu_tanh_(float x) { const float u = 0.7978845608f * (x + 0.044715f * x * x * x); return x * __builtin_amdgcn_rcpf(1.0f + __builtin_amdgcn_exp2f(-2.88539008178f * u)); }

template <class Epi, class Sched, bool GATHER, int ESZ = 2>
__device__ __forceinline__ void gemm_phase(PG8_LAS unsigned char* lds, const int lda, const int ldb, const int K, const Sched& S, const Epi& E) {
    const int tid = threadIdx.x, wid = __builtin_amdgcn_readfirstlane(tid >> 6), lane = tid & 63, wr = wid >> 2, wc = wid & 3, fr = lane & 15, fq = lane >> 4;
    const int nt = (K * ESZ) / (BK * 2);
    unsigned voffA[2], voffB[2], colA[2]; int rowA[2];
#pragma unroll
    for (int i = 0; i < 2; ++i) { int R, C; stage_rc(tid * 16 + i * 8192, R, C); const int Rb = Epi::PERM ? ((R & ~31) + perm32(R & 31)) : R;
        rowA[i] = R; colA[i] = (unsigned)C * 2u; voffA[i] = (unsigned)(R * lda * ESZ + C * 2); voffB[i] = (unsigned)(Rb * ldb * ESZ + C * 2); }
    const size_t kstep = (size_t)(BK * 2);
    const size_t hstepA = GATHER ? (size_t)0 : (size_t)HALF * lda * ESZ;
    const size_t hstepB = (size_t)HALF * ldb * ESZ;
    const unsigned ldsw = (unsigned)wid * 1024u;
    const int aoff = lds_byte(wr * 64 + fr, fq * 8), boff = lds_byte(wc * 32 + fr, fq * 8);
#define PG8_SA(b, h) (((b) * 2 + (h)) * HTB)
#define PG8_SB(b, h) ((4 + (b) * 2 + (h)) * HTB)
#define PG8_STAGE2(bufoff, gbase, o0, o1) do { \
        __builtin_amdgcn_global_load_lds((const unsigned*)((const char*)(gbase) + (o0)), (PG8_LAS unsigned*)(lds + (bufoff) + ldsw), 16, 0, 0); \
        __builtin_amdgcn_global_load_lds((const unsigned*)((const char*)(gbase) + (o1)), (PG8_LAS unsigned*)(lds + (bufoff) + ldsw + 8192), 16, 0, 0); } while (0)
#define PG8_STAGE_B(bufoff, gbase) PG8_STAGE2(bufoff, gbase, voffB[0], voffB[1])
#define PG8_LDA(dst, b, h) do { if constexpr (ESZ == 2) { _Pragma("unroll") for (int m = 0; m < 4; ++m) _Pragma("unroll") for (int k = 0; k < 2; ++k) dst[m][k] = *(const PG8_LAS bf16x8*)(lds + PG8_SA(b, h) + aoff + m * 2048 + k * 1024); } \
        else { _Pragma("unroll") for (int m = 0; m < 4; ++m) { const i32x4 lo_ = *(const PG8_LAS i32x4*)(lds + PG8_SA(b, h) + aoff + m * 2048), hi_ = *(const PG8_LAS i32x4*)(lds + PG8_SA(b, h) + aoff + m * 2048 + 1024); dst##8[m] = __builtin_shufflevector(lo_, hi_, 0, 1, 2, 3, 4, 5, 6, 7); } } } while (0)
#define PG8_LDB(dst, b, h) do { if constexpr (ESZ == 2) { _Pragma("unroll") for (int n = 0; n < 2; ++n) _Pragma("unroll") for (int k = 0; k < 2; ++k) dst[n][k] = *(const PG8_LAS bf16x8*)(lds + PG8_SB(b, h) + boff + n * 2048 + k * 1024); } \
        else { _Pragma("unroll") for (int n = 0; n < 2; ++n) { const i32x4 lo_ = *(const PG8_LAS i32x4*)(lds + PG8_SB(b, h) + boff + n * 2048), hi_ = *(const PG8_LAS i32x4*)(lds + PG8_SB(b, h) + boff + n * 2048 + 1024); dst##8[n] = __builtin_shufflevector(lo_, hi_, 0, 1, 2, 3, 4, 5, 6, 7); } } } while (0)
#define PG8_MMA(ai, bj, At, Bt) do { __builtin_amdgcn_s_setprio(1); \
        if constexpr (ESZ == 2) { _Pragma("unroll") for (int m = 0; m < 4; ++m) _Pragma("unroll") for (int n = 0; n < 2; ++n) _Pragma("unroll") for (int k = 0; k < 2; ++k) \
            acc[ai][bj][m][n] = __builtin_amdgcn_mfma_f32_16x16x32_bf16(Bt[n][k], At[m][k], acc[ai][bj][m][n], 0, 0, 0); } \
        else {   \
            asm volatile("s_nop 3\n\t" \
                "v_mfma_f32_16x16x128_f8f6f4 %0, %8, %10, %0\n\t" "v_mfma_f32_16x16x128_f8f6f4 %1, %9, %10, %1\n\t" \
                "v_mfma_f32_16x16x128_f8f6f4 %2, %8, %11, %2\n\t" "v_mfma_f32_16x16x128_f8f6f4 %3, %9, %11, %3\n\t" \
                "v_mfma_f32_16x16x128_f8f6f4 %4, %8, %12, %4\n\t" "v_mfma_f32_16x16x128_f8f6f4 %5, %9, %12, %5\n\t" \
                "v_mfma_f32_16x16x128_f8f6f4 %6, %8, %13, %6\n\t" "v_mfma_f32_16x16x128_f8f6f4 %7, %9, %13, %7" \
                : "+v"(acc[ai][bj][0][0]), "+v"(acc[ai][bj][0][1]), "+v"(acc[ai][bj][1][0]), "+v"(acc[ai][bj][1][1]), "+v"(acc[ai][bj][2][0]), "+v"(acc[ai][bj][2][1]), "+v"(acc[ai][bj][3][0]), "+v"(acc[ai][bj][3][1]) \
                : "v"(Bt##8[0]), "v"(Bt##8[1]), "v"(At##8[0]), "v"(At##8[1]), "v"(At##8[2]), "v"(At##8[3])); } \
        __builtin_amdgcn_s_setprio(0); } while (0)
#define PG8_WAIT_V(n) asm volatile("s_waitcnt vmcnt(" #n ")" ::: "memory")
#define PG8_WAIT_L(n) asm volatile("s_waitcnt lgkmcnt(" #n ")" ::: "memory")
#define PG8_BAR __builtin_amdgcn_s_barrier()
#define PG8_SCHED __builtin_amdgcn_sched_barrier(0)
    Unit cur, nxt; int ui = 0;
    if (!S.next(0, cur)) return;
    f32x4 acc[2][2][4][2];
#pragma unroll
    for (int a = 0; a < 2; ++a)
#pragma unroll
        for (int b = 0; b < 2; ++b)
#pragma unroll
            for (int m = 0; m < 4; ++m)
#pragma unroll
                for (int n = 0; n < 2; ++n) acc[a][b][m][n] = (f32x4){0.f, 0.f, 0.f, 0.f};
    bf16x8 At[4][2], B0[2][2], B1[2][2]; i32x8 At8[4], B08[2], B18[2];
    const char* cA = S.a_ptr(cur); const char* cB = S.b_ptr(cur);
    unsigned gcur[2][2], gnxt[2][2];
#pragma unroll
    for (int h = 0; h < 2; ++h)
#pragma unroll
        for (int i = 0; i < 2; ++i) { if constexpr (GATHER) gcur[h][i] = S.a_rowoff(cur, h * HALF + rowA[i]) + colA[i]; else gcur[h][i] = voffA[i]; gnxt[h][i] = gcur[h][i]; }
    PG8_STAGE_B(PG8_SB(0, 0), cB); PG8_STAGE_B(PG8_SB(0, 1), cB + hstepB); PG8_STAGE2(PG8_SA(0, 0), cA, gcur[0][0], gcur[0][1]); PG8_STAGE2(PG8_SA(0, 1), cA + hstepA, gcur[1][0], gcur[1][1]);
    if (wr == 1) PG8_BAR;
    PG8_WAIT_V(2); PG8_BAR;
    PG8_STAGE_B(PG8_SB(1, 0), cB + kstep); PG8_STAGE2(PG8_SA(1, 0), cA + kstep, gcur[0][0], gcur[0][1]); PG8_STAGE_B(PG8_SB(1, 1), cB + hstepB + kstep);
    PG8_WAIT_V(6); PG8_BAR;
    for (;;) {
        const bool has_next = S.next(ui + 1, nxt);
        const char* nA = has_next ? S.a_ptr(nxt) : cA; const char* nB = has_next ? S.b_ptr(nxt) : cB;
#pragma unroll 1
        for (int t = 0; t < nt; t += 2) {
            const bool last = (t == nt - 2);
            const char* a1 = cA + (size_t)(t + 1) * kstep;
            const char* a2 = last ? nA : cA + (size_t)(t + 2) * kstep; const char* b2 = last ? nB : cB + (size_t)(t + 2) * kstep;
            const char* a3 = a2 + kstep; const char* b3 = b2 + kstep;
            unsigned o2[2][2];
#pragma unroll
            for (int h = 0; h < 2; ++h)
#pragma unroll
                for (int i = 0; i < 2; ++i) o2[h][i] = gcur[h][i];
            if constexpr (GATHER) {
                if (t == 0 && has_next) {
#pragma unroll
                    for (int h = 0; h < 2; ++h)
#pragma unroll
                        for (int i = 0; i < 2; ++i) gnxt[h][i] = S.a_rowoff(nxt, h * HALF + rowA[i]) + colA[i];
                }
                if (last && has_next) {
                    asm volatile("" : "+v"(gnxt[0][0]), "+v"(gnxt[0][1]), "+v"(gnxt[1][0]), "+v"(gnxt[1][1]));
#pragma unroll
                    for (int h = 0; h < 2; ++h)
#pragma unroll
                        for (int i = 0; i < 2; ++i) o2[h][i] = gnxt[h][i];
                }
            }
            PG8_LDB(B0, 0, 0); PG8_LDB(B1, 0, 1); PG8_SCHED; PG8_LDA(At, 0, 0); PG8_STAGE2(PG8_SA(1, 1), a1 + hstepA, gcur[1][0], gcur[1][1]);
            PG8_WAIT_V(8); PG8_WAIT_L(0); PG8_BAR; PG8_MMA(0, 0, At, B0); PG8_MMA(0, 1, At, B1); PG8_BAR; PG8_SCHED;
            PG8_LDA(At, 0, 1); PG8_STAGE_B(PG8_SB(0, 0), b2); PG8_STAGE_B(PG8_SB(0, 1), b2 + hstepB); PG8_STAGE2(PG8_SA(0, 0), a2, o2[0][0], o2[0][1]);
            PG8_WAIT_V(8); PG8_WAIT_L(0); PG8_BAR; PG8_MMA(1, 0, At, B0); PG8_MMA(1, 1, At, B1); PG8_BAR; PG8_SCHED;
            PG8_LDB(B0, 1, 0); PG8_LDB(B1, 1, 1); PG8_SCHED; PG8_LDA(At, 1, 0); PG8_STAGE2(PG8_SA(0, 1), a2 + hstepA, o2[1][0], o2[1][1]);
            PG8_WAIT_V(8); PG8_WAIT_L(0); PG8_BAR; PG8_MMA(0, 0, At, B0); PG8_MMA(0, 1, At, B1); PG8_BAR; PG8_SCHED;
            PG8_LDA(At, 1, 1); PG8_STAGE_B(PG8_SB(1, 0), b3); PG8_STAGE_B(PG8_SB(1, 1), b3 + hstepB); PG8_STAGE2(PG8_SA(1, 0), a3, o2[0][0], o2[0][1]);
            PG8_WAIT_V(8); PG8_WAIT_L(0); PG8_BAR; PG8_MMA(1, 0, At, B0); PG8_MMA(1, 1, At, B1); PG8_BAR; PG8_SCHED;
        }
        if (wr == 0) PG8_BAR;
        if constexpr (ESZ == 1) asm volatile("s_nop 15\n\ts_nop 15" ::: "memory");
        E(acc, cur, wr, wc, fr, fq);
        if (!has_next) break;
#pragma unroll
        for (int a = 0; a < 2; ++a)
#pragma unroll
            for (int b = 0; b < 2; ++b)
#pragma unroll
                for (int m = 0; m < 4; ++m)
#pragma unroll
                    for (int n = 0; n < 2; ++n) acc[a][b][m][n] = (f32x4){0.f, 0.f, 0.f, 0.f};
        cur = nxt; cA = nA; cB = nB; ++ui;
#pragma unroll
        for (int h = 0; h < 2; ++h)
#pragma unroll
            for (int i = 0; i < 2; ++i) gcur[h][i] = gnxt[h][i];
        if (wr == 1) PG8_BAR;
    }
    PG8_WAIT_V(0);
    PG8_BAR;
#undef PG8_SA
#undef PG8_SB
#undef PG8_STAGE2
#undef PG8_STAGE_B
#undef PG8_LDA
#undef PG8_LDB
#undef PG8_MMA
#undef PG8_WAIT_V
#undef PG8_WAIT_L
#undef PG8_BAR
#undef PG8_SCHED
}
}

constexpr int NWAVES = 8;
#ifndef MK_N_LAUNCHES
#define MK_N_LAUNCHES 1
#endif
#ifndef Z_FP8
#define Z_FP8 1
#endif
constexpr int NPH = 12;
constexpr int N_LAUNCHES = MK_N_LAUNCHES;

constexpr int BATCH = 4, SEQ = 4096, D = 2048, T = BATCH * SEQ;
constexpr int PW = 1024, SW = 1024, INW = PW + SW + 2 * D;
constexpr int NE = 32, TOPK = 4, FE = 2048;
constexpr int SG = 64, SP = 64, SH = 16, CL = 16, NCH = SEQ / CL;
constexpr int UGK = CL * SH + 2 * SP;
constexpr int LCAP = T;
constexpr int MAXBLK = 288;
constexpr float RMS_EPS = 1e-6f;

constexpr size_t MiB = 1u << 20;
constexpr size_t WS_CTL = 0, CTL_ZERO_BYTES = 1 * MiB;
constexpr size_t WS_MOD = 1 * MiB;
constexpr size_t WS_FMOD = WS_MOD + 196608, WS_AL = WS_MOD + 262144;
constexpr size_t WS_WIN = 2 * MiB, WS_POOLW = 26 * MiB, WS_WPO = 27 * MiB, WS_WGLU = 31 * MiB, WS_WOUT = 39 * MiB, WS_WEND = 47 * MiB, WS_TG = 55 * MiB;
constexpr size_t WS_W1 = 68 * MiB, WS_W2 = 580 * MiB;
constexpr size_t WS_XN = 836 * MiB, WS_UP = 900 * MiB, WS_UG = 932 * MiB, WS_SGP = 980 * MiB, WS_SGS = 1044 * MiB, WS_PL = 1108 * MiB, WS_PM = 1140 * MiB, WS_E = 1172 * MiB;
constexpr size_t WS_YPG = 1204 * MiB, WS_YS = 1268 * MiB, WS_MG = 1300 * MiB, WS_X1 = 1364 * MiB, WS_LTOK = 1492 * MiB, WS_LWT = 1494 * MiB, WS_TSLOT = 1496 * MiB;
constexpr size_t WS_ACT = 1498 * MiB, WS_YE = 1786 * MiB, WS_END = 2074 * MiB;
static_assert(WS_TG + (size_t)SG * 256 * UGK * 2 <= WS_W1 && WS_UG + (size_t)SG * 1024 * UGK * 2 <= WS_SGP && WS_ACT + (size_t)MAXBLK * 256 * FE * 2 <= WS_YE, "d_ws map");
constexpr int CW_TMO = 0, CW_CODE = 1, CW_CNT = 64, CW_BAR = 4096;

constexpr int RING_OFF = 0, RING_BYTES = 131072;
constexpr int LDSCTL_OFF = RING_BYTES, MISC_OFF = LDSCTL_OFF + 320;
constexpr int LDS_BYTES = 147456;

#define GAS __attribute__((address_space(1)))
#define LAS __attribute__((address_space(3)))
typedef unsigned short bf16;
typedef unsigned v4u __attribute__((ext_vector_type(4)));
typedef unsigned v2u __attribute__((ext_vector_type(2)));
typedef float f32x4 __attribute__((ext_vector_type(4)));
typedef float f32x16 __attribute__((ext_vector_type(16)));
typedef GAS unsigned gu32;
#define RLX_AGENT __ATOMIC_RELAXED, __HIP_MEMORY_SCOPE_AGENT
#define LDS_WAIT() asm volatile("s_waitcnt lgkmcnt(0)" ::: "memory")
#define VM_WAIT() asm volatile("s_waitcnt vmcnt(0)" ::: "memory")
using pg8::cvt_pk_bf16; using pg8::pk4_fp8; using pg8::bf_lo; using pg8::bf_hi; using pg8::sigmoidf_; using pg8::gelu_tanh_;

#define XB_TMO      128
#define XB_XCNT(j)  (256  + 64 * (j))
#define XB_XSUB(j)  (1280 + 64 * (j))
#define XB_XGEN(j)  (2304 + 64 * (j))
#define XB_TOP      3328
#define XB_TOPGEN   3392
#define XCD_BAR_WORDS 3456
#define XB_SPIN_CAP (1u << 18)

__device__ __forceinline__ unsigned xb_ld(unsigned* p)              { return __hip_atomic_load(p, __ATOMIC_RELAXED, __HIP_MEMORY_SCOPE_AGENT); }
__device__ __forceinline__ unsigned xb_add(unsigned* p, unsigned v) { return __hip_atomic_fetch_add(p, v, __ATOMIC_RELAXED, __HIP_MEMORY_SCOPE_AGENT); }
__device__ __forceinline__ unsigned xb_xcc_id() { return (unsigned)__builtin_amdgcn_s_getreg((3 << 11) | 20) & 0xFu; }
#define XB_SPIN(cond, bar) do { unsigned _sp = 0; while (cond) { __builtin_amdgcn_s_sleep(1); \
    if ((++_sp & 255u) == 0u) { if (xb_ld(&(bar)[XB_TMO])) break; if (_sp > XB_SPIN_CAP) { atomicAdd(&(bar)[XB_TMO], 1u); break; } } } } while (0)

struct XcdBarrier { unsigned* bar; unsigned x; volatile LAS unsigned* st; };

__device__ __forceinline__ XcdBarrier xcd_barrier_post(unsigned* bar, volatile LAS unsigned* st) {
    XcdBarrier b; b.bar = bar; b.x = xb_xcc_id(); b.st = st;
    if (threadIdx.x == 0) (void)xb_add(&bar[XB_XCNT(b.x)], 1u);
    return b;
}
__device__ __forceinline__ void xcd_barrier_complete(unsigned* bar, unsigned x, unsigned& nloc, unsigned& nx) {
    const unsigned G = gridDim.x * gridDim.y * gridDim.z;
    unsigned sum, cnt, mine, sp = 0u;
    for (;;) {
        sum = 0u; cnt = 0u; mine = 0u;
#pragma unroll
        for (unsigned j = 0; j < 16; ++j) { const unsigned c = xb_ld(&bar[XB_XCNT(j)]); sum += c; cnt += (c > 0u) ? 1u : 0u; mine = (j == x) ? c : mine; }
        if (sum == G) break;
        __builtin_amdgcn_s_sleep(1);
        if ((++sp & 255u) == 0u) { if (xb_ld(&bar[XB_TMO])) break; if (sp > XB_SPIN_CAP) { atomicAdd(&bar[XB_TMO], 1u); break; } }
    }
    nloc = mine > 0u ? mine : 1u; nx = cnt > 0u ? cnt : 1u;
}
__device__ __forceinline__ void xcd_barrier(const XcdBarrier& b) {
    asm volatile("s_waitcnt vmcnt(0)" ::: "memory");
    __syncthreads();
    if (threadIdx.x == 0) {
        unsigned* bar = b.bar;
        __builtin_amdgcn_s_waitcnt(0);
        unsigned nloc = b.st[0], nx = b.st[1];
        if (nloc == 0u) { xcd_barrier_complete(bar, b.x, nloc, nx); b.st[0] = nloc; b.st[1] = nx; }
        const unsigned old = xb_add(&bar[XB_XSUB(b.x)], 1u);
        const unsigned gen = old / nloc;
        if (old + 1u == (gen + 1u) * nloc) {
            __builtin_amdgcn_fence(__ATOMIC_RELEASE, "agent");
            asm volatile("s_waitcnt vmcnt(0)" ::: "memory");
            const unsigned og = xb_add(&bar[XB_TOP], 1u);
            const unsigned tg = og / nx;
            if (og + 1u == (tg + 1u) * nx) xb_add(&bar[XB_TOPGEN], 1u);
            else XB_SPIN(xb_ld(&bar[XB_TOPGEN]) == tg, bar);
            __builtin_amdgcn_fence(__ATOMIC_ACQUIRE, "agent");
            xb_add(&bar[XB_XGEN(b.x)], 1u);
            asm volatile("s_waitcnt vmcnt(0)" ::: "memory");
        } else {
            XB_SPIN(xb_ld(&bar[XB_XGEN(b.x)]) == gen, bar);
            __builtin_amdgcn_fence(__ATOMIC_ACQUIRE, "agent");
            asm volatile("s_waitcnt vmcnt(0)" ::: "memory");
        }
    }
    __syncthreads();
}

using pg8::Unit;
struct SchedDense {
    const char* A; const char* Bt; size_t astep, bstep; int nM, nN, nwg, G, c;
    __device__ __forceinline__ void init(const void* A_, const void* Bt_, int M, int N, int lda, int ldb, int G_, int c_, int esz = 2) { A = (const char*)A_; Bt = (const char*)Bt_; astep = (size_t)256 * lda * esz; bstep = (size_t)256 * ldb * esz; nM = M / 256; nN = N / 256; nwg = nM * nN; G = G_; c = c_; }
    __device__ __forceinline__ bool next(int i, Unit& u) const {
        const long L = (long)i * G + c; if (L >= nwg) return false;
        int wgid = (int)L; { const int q = nwg / pg8::NXCD, r = nwg % pg8::NXCD, xcd = wgid % pg8::NXCD, off = wgid / pg8::NXCD; wgid = (xcd < r ? xcd * (q + 1) : r * (q + 1) + (xcd - r) * q) + off; }
        const int nig = pg8::WGM * nN, gid = wgid / nig, fm = gid * pg8::WGM, gsz = (nM - fm) < pg8::WGM ? (nM - fm) : pg8::WGM;
        u.pm = fm + ((wgid % nig) % gsz); u.pn = (wgid % nig) / gsz; u.e = 0; u.rb = 0; u.nvalid = 256; return true;
    }
    __device__ __forceinline__ const char* a_ptr(const Unit& u) const { return A + (size_t)u.pm * astep; }
    __device__ __forceinline__ const char* b_ptr(const Unit& u) const { return Bt + (size_t)u.pn * bstep; }
    __device__ __forceinline__ unsigned a_rowoff(const Unit&, int) const { return 0u; }
};
struct SchedGrouped {
    const char* A; const char* Bt; size_t astep, agstride, bgstride; int nPM, nunits, G, c;
    __device__ __forceinline__ void init(const void* A_, const void* Bt_, int lda, size_t agstride_, size_t bgstride_, int nPM_, int ngroups, int G_, int c_) { A = (const char*)A_; Bt = (const char*)Bt_; astep = (size_t)256 * lda * 2; agstride = agstride_; bgstride = bgstride_; nPM = nPM_; nunits = nPM_ * ngroups; G = G_; c = c_; }
    __device__ __forceinline__ bool next(int i, Unit& u) const { const int L = i * G + c; if (L >= nunits) return false; u.e = L / nPM; u.pm = L % nPM; u.pn = 0; u.rb = 0; u.nvalid = 256; return true; }
    __device__ __forceinline__ const char* a_ptr(const Unit& u) const { return A + (size_t)u.e * agstride + (size_t)u.pm * astep; }
    __device__ __forceinline__ const char* b_ptr(const Unit& u) const { return Bt + (size_t)u.e * bgstride; }
    __device__ __forceinline__ unsigned a_rowoff(const Unit&, int) const { return 0u; }
};
struct SchedMoe {
    const char* A; const char* Bt; size_t astep, bstep_e, bstep_n; int nN, G, c; volatile LAS unsigned* M; const int* ltok; bool gather;
    __device__ __forceinline__ bool next(int i, Unit& u) const {
        const int L = i * G + c; const int total = (int)M[176]; if (L >= total) return false;
        const int ln = threadIdx.x & 63; const int us1 = (int)M[33 + (ln & 31)];
        const int e = __builtin_popcountll(__ballot(ln < 32 && L >= us1));
        const int w = L - (int)M[32 + e], pb = (int)M[80 + e], nb = (int)M[80 + e + 1] - pb, cnt = (int)M[128 + e];
        int rb = w % nb, pn = w / nb;
        rb = __builtin_amdgcn_readfirstlane(rb); pn = __builtin_amdgcn_readfirstlane(pn);
        u.e = e; u.rb = rb; u.pn = pn; u.pm = __builtin_amdgcn_readfirstlane(pb + rb); const int nv = cnt - rb * 256; u.nvalid = __builtin_amdgcn_readfirstlane(nv < 256 ? nv : 256); return true;
    }
    __device__ __forceinline__ const char* a_ptr(const Unit& u) const { return gather ? A : A + (size_t)u.pm * astep; }
    __device__ __forceinline__ const char* b_ptr(const Unit& u) const { return Bt + (size_t)u.e * bstep_e + (size_t)u.pn * bstep_n; }
    __device__ __forceinline__ unsigned a_rowoff(const Unit& u, int r) const { const int idx = (r < u.nvalid) ? (u.rb * 256 + r) : 0; const int tok = ltok[(size_t)u.e * LCAP + idx]; return (unsigned)tok * (unsigned)D; }
};

using pg8::f32x2; using pg8::u32x4;
#define EPI_ARGS const f32x4 (&acc)[2][2][4][2], const Unit& u, int wr, int wc, int fr, int fq
struct EpiZ { static constexpr bool PERM = true; bf16 *UP, *UG, *SGP, *SGS; float asc;
    __device__ __forceinline__ void operator()(EPI_ARGS) const {
        const int pn = u.pn, region = pn < 4 ? 0 : (pn < 8 ? 1 : (pn < 16 ? 2 : 3));
#pragma unroll
        for (int ai = 0; ai < 2; ++ai)
#pragma unroll
            for (int m = 0; m < 4; ++m) { const int row = u.pm * 256 + ai * 128 + wr * 64 + m * 16 + fr;
#pragma unroll
                for (int bj = 0; bj < 2; ++bj) { const int lc = bj * 128 + wc * 32 + 8 * fq; f32x4 v0 = acc[ai][bj][m][0] * asc, v1 = acc[ai][bj][m][1] * asc;
                    if (region >= 2) {
#pragma unroll
                        for (int j = 0; j < 4; ++j) { v0[j] = sigmoidf_(v0[j]); v1[j] = sigmoidf_(v1[j]); } }
                    u32x4 w; w.x = cvt_pk_bf16(v0[0], v0[1]); w.y = cvt_pk_bf16(v0[2], v0[3]); w.z = cvt_pk_bf16(v1[0], v1[1]); w.w = cvt_pk_bf16(v1[2], v1[3]);
                    bf16* dst;
                    if (region == 0) dst = UP + (size_t)row * PW + pn * 256 + lc;
                    else if (region == 1) { const int j = (pn - 4) * 256 + lc, g = j >> 4, h0 = j & 15, b = row >> 12, tp = row & 4095, c = tp >> 4, s = tp & 15; dst = UG + ((size_t)(g * 1024 + b * 256 + c) * UGK + s * 16 + h0); }
                    else if (region == 2) dst = SGP + (size_t)row * D + (pn - 8) * 256 + lc;
                    else dst = SGS + (size_t)row * D + (pn - 16) * 256 + lc;
                    *(u32x4*)dst = w; } }
    }
};
struct EpiS1 { static constexpr bool PERM = false; float* E;
    __device__ __forceinline__ void operator()(EPI_ARGS) const {
#pragma unroll
        for (int ai = 0; ai < 2; ++ai)
#pragma unroll
            for (int m = 0; m < 4; ++m) { const int row = u.pm * 256 + ai * 128 + wr * 64 + m * 16 + fr; float* rp = E + ((size_t)u.e * 1024 + row) * 128 + wc * 32 + 4 * fq;
#pragma unroll
                for (int n = 0; n < 2; ++n) *(f32x4*)(rp + n * 16) = acc[ai][0][m][n]; }
    }
};
struct EpiPmix { static constexpr bool PERM = true; bf16* PM; const float* scale;
    __device__ __forceinline__ void operator()(EPI_ARGS) const {
#pragma unroll
        for (int bj = 0; bj < 2; ++bj) { const int col = u.e * 256 + bj * 128 + wc * 32 + 8 * fq; const f32x4 s0 = *(const f32x4*)(scale + col), s1 = *(const f32x4*)(scale + col + 4);
#pragma unroll
            for (int ai = 0; ai < 2; ++ai)
#pragma unroll
                for (int m = 0; m < 4; ++m) { const int row = u.pm * 256 + ai * 128 + wr * 64 + m * 16 + fr; const f32x4 v0 = acc[ai][bj][m][0] * s0, v1 = acc[ai][bj][m][1] * s1;
                    u32x4 w; w.x = cvt_pk_bf16(v0[0], v0[1]); w.y = cvt_pk_bf16(v0[2], v0[3]); w.z = cvt_pk_bf16(v1[0], v1[1]); w.w = cvt_pk_bf16(v1[2], v1[3]);
                    *(u32x4*)(PM + (size_t)row * PW + col) = w; } }
    }
};
struct EpiS3 { static constexpr bool PERM = true; bf16* YS;
    __device__ __forceinline__ void operator()(EPI_ARGS) const {
#pragma unroll
        for (int ai = 0; ai < 2; ++ai)
#pragma unroll
            for (int m = 0; m < 4; ++m) { const int r = u.pm * 256 + ai * 128 + wr * 64 + m * 16 + fr, b = r >> 8, c = r & 255;
#pragma unroll
                for (int bj = 0; bj < 2; ++bj) { const int lc = bj * 128 + wc * 32 + 8 * fq, t = lc >> 4, h0 = lc & 15; f32x4 v0 = acc[ai][bj][m][0], v1 = acc[ai][bj][m][1];
#pragma unroll
                    for (int j = 0; j < 4; ++j) { v0[j] = gelu_tanh_(v0[j]); v1[j] = gelu_tanh_(v1[j]); }
                    u32x4 w; w.x = cvt_pk_bf16(v0[0], v0[1]); w.y = cvt_pk_bf16(v0[2], v0[3]); w.z = cvt_pk_bf16(v1[0], v1[1]); w.w = cvt_pk_bf16(v1[2], v1[3]);
                    *(u32x4*)(YS + (size_t)(b * SEQ + c * CL + t) * SW + u.e * 16 + h0) = w; } }
    }
};
struct EpiYpool { static constexpr bool PERM = true; bf16* YPG; const bf16* SGP;
    __device__ __forceinline__ void operator()(EPI_ARGS) const {
#pragma unroll
        for (int ai = 0; ai < 2; ++ai)
#pragma unroll
            for (int m = 0; m < 4; ++m) { const int row = u.pm * 256 + ai * 128 + wr * 64 + m * 16 + fr;
#pragma unroll
                for (int bj = 0; bj < 2; ++bj) { const size_t off = (size_t)row * D + u.pn * 256 + bj * 128 + wc * 32 + 8 * fq; const u32x4 g = *(const u32x4*)(SGP + off);
                    const f32x4 v0 = acc[ai][bj][m][0], v1 = acc[ai][bj][m][1];
                    u32x4 w; w.x = cvt_pk_bf16(v0[0] * bf_lo(g.x), v0[1] * bf_hi(g.x)); w.y = cvt_pk_bf16(v0[2] * bf_lo(g.y), v0[3] * bf_hi(g.y));
                    w.z = cvt_pk_bf16(v1[0] * bf_lo(g.z), v1[1] * bf_hi(g.z)); w.w = cvt_pk_bf16(v1[2] * bf_lo(g.w), v1[3] * bf_hi(g.w));
                    *(u32x4*)(YPG + off) = w; } }
    }
};
struct EpiGlu { static constexpr bool PERM = true; bf16* MG; const bf16 *YPG, *SGS; const float* bglu;
    __device__ __forceinline__ void operator()(EPI_ARGS) const {
        const int j0 = u.pn * 128 + wc * 32 + 8 * fq;
        const f32x4 ba0 = *(const f32x4*)(bglu + j0), ba1 = *(const f32x4*)(bglu + j0 + 4), bb0 = *(const f32x4*)(bglu + D + j0), bb1 = *(const f32x4*)(bglu + D + j0 + 4);
#pragma unroll
        for (int ai = 0; ai < 2; ++ai)
#pragma unroll
            for (int m = 0; m < 4; ++m) { const int row = u.pm * 256 + ai * 128 + wr * 64 + m * 16 + fr; const size_t off = (size_t)row * D + j0;
                const u32x4 yp = *(const u32x4*)(YPG + off), gs = *(const u32x4*)(SGS + off);
                const f32x4 a0 = acc[ai][0][m][0] + ba0, a1 = acc[ai][0][m][1] + ba1, b0 = acc[ai][1][m][0] + bb0, b1 = acc[ai][1][m][1] + bb1;
                float o[8];
#pragma unroll
                for (int j = 0; j < 4; ++j) { o[j] = a0[j] * sigmoidf_(b0[j]); o[4 + j] = a1[j] * sigmoidf_(b1[j]); }
                u32x4 w; w.x = cvt_pk_bf16(bf_lo(yp.x) + bf_lo(gs.x) * o[0], bf_hi(yp.x) + bf_hi(gs.x) * o[1]); w.y = cvt_pk_bf16(bf_lo(yp.y) + bf_lo(gs.y) * o[2], bf_hi(yp.y) + bf_hi(gs.y) * o[3]);
                w.z = cvt_pk_bf16(bf_lo(yp.z) + bf_lo(gs.z) * o[4], bf_hi(yp.z) + bf_hi(gs.z) * o[5]); w.w = cvt_pk_bf16(bf_lo(yp.w) + bf_lo(gs.w) * o[6], bf_hi(yp.w) + bf_hi(gs.w) * o[7]);
                *(u32x4*)(MG + off) = w; }
    }
};
struct EpiOut { static constexpr bool PERM = true; float* X1; const float* x; const float* mod;
    __device__ __forceinline__ void operator()(EPI_ARGS) const {
        const int b = (u.pm * 256) >> 12; const float* gt = mod + (size_t)b * 6 * D + 2 * D;
#pragma unroll
        for (int bj = 0; bj < 2; ++bj) { const int col = u.pn * 256 + bj * 128 + wc * 32 + 8 * fq; const f32x4 g0 = *(const f32x4*)(gt + col), g1 = *(const f32x4*)(gt + col + 4);
#pragma unroll
            for (int ai = 0; ai < 2; ++ai)
#pragma unroll
                for (int m = 0; m < 4; ++m) { const int row = u.pm * 256 + ai * 128 + wr * 64 + m * 16 + fr; const size_t off = (size_t)row * D + col;
                    *(f32x4*)(X1 + off) = *(const f32x4*)(x + off) + g0 * acc[ai][bj][m][0]; *(f32x4*)(X1 + off + 4) = *(const f32x4*)(x + off + 4) + g1 * acc[ai][bj][m][1]; } }
    }
};
struct EpiMoe1 { static constexpr bool PERM = true; unsigned char* ACT; const float* b1;
    __device__ __forceinline__ void operator()(EPI_ARGS) const {
        const int j0 = u.pn * 128 + wc * 32 + 8 * fq; const float* bb = b1 + (size_t)u.e * 2 * FE;
        const f32x4 ba0 = *(const f32x4*)(bb + j0), ba1 = *(const f32x4*)(bb + j0 + 4), bl0 = *(const f32x4*)(bb + FE + j0), bl1 = *(const f32x4*)(bb + FE + j0 + 4);
#pragma unroll
        for (int ai = 0; ai < 2; ++ai)
#pragma unroll
            for (int m = 0; m < 4; ++m) { const int row = u.pm * 256 + ai * 128 + wr * 64 + m * 16 + fr;
                const f32x4 a0 = acc[ai][0][m][0] * 0.03125f + ba0, a1 = acc[ai][0][m][1] * 0.03125f + ba1, l0 = acc[ai][1][m][0] * 0.03125f + bl0, l1 = acc[ai][1][m][1] * 0.03125f + bl1;
                float o[8];
#pragma unroll
                for (int j = 0; j < 4; ++j) { const float g0 = fminf(a0[j], 7.0f), g1 = fminf(a1[j], 7.0f), x0 = fminf(fmaxf(l0[j], -7.0f), 7.0f), x1 = fminf(fmaxf(l1[j], -7.0f), 7.0f);
                    o[j] = g0 * sigmoidf_(1.702f * g0) * (x0 + 1.0f); o[4 + j] = g1 * sigmoidf_(1.702f * g1) * (x1 + 1.0f); }
                v2u w; w.x = pk4_fp8(o[0], o[1], o[2], o[3]); w.y = pk4_fp8(o[4], o[5], o[6], o[7]);
                *(v2u*)(ACT + (size_t)row * FE + j0) = w; asm volatile("" ::: "memory"); }
    }
};
struct EpiMoe2 { static constexpr bool PERM = true; bf16* YE; const float* b2; const float* lwt;
    __device__ __forceinline__ void operator()(EPI_ARGS) const {
        const float* bb = b2 + (size_t)u.e * D;
#pragma unroll
        for (int ai = 0; ai < 2; ++ai)
#pragma unroll
            for (int m = 0; m < 4; ++m) { const int r = ai * 128 + wr * 64 + m * 16 + fr; const float wg = (r < u.nvalid) ? lwt[(size_t)u.e * LCAP + u.rb * 256 + r] : 0.0f;
#pragma unroll
                for (int bj = 0; bj < 2; ++bj) { const int col = u.pn * 256 + bj * 128 + wc * 32 + 8 * fq; const f32x4 c0 = *(const f32x4*)(bb + col), c1 = *(const f32x4*)(bb + col + 4);
                    const f32x4 v0 = (acc[ai][bj][m][0] * 0.03125f + c0) * wg, v1 = (acc[ai][bj][m][1] * 0.03125f + c1) * wg;
                    u32x4 w; w.x = cvt_pk_bf16(v0[0], v0[1]); w.y = cvt_pk_bf16(v0[2], v0[3]); w.z = cvt_pk_bf16(v1[0], v1[1]); w.w = cvt_pk_bf16(v1[2], v1[3]);
                    *(u32x4*)(YE + ((size_t)u.pm * 256 + r) * D + col) = w; }
                asm volatile("" ::: "memory"); }
    }
};

__device__ __forceinline__ float wave_sum(float v) {
#pragma unroll
    for (int o = 1; o < 64; o <<= 1) v += __shfl_xor(v, o);
    return v;
}
__device__ __forceinline__ void tr_item(const float* __restrict__ W, int K, int N, bf16* WT, int item, int lane, int mode) {
    const int nblk = N >> 6, kb = item / nblk, nb = item - kb * nblk, k0 = kb * 64, n = nb * 64 + lane;
    int drow = n;
    if (mode) { const int half = N >> 1, hi = n >= half ? 1 : 0, nn = n - hi * half; drow = (nn >> 7) * 256 + hi * 128 + (nn & 127); }
    const float* src = W + (size_t)k0 * N + n;
    float v[64];
#pragma unroll
    for (int i = 0; i < 64; ++i) v[i] = src[(size_t)i * N];
    bf16* dst = WT + (size_t)drow * K + k0;
#pragma unroll
    for (int j = 0; j < 8; ++j) { v4u o; o.x = cvt_pk_bf16(v[8 * j], v[8 * j + 1]); o.y = cvt_pk_bf16(v[8 * j + 2], v[8 * j + 3]); o.z = cvt_pk_bf16(v[8 * j + 4], v[8 * j + 5]); o.w = cvt_pk_bf16(v[8 * j + 6], v[8 * j + 7]);
        *(v4u*)(dst + 8 * j) = o; }
}

struct Args { const void* in[30]; float* out; unsigned char* ws; int ph_lo, ph_hi, li, pad; };

__global__ void __launch_bounds__(NWAVES * 64, 2) fwd_kernel(Args args) {
    extern __shared__ __attribute__((aligned(16))) unsigned char lds_raw[];
    LAS unsigned char* lds = (LAS unsigned char*)lds_raw;
    volatile LAS unsigned* MISC = (volatile LAS unsigned*)(lds + MISC_OFF);
    const int tid = threadIdx.x, lane = tid & 63, wave = __builtin_amdgcn_readfirstlane(tid >> 6);
    const int G = gridDim.x; const int bx = blockIdx.x; const int vcu = (G % 8 == 0) ? (bx % 8) * (G / 8) + bx / 8 : bx;
    unsigned char* ws = args.ws;
    gu32* ctl = (gu32*)(ws + WS_CTL);
    const float* x = (const float*)args.in[0]; const float* cin = (const float*)args.in[1]; const float* ada_w = (const float*)args.in[2]; const float* ada_b = (const float*)args.in[3];
    const float* norm1_g = (const float*)args.in[4]; const float* w_in = (const float*)args.in[5]; const float* pool_w = (const float*)args.in[6]; const float* pool_scale = (const float*)args.in[7];
    const float* w_pool_out = (const float*)args.in[8]; const float* lam_re = (const float*)args.in[9]; const float* lam_im = (const float*)args.in[10]; const float* log_dt = (const float*)args.in[11];
    const float* sb_re = (const float*)args.in[12]; const float* sb_im = (const float*)args.in[13]; const float* sc_re = (const float*)args.in[14]; const float* sc_im = (const float*)args.in[15];
    const float* ssm_d = (const float*)args.in[16]; const float* w_glu = (const float*)args.in[17]; const float* b_glu = (const float*)args.in[18]; const float* w_out = (const float*)args.in[19];
    const float* norm2_g = (const float*)args.in[20]; const float* w_router = (const float*)args.in[21]; const float* b_router = (const float*)args.in[22]; const float* w1 = (const float*)args.in[23];
    const float* b1 = (const float*)args.in[24]; const float* w2 = (const float*)args.in[25]; const float* b2 = (const float*)args.in[26]; const float* fada_w = (const float*)args.in[27];
    const float* fada_b = (const float*)args.in[28]; const float* fnorm_g = (const float*)args.in[29];
    float* out = args.out;
    float* MOD = (float*)(ws + WS_MOD); float* FMOD = (float*)(ws + WS_FMOD); float* AL = (float*)(ws + WS_AL);
    bf16* WinT = (bf16*)(ws + WS_WIN); bf16* PoolWT = (bf16*)(ws + WS_POOLW); bf16* WpoT = (bf16*)(ws + WS_WPO); bf16* WgluT = (bf16*)(ws + WS_WGLU); bf16* WoutT = (bf16*)(ws + WS_WOUT);
    bf16* WendT = (bf16*)(ws + WS_WEND); bf16* TG = (bf16*)(ws + WS_TG); unsigned char* W1T8 = ws + WS_W1; unsigned char* W2T8 = ws + WS_W2;
    bf16* XN = (bf16*)(ws + WS_XN); bf16* UP = (bf16*)(ws + WS_UP); bf16* UG = (bf16*)(ws + WS_UG); bf16* SGP = (bf16*)(ws + WS_SGP); bf16* SGS = (bf16*)(ws + WS_SGS);
    bf16* PL = (bf16*)(ws + WS_PL); bf16* PM = (bf16*)(ws + WS_PM); float* EB = (float*)(ws + WS_E); bf16* YPG = (bf16*)(ws + WS_YPG); bf16* YS = (bf16*)(ws + WS_YS);
    bf16* MG = (bf16*)(ws + WS_MG); float* X1 = (float*)(ws + WS_X1); int* LTOK = (int*)(ws + WS_LTOK); float* LWT = (float*)(ws + WS_LWT); int* TSLOT = (int*)(ws + WS_TSLOT);
    unsigned char* ACT8 = ws + WS_ACT; bf16* YE = (bf16*)(ws + WS_YE); unsigned char* XN8 = ws + WS_XN;

    for (int u = tid; u < (LDS_BYTES - LDSCTL_OFF) / 4; u += NWAVES * 64) ((LAS unsigned*)(lds + LDSCTL_OFF))[u] = 0u;
    __syncthreads();
    XcdBarrier bar; bar.bar = (unsigned*)(ctl + CW_BAR); bar.x = 0; bar.st = nullptr;
    if (N_LAUNCHES == 1) bar = xcd_barrier_post((unsigned*)(ctl + CW_BAR), MISC + 8);
#define GRID_BAR() do { if (N_LAUNCHES == 1) xcd_barrier(bar); } while (0)
    const int lo = args.ph_lo, hi = args.ph_hi;
#ifndef PHSEL
#define PHSEL -1
#endif
#define IN(k) (PHSEL < 0 ? (lo <= (k) && (k) < hi) : ((k) == PHSEL))
#define BOTH(k) (IN(k) && IN((k) + 1))
#ifndef DUPSEL
#define DUPSEL -1
#endif
#define REP(k) ((DUPSEL == (k)) ? 2 : 1)
    const int gw = vcu * NWAVES + wave, NGW = G * NWAVES;

    if (IN(0)) for (int rep_ = 0; rep_ < REP(0); ++rep_) {
        LAS float* CA = (LAS float*)(lds + RING_OFF);
        LAS float* RED = (LAS float*)(lds + RING_OFF + 32768);
        for (int i = tid; i < BATCH * D; i += NWAVES * 64) { const float c = cin[i]; CA[i] = c * sigmoidf_(c); }
        __syncthreads();
        for (int cb = vcu; cb < (6 * D + 2 * D) / 64; cb += G) {
            const int col0 = cb * 64; const float* W; int N, cc; const float* bias; float* dst; int dld;
            if (col0 < 6 * D) { W = ada_w; N = 6 * D; cc = col0; bias = ada_b; dst = MOD; dld = 6 * D; } else { W = fada_w; N = 2 * D; cc = col0 - 6 * D; bias = fada_b; dst = FMOD; dld = 2 * D; }
            const int c4 = lane & 15, kr = lane >> 4;
            f32x4 a0 = {0.f, 0.f, 0.f, 0.f}, a1 = a0, a2 = a0, a3 = a0;
            const float* wp = W + (size_t)(256 * wave + kr) * N + cc + 4 * c4;
#pragma unroll 16
            for (int kk = 0; kk < 64; ++kk) { const f32x4 v = *(const f32x4*)(wp + (size_t)kk * 4 * N); const int k = 256 * wave + kk * 4 + kr;
                a0 += v * CA[k]; a1 += v * CA[D + k]; a2 += v * CA[2 * D + k]; a3 += v * CA[3 * D + k]; }
#pragma unroll
            for (int j = 0; j < 4; ++j) { a0[j] += __shfl_xor(a0[j], 16); a0[j] += __shfl_xor(a0[j], 32); a1[j] += __shfl_xor(a1[j], 16); a1[j] += __shfl_xor(a1[j], 32);
                a2[j] += __shfl_xor(a2[j], 16); a2[j] += __shfl_xor(a2[j], 32); a3[j] += __shfl_xor(a3[j], 16); a3[j] += __shfl_xor(a3[j], 32); }
            if (kr == 0) {
#pragma unroll
                for (int j = 0; j < 4; ++j) { RED[(wave * 4 + 0) * 64 + 4 * c4 + j] = a0[j]; RED[(wave * 4 + 1) * 64 + 4 * c4 + j] = a1[j]; RED[(wave * 4 + 2) * 64 + 4 * c4 + j] = a2[j]; RED[(wave * 4 + 3) * 64 + 4 * c4 + j] = a3[j]; } }
            __syncthreads();
            if (tid < 256) { const int b = tid >> 6, c = tid & 63; float s = bias[cc + c];
#pragma unroll
                for (int w = 0; w < 8; ++w) s += RED[(w * 4 + b) * 64 + c];
                dst[(size_t)b * dld + cc + c] = s; }
            __syncthreads();
        }
        if (BOTH(0)) GRID_BAR();
    }

    if (IN(1)) for (int rep_ = 0; rep_ < REP(1); ++rep_) {
        {
            LAS float* AP = (LAS float*)(lds + RING_OFF);
            LAS float* BBm = (LAS float*)(lds + RING_OFF + 16384);
            LAS float* CCm = (LAS float*)(lds + RING_OFF + 32768);
            LAS float* MT = (LAS float*)(lds + RING_OFF + 49152);
            for (int it = vcu; it < SG * 4; it += G) {
                const int g = it >> 2, part = it & 3;
                if (tid < 64) { const int p = tid; const float dt = expf(log_dt[g]); const float lre = fminf(lam_re[g * SP + p], -1e-4f), lim = lam_im[g * SP + p];
                    for (int k = 0; k <= 16; ++k) { const float mag = expf(lre * dt * (float)k), ang = lim * dt * (float)k; AP[(k * 64 + p) * 2] = mag * cosf(ang); AP[(k * 64 + p) * 2 + 1] = mag * sinf(ang); }
                    const float mag = expf(lre * dt), ang = lim * dt; const float abr = mag * cosf(ang), abi = mag * sinf(ang);
                    const float den = lre * lre + lim * lim, nr = abr - 1.0f, ni = abi; const float fr_ = (nr * lre + ni * lim) / den, fi_ = (ni * lre - nr * lim) / den;
                    for (int h = 0; h < SH; ++h) { const float br = sb_re[((size_t)g * SP + p) * SH + h], bi = sb_im[((size_t)g * SP + p) * SH + h]; BBm[(p * 16 + h) * 2] = fr_ * br - fi_ * bi; BBm[(p * 16 + h) * 2 + 1] = fr_ * bi + fi_ * br; }
                    for (int h = 0; h < SH; ++h) { CCm[(h * 64 + p) * 2] = sc_re[((size_t)g * SH + h) * SP + p]; CCm[(h * 64 + p) * 2 + 1] = sc_im[((size_t)g * SH + h) * SP + p]; }
                    if (part == 0) { AL[(g * SP + p) * 2] = AP[(16 * 64 + p) * 2]; AL[(g * SP + p) * 2 + 1] = AP[(16 * 64 + p) * 2 + 1]; }
                }
                __syncthreads();
                for (int idx = tid; idx < 4096; idx += NWAVES * 64) { const int k = idx >> 8, hp = (idx >> 4) & 15, h = idx & 15; float s = 0.f;
                    for (int p = 0; p < SP; ++p) { const float ar = AP[(k * 64 + p) * 2], ai = AP[(k * 64 + p) * 2 + 1], cr = CCm[(hp * 64 + p) * 2], ci = CCm[(hp * 64 + p) * 2 + 1];
                        const float car = cr * ar - ci * ai, cai = cr * ai + ci * ar; s += car * BBm[(p * 16 + h) * 2] - cai * BBm[(p * 16 + h) * 2 + 1]; }
                    if (k == 0 && h == hp) s += ssm_d[g * SH + hp];
                    MT[idx] = s; }
                __syncthreads();
                for (int vi = tid; vi < 64 * (UGK / 8); vi += NWAVES * 64) { const int nl = vi / (UGK / 8), kv = vi - nl * (UGK / 8), n = part * 64 + nl, t = n >> 4, hp = n & 15, k0 = kv * 8; float val[8];
#pragma unroll
                    for (int j = 0; j < 8; ++j) { const int k = k0 + j;
                        if (k < 256) { const int s = k >> 4, h = k & 15; val[j] = (s <= t) ? MT[((t - s) << 8) + (hp << 4) + h] : 0.f; }
                        else { const int comp = k - 256, p = comp & 63; const float ar = AP[((t + 1) * 64 + p) * 2], ai = AP[((t + 1) * 64 + p) * 2 + 1], cr = CCm[(hp * 64 + p) * 2], ci = CCm[(hp * 64 + p) * 2 + 1];
                            val[j] = comp < 64 ? (cr * ar - ci * ai) : -(cr * ai + ci * ar); } }
                    v4u o; o.x = cvt_pk_bf16(val[0], val[1]); o.y = cvt_pk_bf16(val[2], val[3]); o.z = cvt_pk_bf16(val[4], val[5]); o.w = cvt_pk_bf16(val[6], val[7]);
                    *(v4u*)(TG + ((size_t)g * 256 + n) * UGK + k0) = o; }
                for (int vi = tid; vi < 64 * 32; vi += NWAVES * 64) { const int nl = vi >> 5, kv = vi & 31, n = part * 64 + nl, k0 = kv * 8; float val[8];
#pragma unroll
                    for (int j = 0; j < 8; ++j) { const int k = k0 + j, s = k >> 4, h = k & 15;
                        if (n < 128) { const int p = n & 63; const float ar = AP[((15 - s) * 64 + p) * 2], ai = AP[((15 - s) * 64 + p) * 2 + 1], br = BBm[(p * 16 + h) * 2], bi = BBm[(p * 16 + h) * 2 + 1];
                            val[j] = n < 64 ? (ar * br - ai * bi) : (ar * bi + ai * br); } else val[j] = 0.f; }
                    v4u o; o.x = cvt_pk_bf16(val[0], val[1]); o.y = cvt_pk_bf16(val[2], val[3]); o.z = cvt_pk_bf16(val[4], val[5]); o.w = cvt_pk_bf16(val[6], val[7]);
                    *(v4u*)(WendT + ((size_t)g * 256 + n) * 256 + k0) = o; }
                __syncthreads();
            }
        }
        {
            const int RPW = (T + NGW - 1) / NGW; int cb = -1; f32x4 Av[8], Bv[8];
            for (int i = 0; i < RPW; ++i) {
                const int row = gw * RPW + i; if (row >= T) break;
                const int b = row >> 12;
                if (b != cb) { cb = b; const float* mb = MOD + (size_t)b * 6 * D;
#pragma unroll
                    for (int j = 0; j < 8; ++j) { const int k = 4 * lane + 256 * j; const f32x4 g = *(const f32x4*)(norm1_g + k), sh = *(const f32x4*)(mb + k), sc = *(const f32x4*)(mb + D + k); Av[j] = g * (sc + 1.0f); Bv[j] = sh; } }
                const float* xr = x + (size_t)row * D + 4 * lane;
                f32x4 v[8]; float ss = 0.f;
#pragma unroll
                for (int j = 0; j < 8; ++j) { v[j] = *(const f32x4*)(xr + 256 * j); ss += v[j][0] * v[j][0] + v[j][1] * v[j][1] + v[j][2] * v[j][2] + v[j][3] * v[j][3]; }
                const float rstd = 1.0f / sqrtf(wave_sum(ss) * (1.0f / D) + RMS_EPS);
#pragma unroll
                for (int j = 0; j < 8; ++j) { const int k = 4 * lane + 256 * j; const f32x4 h = v[j] * rstd * Av[j] + Bv[j]; if (Z_FP8) *(unsigned*)(XN8 + (size_t)row * D + k) = pk4_fp8(h[0], h[1], h[2], h[3]); else { v2u o; o.x = cvt_pk_bf16(h[0], h[1]); o.y = cvt_pk_bf16(h[2], h[3]); *(v2u*)(XN + (size_t)row * D + k) = o; } }
            }
        }
        {
            constexpr int T_IN = Z_FP8 ? 0 : (D / 64) * (INW / 256), T_PW = 4 * 4, T_PO = (PW / 64) * (D / 256), T_GL = (SW / 64) * (2 * D / 256), T_OUT = (D / 64) * (D / 256);
            constexpr int NTILES = T_IN + T_PW + T_PO + T_GL + T_OUT;
            constexpr int TRB = 256 * 144;
#define TR_DECODE(it_, W_, WT_, K_, N_, mode_, k0_, n0_) do { int r_ = (it_); \
                if (r_ < T_IN) { W_ = w_in; WT_ = WinT; K_ = D; N_ = INW; mode_ = 0; } \
                else if ((r_ -= T_IN) < T_PW) { const int q_ = r_ >> 2; r_ &= 3; W_ = pool_w + (size_t)q_ * 65536; WT_ = PoolWT + (size_t)q_ * 65536; K_ = 256; N_ = 256; mode_ = 0; } \
                else if ((r_ -= T_PW) < T_PO) { W_ = w_pool_out; WT_ = WpoT; K_ = PW; N_ = D; mode_ = 0; } \
                else if ((r_ -= T_PO) < T_GL) { W_ = w_glu; WT_ = WgluT; K_ = SW; N_ = 2 * D; mode_ = 1; } \
                else { r_ -= T_GL; W_ = w_out; WT_ = WoutT; K_ = D; N_ = D; mode_ = 0; } \
                const int nblk_ = N_ >> 8; k0_ = (r_ / nblk_) * 64; n0_ = (r_ % nblk_) * 256; } while (0)
#define TR_LOAD(reg_, W_, N_, k0_, n0_) do { const float* p_ = W_ + (size_t)(k0_ + 8 * wave) * N_ + n0_ + 4 * lane; \
                _Pragma("unroll") for (int i_ = 0; i_ < 8; ++i_) reg_[i_] = *(const f32x4*)(p_ + (size_t)i_ * N_); } while (0)
#define TR_PUT(reg_, buf_) do { _Pragma("unroll") for (int j_ = 0; j_ < 4; ++j_) { v4u o_; o_.x = cvt_pk_bf16(reg_[0][j_], reg_[1][j_]); o_.y = cvt_pk_bf16(reg_[2][j_], reg_[3][j_]); \
                o_.z = cvt_pk_bf16(reg_[4][j_], reg_[5][j_]); o_.w = cvt_pk_bf16(reg_[6][j_], reg_[7][j_]); *(LAS v4u*)(lds + RING_OFF + (buf_) * TRB + (4 * lane + j_) * 144 + 16 * wave) = o_; } } while (0)
#define TR_FLUSH(buf_, WT_, K_, N_, mode_, k0_, n0_) do { _Pragma("unroll") for (int p_ = 0; p_ < 4; ++p_) { const int n_ = 64 * p_ + (tid >> 3), c_ = tid & 7; \
                const v4u q_ = *(const LAS v4u*)(lds + RING_OFF + (buf_) * TRB + n_ * 144 + 16 * c_); const int gn_ = n0_ + n_; int drow_ = gn_; \
                if (mode_) { const int half_ = N_ >> 1, hi_ = gn_ >= half_ ? 1 : 0, nn_ = gn_ - hi_ * half_; drow_ = (nn_ >> 7) * 256 + hi_ * 128 + (nn_ & 127); } \
                *(v4u*)(WT_ + (size_t)drow_ * K_ + k0_ + 8 * c_) = q_; } } while (0)
#define TR_BAR() do { LDS_WAIT(); __builtin_amdgcn_s_barrier(); asm volatile("" ::: "memory"); } while (0)
            int itA = vcu, itB = vcu + G;
            const float *WA = nullptr, *WB = nullptr; bf16 *TA = nullptr, *TB = nullptr; int KA = 0, NA = 0, mA = 0, kA = 0, nA = 0, KB = 0, NB = 0, mB = 0, kB = 0, nB = 0;
            f32x4 ra[8], rb[8];
            if (itA < NTILES) { TR_DECODE(itA, WA, TA, KA, NA, mA, kA, nA); TR_LOAD(ra, WA, NA, kA, nA); }
            if (itB < NTILES) { TR_DECODE(itB, WB, TB, KB, NB, mB, kB, nB); TR_LOAD(rb, WB, NB, kB, nB); }
            while (itA < NTILES) {
                TR_PUT(ra, 0);
                { bf16* dT = TA; const int dK = KA, dN = NA, dm = mA, dk = kA, dn = nA;
                  itA += 2 * G; if (itA < NTILES) { TR_DECODE(itA, WA, TA, KA, NA, mA, kA, nA); TR_LOAD(ra, WA, NA, kA, nA); }
                  TR_BAR();
                  TR_FLUSH(0, dT, dK, dN, dm, dk, dn); }
                if (itB >= NTILES) break;
                TR_PUT(rb, 1);
                { bf16* dT = TB; const int dK = KB, dN = NB, dm = mB, dk = kB, dn = nB;
                  itB += 2 * G; if (itB < NTILES) { TR_DECODE(itB, WB, TB, KB, NB, mB, kB, nB); TR_LOAD(rb, WB, NB, kB, nB); }
                  TR_BAR();
                  TR_FLUSH(1, dT, dK, dN, dm, dk, dn); }
            }
            __syncthreads();
            {
                constexpr int U_IN = Z_FP8 ? (D / 128) * (INW / 256) : 0, U_W1E = (D / 128) * (2 * FE / 256), U_W2E = (FE / 128) * (D / 256), U_W1 = NE * U_W1E, U_TOT = U_IN + U_W1 + NE * U_W2E;
#define T8_DECODE(it_, W_, WT_, K_, N_, mode_, k0_, n0_) do { int r_ = (it_); \
                    if (r_ < U_IN) { W_ = w_in; WT_ = (unsigned char*)WinT; K_ = D; N_ = INW; mode_ = 0; } \
                    else if ((r_ -= U_IN) < U_W1) { const int e_ = r_ / U_W1E; r_ -= e_ * U_W1E; W_ = w1 + (size_t)e_ * D * 2 * FE; WT_ = W1T8 + (size_t)e_ * D * 2 * FE; K_ = D; N_ = 2 * FE; mode_ = 1; } \
                    else { r_ -= U_W1; const int e_ = r_ / U_W2E; r_ -= e_ * U_W2E; W_ = w2 + (size_t)e_ * FE * D; WT_ = W2T8 + (size_t)e_ * FE * D; K_ = FE; N_ = D; mode_ = 0; } \
                    const int nblk_ = N_ >> 8; k0_ = (r_ / nblk_) * 128; n0_ = (r_ % nblk_) * 256; } while (0)
#define T8_LOAD(reg_, W_, N_, k0_, n0_) do { const float* p_ = W_ + (size_t)(k0_ + 16 * wave) * N_ + n0_ + 4 * lane; \
                    _Pragma("unroll") for (int i_ = 0; i_ < 16; ++i_) reg_[i_] = *(const f32x4*)(p_ + (size_t)i_ * N_); } while (0)
#define T8_PUT(reg_, buf_) do { _Pragma("unroll") for (int j_ = 0; j_ < 4; ++j_) { v4u o_; o_.x = pk4_fp8(32.f * reg_[0][j_], 32.f * reg_[1][j_], 32.f * reg_[2][j_], 32.f * reg_[3][j_]); o_.y = pk4_fp8(32.f * reg_[4][j_], 32.f * reg_[5][j_], 32.f * reg_[6][j_], 32.f * reg_[7][j_]); \
                    o_.z = pk4_fp8(32.f * reg_[8][j_], 32.f * reg_[9][j_], 32.f * reg_[10][j_], 32.f * reg_[11][j_]); o_.w = pk4_fp8(32.f * reg_[12][j_], 32.f * reg_[13][j_], 32.f * reg_[14][j_], 32.f * reg_[15][j_]); \
                    *(LAS v4u*)(lds + RING_OFF + (buf_) * TRB + (4 * lane + j_) * 144 + 16 * wave) = o_; } } while (0)
#define T8_FLUSH(buf_, WT_, K_, N_, mode_, k0_, n0_) do { _Pragma("unroll") for (int p_ = 0; p_ < 4; ++p_) { const int n_ = 64 * p_ + (tid >> 3), c_ = tid & 7; \
                    const v4u q_ = *(const LAS v4u*)(lds + RING_OFF + (buf_) * TRB + n_ * 144 + 16 * c_); const int gn_ = n0_ + n_; int drow_ = gn_; \
                    if (mode_) { const int half_ = N_ >> 1, hi_ = gn_ >= half_ ? 1 : 0, nn_ = gn_ - hi_ * half_; drow_ = (nn_ >> 7) * 256 + hi_ * 128 + (nn_ & 127); } \
                    *(v4u*)(WT_ + (size_t)drow_ * K_ + k0_ + 16 * c_) = q_; } } while (0)
                int itA = vcu, itB = vcu + G;
                const float *WA = nullptr, *WB = nullptr; unsigned char *TA = nullptr, *TB = nullptr; int KA = 0, NA = 0, mA = 0, kA = 0, nA = 0, KB = 0, NB = 0, mB = 0, kB = 0, nB = 0;
                f32x4 ra[16], rb[16];
                if (itA < U_TOT) { T8_DECODE(itA, WA, TA, KA, NA, mA, kA, nA); T8_LOAD(ra, WA, NA, kA, nA); }
                if (itB < U_TOT) { T8_DECODE(itB, WB, TB, KB, NB, mB, kB, nB); T8_LOAD(rb, WB, NB, kB, nB); }
                while (itA < U_TOT) {
                    T8_PUT(ra, 0);
                    { unsigned char* dT = TA; const int dK = KA, dN = NA, dm = mA, dk = kA, dn = nA;
                      itA += 2 * G; if (itA < U_TOT) { T8_DECODE(itA, WA, TA, KA, NA, mA, kA, nA); T8_LOAD(ra, WA, NA, kA, nA); }
                      TR_BAR();
                      T8_FLUSH(0, dT, dK, dN, dm, dk, dn); }
                    if (itB >= U_TOT) break;
                    T8_PUT(rb, 1);
                    { unsigned char* dT = TB; const int dK = KB, dN = NB, dm = mB, dk = kB, dn = nB;
                      itB += 2 * G; if (itB < U_TOT) { T8_DECODE(itB, WB, TB, KB, NB, mB, kB, nB); T8_LOAD(rb, WB, NB, kB, nB); }
                      TR_BAR();
                      T8_FLUSH(1, dT, dK, dN, dm, dk, dn); }
                }
                __syncthreads();
#undef T8_DECODE
#undef T8_LOAD
#undef T8_PUT
#undef T8_FLUSH
            }
#undef TR_DECODE
#undef TR_LOAD
#undef TR_PUT
#undef TR_FLUSH
#undef TR_BAR
        }
        if (BOTH(1)) GRID_BAR();
    }

    if (IN(2)) {
        SchedDense S; S.init(Z_FP8 ? (const void*)XN8 : (const void*)XN, WinT, T, INW, D, D, G, bx, Z_FP8 ? 1 : 2);
        EpiZ E{UP, UG, SGP, SGS, Z_FP8 ? 0.03125f : 1.0f};
        pg8::gemm_phase<EpiZ, SchedDense, false, Z_FP8 ? 1 : 2>(lds + RING_OFF, D, D, D, S, E);
        if (DUPSEL == 2) { pg8::gemm_phase<EpiZ, SchedDense, false, Z_FP8 ? 1 : 2>(lds + RING_OFF, D, D, D, S, E); }
        if (BOTH(2)) GRID_BAR();
    }

    if (IN(3)) {
        for (int it = gw; it < BATCH * 128 * 4; it += NGW) {
            const int gq = it & 3, tb = (it >> 2) & 127, b = it >> 9, w = 2 << gq, oct = lane & 31, th = lane >> 5, t0 = tb * 32 + th * 16;
            const bf16* up = UP + (size_t)b * SEQ * PW + gq * 256 + oct * 8; bf16* pl = PL + (size_t)b * SEQ * PW + gq * 256 + oct * 8;
            float Sx[8];
#pragma unroll
            for (int j = 0; j < 8; ++j) Sx[j] = 0.f;
            for (int jj = w - 1; jj >= 1; --jj) { const int tp = t0 - jj; if (tp >= 0) { const v4u q = *(const v4u*)(up + (size_t)tp * PW);
                Sx[0] += bf_lo(q.x); Sx[1] += bf_hi(q.x); Sx[2] += bf_lo(q.y); Sx[3] += bf_hi(q.y); Sx[4] += bf_lo(q.z); Sx[5] += bf_hi(q.z); Sx[6] += bf_lo(q.w); Sx[7] += bf_hi(q.w); } }
            for (int tt = 0; tt < 16; ++tt) { const int tp = t0 + tt; const v4u q = *(const v4u*)(up + (size_t)tp * PW);
                float uu[8] = {bf_lo(q.x), bf_hi(q.x), bf_lo(q.y), bf_hi(q.y), bf_lo(q.z), bf_hi(q.z), bf_lo(q.w), bf_hi(q.w)};
                const float cnt = (float)((tp + 1) < w ? (tp + 1) : w); float o[8];
#pragma unroll
                for (int j = 0; j < 8; ++j) { Sx[j] += uu[j]; o[j] = Sx[j] / cnt - uu[j]; }
                v4u ov; ov.x = cvt_pk_bf16(o[0], o[1]); ov.y = cvt_pk_bf16(o[2], o[3]); ov.z = cvt_pk_bf16(o[4], o[5]); ov.w = cvt_pk_bf16(o[6], o[7]);
                *(v4u*)(pl + (size_t)tp * PW) = ov;
                const int tq = tp - w + 1; if (tq >= 0) { const v4u q2 = *(const v4u*)(up + (size_t)tq * PW);
                    Sx[0] -= bf_lo(q2.x); Sx[1] -= bf_hi(q2.x); Sx[2] -= bf_lo(q2.y); Sx[3] -= bf_hi(q2.y); Sx[4] -= bf_lo(q2.z); Sx[5] -= bf_hi(q2.z); Sx[6] -= bf_lo(q2.w); Sx[7] -= bf_hi(q2.w); } }
        }
        __syncthreads();
        SchedGrouped S; S.init(UG, WendT, UGK, (size_t)1024 * UGK * 2, (size_t)256 * 256 * 2, 4, SG, G, vcu);
        EpiS1 E{EB};
        pg8::gemm_phase<EpiS1, SchedGrouped, false>(lds + RING_OFF, UGK, 256, 256, S, E); if (DUPSEL == 3) { pg8::gemm_phase<EpiS1, SchedGrouped, false>(lds + RING_OFF, UGK, 256, 256, S, E); }
        if (BOTH(3)) GRID_BAR();
    }

    if (IN(4)) {
        if (wave == 0) {
            for (int it = vcu; it < BATCH * SG; it += G) {
                const int b = it >> 6, g = it & 63, p = lane; const float ar = AL[(g * SP + p) * 2], ai = AL[(g * SP + p) * 2 + 1];
                float xr = 0.f, xi = 0.f; const size_t rb = (size_t)g * 1024 + b * 256;
#pragma unroll 8
                for (int c = 0; c < NCH; ++c) { const float er = EB[(rb + c) * 128 + p], ei = EB[(rb + c) * 128 + 64 + p];
                    UG[(rb + c) * UGK + 256 + p] = (bf16)(cvt_pk_bf16(xr, 0.f) & 0xffffu); UG[(rb + c) * UGK + 320 + p] = (bf16)(cvt_pk_bf16(xi, 0.f) & 0xffffu);
                    const float nr = ar * xr - ai * xi + er, ni = ar * xi + ai * xr + ei; xr = nr; xi = ni; }
            }
        }
        SchedGrouped S; S.init(PL, PoolWT, PW, (size_t)256 * 2, (size_t)256 * 256 * 2, T / 256, 4, G, vcu);
        EpiPmix E{PM, pool_scale};
        pg8::gemm_phase<EpiPmix, SchedGrouped, false>(lds + RING_OFF, PW, 256, 256, S, E); if (DUPSEL == 4) { pg8::gemm_phase<EpiPmix, SchedGrouped, false>(lds + RING_OFF, PW, 256, 256, S, E); }
        if (BOTH(4)) GRID_BAR();
    }

    if (IN(5)) {
        { SchedGrouped S; S.init(UG, TG, UGK, (size_t)1024 * UGK * 2, (size_t)256 * UGK * 2, 4, SG, G, vcu);
          EpiS3 E{YS};
          pg8::gemm_phase<EpiS3, SchedGrouped, false>(lds + RING_OFF, UGK, UGK, UGK, S, E); if (DUPSEL == 5) { pg8::gemm_phase<EpiS3, SchedGrouped, false>(lds + RING_OFF, UGK, UGK, UGK, S, E); } }
        { SchedDense S; S.init(PM, WpoT, T, D, PW, PW, G, bx);
          EpiYpool E{YPG, SGP};
          pg8::gemm_phase<EpiYpool, SchedDense, false>(lds + RING_OFF, PW, PW, PW, S, E); if (DUPSEL == 5) { pg8::gemm_phase<EpiYpool, SchedDense, false>(lds + RING_OFF, PW, PW, PW, S, E); } }
        if (BOTH(5)) GRID_BAR();
    }

    if (IN(6)) {
        SchedDense S; S.init(YS, WgluT, T, 2 * D, SW, SW, G, bx);
        EpiGlu E{MG, YPG, SGS, b_glu};
        pg8::gemm_phase<EpiGlu, SchedDense, false>(lds + RING_OFF, SW, SW, SW, S, E);
        if (DUPSEL == 6) { pg8::gemm_phase<EpiGlu, SchedDense, false>(lds + RING_OFF, SW, SW, SW, S, E); }
        if (BOTH(6)) GRID_BAR();
    }

    if (IN(7)) {
        SchedDense S; S.init(MG, WoutT, T, D, D, D, G, bx);
        EpiOut E{X1, x, MOD};
        pg8::gemm_phase<EpiOut, SchedDense, false>(lds + RING_OFF, D, D, D, S, E);
        if (DUPSEL == 7) { pg8::gemm_phase<EpiOut, SchedDense, false>(lds + RING_OFF, D, D, D, S, E); }
        if (BOTH(7)) GRID_BAR();
    }

    if (IN(8)) for (int rep_ = 0; rep_ < REP(8); ++rep_) {
        LAS float* HT = (LAS float*)(lds + RING_OFF);
        LAS float* RED = (LAS float*)(lds + RING_OFF + 65792);
        LAS float* LG = (LAS float*)(lds + RING_OFF + 98560);
        LAS int* HIST = (LAS int*)(lds + RING_OFF + 102784);
        LAS int* BASE = (LAS int*)(lds + RING_OFF + 102912);
        for (int tile = vcu; tile < T / 32; tile += G) {
            const int R0 = tile * 32, b = R0 >> 12; const float* mb = MOD + (size_t)b * 6 * D;
            f32x4 v[4][8]; float rstd[4];
#pragma unroll
            for (int rr = 0; rr < 4; ++rr) { const int row = R0 + 4 * wave + rr; const float* xr = X1 + (size_t)row * D + 4 * lane; float ss = 0.f;
#pragma unroll
                for (int j = 0; j < 8; ++j) { v[rr][j] = *(const f32x4*)(xr + 256 * j); ss += v[rr][j][0] * v[rr][j][0] + v[rr][j][1] * v[rr][j][1] + v[rr][j][2] * v[rr][j][2] + v[rr][j][3] * v[rr][j][3]; }
                rstd[rr] = 1.0f / sqrtf(wave_sum(ss) * (1.0f / D) + RMS_EPS); }
#pragma unroll
            for (int j = 0; j < 8; ++j) { const int k = 4 * lane + 256 * j; const f32x4 g = *(const f32x4*)(norm2_g + k), sh = *(const f32x4*)(mb + 3 * D + k), sc = *(const f32x4*)(mb + 4 * D + k); const f32x4 Aj = g * (sc + 1.0f);
#pragma unroll
                for (int rr = 0; rr < 4; ++rr) { const int row = R0 + 4 * wave + rr; v[rr][j] = v[rr][j] * rstd[rr] * Aj + sh;
                    *(unsigned*)(XN8 + (size_t)row * D + k) = pk4_fp8(v[rr][j][0], v[rr][j][1], v[rr][j][2], v[rr][j][3]); } }
            if (tid < 32) HIST[tid] = 0;
            f32x16 lacc;
#pragma unroll
            for (int j = 0; j < 16; ++j) lacc[j] = 0.f;
#pragma unroll
            for (int q = 0; q < 4; ++q) {
                __syncthreads();
#pragma unroll
                for (int rr = 0; rr < 4; ++rr)
#pragma unroll
                    for (int jj = 0; jj < 2; ++jj) { const int lk = 4 * lane + 256 * jj; LAS float* hp = HT + (4 * wave + rr) * 513 + lk; const f32x4 q4 = v[rr][2 * q + jj]; hp[0] = q4[0]; hp[1] = q4[1]; hp[2] = q4[2]; hp[3] = q4[3]; }
                __syncthreads();
                const float* wrp = w_router + (size_t)(q * 512 + 64 * wave + (lane >> 5)) * NE + (lane & 31); const LAS float* ap = HT + (lane & 31) * 513 + 64 * wave + (lane >> 5);
#pragma unroll 8
                for (int s = 0; s < 32; ++s) lacc = __builtin_amdgcn_mfma_f32_32x32x2f32(ap[2 * s], wrp[(size_t)2 * s * NE], lacc, 0, 0, 0);
            }
#pragma unroll
            for (int rg = 0; rg < 16; ++rg) { const int i = (rg & 3) + 8 * (rg >> 2) + 4 * (lane >> 5); RED[(wave * 32 + i) * 32 + (lane & 31)] = lacc[rg]; }
            __syncthreads();
#pragma unroll
            for (int pp = 0; pp < 2; ++pp) { const int p = tid + pp * 512, i = p >> 5, j = p & 31; float s = b_router[j];
#pragma unroll
                for (int w = 0; w < 8; ++w) s += RED[(w * 32 + i) * 32 + j];
                LG[i * 33 + j] = s; }
            __syncthreads();
            int idx[4] = {0, 0, 0, 0}; float wv[4] = {0.f, 0.f, 0.f, 0.f}; int lrk[4] = {0, 0, 0, 0};
            if (tid < 32) {
                unsigned chosen = 0u; float val[4];
#pragma unroll
                for (int k = 0; k < 4; ++k) { float best = -3.0e38f; int bi = 0;
                    for (int j = 0; j < NE; ++j) { const float xv = LG[tid * 33 + j]; if (!((chosen >> j) & 1u) && xv > best) { best = xv; bi = j; } }
                    val[k] = best; idx[k] = bi; chosen |= 1u << bi; }
                float den = 0.f;
#pragma unroll
                for (int k = 0; k < 4; ++k) { wv[k] = expf(val[k] - val[0]); den += wv[k]; }
#pragma unroll
                for (int k = 0; k < 4; ++k) { wv[k] /= den; lrk[k] = atomicAdd((int*)&HIST[idx[k]], 1); }
            }
            __syncthreads();
            if (tid < 32) { const int c = HIST[tid]; BASE[tid] = c ? (int)__hip_atomic_fetch_add((unsigned*)(ctl + CW_CNT + tid), (unsigned)c, RLX_AGENT) : 0; }
            __syncthreads();
            if (tid < 32) { const int tok = R0 + tid;
#pragma unroll
                for (int k = 0; k < 4; ++k) { const int e = idx[k], rank = BASE[e] + lrk[k]; LTOK[(size_t)e * LCAP + rank] = tok; LWT[(size_t)e * LCAP + rank] = wv[k]; TSLOT[tok * 4 + k] = e * LCAP + rank; } }
            __syncthreads();
        }
        if (BOTH(8)) GRID_BAR();
    }

#define MOE_TABLES(nN_) do { __syncthreads(); if (tid == 0) { unsigned us = 0u, pb = 0u; for (int e = 0; e < NE; ++e) { const unsigned c = __hip_atomic_load(ctl + CW_CNT + e, RLX_AGENT); const unsigned nb = (c + 255u) >> 8; \
        MISC[32 + e] = us; MISC[80 + e] = pb; MISC[128 + e] = c; us += nb * (unsigned)(nN_); pb += nb; } MISC[32 + NE] = us; MISC[80 + NE] = pb; MISC[176] = us; } __syncthreads(); } while (0)

    if (IN(9)) {
        MOE_TABLES(2 * FE / 256);
        SchedMoe S; S.A = (const char*)XN8; S.Bt = (const char*)W1T8; S.astep = 0; S.bstep_e = (size_t)2 * FE * D; S.bstep_n = (size_t)256 * D; S.nN = 2 * FE / 256; S.G = G; S.c = vcu; S.M = MISC; S.ltok = LTOK; S.gather = true;
        EpiMoe1 E{ACT8, b1};
        pg8::gemm_phase<EpiMoe1, SchedMoe, true, 1>(lds + RING_OFF, D, D, D, S, E);
        if (DUPSEL == 9) { pg8::gemm_phase<EpiMoe1, SchedMoe, true, 1>(lds + RING_OFF, D, D, D, S, E); }
        if (BOTH(9)) GRID_BAR();
    }

    if (IN(10)) {
        MOE_TABLES(D / 256);
        SchedMoe S; S.A = (const char*)ACT8; S.Bt = (const char*)W2T8; S.astep = (size_t)256 * FE; S.bstep_e = (size_t)D * FE; S.bstep_n = (size_t)256 * FE; S.nN = D / 256; S.G = G; S.c = vcu; S.M = MISC; S.ltok = LTOK; S.gather = false;
        EpiMoe2 E{YE, b2, LWT};
        pg8::gemm_phase<EpiMoe2, SchedMoe, false, 1>(lds + RING_OFF, FE, FE, FE, S, E);
        if (DUPSEL == 10) { pg8::gemm_phase<EpiMoe2, SchedMoe, false, 1>(lds + RING_OFF, FE, FE, FE, S, E); }
        if (BOTH(10)) GRID_BAR();
    }

    if (IN(11)) for (int rep_ = 0; rep_ < REP(11); ++rep_) {
        MOE_TABLES(1);
        {
            const int RPW = (T + NGW - 1) / NGW; int cb = -1;
            f32x4 Av[8], Bv[8], Gv[8];
            int sl[4];
            { const int r0 = gw * RPW < T ? gw * RPW : T - 1;
#pragma unroll
              for (int k = 0; k < 4; ++k) sl[k] = TSLOT[r0 * 4 + k]; }
            for (int i = 0; i < RPW; ++i) {
                const int row = gw * RPW + i; if (row >= T) break;
                const int b = row >> 12;
                if (b != cb) { cb = b; const float* mb = MOD + (size_t)b * 6 * D; const float* fb = FMOD + (size_t)b * 2 * D;
#pragma unroll
                    for (int j = 0; j < 8; ++j) { const int k = 8 * lane + 512 * (j >> 1) + 4 * (j & 1); const f32x4 g = *(const f32x4*)(fnorm_g + k), sh = *(const f32x4*)(fb + k), sc = *(const f32x4*)(fb + D + k);
                        Av[j] = g * (sc + 1.0f); Bv[j] = sh; Gv[j] = *(const f32x4*)(mb + 5 * D + k); } }
                size_t prow[4];
#pragma unroll
                for (int k = 0; k < 4; ++k) { const int sv = sl[k]; const int e = sv >> 14, rank = sv & (LCAP - 1); prow[k] = ((size_t)MISC[80 + e] * 256 + rank) * D; }
                { const int rn = (row + 1 < T) ? row + 1 : row;
#pragma unroll
                  for (int k = 0; k < 4; ++k) sl[k] = TSLOT[rn * 4 + k]; }
                f32x4 v[8]; float ss = 0.f;
#pragma unroll
                for (int j = 0; j < 4; ++j) { const int k = 8 * lane + 512 * j; float f[8] = {0.f, 0.f, 0.f, 0.f, 0.f, 0.f, 0.f, 0.f};
#pragma unroll
                    for (int kk = 0; kk < 4; ++kk) { const v4u y = *(const v4u*)(YE + prow[kk] + k); f[0] += bf_lo(y.x); f[1] += bf_hi(y.x); f[2] += bf_lo(y.y); f[3] += bf_hi(y.y); f[4] += bf_lo(y.z); f[5] += bf_hi(y.z); f[6] += bf_lo(y.w); f[7] += bf_hi(y.w); }
                    const f32x4 x0 = *(const f32x4*)(X1 + (size_t)row * D + k), x1v = *(const f32x4*)(X1 + (size_t)row * D + k + 4);
                    v[2 * j] = x0 + Gv[2 * j] * (f32x4){f[0], f[1], f[2], f[3]}; v[2 * j + 1] = x1v + Gv[2 * j + 1] * (f32x4){f[4], f[5], f[6], f[7]};
                    ss += v[2 * j][0] * v[2 * j][0] + v[2 * j][1] * v[2 * j][1] + v[2 * j][2] * v[2 * j][2] + v[2 * j][3] * v[2 * j][3];
                    ss += v[2 * j + 1][0] * v[2 * j + 1][0] + v[2 * j + 1][1] * v[2 * j + 1][1] + v[2 * j + 1][2] * v[2 * j + 1][2] + v[2 * j + 1][3] * v[2 * j + 1][3]; }
                const float rstd = 1.0f / sqrtf(wave_sum(ss) * (1.0f / D) + RMS_EPS);
#pragma unroll
                for (int j = 0; j < 8; ++j) { const int k = 8 * lane + 512 * (j >> 1) + 4 * (j & 1); *(f32x4*)(out + (size_t)row * D + k) = v[j] * rstd * Av[j] + Bv[j]; }
            }
        }
    }
#undef IN
#undef BOTH
}

extern "C" void kernel_launch(void* const* d_in, const int* in_sizes, int n_in, void* d_out, int out_size, void* d_ws, size_t ws_size, hipStream_t stream) {
    static int grid = 0;
    if (grid == 0) {
        if (n_in != 30 || out_size != T * D || ws_size < WS_END) { fprintf(stderr, "kernel_launch: unexpected shapes (n_in %d, out %d, ws %zu); nothing launched\n", n_in, out_size, ws_size); grid = -1; return; }
        int dev = 0, cus = 0, per_cu = 0;
        if (hipGetDevice(&dev) != hipSuccess || hipDeviceGetAttribute(&cus, hipDeviceAttributeMultiprocessorCount, dev) != hipSuccess) { grid = -1; return; }
        if (hipFuncSetAttribute((const void*)fwd_kernel, hipFuncAttributeMaxDynamicSharedMemorySize, LDS_BYTES) != hipSuccess) { fprintf(stderr, "kernel_launch: hipFuncSetAttribute failed\n"); grid = -1; return; }
        if (hipOccupancyMaxActiveBlocksPerMultiprocessor(&per_cu, (const void*)fwd_kernel, NWAVES * 64, LDS_BYTES) != hipSuccess || per_cu < 1)
            fprintf(stderr, "kernel_launch: note: occupancy query reports %d workgroups per CU\n", per_cu);
        (void)hipGetLastError();
        grid = cus;
    }
    if (grid < 0) return;
    if (hipMemsetAsync((char*)d_ws + WS_CTL, 0, CTL_ZERO_BYTES, stream) != hipSuccess) { fprintf(stderr, "kernel_launch: hipMemsetAsync failed\n"); return; }
    Args a{};
    for (int i = 0; i < 30; ++i) a.in[i] = d_in[i];
    a.out = (float*)d_out; a.ws = (unsigned char*)d_ws;
    for (int li = 0; li < N_LAUNCHES; ++li) {
        if (N_LAUNCHES == 1) { a.ph_lo = 0; a.ph_hi = NPH; } else { a.ph_lo = li; a.ph_hi = li + 1; }
        a.li = li; a.pad = 0;
        hipLaunchKernelGGL(fwd_kernel, dim3(grid), dim3(NWAVES * 64), LDS_BYTES, stream, a);
        const hipError_t le = hipPeekAtLastError();
        if (le != hipSuccess) { fprintf(stderr, "kernel_launch: launch %d failed: %s\n", li, hipGetErrorName(le)); break; }
    }
}
```

```cpp
#include <hip/hip_runtime.h>
#include <cstdio>
#include <cstdint>

namespace pg8 {
#define PG8_LAS __attribute__((address_space(3)))
typedef unsigned short bf16_t;
typedef short bf16x8 __attribute__((ext_vector_type(8)));
typedef float f32x4 __attribute__((ext_vector_type(4)));
typedef float f32x2 __attribute__((ext_vector_type(2)));
typedef unsigned u32x4 __attribute__((ext_vector_type(4)));
typedef int i32x4 __attribute__((ext_vector_type(4)));
typedef int i32x8 __attribute__((ext_vector_type(8)));
constexpr int BM = 256, BK = 64, HALF = 128, HTB = HALF * BK * 2, STAGE_BYTES = 8 * HTB, NXCD = 8, WGM = 8;

__host__ __device__ __forceinline__ int lds_byte(int r, int c) { const int st = (r >> 4) * 2 + (c >> 5), rr = r & 15, cc = c & 31, ob = rr * 64 + cc * 2; return st * 1024 + (ob ^ (((ob >> 9) & 1) << 5)); }
__host__ __device__ __forceinline__ void stage_rc(int b, int& R, int& C) { const int st = b / 1024, sb = b % 1024, swz = sb ^ (((sb >> 9) & 1) << 5); R = (st >> 1) * 16 + swz / 64; C = (st & 1) * 32 + (swz % 64) / 2; }
__host__ __device__ __forceinline__ int perm32(int rho) { const int n = rho >> 4, i = rho & 15; return 8 * (i >> 2) + 4 * n + (i & 3); }

struct Unit { int pm, pn, e, rb, nvalid; };

__device__ __forceinline__ unsigned cvt_pk_bf16(float lo, float hi) { unsigned r; asm volatile("v_cvt_pk_bf16_f32 %0, %1, %2" : "=v"(r) : "v"(lo), "v"(hi)); return r; }
__device__ __forceinline__ unsigned pk4_fp8(float a, float b, float c, float d) {
    a = __builtin_amdgcn_fmed3f(a, -448.f, 448.f); b = __builtin_amdgcn_fmed3f(b, -448.f, 448.f); c = __builtin_amdgcn_fmed3f(c, -448.f, 448.f); d = __builtin_amdgcn_fmed3f(d, -448.f, 448.f);
    int w = 0; w = __builtin_amdgcn_cvt_pk_fp8_f32(a, b, w, false); w = __builtin_amdgcn_cvt_pk_fp8_f32(c, d, w, true); return (unsigned)w; }
__device__ __forceinline__ unsigned pk4_u8(float a, float b, float c, float d) {
    unsigned w = 0; w = __builtin_amdgcn_cvt_pk_u8_f32(a, 0, w); w = __builtin_amdgcn_cvt_pk_u8_f32(b, 1, w); w = __builtin_amdgcn_cvt_pk_u8_f32(c, 2, w); w = __builtin_amdgcn_cvt_pk_u8_f32(d, 3, w); return w; }
__device__ __forceinline__ u32x4 pair16(unsigned ax, unsigned ay, unsigned bx, unsigned by) {
    const auto rx = __builtin_amdgcn_permlane16_swap(ax, bx, false, false); const auto ry = __builtin_amdgcn_permlane16_swap(ay, by, false, false);
    return (u32x4){rx[0], ry[0], rx[1], ry[1]};
}
__device__ __forceinline__ void unpair16(u32x4 q, unsigned& ax, unsigned& ay, unsigned& bx, unsigned& by) {
    const auto rx = __builtin_amdgcn_permlane16_swap(q.x, q.z, false, false); const auto ry = __builtin_amdgcn_permlane16_swap(q.y, q.w, false, false);
    ax = rx[0]; ay = ry[0]; bx = rx[1]; by = ry[1];
}
__device__ __forceinline__ float bf_lo(unsigned w) { return __uint_as_float(w << 16); }
__device__ __forceinline__ float bf_hi(unsigned w) { return __uint_as_float(w & 0xffff0000u); }
__device__ __forceinline__ float sigmoidf_(float x) { return __builtin_amdgcn_rcpf(1.0f + __builtin_amdgcn_exp2f(-1.44269504089f * x)); }
__device__ __forceinline__ float gelu_tanh_(float x) { const float u = 0.7978845608f * (x + 0.044715f * x * x * x); return x * __builtin_amdgcn_rcpf(1.0f + __builtin_amdgcn_exp2f(-2.88539008178f * u)); }

template <class Epi, class Sched, bool GATHER, int ESZ = 2, bool HALFU = false>
__device__ __forceinline__ void gemm_phase(PG8_LAS unsigned char* lds, const int lda, const int ldb, const int K, const Sched& S, const Epi& E) {
    const int tid = threadIdx.x, wid = __builtin_amdgcn_readfirstlane(tid >> 6), lane = tid & 63, wr = wid >> 2, wc = wid & 3, fr = lane & 15, fq = lane >> 4;
    const int nt = (K * ESZ) / (BK * 2);
    unsigned voffA[2], voffB[2], colA[2]; int rowA[2];
#pragma unroll
    for (int i = 0; i < 2; ++i) { int R, C; stage_rc(tid * 16 + i * 8192, R, C); const int Rb = Epi::PERM ? ((R & ~31) + perm32(R & 31)) : R;
        rowA[i] = R; colA[i] = (unsigned)C * 2u; voffA[i] = (unsigned)(R * lda * ESZ + C * 2); voffB[i] = (unsigned)(Rb * ldb * ESZ + C * 2); }
    const size_t kstep = (size_t)(BK * 2);
    const size_t hstepA = GATHER ? (size_t)0 : (size_t)HALF * lda * ESZ;
    const size_t hstepB = (size_t)HALF * ldb * ESZ;
    const unsigned ldsw = (unsigned)wid * 1024u;
    const int aoff = lds_byte(wr * 64 + fr, fq * 8), boff = lds_byte(wc * 32 + fr, fq * 8);
#define PG8_SA(b, h) (((b) * 2 + (h)) * HTB)
#define PG8_SB(b, h) ((4 + (b) * 2 + (h)) * HTB)
#define PG8_STAGE2(bufoff, gbase, o0, o1) do { \
        __builtin_amdgcn_global_load_lds((const unsigned*)((const char*)(gbase) + (o0)), (PG8_LAS unsigned*)(lds + (bufoff) + ldsw), 16, 0, 0); \
        __builtin_amdgcn_global_load_lds((const unsigned*)((const char*)(gbase) + (o1)), (PG8_LAS unsigned*)(lds + (bufoff) + ldsw + 8192), 16, 0, 0); } while (0)
#define PG8_STAGE_B(bufoff, gbase) PG8_STAGE2(bufoff, gbase, voffB[0], voffB[1])
#define PG8_LDA(dst, b, h) do { if constexpr (ESZ == 2) { _Pragma("unroll") for (int m = 0; m < 4; ++m) _Pragma("unroll") for (int k = 0; k < 2; ++k) dst[m][k] = *(const PG8_LAS bf16x8*)(lds + PG8_SA(b, h) + aoff + m * 2048 + k * 1024); } \
        else { _Pragma("unroll") for (int m = 0; m < 4; ++m) { const i32x4 lo_ = *(const PG8_LAS i32x4*)(lds + PG8_SA(b, h) + aoff + m * 2048), hi_ = *(const PG8_LAS i32x4*)(lds + PG8_SA(b, h) + aoff + m * 2048 + 1024); dst##8[m] = __builtin_shufflevector(lo_, hi_, 0, 1, 2, 3, 4, 5, 6, 7); } } } while (0)
#define PG8_LDB(dst, b, h) do { if constexpr (ESZ == 2) { _Pragma("unroll") for (int n = 0; n < 2; ++n) _Pragma("unroll") for (int k = 0; k < 2; ++k) dst[n][k] = *(const PG8_LAS bf16x8*)(lds + PG8_SB(b, h) + boff + n * 2048 + k * 1024); } \
        else { _Pragma("unroll") for (int n = 0; n < 2; ++n) { const i32x4 lo_ = *(const PG8_LAS i32x4*)(lds + PG8_SB(b, h) + boff + n * 2048), hi_ = *(const PG8_LAS i32x4*)(lds + PG8_SB(b, h) + boff + n * 2048 + 1024); dst##8[n] = __builtin_shufflevector(lo_, hi_, 0, 1, 2, 3, 4, 5, 6, 7); } } } while (0)
#define PG8_MMA(ai, bj, At, Bt) do { __builtin_amdgcn_s_setprio(1); \
        if constexpr (ESZ == 2) { _Pragma("unroll") for (int m = 0; m < 4; ++m) _Pragma("unroll") for (int n = 0; n < 2; ++n) _Pragma("unroll") for (int k = 0; k < 2; ++k) \
            acc[ai][bj][m][n] = __builtin_amdgcn_mfma_f32_16x16x32_bf16(Bt[n][k], At[m][k], acc[ai][bj][m][n], 0, 0, 0); } \
        else {   \
            asm volatile("s_nop 3\n\t" \
                "v_mfma_f32_16x16x128_f8f6f4 %0, %8, %10, %0\n\t" "v_mfma_f32_16x16x128_f8f6f4 %1, %9, %10, %1\n\t" \
                "v_mfma_f32_16x16x128_f8f6f4 %2, %8, %11, %2\n\t" "v_mfma_f32_16x16x128_f8f6f4 %3, %9, %11, %3\n\t" \
                "v_mfma_f32_16x16x128_f8f6f4 %4, %8, %12, %4\n\t" "v_mfma_f32_16x16x128_f8f6f4 %5, %9, %12, %5\n\t" \
                "v_mfma_f32_16x16x128_f8f6f4 %6, %8, %13, %6\n\t" "v_mfma_f32_16x16x128_f8f6f4 %7, %9, %13, %7" \
                : "+v"(acc[ai][bj][0][0]), "+v"(acc[ai][bj][0][1]), "+v"(acc[ai][bj][1][0]), "+v"(acc[ai][bj][1][1]), "+v"(acc[ai][bj][2][0]), "+v"(acc[ai][bj][2][1]), "+v"(acc[ai][bj][3][0]), "+v"(acc[ai][bj][3][1]) \
                : "v"(Bt##8[0]), "v"(Bt##8[1]), "v"(At##8[0]), "v"(At##8[1]), "v"(At##8[2]), "v"(At##8[3])); } \
        __builtin_amdgcn_s_setprio(0); } while (0)
#define PG8_WAIT_V(n) asm volatile("s_waitcnt vmcnt(" #n ")" ::: "memory")
#define PG8_WAIT_L(n) asm volatile("s_waitcnt lgkmcnt(" #n ")" ::: "memory")
#define PG8_BAR __builtin_amdgcn_s_barrier()
#define PG8_SCHED __builtin_amdgcn_sched_barrier(0)
    Unit cur, nxt; int ui = 0;
    if (!S.next(0, cur)) return;
    f32x4 acc[2][2][4][2];
#pragma unroll
    for (int a = 0; a < 2; ++a)
#pragma unroll
        for (int b = 0; b < 2; ++b)
#pragma unroll
            for (int m = 0; m < 4; ++m)
#pragma unroll
                for (int n = 0; n < 2; ++n) acc[a][b][m][n] = (f32x4){0.f, 0.f, 0.f, 0.f};
    bf16x8 At[4][2], B0[2][2], B1[2][2]; i32x8 At8[4], B08[2], B18[2];
    const char* cA = S.a_ptr(cur); const char* cB = S.b_ptr(cur);
    unsigned gcur[2][2], gnxt[2][2];
#pragma unroll
    for (int h = 0; h < 2; ++h)
#pragma unroll
        for (int i = 0; i < 2; ++i) { if constexpr (GATHER) gcur[h][i] = S.a_rowoff(cur, h * HALF + rowA[i]) + colA[i]; else gcur[h][i] = voffA[i]; gnxt[h][i] = gcur[h][i]; }
    int rotc = S.krot(cur, nt), rotn = rotc;
#define PG8_KOFS(rot, j) ((size_t)(((j) + (rot)) >= nt ? ((j) + (rot) - nt) : ((j) + (rot))) * kstep)
    { const size_t k0 = PG8_KOFS(rotc, 0), k1 = PG8_KOFS(rotc, 1);
    PG8_STAGE_B(PG8_SB(0, 0), cB + k0); PG8_STAGE_B(PG8_SB(0, 1), cB + hstepB + k0); PG8_STAGE2(PG8_SA(0, 0), cA + k0, gcur[0][0], gcur[0][1]); PG8_STAGE2(PG8_SA(0, 1), cA + hstepA + k0, gcur[1][0], gcur[1][1]);
    if (wr == 1) PG8_BAR;
    PG8_WAIT_V(2); PG8_BAR;
    PG8_STAGE_B(PG8_SB(1, 0), cB + k1); PG8_STAGE2(PG8_SA(1, 0), cA + k1, gcur[0][0], gcur[0][1]); PG8_STAGE_B(PG8_SB(1, 1), cB + hstepB + k1);
    PG8_WAIT_V(6); PG8_BAR; }
    for (;;) {
        const bool has_next = S.next(ui + 1, nxt);
        const char* nA = has_next ? S.a_ptr(nxt) : cA; const char* nB = has_next ? S.b_ptr(nxt) : cB;
        rotn = has_next ? S.krot(nxt, nt) : rotc;
        const bool full = !HALFU || cur.nvalid > 128;
#pragma unroll 1
        for (int t = 0; t < nt; t += 2) {
            const bool last = (t == nt - 2);
            const bool fin = last && !has_next;
            const char* a1 = cA + PG8_KOFS(rotc, t + 1);
            const size_t k2 = last ? PG8_KOFS(rotn, 0) : PG8_KOFS(rotc, t + 2), k3 = last ? PG8_KOFS(rotn, 1) : PG8_KOFS(rotc, t + 3);
            const char* a2 = (last ? nA : cA) + k2; const char* b2 = (last ? nB : cB) + k2;
            const char* a3 = (last ? nA : cA) + k3; const char* b3 = (last ? nB : cB) + k3;
            unsigned o2[2][2];
#pragma unroll
            for (int h = 0; h < 2; ++h)
#pragma unroll
                for (int i = 0; i < 2; ++i) o2[h][i] = gcur[h][i];
            if constexpr (GATHER) {
                if (t == 0 && has_next) {
#pragma unroll
                    for (int h = 0; h < 2; ++h)
#pragma unroll
                        for (int i = 0; i < 2; ++i) gnxt[h][i] = S.a_rowoff(nxt, h * HALF + rowA[i]) + colA[i];
                }
                if (last && has_next) {
                    asm volatile("" : "+v"(gnxt[0][0]), "+v"(gnxt[0][1]), "+v"(gnxt[1][0]), "+v"(gnxt[1][1]));
#pragma unroll
                    for (int h = 0; h < 2; ++h)
#pragma unroll
                        for (int i = 0; i < 2; ++i) o2[h][i] = gnxt[h][i];
                }
            }
            PG8_LDB(B0, 0, 0); PG8_LDB(B1, 0, 1); PG8_SCHED; PG8_LDA(At, 0, 0); PG8_STAGE2(PG8_SA(1, 1), a1 + hstepA, gcur[1][0], gcur[1][1]);
            PG8_WAIT_V(8); PG8_WAIT_L(0); PG8_BAR; PG8_MMA(0, 0, At, B0); PG8_MMA(0, 1, At, B1); PG8_BAR; PG8_SCHED;
            if (full) { PG8_LDA(At, 0, 1); }
            if (!fin) { PG8_STAGE_B(PG8_SB(0, 0), b2); PG8_STAGE_B(PG8_SB(0, 1), b2 + hstepB); PG8_STAGE2(PG8_SA(0, 0), a2, o2[0][0], o2[0][1]); PG8_WAIT_V(8); }
            else { PG8_WAIT_V(2); }
            PG8_WAIT_L(0); PG8_BAR; if (full) { PG8_MMA(1, 0, At, B0); PG8_MMA(1, 1, At, B1); } PG8_BAR; PG8_SCHED;
            PG8_LDB(B0, 1, 0); PG8_LDB(B1, 1, 1); PG8_SCHED; PG8_LDA(At, 1, 0);
            if (!fin) { PG8_STAGE2(PG8_SA(0, 1), a2 + hstepA, o2[1][0], o2[1][1]); PG8_WAIT_V(8); } else { PG8_WAIT_V(0); }
            PG8_WAIT_L(0); PG8_BAR; PG8_MMA(0, 0, At, B0); PG8_MMA(0, 1, At, B1); PG8_BAR; PG8_SCHED;
            if (full) { PG8_LDA(At, 1, 1); }
            if (!fin) { PG8_STAGE_B(PG8_SB(1, 0), b3); PG8_STAGE_B(PG8_SB(1, 1), b3 + hstepB); PG8_STAGE2(PG8_SA(1, 0), a3, o2[0][0], o2[0][1]); PG8_WAIT_V(8); }
            PG8_WAIT_L(0); PG8_BAR; if (full) { PG8_MMA(1, 0, At, B0); PG8_MMA(1, 1, At, B1); } PG8_BAR; PG8_SCHED;
        }
        if (wr == 0) PG8_BAR;
        if constexpr (ESZ == 1) asm volatile("s_nop 15\n\ts_nop 15" ::: "memory");
        E(acc, cur, wr, wc, fr, fq);
        if (!has_next) break;
#pragma unroll
        for (int a = 0; a < 2; ++a)
#pragma unroll
            for (int b = 0; b < 2; ++b)
#pragma unroll
                for (int m = 0; m < 4; ++m)
#pragma unroll
                    for (int n = 0; n < 2; ++n) acc[a][b][m][n] = (f32x4){0.f, 0.f, 0.f, 0.f};
        cur = nxt; cA = nA; cB = nB; rotc = rotn; ++ui;
#pragma unroll
        for (int h = 0; h < 2; ++h)
#pragma unroll
            for (int i = 0; i < 2; ++i) gcur[h][i] = gnxt[h][i];
        if (wr == 1) PG8_BAR;
    }
    PG8_WAIT_V(0);
    PG8_BAR;
#undef PG8_KOFS
#undef PG8_SA
#undef PG8_SB
#undef PG8_STAGE2
#undef PG8_STAGE_B
#undef PG8_LDA
#undef PG8_LDB
#undef PG8_MMA
#undef PG8_WAIT_V
#undef PG8_WAIT_L
#undef PG8_BAR
#undef PG8_SCHED
}
}

constexpr int NWAVES = 8;
#ifndef MK_N_LAUNCHES
#define MK_N_LAUNCHES 1
#endif
#ifndef GATE_FP8
#define GATE_FP8 1
#endif
#ifndef PO_FP8
#define PO_FP8 1
#endif
#ifndef OUT_FP8
#define OUT_FP8 1
#endif
#ifndef GLU_FP8
#define GLU_FP8 1
#endif
#ifndef Z_FP8
#define Z_FP8 1
#endif
constexpr int NPH = 12;
constexpr int N_LAUNCHES = MK_N_LAUNCHES;

constexpr int BATCH = 4, SEQ = 4096, D = 2048, T = BATCH * SEQ;
constexpr int PW = 1024, SW = 1024, INW = PW + SW + 2 * D;
constexpr int NE = 32, TOPK = 4, FE = 2048;
constexpr int SG = 64, SP = 64, SH = 16, CL = 16, NCH = SEQ / CL;
constexpr int UGK = CL * SH + 2 * SP;
constexpr int LCAP = T;
constexpr int MAXBLK = 288;
constexpr float RMS_EPS = 1e-6f;

constexpr size_t MiB = 1u << 20;
constexpr size_t WS_CTL = 0, CTL_ZERO_BYTES = 32768;
constexpr size_t WS_MOD = 1 * MiB;
constexpr size_t WS_FMOD = WS_MOD + 196608, WS_AL = WS_MOD + 262144;
constexpr size_t WS_WIN = 2 * MiB, WS_POOLW = 26 * MiB, WS_WPO = 27 * MiB, WS_WGLU = 31 * MiB, WS_WOUT = 39 * MiB, WS_WEND = 47 * MiB, WS_TG = 55 * MiB;
constexpr size_t WS_W1 = 68 * MiB, WS_W2 = 580 * MiB;
constexpr size_t WS_XN = 836 * MiB, WS_UP = 900 * MiB, WS_UG = 932 * MiB, WS_SGP = 980 * MiB, WS_SGS = 1044 * MiB, WS_PL = 1108 * MiB, WS_PM = 1140 * MiB, WS_E = 1172 * MiB;
constexpr size_t WS_YPG = 1204 * MiB, WS_YS = 1268 * MiB, WS_MG = 1300 * MiB, WS_X1 = 1364 * MiB, WS_LTOK = 1492 * MiB, WS_LWT = 1494 * MiB, WS_TSLOT = 1496 * MiB;
constexpr size_t WS_ACT = 1498 * MiB, WS_YE = 1786 * MiB, WS_END = 2074 * MiB;
static_assert(WS_TG + (size_t)SG * 256 * UGK * 2 <= WS_W1 && WS_UG + (size_t)SG * 1024 * UGK * 2 <= WS_SGP && WS_ACT + (size_t)MAXBLK * 256 * FE * 2 <= WS_YE, "d_ws map");
constexpr int CW_TMO = 0, CW_CODE = 1, CW_CNT = 64, CW_BAR = 4096;

constexpr int RING_OFF = 0, RING_BYTES = 131072;
constexpr int LDSCTL_OFF = RING_BYTES, MISC_OFF = LDSCTL_OFF + 320;
constexpr int LDS_BYTES = 147456;

#define GAS __attribute__((address_space(1)))
#define LAS __attribute__((address_space(3)))
typedef unsigned short bf16;
typedef unsigned v4u __attribute__((ext_vector_type(4)));
typedef unsigned v2u __attribute__((ext_vector_type(2)));
typedef float f32x4 __attribute__((ext_vector_type(4)));
typedef float f32x16 __attribute__((ext_vector_type(16)));
typedef GAS unsigned gu32;
#define RLX_AGENT __ATOMIC_RELAXED, __HIP_MEMORY_SCOPE_AGENT
#define LDS_WAIT() asm volatile("s_waitcnt lgkmcnt(0)" ::: "memory")
#define VM_WAIT() asm volatile("s_waitcnt vmcnt(0)" ::: "memory")
using pg8::cvt_pk_bf16; using pg8::pk4_fp8; using pg8::pk4_u8; using pg8::pair16; using pg8::unpair16; using pg8::bf_lo; using pg8::bf_hi; using pg8::sigmoidf_; using pg8::gelu_tanh_;

#define XB_TMO      128
#define XB_XCNT(j)  (256  + 64 * (j))
#define XB_XSUB(j)  (1280 + 64 * (j))
#define XB_XGEN(j)  (2304 + 64 * (j))
#define XB_TOP      3328
#define XB_TOPGEN   3392
#define XCD_BAR_WORDS 3456
#define XB_SPIN_CAP (1u << 18)

__device__ __forceinline__ unsigned xb_ld(unsigned* p)              { return __hip_atomic_load(p, __ATOMIC_RELAXED, __HIP_MEMORY_SCOPE_AGENT); }
__device__ __forceinline__ unsigned xb_add(unsigned* p, unsigned v) { return __hip_atomic_fetch_add(p, v, __ATOMIC_RELAXED, __HIP_MEMORY_SCOPE_AGENT); }
__device__ __forceinline__ unsigned xb_xcc_id() { return (unsigned)__builtin_amdgcn_s_getreg((3 << 11) | 20) & 0xFu; }
#define XB_SPIN(cond, bar) do { unsigned _sp = 0; while (cond) { __builtin_amdgcn_s_sleep(1); \
    if ((++_sp & 255u) == 0u) { if (xb_ld(&(bar)[XB_TMO])) break; if (_sp > XB_SPIN_CAP) { atomicAdd(&(bar)[XB_TMO], 1u); break; } } } } while (0)

struct XcdBarrier { unsigned* bar; unsigned x; volatile LAS unsigned* st; };

__device__ __forceinline__ XcdBarrier xcd_barrier_post(unsigned* bar, volatile LAS unsigned* st) {
    XcdBarrier b; b.bar = bar; b.x = xb_xcc_id(); b.st = st;
    if (threadIdx.x == 0) (void)xb_add(&bar[XB_XCNT(b.x)], 1u);
    return b;
}
__device__ __forceinline__ void xcd_barrier_complete(unsigned* bar, unsigned x, unsigned& nloc, unsigned& nx) {
    const unsigned G = gridDim.x * gridDim.y * gridDim.z;
    unsigned sum, cnt, mine, sp = 0u;
    for (;;) {
        sum = 0u; cnt = 0u; mine = 0u;
#pragma unroll
        for (unsigned j = 0; j < 16; ++j) { const unsigned c = xb_ld(&bar[XB_XCNT(j)]); sum += c; cnt += (c > 0u) ? 1u : 0u; mine = (j == x) ? c : mine; }
        if (sum == G) break;
        __builtin_amdgcn_s_sleep(1);
        if ((++sp & 255u) == 0u) { if (xb_ld(&bar[XB_TMO])) break; if (sp > XB_SPIN_CAP) { atomicAdd(&bar[XB_TMO], 1u); break; } }
    }
    nloc = mine > 0u ? mine : 1u; nx = cnt > 0u ? cnt : 1u;
}
__device__ __forceinline__ void xcd_barrier(const XcdBarrier& b) {
    asm volatile("s_waitcnt vmcnt(0)" ::: "memory");
    __syncthreads();
    if (threadIdx.x == 0) {
        unsigned* bar = b.bar;
        __builtin_amdgcn_s_waitcnt(0);
        unsigned nloc = b.st[0], nx = b.st[1];
        if (nloc == 0u) { xcd_barrier_complete(bar, b.x, nloc, nx); b.st[0] = nloc; b.st[1] = nx; }
        const unsigned old = xb_add(&bar[XB_XSUB(b.x)], 1u);
        const unsigned gen = old / nloc;
        if (old + 1u == (gen + 1u) * nloc) {
            __builtin_amdgcn_fence(__ATOMIC_RELEASE, "agent");
            asm volatile("s_waitcnt vmcnt(0)" ::: "memory");
            const unsigned og = xb_add(&bar[XB_TOP], 1u);
            const unsigned tg = og / nx;
            if (og + 1u == (tg + 1u) * nx) xb_add(&bar[XB_TOPGEN], 1u);
            else XB_SPIN(xb_ld(&bar[XB_TOPGEN]) == tg, bar);
            __builtin_amdgcn_fence(__ATOMIC_ACQUIRE, "agent");
            xb_add(&bar[XB_XGEN(b.x)], 1u);
            asm volatile("s_waitcnt vmcnt(0)" ::: "memory");
        } else {
            XB_SPIN(xb_ld(&bar[XB_XGEN(b.x)]) == gen, bar);
            __builtin_amdgcn_fence(__ATOMIC_ACQUIRE, "agent");
            asm volatile("s_waitcnt vmcnt(0)" ::: "memory");
        }
    }
    __syncthreads();
}

using pg8::Unit;
struct SchedDense {
    const char* A; const char* Bt; size_t astep, bstep; int nM, nN, nwg, G, c;
    __device__ __forceinline__ void init(const void* A_, const void* Bt_, int M, int N, int lda, int ldb, int G_, int c_, int esz = 2) { A = (const char*)A_; Bt = (const char*)Bt_; astep = (size_t)256 * lda * esz; bstep = (size_t)256 * ldb * esz; nM = M / 256; nN = N / 256; nwg = nM * nN; G = G_; c = c_; }
    __device__ __forceinline__ bool next(int i, Unit& u) const {
        const long L = (long)i * G + c; if (L >= nwg) return false;
        int wgid = (int)L; { const int q = nwg / pg8::NXCD, r = nwg % pg8::NXCD, xcd = wgid % pg8::NXCD, off = wgid / pg8::NXCD; wgid = (xcd < r ? xcd * (q + 1) : r * (q + 1) + (xcd - r) * q) + off; }
        const int nig = pg8::WGM * nN, gid = wgid / nig, fm = gid * pg8::WGM, gsz = (nM - fm) < pg8::WGM ? (nM - fm) : pg8::WGM;
        u.pm = fm + ((wgid % nig) % gsz); u.pn = (wgid % nig) / gsz; u.e = 0; u.rb = 0; u.nvalid = 256; return true;
    }
    __device__ __forceinline__ const char* a_ptr(const Unit& u) const { return A + (size_t)u.pm * astep; }
    __device__ __forceinline__ const char* b_ptr(const Unit& u) const { return Bt + (size_t)u.pn * bstep; }
    __device__ __forceinline__ unsigned a_rowoff(const Unit&, int) const { return 0u; }
    __device__ __forceinline__ int krot(const Unit&, int) const { return 0; }
};
struct SchedGrouped {
    const char* A; const char* Bt; size_t astep, agstride, bgstride; int nPM, nunits, G, c;
    __device__ __forceinline__ void init(const void* A_, const void* Bt_, int lda, size_t agstride_, size_t bgstride_, int nPM_, int ngroups, int G_, int c_) { A = (const char*)A_; Bt = (const char*)Bt_; astep = (size_t)256 * lda * 2; agstride = agstride_; bgstride = bgstride_; nPM = nPM_; nunits = nPM_ * ngroups; G = G_; c = c_; }
    __device__ __forceinline__ bool next(int i, Unit& u) const { const int L = i * G + c; if (L >= nunits) return false; u.e = L / nPM; u.pm = L % nPM; u.pn = 0; u.rb = 0; u.nvalid = 256; return true; }
    __device__ __forceinline__ const char* a_ptr(const Unit& u) const { return A + (size_t)u.e * agstride + (size_t)u.pm * astep; }
    __device__ __forceinline__ const char* b_ptr(const Unit& u) const { return Bt + (size_t)u.e * bgstride; }
    __device__ __forceinline__ unsigned a_rowoff(const Unit&, int) const { return 0u; }
    __device__ __forceinline__ int krot(const Unit&, int) const { return 0; }
};
struct SchedMoe {
    const char* A; const char* Bt; size_t astep, bstep_e, bstep_n; int nN, G, c; volatile LAS unsigned* M; const int* ltok; bool gather;
    __device__ __forceinline__ bool next(int i, Unit& u) const {
        const int L = i * G + c; const int total = (int)M[176]; if (L >= total) return false;
        const int ln = threadIdx.x & 63; const int us1 = (int)M[33 + (ln & 31)];
        const int e = __builtin_popcountll(__ballot(ln < 32 && L >= us1));
        const int w = L - (int)M[32 + e], pb = (int)M[80 + e], nb = (int)M[80 + e + 1] - pb, cnt = (int)M[128 + e];
        int rb = w % nb, pn = w / nb;
        rb = __builtin_amdgcn_readfirstlane(rb); pn = __builtin_amdgcn_readfirstlane(pn);
        u.e = e; u.rb = rb; u.pn = pn; u.pm = __builtin_amdgcn_readfirstlane(pb + rb); const int nv = cnt - rb * 256; u.nvalid = __builtin_amdgcn_readfirstlane(nv < 256 ? nv : 256); return true;
    }
    __device__ __forceinline__ const char* a_ptr(const Unit& u) const { return gather ? A : A + (size_t)u.pm * astep; }
    __device__ __forceinline__ const char* b_ptr(const Unit& u) const { return Bt + (size_t)u.e * bstep_e + (size_t)u.pn * bstep_n; }
    __device__ __forceinline__ unsigned a_rowoff(const Unit& u, int r) const { const int idx = (r < u.nvalid) ? (u.rb * 256 + r) : 0; const int tok = ltok[(size_t)u.e * LCAP + idx]; return (unsigned)tok * (unsigned)D; }
    __device__ __forceinline__ int krot(const Unit& u, int nt) const { return (2 * u.rb + u.pn) % nt; }
};

using pg8::f32x2; using pg8::u32x4;
#define EPI_ARGS const f32x4 (&acc)[2][2][4][2], const Unit& u, int wr, int wc, int fr, int fq
struct EpiZ { static constexpr bool PERM = true; bf16 *UP, *UG, *SGP, *SGS; float asc;
    __device__ __forceinline__ void operator()(EPI_ARGS) const {
        const int pn = u.pn, region = pn < 4 ? 0 : (pn < 8 ? 1 : (pn < 16 ? 2 : 3));
        if (GATE_FP8 && region >= 2) {
            unsigned char* gb = (unsigned char*)(region == 2 ? SGP : SGS); const int cbase = (region == 2 ? pn - 8 : pn - 16) * 256;
#pragma unroll
            for (int ai = 0; ai < 2; ++ai)
#pragma unroll
                for (int bj = 0; bj < 2; ++bj)
#pragma unroll
                    for (int mp = 0; mp < 2; ++mp) { unsigned px[2], py[2];
#pragma unroll
                        for (int h = 0; h < 2; ++h) { const int m = 2 * mp + h; f32x4 v0 = acc[ai][bj][m][0] * asc, v1 = acc[ai][bj][m][1] * asc;
#pragma unroll
                            for (int j = 0; j < 4; ++j) { v0[j] = 255.0f * sigmoidf_(v0[j]); v1[j] = 255.0f * sigmoidf_(v1[j]); }
                            px[h] = pk4_u8(v0[0], v0[1], v0[2], v0[3]); py[h] = pk4_u8(v1[0], v1[1], v1[2], v1[3]); }
                        const u32x4 q = pair16(px[0], py[0], px[1], py[1]);
                        const int row = u.pm * 256 + ai * 128 + wr * 64 + (2 * mp + (fq & 1)) * 16 + fr;
                        *(u32x4*)(gb + (size_t)row * D + cbase + bj * 128 + wc * 32 + 8 * (fq & ~1)) = q; }
            return;
        }
#pragma unroll
        for (int ai = 0; ai < 2; ++ai)
#pragma unroll
            for (int m = 0; m < 4; ++m) { const int row = u.pm * 256 + ai * 128 + wr * 64 + m * 16 + fr;
#pragma unroll
                for (int bj = 0; bj < 2; ++bj) { const int lc = bj * 128 + wc * 32 + 8 * fq; f32x4 v0 = acc[ai][bj][m][0] * asc, v1 = acc[ai][bj][m][1] * asc;
                    if (region >= 2) {
#pragma unroll
                        for (int j = 0; j < 4; ++j) { v0[j] = sigmoidf_(v0[j]); v1[j] = sigmoidf_(v1[j]); } }
                    u32x4 w; w.x = cvt_pk_bf16(v0[0], v0[1]); w.y = cvt_pk_bf16(v0[2], v0[3]); w.z = cvt_pk_bf16(v1[0], v1[1]); w.w = cvt_pk_bf16(v1[2], v1[3]);
                    bf16* dst;
                    if (region == 0) dst = UP + (size_t)row * PW + pn * 256 + lc;
                    else if (region == 1) { const int j = (pn - 4) * 256 + lc, g = j >> 4, h0 = j & 15, b = row >> 12, tp = row & 4095, c = tp >> 4, s = tp & 15; dst = UG + ((size_t)(g * 1024 + b * 256 + c) * UGK + s * 16 + h0); }
                    else if (region == 2) dst = SGP + (size_t)row * D + (pn - 8) * 256 + lc;
                    else dst = SGS + (size_t)row * D + (pn - 16) * 256 + lc;
                    *(u32x4*)dst = w; } }
    }
};
struct EpiS1 { static constexpr bool PERM = false; float* E;
    __device__ __forceinline__ void operator()(EPI_ARGS) const {
#pragma unroll
        for (int ai = 0; ai < 2; ++ai)
#pragma unroll
            for (int m = 0; m < 4; ++m) { const int row = u.pm * 256 + ai * 128 + wr * 64 + m * 16 + fr; float* rp = E + ((size_t)u.e * 1024 + row) * 128 + wc * 32 + 4 * fq;
#pragma unroll
                for (int n = 0; n < 2; ++n) *(f32x4*)(rp + n * 16) = acc[ai][0][m][n]; }
    }
};
struct EpiPmix { static constexpr bool PERM = true; bf16* PM; const float* scale;
    __device__ __forceinline__ void operator()(EPI_ARGS) const {
#pragma unroll
        for (int bj = 0; bj < 2; ++bj) { const int col = u.e * 256 + bj * 128 + wc * 32 + 8 * fq; const f32x4 s0 = *(const f32x4*)(scale + col), s1 = *(const f32x4*)(scale + col + 4);
#pragma unroll
            for (int ai = 0; ai < 2; ++ai)
#pragma unroll
                for (int m = 0; m < 4; ++m) { const int row = u.pm * 256 + ai * 128 + wr * 64 + m * 16 + fr; const f32x4 v0 = acc[ai][bj][m][0] * s0, v1 = acc[ai][bj][m][1] * s1;
                    if (PO_FP8) { v2u w; w.x = pk4_fp8(v0[0], v0[1], v0[2], v0[3]); w.y = pk4_fp8(v1[0], v1[1], v1[2], v1[3]); *(v2u*)((unsigned char*)PM + (size_t)row * PW + col) = w; }
                    else { u32x4 w; w.x = cvt_pk_bf16(v0[0], v0[1]); w.y = cvt_pk_bf16(v0[2], v0[3]); w.z = cvt_pk_bf16(v1[0], v1[1]); w.w = cvt_pk_bf16(v1[2], v1[3]);
                    *(u32x4*)(PM + (size_t)row * PW + col) = w; } } }
    }
};
struct EpiS3 { static constexpr bool PERM = true; bf16* YS;
    __device__ __forceinline__ void operator()(EPI_ARGS) const {
#pragma unroll
        for (int ai = 0; ai < 2; ++ai)
#pragma unroll
            for (int bj = 0; bj < 2; ++bj) { const int lc = bj * 128 + wc * 32 + 8 * fq, t = lc >> 4, h0 = lc & 15;
#pragma unroll
                for (int mp = 0; mp < 2; ++mp) { unsigned px[2], py[2];
#pragma unroll
                    for (int h = 0; h < 2; ++h) { const int m = 2 * mp + h; f32x4 v0 = acc[ai][bj][m][0], v1 = acc[ai][bj][m][1];
#pragma unroll
                        for (int j = 0; j < 4; ++j) { v0[j] = gelu_tanh_(v0[j]); v1[j] = gelu_tanh_(v1[j]); }
                        if (GLU_FP8) { px[h] = pk4_fp8(v0[0], v0[1], v0[2], v0[3]); py[h] = pk4_fp8(v1[0], v1[1], v1[2], v1[3]); }
                        else { const int r = u.pm * 256 + ai * 128 + wr * 64 + m * 16 + fr, b = r >> 8, c = r & 255; u32x4 w; w.x = cvt_pk_bf16(v0[0], v0[1]); w.y = cvt_pk_bf16(v0[2], v0[3]); w.z = cvt_pk_bf16(v1[0], v1[1]); w.w = cvt_pk_bf16(v1[2], v1[3]);
                            *(u32x4*)(YS + (size_t)(b * SEQ + c * CL + t) * SW + u.e * 16 + h0) = w; } }
                    if (GLU_FP8) { const u32x4 q = pair16(px[0], py[0], px[1], py[1]);
                        const int r = u.pm * 256 + ai * 128 + wr * 64 + (2 * mp + (fq & 1)) * 16 + fr, b = r >> 8, c = r & 255;
                        *(u32x4*)((unsigned char*)YS + (size_t)(b * SEQ + c * CL + t) * SW + u.e * 16) = q; } } }
    }
};
#define EPI_ALD16(dst_, ptr_) asm volatile("global_load_dwordx4 %0, %1, off" : "=v"(dst_) : "v"(ptr_))
struct EpiYpool { static constexpr bool PERM = true; bf16* YPG; const bf16* SGP; float asc;
    __device__ __forceinline__ void operator()(EPI_ARGS) const {
        u32x4 glq[2][2][2];
        if (GATE_FP8) {
#pragma unroll
            for (int ai = 0; ai < 2; ++ai)
#pragma unroll
                for (int bj = 0; bj < 2; ++bj)
#pragma unroll
                    for (int mp = 0; mp < 2; ++mp) { const int rowq = u.pm * 256 + ai * 128 + wr * 64 + (2 * mp + (fq & 1)) * 16 + fr;
                        const unsigned char* gp = (const unsigned char*)SGP + (size_t)rowq * D + u.pn * 256 + bj * 128 + wc * 32 + 8 * (fq & ~1); EPI_ALD16(glq[ai][bj][mp], gp); }
            asm volatile("s_waitcnt vmcnt(0)" : "+v"(glq[0][0][0]), "+v"(glq[0][0][1]), "+v"(glq[0][1][0]), "+v"(glq[0][1][1]), "+v"(glq[1][0][0]), "+v"(glq[1][0][1]), "+v"(glq[1][1][0]), "+v"(glq[1][1][1])); }
#pragma unroll
        for (int ai = 0; ai < 2; ++ai)
#pragma unroll
            for (int bj = 0; bj < 2; ++bj) { const int colb = u.pn * 256 + bj * 128 + wc * 32;
#pragma unroll
                for (int mp = 0; mp < 2; ++mp) { unsigned gq[2][2] = {{0u, 0u}, {0u, 0u}};
                    if (GATE_FP8) unpair16(glq[ai][bj][mp], gq[0][0], gq[0][1], gq[1][0], gq[1][1]);
#pragma unroll
                    for (int h = 0; h < 2; ++h) { const int m = 2 * mp + h; const int row = u.pm * 256 + ai * 128 + wr * 64 + m * 16 + fr; const size_t off = (size_t)row * D + colb + 8 * fq;
                        float gg[8];
                        if (GATE_FP8) { const unsigned gx = gq[h][0], gy = gq[h][1]; const float k255 = 1.0f / 255.0f;
                            gg[0] = (float)(gx & 0xffu) * k255; gg[1] = (float)((gx >> 8) & 0xffu) * k255; gg[2] = (float)((gx >> 16) & 0xffu) * k255; gg[3] = (float)(gx >> 24) * k255;
                            gg[4] = (float)(gy & 0xffu) * k255; gg[5] = (float)((gy >> 8) & 0xffu) * k255; gg[6] = (float)((gy >> 16) & 0xffu) * k255; gg[7] = (float)(gy >> 24) * k255; }
                        else { const u32x4 g = *(const u32x4*)(SGP + off); gg[0] = bf_lo(g.x); gg[1] = bf_hi(g.x); gg[2] = bf_lo(g.y); gg[3] = bf_hi(g.y); gg[4] = bf_lo(g.z); gg[5] = bf_hi(g.z); gg[6] = bf_lo(g.w); gg[7] = bf_hi(g.w); }
                        const f32x4 v0 = acc[ai][bj][m][0] * asc, v1 = acc[ai][bj][m][1] * asc;
                        u32x4 w; w.x = cvt_pk_bf16(v0[0] * gg[0], v0[1] * gg[1]); w.y = cvt_pk_bf16(v0[2] * gg[2], v0[3] * gg[3]);
                        w.z = cvt_pk_bf16(v1[0] * gg[4], v1[1] * gg[5]); w.w = cvt_pk_bf16(v1[2] * gg[6], v1[3] * gg[7]);
                        *(u32x4*)(YPG + off) = w; } } }
    }
};
struct EpiGlu { static constexpr bool PERM = true; bf16* MG; const bf16 *YPG, *SGS; const float* bglu; float asc;
    __device__ __forceinline__ void operator()(EPI_ARGS) const {
        const int j0 = u.pn * 128 + wc * 32 + 8 * fq, j0q = u.pn * 128 + wc * 32 + 8 * (fq & ~1);
        f32x4 ba0, ba1, bb0, bb1; u32x4 glq[2][2], ypq[2][2][2];
        EPI_ALD16(ba0, bglu + j0); EPI_ALD16(ba1, bglu + j0 + 4); EPI_ALD16(bb0, bglu + D + j0); EPI_ALD16(bb1, bglu + D + j0 + 4);
#pragma unroll
        for (int ai = 0; ai < 2; ++ai)
#pragma unroll
            for (int mp = 0; mp < 2; ++mp) {
                if (GATE_FP8) { const int rowq = u.pm * 256 + ai * 128 + wr * 64 + (2 * mp + (fq & 1)) * 16 + fr;
                    const unsigned char* gp = (const unsigned char*)SGS + (size_t)rowq * D + j0q; EPI_ALD16(glq[ai][mp], gp); }
#pragma unroll
                for (int h = 0; h < 2; ++h) { const int row = u.pm * 256 + ai * 128 + wr * 64 + (2 * mp + h) * 16 + fr; const bf16* yq = YPG + (size_t)row * D + j0; EPI_ALD16(ypq[ai][mp][h], yq); } }
        asm volatile("s_waitcnt vmcnt(0)" : "+v"(ba0), "+v"(ba1), "+v"(bb0), "+v"(bb1), "+v"(ypq[0][0][0]), "+v"(ypq[0][0][1]), "+v"(ypq[0][1][0]), "+v"(ypq[0][1][1]), "+v"(ypq[1][0][0]), "+v"(ypq[1][0][1]), "+v"(ypq[1][1][0]), "+v"(ypq[1][1][1]));
        if (GATE_FP8) asm volatile("" : "+v"(glq[0][0]), "+v"(glq[0][1]), "+v"(glq[1][0]), "+v"(glq[1][1]));
#pragma unroll
        for (int ai = 0; ai < 2; ++ai)
#pragma unroll
            for (int mp = 0; mp < 2; ++mp) { unsigned px[2], py[2]; unsigned gq[2][2] = {{0u, 0u}, {0u, 0u}};
                if (GATE_FP8) unpair16(glq[ai][mp], gq[0][0], gq[0][1], gq[1][0], gq[1][1]);
#pragma unroll
                for (int h = 0; h < 2; ++h) { const int m = 2 * mp + h; const int row = u.pm * 256 + ai * 128 + wr * 64 + m * 16 + fr; const size_t off = (size_t)row * D + j0;
                    const u32x4 yp = ypq[ai][mp][h]; float gsf[8];
                    if (GATE_FP8) { v2u g8; g8.x = gq[h][0]; g8.y = gq[h][1]; const float k255 = 1.0f / 255.0f;
                        gsf[0] = (float)(g8.x & 0xffu) * k255; gsf[1] = (float)((g8.x >> 8) & 0xffu) * k255; gsf[2] = (float)((g8.x >> 16) & 0xffu) * k255; gsf[3] = (float)(g8.x >> 24) * k255;
                        gsf[4] = (float)(g8.y & 0xffu) * k255; gsf[5] = (float)((g8.y >> 8) & 0xffu) * k255; gsf[6] = (float)((g8.y >> 16) & 0xffu) * k255; gsf[7] = (float)(g8.y >> 24) * k255; }
                    else { const u32x4 gs = *(const u32x4*)(SGS + off); gsf[0] = bf_lo(gs.x); gsf[1] = bf_hi(gs.x); gsf[2] = bf_lo(gs.y); gsf[3] = bf_hi(gs.y); gsf[4] = bf_lo(gs.z); gsf[5] = bf_hi(gs.z); gsf[6] = bf_lo(gs.w); gsf[7] = bf_hi(gs.w); }
                    const f32x4 a0 = acc[ai][0][m][0] * asc + ba0, a1 = acc[ai][0][m][1] * asc + ba1, b0 = acc[ai][1][m][0] * asc + bb0, b1 = acc[ai][1][m][1] * asc + bb1;
                    float o[8];
#pragma unroll
                    for (int j = 0; j < 4; ++j) { o[j] = a0[j] * sigmoidf_(b0[j]); o[4 + j] = a1[j] * sigmoidf_(b1[j]); }
                    float mo[8] = {bf_lo(yp.x) + gsf[0] * o[0], bf_hi(yp.x) + gsf[1] * o[1], bf_lo(yp.y) + gsf[2] * o[2], bf_hi(yp.y) + gsf[3] * o[3],
                                   bf_lo(yp.z) + gsf[4] * o[4], bf_hi(yp.z) + gsf[5] * o[5], bf_lo(yp.w) + gsf[6] * o[6], bf_hi(yp.w) + gsf[7] * o[7]};
                    if (OUT_FP8) { px[h] = pk4_fp8(mo[0], mo[1], mo[2], mo[3]); py[h] = pk4_fp8(mo[4], mo[5], mo[6], mo[7]); }
                    else { u32x4 w; w.x = cvt_pk_bf16(mo[0], mo[1]); w.y = cvt_pk_bf16(mo[2], mo[3]); w.z = cvt_pk_bf16(mo[4], mo[5]); w.w = cvt_pk_bf16(mo[6], mo[7]); *(u32x4*)(MG + off) = w; } }
                if (OUT_FP8) { const u32x4 q = pair16(px[0], py[0], px[1], py[1]);
                    const int row = u.pm * 256 + ai * 128 + wr * 64 + (2 * mp + (fq & 1)) * 16 + fr; *(u32x4*)((unsigned char*)MG + (size_t)row * D + j0q) = q; } }
    }
};
struct EpiMix { static constexpr bool PERM = true; bf16* MX; float asc; const float* gtm;
    __device__ __forceinline__ void operator()(EPI_ARGS) const {
        const float* gb = gtm + (size_t)(u.pm >> 4) * 6 * D;
#pragma unroll
        for (int bj = 0; bj < 2; ++bj) { const int col = u.pn * 256 + bj * 128 + wc * 32 + 8 * fq; const f32x4 g0 = *(const f32x4*)(gb + col) * asc, g1 = *(const f32x4*)(gb + col + 4) * asc;
#pragma unroll
            for (int ai = 0; ai < 2; ++ai)
#pragma unroll
                for (int m = 0; m < 4; ++m) { const int row = u.pm * 256 + ai * 128 + wr * 64 + m * 16 + fr; const f32x4 v0 = acc[ai][bj][m][0] * g0, v1 = acc[ai][bj][m][1] * g1;
                    u32x4 w; w.x = cvt_pk_bf16(v0[0], v0[1]); w.y = cvt_pk_bf16(v0[2], v0[3]); w.z = cvt_pk_bf16(v1[0], v1[1]); w.w = cvt_pk_bf16(v1[2], v1[3]);
                    *(u32x4*)(MX + (size_t)row * D + col) = w; } }
    }
};
struct EpiMoe1 { static constexpr bool PERM = true; unsigned char* ACT; const float* b1;
    __device__ __forceinline__ void operator()(EPI_ARGS) const {
        const int j0 = u.pn * 128 + wc * 32 + 8 * fq; const float* bb = b1 + (size_t)u.e * 2 * FE;
        const f32x4 ba0 = *(const f32x4*)(bb + j0), ba1 = *(const f32x4*)(bb + j0 + 4), bl0 = *(const f32x4*)(bb + FE + j0), bl1 = *(const f32x4*)(bb + FE + j0 + 4);
        const int j0q = u.pn * 128 + wc * 32 + 8 * (fq & ~1);
#pragma unroll
        for (int ai = 0; ai < 2; ++ai)
#pragma unroll
            for (int mp = 0; mp < 2; ++mp) { unsigned px[2], py[2];
#pragma unroll
                for (int h = 0; h < 2; ++h) { const int m = 2 * mp + h;
                    const f32x4 a0 = acc[ai][0][m][0] * 0.03125f + ba0, a1 = acc[ai][0][m][1] * 0.03125f + ba1, l0 = acc[ai][1][m][0] * 0.03125f + bl0, l1 = acc[ai][1][m][1] * 0.03125f + bl1;
                    float o[8];
#pragma unroll
                    for (int j = 0; j < 4; ++j) { const float g0 = fminf(a0[j], 7.0f), g1 = fminf(a1[j], 7.0f), x0 = fminf(fmaxf(l0[j], -7.0f), 7.0f), x1 = fminf(fmaxf(l1[j], -7.0f), 7.0f);
                        o[j] = g0 * sigmoidf_(1.702f * g0) * (x0 + 1.0f); o[4 + j] = g1 * sigmoidf_(1.702f * g1) * (x1 + 1.0f); }
                    px[h] = pk4_fp8(o[0], o[1], o[2], o[3]); py[h] = pk4_fp8(o[4], o[5], o[6], o[7]); }
                const u32x4 q = pair16(px[0], py[0], px[1], py[1]);
                const int row = u.pm * 256 + ai * 128 + wr * 64 + (2 * mp + (fq & 1)) * 16 + fr;
                *(u32x4*)(ACT + (size_t)row * FE + j0q) = q; }
    }
};
struct EpiMoe2 { static constexpr bool PERM = true; unsigned char* YE; const float* b2; const float* lwt;
    __device__ __forceinline__ void operator()(EPI_ARGS) const {
        const float* bb = b2 + (size_t)u.e * D; const float* lw = lwt + (size_t)u.e * LCAP + u.rb * 256;
        float wg[2][4];
#pragma unroll
        for (int ai = 0; ai < 2; ++ai)
#pragma unroll
            for (int m = 0; m < 4; ++m) { const int r = ai * 128 + wr * 64 + m * 16 + fr; wg[ai][m] = (r < u.nvalid) ? 16.0f * lw[r] : 0.0f; }
#pragma unroll
        for (int bj = 0; bj < 2; ++bj) { const int col = u.pn * 256 + bj * 128 + wc * 32 + 8 * fq; const f32x4 c0 = *(const f32x4*)(bb + col), c1 = *(const f32x4*)(bb + col + 4);
            const int colq = u.pn * 256 + bj * 128 + wc * 32 + 8 * (fq & ~1);
#pragma unroll
            for (int ai = 0; ai < 2; ++ai)
#pragma unroll
                for (int mp = 0; mp < 2; ++mp) { unsigned px[2], py[2];
#pragma unroll
                    for (int h = 0; h < 2; ++h) { const int m = 2 * mp + h; const f32x4 v0 = (acc[ai][bj][m][0] * 0.03125f + c0) * wg[ai][m], v1 = (acc[ai][bj][m][1] * 0.03125f + c1) * wg[ai][m];
                        px[h] = pk4_fp8(v0[0], v0[1], v0[2], v0[3]); py[h] = pk4_fp8(v1[0], v1[1], v1[2], v1[3]); }
                    const u32x4 q = pair16(px[0], py[0], px[1], py[1]);
                    const int r = ai * 128 + wr * 64 + (2 * mp + (fq & 1)) * 16 + fr;
                    *(u32x4*)(YE + ((size_t)u.pm * 256 + r) * D + colq) = q; } }
    }
};

__device__ __forceinline__ float wave_sum(float v) {
#pragma unroll
    for (int o = 1; o < 64; o <<= 1) v += __shfl_xor(v, o);
    return v;
}
__device__ __forceinline__ void tr_item(const float* __restrict__ W, int K, int N, bf16* WT, int item, int lane, int mode) {
    const int nblk = N >> 6, kb = item / nblk, nb = item - kb * nblk, k0 = kb * 64, n = nb * 64 + lane;
    int drow = n;
    if (mode) { const int half = N >> 1, hi = n >= half ? 1 : 0, nn = n - hi * half; drow = (nn >> 7) * 256 + hi * 128 + (nn & 127); }
    const float* src = W + (size_t)k0 * N + n;
    float v[64];
#pragma unroll
    for (int i = 0; i < 64; ++i) v[i] = src[(size_t)i * N];
    bf16* dst = WT + (size_t)drow * K + k0;
#pragma unroll
    for (int j = 0; j < 8; ++j) { v4u o; o.x = cvt_pk_bf16(v[8 * j], v[8 * j + 1]); o.y = cvt_pk_bf16(v[8 * j + 2], v[8 * j + 3]); o.z = cvt_pk_bf16(v[8 * j + 4], v[8 * j + 5]); o.w = cvt_pk_bf16(v[8 * j + 6], v[8 * j + 7]);
        *(v4u*)(dst + 8 * j) = o; }
}

template <int W> __device__ __forceinline__ void pool_item(const bf16* ub, unsigned voff, bf16* pl, int t0) {
    constexpr int NR = 15 + W;
    v4u R[NR];
#pragma unroll
    for (int i = 0; i < NR; ++i) { const bf16* p_ = ub + (size_t)i * PW; asm volatile("global_load_dwordx4 %0, %1, %2" : "=v"(R[i]) : "v"(voff), "s"(p_)); }
#pragma unroll
    for (int i0 = 0; i0 < NR; i0 += 8) {
        if (i0 == 0) asm volatile("s_waitcnt vmcnt(0)" : "+v"(R[0]), "+v"(R[1]), "+v"(R[2]), "+v"(R[3]), "+v"(R[4]), "+v"(R[5]), "+v"(R[6]), "+v"(R[7]));
        else if (i0 + 8 <= NR) asm volatile("" : "+v"(R[i0]), "+v"(R[i0 + 1]), "+v"(R[i0 + 2]), "+v"(R[i0 + 3]), "+v"(R[i0 + 4]), "+v"(R[i0 + 5]), "+v"(R[i0 + 6]), "+v"(R[i0 + 7]));
        else {
#pragma unroll
            for (int i = i0; i < NR; ++i) asm volatile("" : "+v"(R[i])); } }
#pragma unroll
    for (int i = 0; i < W - 1; ++i) { if (t0 - (W - 1) + i < 0) R[i] = (v4u){0u, 0u, 0u, 0u}; }
    float Sx[8] = {0.f, 0.f, 0.f, 0.f, 0.f, 0.f, 0.f, 0.f};
#pragma unroll
    for (int i = 0; i < W - 1; ++i) { Sx[0] += bf_lo(R[i].x); Sx[1] += bf_hi(R[i].x); Sx[2] += bf_lo(R[i].y); Sx[3] += bf_hi(R[i].y); Sx[4] += bf_lo(R[i].z); Sx[5] += bf_hi(R[i].z); Sx[6] += bf_lo(R[i].w); Sx[7] += bf_hi(R[i].w); }
#pragma unroll
    for (int tt = 0; tt < 16; ++tt) { const int tp = t0 + tt; const v4u q = R[tt + W - 1];
        const float uu[8] = {bf_lo(q.x), bf_hi(q.x), bf_lo(q.y), bf_hi(q.y), bf_lo(q.z), bf_hi(q.z), bf_lo(q.w), bf_hi(q.w)};
        const float rc = 1.0f / (float)((tp + 1) < W ? (tp + 1) : W); float o[8];
#pragma unroll
        for (int j = 0; j < 8; ++j) { Sx[j] += uu[j]; o[j] = Sx[j] * rc - uu[j]; }
        v4u ov; ov.x = cvt_pk_bf16(o[0], o[1]); ov.y = cvt_pk_bf16(o[2], o[3]); ov.z = cvt_pk_bf16(o[4], o[5]); ov.w = cvt_pk_bf16(o[6], o[7]);
        *(v4u*)(pl + (size_t)tp * PW) = ov;
        v4u q2 = R[tt];
        asm volatile("" : "+v"(q2.x), "+v"(q2.y), "+v"(q2.z), "+v"(q2.w));
        Sx[0] -= bf_lo(q2.x); Sx[1] -= bf_hi(q2.x); Sx[2] -= bf_lo(q2.y); Sx[3] -= bf_hi(q2.y); Sx[4] -= bf_lo(q2.z); Sx[5] -= bf_hi(q2.z); Sx[6] -= bf_lo(q2.w); Sx[7] -= bf_hi(q2.w); }
}

struct Args { const void* in[30]; float* out; unsigned char* ws; int ph_lo, ph_hi, li, pad; };

__global__ void __launch_bounds__(NWAVES * 64, 2) fwd_kernel(Args args) {
    extern __shared__ __attribute__((aligned(16))) unsigned char lds_raw[];
    LAS unsigned char* lds = (LAS unsigned char*)lds_raw;
    volatile LAS unsigned* MISC = (volatile LAS unsigned*)(lds + MISC_OFF);
    const int tid = threadIdx.x, lane = tid & 63, wave = __builtin_amdgcn_readfirstlane(tid >> 6);
    const int G = gridDim.x; const int bx = blockIdx.x; const int vcu = (G % 8 == 0) ? (bx % 8) * (G / 8) + bx / 8 : bx;
    gu32* ctl = (gu32*)(args.ws + WS_CTL);
#define KARG_PTR(off_) (*(void* const __attribute__((address_space(4)))*)(kp_ + (off_)))
#define PH_PTRS() const __attribute__((address_space(4))) char* kp_ = (const __attribute__((address_space(4))) char*)__builtin_amdgcn_kernarg_segment_ptr(); asm volatile("" : "+s"(kp_)); \
    unsigned char* ws = (unsigned char*)KARG_PTR(248); const float* x = (const float*)KARG_PTR(0); const float* cin = (const float*)KARG_PTR(8); const float* ada_w = (const float*)KARG_PTR(16); const float* ada_b = (const float*)KARG_PTR(24); const float* norm1_g = (const float*)KARG_PTR(32); const float* w_in = (const float*)KARG_PTR(40); const float* pool_w = (const float*)KARG_PTR(48); const float* pool_scale = (const float*)KARG_PTR(56); const float* w_pool_out = (const float*)KARG_PTR(64); const float* lam_re = (const float*)KARG_PTR(72); const float* lam_im = (const float*)KARG_PTR(80); const float* log_dt = (const float*)KARG_PTR(88); const float* sb_re = (const float*)KARG_PTR(96); const float* sb_im = (const float*)KARG_PTR(104); const float* sc_re = (const float*)KARG_PTR(112); const float* sc_im = (const float*)KARG_PTR(120); const float* ssm_d = (const float*)KARG_PTR(128); const float* w_glu = (const float*)KARG_PTR(136); const float* b_glu = (const float*)KARG_PTR(144); const float* w_out = (const float*)KARG_PTR(152); const float* norm2_g = (const float*)KARG_PTR(160); const float* w_router = (const float*)KARG_PTR(168); const float* b_router = (const float*)KARG_PTR(176); const float* w1 = (const float*)KARG_PTR(184); const float* b1 = (const float*)KARG_PTR(192); const float* w2 = (const float*)KARG_PTR(200); const float* b2 = (const float*)KARG_PTR(208); const float* fada_w = (const float*)KARG_PTR(216); const float* fada_b = (const float*)KARG_PTR(224); const float* fnorm_g = (const float*)KARG_PTR(232); float* out = (float*)KARG_PTR(240); float* MOD = (float*)(ws + WS_MOD); float* FMOD = (float*)(ws + WS_FMOD); float* AL = (float*)(ws + WS_AL); bf16* WinT = (bf16*)(ws + WS_WIN); bf16* PoolWT = (bf16*)(ws + WS_POOLW); bf16* WpoT = (bf16*)(ws + WS_WPO); bf16* WgluT = (bf16*)(ws + WS_WGLU); bf16* WoutT = (bf16*)(ws + WS_WOUT); bf16* WendT = (bf16*)(ws + WS_WEND); bf16* TG = (bf16*)(ws + WS_TG); unsigned char* W1T8 = ws + WS_W1; unsigned char* W2T8 = ws + WS_W2; bf16* XN = (bf16*)(ws + WS_XN); bf16* UP = (bf16*)(ws + WS_UP); bf16* UG = (bf16*)(ws + WS_UG); bf16* SGP = (bf16*)(ws + WS_SGP); bf16* SGS = (bf16*)(ws + WS_SGS); bf16* PL = (bf16*)(ws + WS_PL); bf16* PM = (bf16*)(ws + WS_PM); float* EB = (float*)(ws + WS_E); bf16* YPG = (bf16*)(ws + WS_YPG); bf16* YS = (bf16*)(ws + WS_YS); bf16* MG = (bf16*)(ws + WS_MG); bf16* MX = (bf16*)(ws + WS_X1); bf16* X1B = (bf16*)(ws + WS_X1 + 64 * MiB); int* LTOK = (int*)(ws + WS_LTOK); float* LWT = (float*)(ws + WS_LWT); int* TSLOT = (int*)(ws + WS_TSLOT); unsigned char* ACT8 = ws + WS_ACT; unsigned char* YE = ws + WS_YE; unsigned char* XN8 = ws + WS_XN;
    for (int u = tid; u < (LDS_BYTES - LDSCTL_OFF) / 4; u += NWAVES * 64) ((LAS unsigned*)(lds + LDSCTL_OFF))[u] = 0u;
    __syncthreads();
    XcdBarrier bar; bar.bar = (unsigned*)(ctl + CW_BAR); bar.x = 0; bar.st = nullptr;
    if (N_LAUNCHES == 1) bar = xcd_barrier_post((unsigned*)(ctl + CW_BAR), MISC + 8);
#define GRID_BAR() do { if (N_LAUNCHES == 1) xcd_barrier(bar); } while (0)
    const int lo = args.ph_lo, hi = args.ph_hi;
#ifndef PHSEL
#define PHSEL -1
#endif
#define IN(k) (PHSEL < 0 ? (lo <= (k) && (k) < hi) : ((k) == PHSEL))
#define BOTH(k) (IN(k) && IN((k) + 1))
#ifndef DUPSEL
#define DUPSEL -1
#endif
#define REP(k) ((DUPSEL == (k)) ? 2 : 1)
    const int gw = vcu * NWAVES + wave, NGW = G * NWAVES;
#ifndef PROBE_PH
#define PROBE_PH -1
#endif
#ifndef PROBE_MODE
#define PROBE_MODE 0
#endif
#ifndef PROBE_N
#define PROBE_N 4
#endif
    unsigned long long pr_t0 = 0ull, pr_dt = 0ull;
#define PROBE_BEGIN(k) do { if (PROBE_PH == (k)) { __syncthreads(); pr_t0 = __builtin_amdgcn_s_memrealtime(); } } while (0)
#define PROBE_MID(k) do { if (PROBE_PH == (k) && PROBE_MODE == 0) { __syncthreads(); pr_dt = __builtin_amdgcn_s_memrealtime() - pr_t0; } } while (0)
#define PROBE_END(k) do { if (PROBE_PH == (k) && PROBE_MODE == 1) { pr_dt = __builtin_amdgcn_s_memrealtime() - pr_t0; } } while (0)

    if (IN(0)) for (int rep_ = 0; rep_ < REP(0); ++rep_) {
        PH_PTRS(); PROBE_BEGIN(0);
        LAS float* CA = (LAS float*)(lds + RING_OFF);
        LAS float* RED = (LAS float*)(lds + RING_OFF + 32768);
        { f32x4 cv[4];
#pragma unroll
          for (int j = 0; j < 4; ++j) cv[j] = *(const f32x4*)(cin + 4 * (tid + 512 * j));
#pragma unroll
          for (int j = 0; j < 4; ++j) { f32x4 o; o[0] = cv[j][0] * sigmoidf_(cv[j][0]); o[1] = cv[j][1] * sigmoidf_(cv[j][1]); o[2] = cv[j][2] * sigmoidf_(cv[j][2]); o[3] = cv[j][3] * sigmoidf_(cv[j][3]); *(LAS f32x4*)(CA + 4 * (tid + 512 * j)) = o; } }
        __syncthreads();
        for (int cb = vcu; cb < (6 * D + 2 * D) / 64; cb += G) {
            const int col0 = cb * 64; const float* W; int N, cc; const float* bias; float* dst; int dld;
            if (col0 < 6 * D) { W = ada_w; N = 6 * D; cc = col0; bias = ada_b; dst = MOD; dld = 6 * D; } else { W = fada_w; N = 2 * D; cc = col0 - 6 * D; bias = fada_b; dst = FMOD; dld = 2 * D; }
            const int c4 = lane & 15, kr = lane >> 4;
            f32x4 a0 = {0.f, 0.f, 0.f, 0.f}, a1 = a0, a2 = a0, a3 = a0;
            const float* rowp = W + (size_t)(256 * wave) * N + cc; const unsigned voff = (unsigned)(kr * N + 4 * c4) * 4u;
            f32x4 va[16], vb[16];
#define GV_LOAD(buf_, base_) do { _Pragma("unroll") for (int i_ = 0; i_ < 16; ++i_) { const float* p_ = rowp + (size_t)((base_) + i_) * 4 * N; asm volatile("global_load_dwordx4 %0, %1, %2 nt" : "=v"(buf_[i_]) : "v"(voff), "s"(p_)); } } while (0)
#define GV_WAIT(buf_, n_) do { asm volatile("s_waitcnt vmcnt(" #n_ ")" : "+v"(buf_[0]), "+v"(buf_[1]), "+v"(buf_[2]), "+v"(buf_[3]), "+v"(buf_[4]), "+v"(buf_[5]), "+v"(buf_[6]), "+v"(buf_[7])); \
                asm volatile("" : "+v"(buf_[8]), "+v"(buf_[9]), "+v"(buf_[10]), "+v"(buf_[11]), "+v"(buf_[12]), "+v"(buf_[13]), "+v"(buf_[14]), "+v"(buf_[15])); } while (0)
#define GV_FMA(buf_, base_) do { _Pragma("unroll") for (int i_ = 0; i_ < 16; ++i_) { const int k = 256 * wave + ((base_) + i_) * 4 + kr; const f32x4 v = buf_[i_]; \
                a0 += v * CA[k]; a1 += v * CA[D + k]; a2 += v * CA[2 * D + k]; a3 += v * CA[3 * D + k]; } } while (0)
#define GV_PIN() asm volatile("" : "+v"(a0), "+v"(a1), "+v"(a2), "+v"(a3))
            GV_LOAD(va, 0); GV_LOAD(vb, 16); GV_WAIT(va, 16); GV_FMA(va, 0); GV_PIN(); GV_LOAD(va, 32); GV_WAIT(vb, 16); GV_FMA(vb, 16); GV_PIN(); GV_LOAD(vb, 48); GV_WAIT(va, 16); GV_FMA(va, 32); GV_PIN(); GV_WAIT(vb, 0); GV_FMA(vb, 48);
#pragma unroll
            for (int j = 0; j < 4; ++j) { a0[j] += __shfl_xor(a0[j], 16); a0[j] += __shfl_xor(a0[j], 32); a1[j] += __shfl_xor(a1[j], 16); a1[j] += __shfl_xor(a1[j], 32);
                a2[j] += __shfl_xor(a2[j], 16); a2[j] += __shfl_xor(a2[j], 32); a3[j] += __shfl_xor(a3[j], 16); a3[j] += __shfl_xor(a3[j], 32); }
            if (kr == 0) {
#pragma unroll
                for (int j = 0; j < 4; ++j) { RED[(wave * 4 + 0) * 64 + 4 * c4 + j] = a0[j]; RED[(wave * 4 + 1) * 64 + 4 * c4 + j] = a1[j]; RED[(wave * 4 + 2) * 64 + 4 * c4 + j] = a2[j]; RED[(wave * 4 + 3) * 64 + 4 * c4 + j] = a3[j]; } }
            __syncthreads();
            if (tid < 256) { const int b = tid >> 6, c = tid & 63; float s = bias[cc + c];
#pragma unroll
                for (int w = 0; w < 8; ++w) s += RED[(w * 4 + b) * 64 + c];
                dst[(size_t)b * dld + cc + c] = s; }
            __syncthreads();
        }
        PROBE_MID(0); if (BOTH(0)) GRID_BAR(); PROBE_END(0);
    }

    if (IN(1)) for (int rep_ = 0; rep_ < REP(1); ++rep_) {
        PH_PTRS(); PROBE_BEGIN(1);
        {
            LAS float* AP = (LAS float*)(lds + RING_OFF);
            LAS float* BBm = (LAS float*)(lds + RING_OFF + 16384);
            LAS float* CCm = (LAS float*)(lds + RING_OFF + 32768);
            LAS float* MT = (LAS float*)(lds + RING_OFF + 49152);
            LAS float* FF = (LAS float*)(lds + RING_OFF + 53248);
            for (int it = vcu; it < SG * 4; it += G) {
                const int g = it >> 2, part = it & 3;
                if (tid < 64) { const int p = tid; const float dt = expf(log_dt[g]); const float lre = fminf(lam_re[g * SP + p], -1e-4f), lim = lam_im[g * SP + p];
                    const float mag = expf(lre * dt), ang = lim * dt; float sn, cs; sincosf(ang, &sn, &cs); const float abr = mag * cs, abi = mag * sn;
                    float pr = 1.0f, pi = 0.0f;
                    for (int k = 0; k <= 16; ++k) { AP[(k * 64 + p) * 2] = pr; AP[(k * 64 + p) * 2 + 1] = pi; const float nr2 = pr * abr - pi * abi, ni2 = pr * abi + pi * abr; pr = nr2; pi = ni2; }
                    const float den = lre * lre + lim * lim, nr = abr - 1.0f, ni = abi; FF[2 * p] = (nr * lre + ni * lim) / den; FF[2 * p + 1] = (ni * lre - nr * lim) / den;
                }
                __syncthreads();
                for (int idx = tid; idx < SP * SH; idx += NWAVES * 64) { const int p = idx >> 4, h = idx & 15; const float fr_ = FF[2 * p], fi_ = FF[2 * p + 1];
                    const float br = sb_re[((size_t)g * SP + p) * SH + h], bi = sb_im[((size_t)g * SP + p) * SH + h]; BBm[(p * 16 + h) * 2] = fr_ * br - fi_ * bi; BBm[(p * 16 + h) * 2 + 1] = fr_ * bi + fi_ * br;
                    const int h2 = idx >> 6, p2 = idx & 63; CCm[(h2 * 64 + p2) * 2] = sc_re[((size_t)g * SH + h2) * SP + p2]; CCm[(h2 * 64 + p2) * 2 + 1] = sc_im[((size_t)g * SH + h2) * SP + p2]; }
                if (part == 0 && tid < 64) { AL[(g * SP + tid) * 2] = AP[(16 * 64 + tid) * 2]; AL[(g * SP + tid) * 2 + 1] = AP[(16 * 64 + tid) * 2 + 1]; }
                __syncthreads();
                for (int idx = tid; idx < 1024; idx += NWAVES * 64) { const int k = idx >> 6, hq = (idx >> 4) & 3, h = idx & 15, hp = 4 * part + hq; float s = 0.f;
                    for (int p = 0; p < SP; ++p) { const float ar = AP[(k * 64 + p) * 2], ai = AP[(k * 64 + p) * 2 + 1], cr = CCm[(hp * 64 + p) * 2], ci = CCm[(hp * 64 + p) * 2 + 1];
                        const float car = cr * ar - ci * ai, cai = cr * ai + ci * ar; s += car * BBm[(p * 16 + h) * 2] - cai * BBm[(p * 16 + h) * 2 + 1]; }
                    if (k == 0 && h == hp) s += ssm_d[g * SH + hp];
                    MT[idx] = s; }
                __syncthreads();
                for (int vi = tid; vi < 64 * (UGK / 8); vi += NWAVES * 64) { const int nl = vi / (UGK / 8), kv = vi - nl * (UGK / 8), t = nl >> 2, hq = nl & 3, hp = 4 * part + hq, n = t * 16 + hp, k0 = kv * 8; float val[8];
#pragma unroll
                    for (int j = 0; j < 8; ++j) { const int k = k0 + j;
                        if (k < 256) { const int s2 = k >> 4, h = k & 15; val[j] = (s2 <= t) ? MT[((t - s2) << 6) + (hq << 4) + h] : 0.f; }
                        else { const int comp = k - 256, p = comp & 63; const float ar = AP[((t + 1) * 64 + p) * 2], ai = AP[((t + 1) * 64 + p) * 2 + 1], cr = CCm[(hp * 64 + p) * 2], ci = CCm[(hp * 64 + p) * 2 + 1];
                            val[j] = comp < 64 ? (cr * ar - ci * ai) : -(cr * ai + ci * ar); } }
                    v4u o; o.x = cvt_pk_bf16(val[0], val[1]); o.y = cvt_pk_bf16(val[2], val[3]); o.z = cvt_pk_bf16(val[4], val[5]); o.w = cvt_pk_bf16(val[6], val[7]);
                    *(v4u*)(TG + ((size_t)g * 256 + n) * UGK + k0) = o; }
                for (int vi = tid; vi < 64 * 32; vi += NWAVES * 64) { const int nl = vi >> 5, kv = vi & 31, n = part * 64 + nl, k0 = kv * 8; float val[8];
#pragma unroll
                    for (int j = 0; j < 8; ++j) { const int k = k0 + j, s2 = k >> 4, h = k & 15;
                        if (n < 128) { const int p = n & 63; const float ar = AP[((15 - s2) * 64 + p) * 2], ai = AP[((15 - s2) * 64 + p) * 2 + 1], br = BBm[(p * 16 + h) * 2], bi = BBm[(p * 16 + h) * 2 + 1];
                            val[j] = n < 64 ? (ar * br - ai * bi) : (ar * bi + ai * br); } else val[j] = 0.f; }
                    v4u o; o.x = cvt_pk_bf16(val[0], val[1]); o.y = cvt_pk_bf16(val[2], val[3]); o.z = cvt_pk_bf16(val[4], val[5]); o.w = cvt_pk_bf16(val[6], val[7]);
                    *(v4u*)(WendT + ((size_t)g * 256 + n) * 256 + k0) = o; }
                __syncthreads();
            }
        }
        {
            const int RPW = (T + NGW - 1) / NGW; int cb = -1; f32x4 Av[8], Bv[8];
            const unsigned nvo = 16u * lane;
#define N1_ROWS(i_, row_, row2_) const int row_ = gw * RPW + (i_); const int row2_ = ((i_) + 1 < RPW && row_ + 1 < T && ((row_ + 1) >> 12) == (row_ >> 12)) ? row_ + 1 : row_
#define N1_LD1(dst_, base_, off_) asm volatile("global_load_dwordx4 %0, %1, %2 offset:" #off_ : "=v"(dst_) : "v"(nvo), "s"(base_))
#define N1_LOAD(V_, W_, row_, row2_) do { const float* pa_ = x + (size_t)(row_) * D; const float* pb_ = pa_ + 1024; const float* qa_ = x + (size_t)(row2_) * D; const float* qb_ = qa_ + 1024; \
                N1_LD1(V_[0], pa_, 0); N1_LD1(V_[1], pa_, 1024); N1_LD1(V_[2], pa_, 2048); N1_LD1(V_[3], pa_, 3072); N1_LD1(V_[4], pb_, 0); N1_LD1(V_[5], pb_, 1024); N1_LD1(V_[6], pb_, 2048); N1_LD1(V_[7], pb_, 3072); \
                N1_LD1(W_[0], qa_, 0); N1_LD1(W_[1], qa_, 1024); N1_LD1(W_[2], qa_, 2048); N1_LD1(W_[3], qa_, 3072); N1_LD1(W_[4], qb_, 0); N1_LD1(W_[5], qb_, 1024); N1_LD1(W_[6], qb_, 2048); N1_LD1(W_[7], qb_, 3072); } while (0)
#define N1_TIE(V_, W_, cnt_) do { asm volatile("s_waitcnt vmcnt(" #cnt_ ")" : "+v"(V_[0]), "+v"(V_[1]), "+v"(V_[2]), "+v"(V_[3]), "+v"(V_[4]), "+v"(V_[5]), "+v"(V_[6]), "+v"(V_[7])); \
                asm volatile("" : "+v"(W_[0]), "+v"(W_[1]), "+v"(W_[2]), "+v"(W_[3]), "+v"(W_[4]), "+v"(W_[5]), "+v"(W_[6]), "+v"(W_[7])); } while (0)
#define N1_VECS(row_) do { const int b_ = (row_) >> 12; \
                if (b_ != cb) { cb = b_; const float* mb = MOD + (size_t)b_ * 6 * D; \
                    _Pragma("unroll") for (int j = 0; j < 8; ++j) { const int k = 4 * lane + 256 * j; const f32x4 g = *(const f32x4*)(norm1_g + k), sh = *(const f32x4*)(mb + k), sc = *(const f32x4*)(mb + D + k); Av[j] = g * (sc + 1.0f); Bv[j] = sh; } } } while (0)
#define N1_BODY(V_, W_, row_, row2_) do { \
                float ss = 0.f, ss2 = 0.f; \
                _Pragma("unroll") for (int j = 0; j < 8; ++j) { ss += V_[j][0] * V_[j][0] + V_[j][1] * V_[j][1] + V_[j][2] * V_[j][2] + V_[j][3] * V_[j][3]; ss2 += W_[j][0] * W_[j][0] + W_[j][1] * W_[j][1] + W_[j][2] * W_[j][2] + W_[j][3] * W_[j][3]; } \
                const float rstd = 1.0f / sqrtf(wave_sum(ss) * (1.0f / D) + RMS_EPS), rstd2 = 1.0f / sqrtf(wave_sum(ss2) * (1.0f / D) + RMS_EPS); \
                _Pragma("unroll") for (int j = 0; j < 8; ++j) { const int k = 4 * lane + 256 * j; const f32x4 h = V_[j] * rstd * Av[j] + Bv[j], h2 = W_[j] * rstd2 * Av[j] + Bv[j]; \
                    if (Z_FP8) { *(unsigned*)(XN8 + (size_t)(row_) * D + k) = pk4_fp8(h[0], h[1], h[2], h[3]); *(unsigned*)(XN8 + (size_t)(row2_) * D + k) = pk4_fp8(h2[0], h2[1], h2[2], h2[3]); } \
                    else { v2u o; o.x = cvt_pk_bf16(h[0], h[1]); o.y = cvt_pk_bf16(h[2], h[3]); *(v2u*)(XN + (size_t)(row_) * D + k) = o; o.x = cvt_pk_bf16(h2[0], h2[1]); o.y = cvt_pk_bf16(h2[2], h2[3]); *(v2u*)(XN + (size_t)(row2_) * D + k) = o; } } } while (0)
            if (RPW == 8 && gw * RPW + 7 < T) {
                f32x4 va[8], wa[8], vb[8], wb[8];
                const int r0 = gw * 8;
                N1_VECS(r0);
                N1_LOAD(va, wa, r0, r0 + 1); N1_LOAD(vb, wb, r0 + 2, r0 + 3);
                N1_TIE(va, wa, 16); N1_BODY(va, wa, r0, r0 + 1);
                N1_LOAD(va, wa, r0 + 4, r0 + 5);
                N1_TIE(vb, wb, 16); N1_BODY(vb, wb, r0 + 2, r0 + 3);
                N1_LOAD(vb, wb, r0 + 6, r0 + 7);
                N1_TIE(va, wa, 16); N1_BODY(va, wa, r0 + 4, r0 + 5);
                N1_TIE(vb, wb, 0); N1_BODY(vb, wb, r0 + 6, r0 + 7);
            } else {
                for (int i = 0; i < RPW; i += 2) {
                    N1_ROWS(i, row, row2); if (row >= T) break;
                    f32x4 v[8], w[8];
                    const float* xr = x + (size_t)row * D + 4 * lane; const float* xr2 = x + (size_t)row2 * D + 4 * lane;
#pragma unroll
                    for (int j = 0; j < 8; ++j) { v[j] = *(const f32x4*)(xr + 256 * j); w[j] = *(const f32x4*)(xr2 + 256 * j); }
                    N1_VECS(row); N1_BODY(v, w, row, row2);
                }
            }
#undef N1_ROWS
#undef N1_LD1
#undef N1_LOAD
#undef N1_TIE
#undef N1_BODY
#undef N1_VECS
        }
        {
            constexpr int T_IN = Z_FP8 ? 0 : (D / 64) * (INW / 256), T_PW = 4 * 4, T_PO = PO_FP8 ? 0 : (PW / 64) * (D / 256), T_GL = GLU_FP8 ? 0 : (SW / 64) * (2 * D / 256), T_OUT = OUT_FP8 ? 0 : (D / 64) * (D / 256);
            constexpr int NTILES = T_IN + T_PW + T_PO + T_GL + T_OUT;
            constexpr int TRB = 256 * 144;
#define TR_DECODE(it_, W_, WT_, K_, N_, mode_, k0_, n0_) do { int r_ = (it_); \
                if (r_ < T_IN) { W_ = w_in; WT_ = WinT; K_ = D; N_ = INW; mode_ = 0; } \
                else if ((r_ -= T_IN) < T_PW) { const int q_ = r_ >> 2; r_ &= 3; W_ = pool_w + (size_t)q_ * 65536; WT_ = PoolWT + (size_t)q_ * 65536; K_ = 256; N_ = 256; mode_ = 0; } \
                else if ((r_ -= T_PW) < T_PO) { W_ = w_pool_out; WT_ = WpoT; K_ = PW; N_ = D; mode_ = 0; } \
                else if ((r_ -= T_PO) < T_GL) { W_ = w_glu; WT_ = WgluT; K_ = SW; N_ = 2 * D; mode_ = 1; } \
                else { r_ -= T_GL; W_ = w_out; WT_ = WoutT; K_ = D; N_ = D; mode_ = 0; } \
                const int nblk_ = N_ >> 8; k0_ = (r_ / nblk_) * 64; n0_ = (r_ % nblk_) * 256; } while (0)
#define TR_LOAD(reg_, W_, N_, k0_, n0_) do { const float* p_ = W_ + (size_t)(k0_ + 8 * wave) * N_ + n0_ + 4 * lane; \
                _Pragma("unroll") for (int i_ = 0; i_ < 8; ++i_) reg_[i_] = __builtin_nontemporal_load((const f32x4*)(p_ + (size_t)i_ * N_)); } while (0)
#define TR_PUT(reg_, buf_) do { _Pragma("unroll") for (int j_ = 0; j_ < 4; ++j_) { v4u o_; o_.x = cvt_pk_bf16(reg_[0][j_], reg_[1][j_]); o_.y = cvt_pk_bf16(reg_[2][j_], reg_[3][j_]); \
                o_.z = cvt_pk_bf16(reg_[4][j_], reg_[5][j_]); o_.w = cvt_pk_bf16(reg_[6][j_], reg_[7][j_]); *(LAS v4u*)(lds + RING_OFF + (buf_) * TRB + (4 * lane + j_) * 144 + 16 * wave) = o_; } } while (0)
#define TR_FLUSH(buf_, WT_, K_, N_, mode_, k0_, n0_) do { _Pragma("unroll") for (int p_ = 0; p_ < 4; ++p_) { const int n_ = 64 * p_ + (tid >> 3), c_ = tid & 7; \
                const v4u q_ = *(const LAS v4u*)(lds + RING_OFF + (buf_) * TRB + n_ * 144 + 16 * c_); const int gn_ = n0_ + n_; int drow_ = gn_; \
                if (mode_) { const int half_ = N_ >> 1, hi_ = gn_ >= half_ ? 1 : 0, nn_ = gn_ - hi_ * half_; drow_ = (nn_ >> 7) * 256 + hi_ * 128 + (nn_ & 127); } \
                *(v4u*)(WT_ + (size_t)drow_ * K_ + k0_ + 8 * c_) = q_; } } while (0)
#define TR_BAR() do { LDS_WAIT(); __builtin_amdgcn_s_barrier(); asm volatile("" ::: "memory"); } while (0)
            int itA = vcu, itB = vcu + G;
            const float *WA = nullptr, *WB = nullptr; bf16 *TA = nullptr, *TB = nullptr; int KA = 0, NA = 0, mA = 0, kA = 0, nA = 0, KB = 0, NB = 0, mB = 0, kB = 0, nB = 0;
            f32x4 ra[8], rb[8];
            if (itA < NTILES) { TR_DECODE(itA, WA, TA, KA, NA, mA, kA, nA); TR_LOAD(ra, WA, NA, kA, nA); }
            if (itB < NTILES) { TR_DECODE(itB, WB, TB, KB, NB, mB, kB, nB); TR_LOAD(rb, WB, NB, kB, nB); }
            while (itA < NTILES) {
                TR_PUT(ra, 0);
                { bf16* dT = TA; const int dK = KA, dN = NA, dm = mA, dk = kA, dn = nA;
                  itA += 2 * G; if (itA < NTILES) { TR_DECODE(itA, WA, TA, KA, NA, mA, kA, nA); TR_LOAD(ra, WA, NA, kA, nA); }
                  TR_BAR();
                  TR_FLUSH(0, dT, dK, dN, dm, dk, dn); }
                if (itB >= NTILES) break;
                TR_PUT(rb, 1);
                { bf16* dT = TB; const int dK = KB, dN = NB, dm = mB, dk = kB, dn = nB;
                  itB += 2 * G; if (itB < NTILES) { TR_DECODE(itB, WB, TB, KB, NB, mB, kB, nB); TR_LOAD(rb, WB, NB, kB, nB); }
                  TR_BAR();
                  TR_FLUSH(1, dT, dK, dN, dm, dk, dn); }
            }
            __syncthreads();
            {
                constexpr int U_IN = Z_FP8 ? (D / 128) * (INW / 256) : 0, U_GL = GLU_FP8 ? (SW / 128) * (2 * D / 256) : 0, U_PO = PO_FP8 ? (PW / 128) * (D / 256) : 0, U_OUT = OUT_FP8 ? (D / 128) * (D / 256) : 0, U_W1E = (D / 128) * (2 * FE / 256), U_W2E = (FE / 128) * (D / 256), U_W1 = NE * U_W1E, U_TOT = U_IN + U_GL + U_PO + U_OUT + U_W1 + NE * U_W2E;
#define T8_DECODE(it_, W_, WT_, K_, N_, mode_, k0_, n0_) do { int r_ = (it_); \
                    if (r_ < U_IN) { W_ = w_in; WT_ = (unsigned char*)WinT; K_ = D; N_ = INW; mode_ = 0; } \
                    else if ((r_ -= U_IN) < U_GL) { W_ = w_glu; WT_ = (unsigned char*)WgluT; K_ = SW; N_ = 2 * D; mode_ = 1; } \
                    else if ((r_ -= U_GL) < U_PO) { W_ = w_pool_out; WT_ = (unsigned char*)WpoT; K_ = PW; N_ = D; mode_ = 0; } \
                    else if ((r_ -= U_PO) < U_OUT) { W_ = w_out; WT_ = (unsigned char*)WoutT; K_ = D; N_ = D; mode_ = 0; } \
                    else if ((r_ -= U_OUT) < U_W1) { const int e_ = r_ / U_W1E; r_ -= e_ * U_W1E; W_ = w1 + (size_t)e_ * D * 2 * FE; WT_ = W1T8 + (size_t)e_ * D * 2 * FE; K_ = D; N_ = 2 * FE; mode_ = 1; } \
                    else { r_ -= U_W1; const int e_ = r_ / U_W2E; r_ -= e_ * U_W2E; W_ = w2 + (size_t)e_ * FE * D; WT_ = W2T8 + (size_t)e_ * FE * D; K_ = FE; N_ = D; mode_ = 0; } \
                    const int nblk_ = N_ >> 8; k0_ = (r_ / nblk_) * 128; n0_ = (r_ % nblk_) * 256; } while (0)
#define T8_LOAD(reg_, W_, N_, k0_, n0_) do { const float* p_ = W_ + (size_t)(k0_ + 16 * wave) * N_ + n0_ + 4 * lane; \
                    _Pragma("unroll") for (int i_ = 0; i_ < 16; ++i_) reg_[i_] = __builtin_nontemporal_load((const f32x4*)(p_ + (size_t)i_ * N_)); } while (0)
#define T8_PUT(reg_, buf_) do { _Pragma("unroll") for (int j_ = 0; j_ < 4; ++j_) { v4u o_; o_.x = pk4_fp8(32.f * reg_[0][j_], 32.f * reg_[1][j_], 32.f * reg_[2][j_], 32.f * reg_[3][j_]); o_.y = pk4_fp8(32.f * reg_[4][j_], 32.f * reg_[5][j_], 32.f * reg_[6][j_], 32.f * reg_[7][j_]); \
                    o_.z = pk4_fp8(32.f * reg_[8][j_], 32.f * reg_[9][j_], 32.f * reg_[10][j_], 32.f * reg_[11][j_]); o_.w = pk4_fp8(32.f * reg_[12][j_], 32.f * reg_[13][j_], 32.f * reg_[14][j_], 32.f * reg_[15][j_]); \
                    *(LAS v4u*)(lds + RING_OFF + (buf_) * TRB + (4 * lane + j_) * 144 + 16 * wave) = o_; } } while (0)
#define T8_FLUSH(buf_, WT_, K_, N_, mode_, k0_, n0_) do { _Pragma("unroll") for (int p_ = 0; p_ < 4; ++p_) { const int n_ = 64 * p_ + (tid >> 3), c_ = tid & 7; \
                    const v4u q_ = *(const LAS v4u*)(lds + RING_OFF + (buf_) * TRB + n_ * 144 + 16 * c_); const int gn_ = n0_ + n_; int drow_ = gn_; \
                    if (mode_) { const int half_ = N_ >> 1, hi_ = gn_ >= half_ ? 1 : 0, nn_ = gn_ - hi_ * half_; drow_ = (nn_ >> 7) * 256 + hi_ * 128 + (nn_ & 127); } \
                    __builtin_nontemporal_store(q_, (v4u*)(WT_ + (size_t)drow_ * K_ + k0_ + 16 * c_)); } } while (0)
                int itA = vcu, itB = vcu + G;
                const float *WA = nullptr, *WB = nullptr; unsigned char *TA = nullptr, *TB = nullptr; int KA = 0, NA = 0, mA = 0, kA = 0, nA = 0, KB = 0, NB = 0, mB = 0, kB = 0, nB = 0;
                f32x4 ra[16], rb[16];
                if (itA < U_TOT) { T8_DECODE(itA, WA, TA, KA, NA, mA, kA, nA); T8_LOAD(ra, WA, NA, kA, nA); }
                if (itB < U_TOT) { T8_DECODE(itB, WB, TB, KB, NB, mB, kB, nB); T8_LOAD(rb, WB, NB, kB, nB); }
                while (itA < U_TOT) {
                    T8_PUT(ra, 0);
                    { unsigned char* dT = TA; const int dK = KA, dN = NA, dm = mA, dk = kA, dn = nA;
                      itA += 2 * G; if (itA < U_TOT) { T8_DECODE(itA, WA, TA, KA, NA, mA, kA, nA); T8_LOAD(ra, WA, NA, kA, nA); }
                      TR_BAR();
                      T8_FLUSH(0, dT, dK, dN, dm, dk, dn); }
                    if (itB >= U_TOT) break;
                    T8_PUT(rb, 1);
                    { unsigned char* dT = TB; const int dK = KB, dN = NB, dm = mB, dk = kB, dn = nB;
                      itB += 2 * G; if (itB < U_TOT) { T8_DECODE(itB, WB, TB, KB, NB, mB, kB, nB); T8_LOAD(rb, WB, NB, kB, nB); }
                      TR_BAR();
                      T8_FLUSH(1, dT, dK, dN, dm, dk, dn); }
                }
                __syncthreads();
#undef T8_DECODE
#undef T8_LOAD
#undef T8_PUT
#undef T8_FLUSH
            }
#undef TR_DECODE
#undef TR_LOAD
#undef TR_PUT
#undef TR_FLUSH
#undef TR_BAR
        }
        PROBE_MID(1); if (BOTH(1)) GRID_BAR(); PROBE_END(1);
    }

    if (IN(2)) {
        PH_PTRS(); PROBE_BEGIN(2);
        SchedDense S; S.init(Z_FP8 ? (const void*)XN8 : (const void*)XN, WinT, T, INW, D, D, G, bx, Z_FP8 ? 1 : 2);
        EpiZ E{UP, UG, SGP, SGS, Z_FP8 ? 0.03125f : 1.0f};
        pg8::gemm_phase<EpiZ, SchedDense, false, Z_FP8 ? 1 : 2>(lds + RING_OFF, D, D, D, S, E);
        if (DUPSEL == 2) { pg8::gemm_phase<EpiZ, SchedDense, false, Z_FP8 ? 1 : 2>(lds + RING_OFF, D, D, D, S, E); }
        PROBE_MID(2); if (BOTH(2)) GRID_BAR(); PROBE_END(2);
    }

    if (IN(3)) {
        PH_PTRS(); PROBE_BEGIN(3);
        for (int L = vcu; L < 4 * (T / 256); L += G) {
            const int gq = L / (T / 256), pm = L % (T / 256), b = pm >> 4, oct = lane & 31, th = lane >> 5, t0 = (pm & 15) * 256 + wave * 32 + th * 16;
            bf16* pl = PL + (size_t)b * SEQ * PW + gq * 256 + oct * 8; const unsigned voff = (unsigned)(th * 16 * PW + oct * 8) * 2u;
            const bf16* ub0 = UP + ((size_t)b * SEQ + (pm & 15) * 256 + wave * 32) * PW + gq * 256;
            if (gq == 0) pool_item<2>(ub0 - 1 * PW, voff, pl, t0); else if (gq == 1) pool_item<4>(ub0 - 3 * PW, voff, pl, t0); else if (gq == 2) pool_item<8>(ub0 - 7 * PW, voff, pl, t0); else pool_item<16>(ub0 - 15 * PW, voff, pl, t0);
        }
        VM_WAIT(); __syncthreads();
        { SchedGrouped S; S.init(PL, PoolWT, PW, (size_t)256 * 2, (size_t)256 * 256 * 2, T / 256, 4, G, vcu);
          EpiPmix E{PM, pool_scale};
          pg8::gemm_phase<EpiPmix, SchedGrouped, false>(lds + RING_OFF, PW, 256, 256, S, E); }
        { SchedGrouped S; S.init(UG, WendT, UGK, (size_t)1024 * UGK * 2, (size_t)256 * 256 * 2, 4, SG, G, vcu);
          EpiS1 E{EB};
          pg8::gemm_phase<EpiS1, SchedGrouped, false>(lds + RING_OFF, UGK, 256, 256, S, E); }
        PROBE_MID(3); if (BOTH(3)) GRID_BAR(); PROBE_END(3);
    }


    if (IN(5)) {
        PH_PTRS(); PROBE_BEGIN(5);
        {
            LAS float* SB = (LAS float*)(lds + RING_OFF);
            for (int L = vcu; L < SG * 4; L += G) {
                const int g = L >> 2, b = L & 3, p = lane; const float ar = AL[(g * SP + p) * 2], ai = AL[(g * SP + p) * 2 + 1];
                const size_t rb = (size_t)g * 1024 + b * 256 + 32 * wave;
                float er[32], ei[32], lr[32], li[32];
#pragma unroll
                for (int j = 0; j < 32; ++j) { er[j] = EB[(rb + j) * 128 + p]; ei[j] = EB[(rb + j) * 128 + 64 + p]; }
                float xr = 0.f, xi = 0.f;
#pragma unroll
                for (int j = 0; j < 32; ++j) { lr[j] = xr; li[j] = xi; const float nr = ar * xr - ai * xi + er[j], ni = ar * xi + ai * xr + ei[j]; xr = nr; xi = ni; }
                SB[(wave * 64 + p) * 2] = xr; SB[(wave * 64 + p) * 2 + 1] = xi;
                float qr = ar, qi = ai;
#pragma unroll
                for (int k = 0; k < 5; ++k) { const float t0 = qr * qr - qi * qi, t1 = 2.f * qr * qi; qr = t0; qi = t1; }
                __syncthreads();
                float cr = 0.f, ci = 0.f;
                for (int v = 0; v < wave; ++v) { const float sr = SB[(v * 64 + p) * 2], si = SB[(v * 64 + p) * 2 + 1]; const float nr = qr * cr - qi * ci + sr, ni = qr * ci + qi * cr + si; cr = nr; ci = ni; }
                float pr = 1.f, pi = 0.f;
#pragma unroll
                for (int j = 0; j < 32; ++j) { const float fr_ = lr[j] + pr * cr - pi * ci, fi_ = li[j] + pr * ci + pi * cr;
                    UG[(rb + j) * UGK + 256 + p] = (bf16)(cvt_pk_bf16(fr_, 0.f) & 0xffffu); UG[(rb + j) * UGK + 320 + p] = (bf16)(cvt_pk_bf16(fi_, 0.f) & 0xffffu);
                    const float t0 = pr * ar - pi * ai, t1 = pr * ai + pi * ar; pr = t0; pi = t1; }
                __syncthreads();
            }
        }
        VM_WAIT(); __syncthreads();
        { SchedGrouped S; S.init(UG, TG, UGK, (size_t)1024 * UGK * 2, (size_t)256 * UGK * 2, 4, SG, G, vcu);
          EpiS3 E{YS};
          pg8::gemm_phase<EpiS3, SchedGrouped, false>(lds + RING_OFF, UGK, UGK, UGK, S, E); }
        { SchedDense S; S.init(PM, WpoT, T, D, PW, PW, G, bx, PO_FP8 ? 1 : 2);
          EpiYpool E{YPG, SGP, PO_FP8 ? 0.03125f : 1.0f};
          pg8::gemm_phase<EpiYpool, SchedDense, false, PO_FP8 ? 1 : 2>(lds + RING_OFF, PW, PW, PW, S, E); }
        PROBE_MID(5); if (BOTH(5)) GRID_BAR(); PROBE_END(5);
    }

    if (IN(6)) {
        PH_PTRS(); PROBE_BEGIN(6);
        SchedDense S; S.init(YS, WgluT, T, 2 * D, SW, SW, G, bx, GLU_FP8 ? 1 : 2);
        EpiGlu E{MG, YPG, SGS, b_glu, GLU_FP8 ? 0.03125f : 1.0f};
        pg8::gemm_phase<EpiGlu, SchedDense, false, GLU_FP8 ? 1 : 2>(lds + RING_OFF, SW, SW, SW, S, E);
        PROBE_MID(6); if (BOTH(6)) GRID_BAR(); PROBE_END(6);
    }

    if (IN(7)) {
        PH_PTRS(); PROBE_BEGIN(7);
        SchedDense S; S.init(MG, WoutT, T, D, D, D, G, bx, OUT_FP8 ? 1 : 2);
        EpiMix E{MX, OUT_FP8 ? 0.03125f : 1.0f, MOD + 2 * D};
        pg8::gemm_phase<EpiMix, SchedDense, false, OUT_FP8 ? 1 : 2>(lds + RING_OFF, D, D, D, S, E);
        PROBE_MID(7); if (BOTH(7)) GRID_BAR(); PROBE_END(7);
    }

    if (IN(8)) for (int rep_ = 0; rep_ < REP(8); ++rep_) {
        PH_PTRS(); PROBE_BEGIN(8);
        LAS float* HT = (LAS float*)(lds + RING_OFF);
        LAS float* RED = (LAS float*)(lds + RING_OFF + 65792);
        LAS float* LG = (LAS float*)(lds + RING_OFF + 98560);
        LAS int* HIST = (LAS int*)(lds + RING_OFF + 102784);
        LAS int* BASE = (LAS int*)(lds + RING_OFF + 102912);
        LAS float* PVA = (LAS float*)(lds + RING_OFF + 104448);
        LAS float* PVS = PVA + D;
        const int TPW8 = (T / 32 + G - 1) / G; int cb8 = -1;
        for (int ti8 = 0; ti8 < TPW8; ++ti8) {
            const int tile = vcu * TPW8 + ti8; if (tile >= T / 32) break;
            const int R0 = tile * 32, b = R0 >> 12; const float* mb = MOD + (size_t)b * 6 * D;
            if (b != cb8) { cb8 = b; __syncthreads(); const int k = 4 * tid;
                const f32x4 g = *(const f32x4*)(norm2_g + k), sh = *(const f32x4*)(mb + 3 * D + k), sc = *(const f32x4*)(mb + 4 * D + k);
                *(LAS f32x4*)(PVA + k) = g * (sc + 1.0f); *(LAS f32x4*)(PVS + k) = sh; __syncthreads(); }
            f32x4 v[4][8]; float rstd[4], ssq[4] = {0.f, 0.f, 0.f, 0.f};
#pragma unroll
            for (int j = 0; j < 8; ++j) { const int k = 4 * lane + 256 * j;
#pragma unroll
                for (int rr = 0; rr < 4; ++rr) { const size_t off = (size_t)(R0 + 4 * wave + rr) * D + k; const v2u mq = *(const v2u*)(MX + off);
                    v[rr][j] = *(const f32x4*)(x + off) + (f32x4){bf_lo(mq.x), bf_hi(mq.x), bf_lo(mq.y), bf_hi(mq.y)};
                    { v2u xo; xo.x = cvt_pk_bf16(v[rr][j][0], v[rr][j][1]); xo.y = cvt_pk_bf16(v[rr][j][2], v[rr][j][3]); *(v2u*)(X1B + off) = xo; }
                    ssq[rr] += v[rr][j][0] * v[rr][j][0] + v[rr][j][1] * v[rr][j][1] + v[rr][j][2] * v[rr][j][2] + v[rr][j][3] * v[rr][j][3]; } }
#pragma unroll
            for (int rr = 0; rr < 4; ++rr) rstd[rr] = 1.0f / sqrtf(wave_sum(ssq[rr]) * (1.0f / D) + RMS_EPS);
#pragma unroll
            for (int j = 0; j < 8; ++j) { const int k = 4 * lane + 256 * j; const f32x4 Aj = *(const LAS f32x4*)(PVA + k), sh = *(const LAS f32x4*)(PVS + k);
#pragma unroll
                for (int rr = 0; rr < 4; ++rr) { const int row = R0 + 4 * wave + rr; v[rr][j] = v[rr][j] * rstd[rr] * Aj + sh;
                    *(unsigned*)(XN8 + (size_t)row * D + k) = pk4_fp8(v[rr][j][0], v[rr][j][1], v[rr][j][2], v[rr][j][3]); } }
            if (tid < 32) HIST[tid] = 0;
            f32x16 lacc;
#pragma unroll
            for (int j = 0; j < 16; ++j) lacc[j] = 0.f;
#pragma unroll
            for (int q = 0; q < 4; ++q) {
                float bq[16];
                const float* wr0 = w_router + (size_t)(q * 512 + 64 * wave) * NE; const float* wr1 = wr0 + 16 * 2 * NE; const unsigned wvo = (unsigned)((lane >> 5) * NE + (lane & 31)) * 4u;
#define RB_LD(i_, off_, base_) asm volatile("global_load_dword %0, %1, %2 offset:" #off_ : "=v"(bq[i_]) : "v"(wvo), "s"(base_))
#define RB_LD16(base_) do { RB_LD(0, 0, base_); RB_LD(1, 256, base_); RB_LD(2, 512, base_); RB_LD(3, 768, base_); RB_LD(4, 1024, base_); RB_LD(5, 1280, base_); RB_LD(6, 1536, base_); RB_LD(7, 1792, base_); \
                    RB_LD(8, 2048, base_); RB_LD(9, 2304, base_); RB_LD(10, 2560, base_); RB_LD(11, 2816, base_); RB_LD(12, 3072, base_); RB_LD(13, 3328, base_); RB_LD(14, 3584, base_); RB_LD(15, 3840, base_); } while (0)
#define RB_WAIT() do { asm volatile("s_waitcnt vmcnt(0)" : "+v"(bq[0]), "+v"(bq[1]), "+v"(bq[2]), "+v"(bq[3]), "+v"(bq[4]), "+v"(bq[5]), "+v"(bq[6]), "+v"(bq[7])); \
                    asm volatile("" : "+v"(bq[8]), "+v"(bq[9]), "+v"(bq[10]), "+v"(bq[11]), "+v"(bq[12]), "+v"(bq[13]), "+v"(bq[14]), "+v"(bq[15])); } while (0)
                RB_LD16(wr0);
                __syncthreads();
#pragma unroll
                for (int rr = 0; rr < 4; ++rr)
#pragma unroll
                    for (int jj = 0; jj < 2; ++jj) { const int lk = 4 * lane + 256 * jj; LAS float* hp = HT + (4 * wave + rr) * 513 + lk; const f32x4 q4 = v[rr][2 * q + jj]; hp[0] = q4[0]; hp[1] = q4[1]; hp[2] = q4[2]; hp[3] = q4[3]; }
                __syncthreads();
                const LAS float* ap = HT + (lane & 31) * 513 + 64 * wave + (lane >> 5);
                RB_WAIT();
#pragma unroll
                for (int s = 0; s < 16; ++s) lacc = __builtin_amdgcn_mfma_f32_32x32x2f32(ap[2 * s], bq[s], lacc, 0, 0, 0);
                asm volatile("" : "+v"(lacc));
                RB_LD16(wr1); RB_WAIT();
#pragma unroll
                for (int s = 0; s < 16; ++s) lacc = __builtin_amdgcn_mfma_f32_32x32x2f32(ap[32 + 2 * s], bq[s], lacc, 0, 0, 0);
                asm volatile("" : "+v"(lacc));
            }
#pragma unroll
            for (int rg = 0; rg < 16; ++rg) { const int i = (rg & 3) + 8 * (rg >> 2) + 4 * (lane >> 5); RED[(wave * 32 + i) * 32 + (lane & 31)] = lacc[rg]; }
            __syncthreads();
#pragma unroll
            for (int pp = 0; pp < 2; ++pp) { const int p = tid + pp * 512, i = p >> 5, j = p & 31; float s = b_router[j];
#pragma unroll
                for (int w = 0; w < 8; ++w) s += RED[(w * 32 + i) * 32 + j];
                LG[i * 33 + j] = s; }
            __syncthreads();
            int ae[2], al[2]; float aw[2];
            { const int hw = tid >> 5, l32 = tid & 31;
#pragma unroll
              for (int it = 0; it < 2; ++it) { const int i = hw * 2 + it; float val = LG[i * 33 + l32]; float tv[4]; int ti[4];
#pragma unroll
                for (int k = 0; k < 4; ++k) { float bv = val; int bi = l32;
#pragma unroll
                    for (int off = 16; off >= 1; off >>= 1) { const float ov = __shfl_xor(bv, off); const int oi = __shfl_xor(bi, off); if (ov > bv || (ov == bv && oi < bi)) { bv = ov; bi = oi; } }
                    tv[k] = bv; ti[k] = bi; if (l32 == bi) val = -3.0e38f; }
                float den = 0.f, ex[4];
#pragma unroll
                for (int k = 0; k < 4; ++k) { ex[k] = expf(tv[k] - tv[0]); den += ex[k]; }
                const int ke = l32 & 3; ae[it] = ke == 0 ? ti[0] : (ke == 1 ? ti[1] : (ke == 2 ? ti[2] : ti[3])); aw[it] = (ke == 0 ? ex[0] : (ke == 1 ? ex[1] : (ke == 2 ? ex[2] : ex[3]))) / den;
                al[it] = (l32 < 4) ? atomicAdd((int*)&HIST[ae[it]], 1) : 0; } }
            __syncthreads();
            if (tid < 32) { const int c = HIST[tid]; BASE[tid] = c ? (int)__hip_atomic_fetch_add((unsigned*)(ctl + CW_CNT + tid), (unsigned)c, RLX_AGENT) : 0; }
            __syncthreads();
            if ((tid & 31) < 4) { const int hw = tid >> 5, k = tid & 3;
#pragma unroll
                for (int it = 0; it < 2; ++it) { const int tok = R0 + hw * 2 + it, e = ae[it], rank = BASE[e] + al[it]; LTOK[(size_t)e * LCAP + rank] = tok; LWT[(size_t)e * LCAP + rank] = aw[it]; TSLOT[tok * 4 + k] = e * LCAP + rank; } }
            __syncthreads();
        }
        PROBE_MID(8); if (BOTH(8)) GRID_BAR(); PROBE_END(8);
    }

#define MOE_TABLES(nN_) do { __syncthreads(); if (tid < 64) { const int e_ = tid & 31; const unsigned c_ = (tid < 32) ? __hip_atomic_load(ctl + CW_CNT + e_, RLX_AGENT) : 0u; const unsigned nb_ = (c_ + 255u) >> 8; \
        unsigned incl_ = nb_; _Pragma("unroll") for (int off_ = 1; off_ < 32; off_ <<= 1) { const unsigned t_ = __shfl_up(incl_, off_); if (e_ >= off_) incl_ += t_; } \
        if (tid < 32) { const unsigned excl_ = incl_ - nb_; MISC[32 + e_] = excl_ * (unsigned)(nN_); MISC[80 + e_] = excl_; MISC[128 + e_] = c_; \
            if (e_ == NE - 1) { MISC[32 + NE] = incl_ * (unsigned)(nN_); MISC[80 + NE] = incl_; MISC[176] = incl_ * (unsigned)(nN_); } } } __syncthreads(); } while (0)

    if (IN(9)) {
        PH_PTRS(); PROBE_BEGIN(9);
        MOE_TABLES(2 * FE / 256);
        SchedMoe S; S.A = (const char*)XN8; S.Bt = (const char*)W1T8; S.astep = 0; S.bstep_e = (size_t)2 * FE * D; S.bstep_n = (size_t)256 * D; S.nN = 2 * FE / 256; S.G = G; S.c = vcu; S.M = MISC; S.ltok = LTOK; S.gather = true;
        EpiMoe1 E{ACT8, b1};
        pg8::gemm_phase<EpiMoe1, SchedMoe, true, 1, true>(lds + RING_OFF, D, D, D, S, E);
        if (DUPSEL == 9) { pg8::gemm_phase<EpiMoe1, SchedMoe, true, 1, true>(lds + RING_OFF, D, D, D, S, E); }
        PROBE_MID(9); if (BOTH(9)) GRID_BAR(); PROBE_END(9);
    }

    if (IN(10)) {
        PH_PTRS(); PROBE_BEGIN(10);
        MOE_TABLES(D / 256);
        SchedMoe S; S.A = (const char*)ACT8; S.Bt = (const char*)W2T8; S.astep = (size_t)256 * FE; S.bstep_e = (size_t)D * FE; S.bstep_n = (size_t)256 * FE; S.nN = D / 256; S.G = G; S.c = vcu; S.M = MISC; S.ltok = LTOK; S.gather = false;
        EpiMoe2 E{YE, b2, LWT};
        pg8::gemm_phase<EpiMoe2, SchedMoe, false, 1, true>(lds + RING_OFF, FE, FE, FE, S, E);
        if (DUPSEL == 10) { pg8::gemm_phase<EpiMoe2, SchedMoe, false, 1, true>(lds + RING_OFF, FE, FE, FE, S, E); }
        PROBE_MID(10); if (BOTH(10)) GRID_BAR(); PROBE_END(10);
    }

    if (IN(11)) for (int rep_ = 0; rep_ < REP(11); ++rep_) {
        PH_PTRS(); PROBE_BEGIN(11);
        MOE_TABLES(1);
        {
            const int RPW = (T + NGW - 1) / NGW; int cb = -1;
            f32x4 Av[8], Bv[8], Gv[8];
            int sl[4];
            { const int r0 = gw * RPW < T ? gw * RPW : T - 1;
#pragma unroll
              for (int k = 0; k < 4; ++k) sl[k] = TSLOT[r0 * 4 + k]; }
            for (int i = 0; i < RPW; ++i) {
                const int row = gw * RPW + i; if (row >= T) break;
                const int b = row >> 12;
                if (b != cb) { cb = b; const float* mb = MOD + (size_t)b * 6 * D; const float* fb = FMOD + (size_t)b * 2 * D;
#pragma unroll
                    for (int j = 0; j < 8; ++j) { const int k = 8 * lane + 512 * (j >> 1) + 4 * (j & 1); const f32x4 g = *(const f32x4*)(fnorm_g + k), sh = *(const f32x4*)(fb + k), sc = *(const f32x4*)(fb + D + k);
                        Av[j] = g * (sc + 1.0f); Bv[j] = sh; Gv[j] = *(const f32x4*)(mb + 5 * D + k); } }
                size_t prow[4];
#pragma unroll
                for (int k = 0; k < 4; ++k) { const int sv = sl[k]; const int e = sv >> 14, rank = sv & (LCAP - 1); prow[k] = ((size_t)MISC[80 + e] * 256 + rank) * D; }
                { const int rn = (row + 1 < T) ? row + 1 : row;
#pragma unroll
                  for (int k = 0; k < 4; ++k) sl[k] = TSLOT[rn * 4 + k]; }
                f32x4 v[8]; float ss = 0.f;
#pragma unroll
                for (int j = 0; j < 4; ++j) { const int k = 8 * lane + 512 * j; float f[8] = {0.f, 0.f, 0.f, 0.f, 0.f, 0.f, 0.f, 0.f};
#pragma unroll
                    for (int kk = 0; kk < 4; ++kk) { const v2u y = *(const v2u*)(YE + prow[kk] + k); const pg8::f32x2 q0 = __builtin_amdgcn_cvt_pk_f32_fp8((int)y.x, false), q1 = __builtin_amdgcn_cvt_pk_f32_fp8((int)y.x, true), q2 = __builtin_amdgcn_cvt_pk_f32_fp8((int)y.y, false), q3 = __builtin_amdgcn_cvt_pk_f32_fp8((int)y.y, true);
                        f[0] += q0.x; f[1] += q0.y; f[2] += q1.x; f[3] += q1.y; f[4] += q2.x; f[5] += q2.y; f[6] += q3.x; f[7] += q3.y; }
                    const v4u mq = *(const v4u*)(X1B + (size_t)row * D + k);
                    const f32x4 x0 = (f32x4){bf_lo(mq.x), bf_hi(mq.x), bf_lo(mq.y), bf_hi(mq.y)}, x1v = (f32x4){bf_lo(mq.z), bf_hi(mq.z), bf_lo(mq.w), bf_hi(mq.w)};
                    v[2 * j] = x0 + Gv[2 * j] * ((f32x4){f[0], f[1], f[2], f[3]} * 0.0625f); v[2 * j + 1] = x1v + Gv[2 * j + 1] * ((f32x4){f[4], f[5], f[6], f[7]} * 0.0625f);
                    ss += v[2 * j][0] * v[2 * j][0] + v[2 * j][1] * v[2 * j][1] + v[2 * j][2] * v[2 * j][2] + v[2 * j][3] * v[2 * j][3];
                    ss += v[2 * j + 1][0] * v[2 * j + 1][0] + v[2 * j + 1][1] * v[2 * j + 1][1] + v[2 * j + 1][2] * v[2 * j + 1][2] + v[2 * j + 1][3] * v[2 * j + 1][3]; }
                const float rstd = 1.0f / sqrtf(wave_sum(ss) * (1.0f / D) + RMS_EPS);
#pragma unroll
                for (int j = 0; j < 8; ++j) { const int k = 8 * lane + 512 * (j >> 1) + 4 * (j & 1); *(f32x4*)(out + (size_t)row * D + k) = v[j] * rstd * Av[j] + Bv[j]; }
            }
        }
    }
    if (PROBE_PH == 11) { __syncthreads(); pr_dt = __builtin_amdgcn_s_memrealtime() - pr_t0; }
    if (PROBE_PH >= 0) { const unsigned long long te = __builtin_amdgcn_s_memrealtime(); while (__builtin_amdgcn_s_memrealtime() - te < (unsigned long long)PROBE_N * pr_dt) __builtin_amdgcn_s_sleep(8); }
#undef IN
#undef BOTH
}

extern "C" void kernel_launch(void* const* d_in, const int* in_sizes, int n_in, void* d_out, int out_size, void* d_ws, size_t ws_size, hipStream_t stream) {
    static int grid = 0;
    if (grid == 0) {
        if (n_in != 30 || out_size != T * D || ws_size < WS_END) { fprintf(stderr, "kernel_launch: unexpected shapes (n_in %d, out %d, ws %zu); nothing launched\n", n_in, out_size, ws_size); grid = -1; return; }
        int dev = 0, cus = 0, per_cu = 0;
        if (hipGetDevice(&dev) != hipSuccess || hipDeviceGetAttribute(&cus, hipDeviceAttributeMultiprocessorCount, dev) != hipSuccess) { grid = -1; return; }
        if (hipFuncSetAttribute((const void*)fwd_kernel, hipFuncAttributeMaxDynamicSharedMemorySize, LDS_BYTES) != hipSuccess) { fprintf(stderr, "kernel_launch: hipFuncSetAttribute failed\n"); grid = -1; return; }
        if (hipOccupancyMaxActiveBlocksPerMultiprocessor(&per_cu, (const void*)fwd_kernel, NWAVES * 64, LDS_BYTES) != hipSuccess || per_cu < 1)
            fprintf(stderr, "kernel_launch: note: occupancy query reports %d workgroups per CU\n", per_cu);
        (void)hipGetLastError();
        grid = cus;
    }
    if (grid < 0) return;
    if (hipMemsetAsync((char*)d_ws + WS_CTL, 0, CTL_ZERO_BYTES, stream) != hipSuccess) { fprintf(stderr, "kernel_launch: hipMemsetAsync failed\n"); return; }
    Args a{};
    for (int i = 0; i < 30; ++i) a.in[i] = d_in[i];
    a.out = (float*)d_out; a.ws = (unsigned char*)d_ws;
    for (int li = 0; li < N_LAUNCHES; ++li) {
        if (N_LAUNCHES == 1) { a.ph_lo = 0; a.ph_hi = NPH; } else { a.ph_lo = li; a.ph_hi = li + 1; }
        a.li = li; a.pad = 0;
        hipLaunchKernelGGL(fwd_kernel, dim3(grid), dim3(NWAVES * 64), LDS_BYTES, stream, a);
        const hipError_t le = hipPeekAtLastError();
        if (le != hipSuccess) { fprintf(stderr, "kernel_launch: launch %d failed: %s\n", li, hipGetErrorName(le)); break; }
    }
}
```

```cpp
#include <hip/hip_runtime.h>
#include <cstdio>
#include <cstdint>

namespace pg8 {
#define PG8_LAS __attribute__((address_space(3)))
typedef unsigned short bf16_t;
typedef short bf16x8 __attribute__((ext_vector_type(8)));
typedef float f32x4 __attribute__((ext_vector_type(4)));
typedef float f32x2 __attribute__((ext_vector_type(2)));
typedef unsigned u32x4 __attribute__((ext_vector_type(4)));
typedef int i32x4 __attribute__((ext_vector_type(4)));
typedef int i32x8 __attribute__((ext_vector_type(8)));
constexpr int BM = 256, BK = 64, HALF = 128, HTB = HALF * BK * 2, STAGE_BYTES = 8 * HTB, NXCD = 8, WGM = 8;

__host__ __device__ __forceinline__ int lds_byte(int r, int c) { const int st = (r >> 4) * 2 + (c >> 5), rr = r & 15, cc = c & 31, ob = rr * 64 + cc * 2; return st * 1024 + (ob ^ (((ob >> 9) & 1) << 5)); }
__host__ __device__ __forceinline__ void stage_rc(int b, int& R, int& C) { const int st = b / 1024, sb = b % 1024, swz = sb ^ (((sb >> 9) & 1) << 5); R = (st >> 1) * 16 + swz / 64; C = (st & 1) * 32 + (swz % 64) / 2; }
__host__ __device__ __forceinline__ int perm32(int rho) { const int n = rho >> 4, i = rho & 15; return 8 * (i >> 2) + 4 * n + (i & 3); }

struct Unit { int pm, pn, e, rb, nvalid; };

__device__ __forceinline__ unsigned cvt_pk_bf16(float lo, float hi) { unsigned r; asm volatile("v_cvt_pk_bf16_f32 %0, %1, %2" : "=v"(r) : "v"(lo), "v"(hi)); return r; }
__device__ __forceinline__ unsigned pk4_fp8(float a, float b, float c, float d) {
    a = __builtin_amdgcn_fmed3f(a, -448.f, 448.f); b = __builtin_amdgcn_fmed3f(b, -448.f, 448.f); c = __builtin_amdgcn_fmed3f(c, -448.f, 448.f); d = __builtin_amdgcn_fmed3f(d, -448.f, 448.f);
    int w = 0; w = __builtin_amdgcn_cvt_pk_fp8_f32(a, b, w, false); w = __builtin_amdgcn_cvt_pk_fp8_f32(c, d, w, true); return (unsigned)w; }
__device__ __forceinline__ unsigned pk4_u8(float a, float b, float c, float d) {
    unsigned w = 0; w = __builtin_amdgcn_cvt_pk_u8_f32(a, 0, w); w = __builtin_amdgcn_cvt_pk_u8_f32(b, 1, w); w = __builtin_amdgcn_cvt_pk_u8_f32(c, 2, w); w = __builtin_amdgcn_cvt_pk_u8_f32(d, 3, w); return w; }
__device__ __forceinline__ u32x4 pair16(unsigned ax, unsigned ay, unsigned bx, unsigned by) {
    const auto rx = __builtin_amdgcn_permlane16_swap(ax, bx, false, false); const auto ry = __builtin_amdgcn_permlane16_swap(ay, by, false, false);
    return (u32x4){rx[0], ry[0], rx[1], ry[1]};
}
__device__ __forceinline__ void unpair16(u32x4 q, unsigned& ax, unsigned& ay, unsigned& bx, unsigned& by) {
    const auto rx = __builtin_amdgcn_permlane16_swap(q.x, q.z, false, false); const auto ry = __builtin_amdgcn_permlane16_swap(q.y, q.w, false, false);
    ax = rx[0]; ay = ry[0]; bx = rx[1]; by = ry[1];
}
__device__ __forceinline__ float bf_lo(unsigned w) { return __uint_as_float(w << 16); }
__device__ __forceinline__ float bf_hi(unsigned w) { return __uint_as_float(w & 0xffff0000u); }
__device__ __forceinline__ float sigmoidf_(float x) { return __builtin_amdgcn_rcpf(1.0f + __builtin_amdgcn_exp2f(-1.44269504089f * x)); }
__device__ __forceinline__ float gelu_tanh_(float x) { const float u = 0.7978845608f * (x + 0.044715f * x * x * x); return x * __builtin_amdgcn_rcpf(1.0f + __builtin_amdgcn_exp2f(-2.88539008178f * u)); }

template <class Epi, class Sched, bool GATHER, int ESZ = 2, bool HALFU = false>
__device__ __forceinline__ void gemm_phase(PG8_LAS unsigned char* lds, const int lda, const int ldb, const int K, const Sched& S, const Epi& E) {
    const int tid = threadIdx.x, wid = __builtin_amdgcn_readfirstlane(tid >> 6), lane = tid & 63, wr = wid >> 2, wc = wid & 3, fr = lane & 15, fq = lane >> 4;
    const int nt = (K * ESZ) / (BK * 2);
    unsigned voffA[2], voffB[2], colA[2]; int rowA[2];
#pragma unroll
    for (int i = 0; i < 2; ++i) { int R, C; stage_rc(tid * 16 + i * 8192, R, C); const int Rb = Epi::PERM ? ((R & ~31) + perm32(R & 31)) : R;
        rowA[i] = R; colA[i] = (unsigned)C * 2u; voffA[i] = (unsigned)(R * lda * ESZ + C * 2); voffB[i] = (unsigned)(Rb * ldb * ESZ + C * 2); }
    const size_t kstep = (size_t)(BK * 2);
    const size_t hstepA = GATHER ? (size_t)0 : (size_t)HALF * lda * ESZ;
    const size_t hstepB = (size_t)HALF * ldb * ESZ;
    const unsigned ldsw = (unsigned)wid * 1024u;
    const int aoff = lds_byte(wr * 64 + fr, fq * 8), boff = lds_byte(wc * 32 + fr, fq * 8);
#define PG8_SA(b, h) (((b) * 2 + (h)) * HTB)
#define PG8_SB(b, h) ((4 + (b) * 2 + (h)) * HTB)
#define PG8_STAGE2(bufoff, gbase, o0, o1) do { \
        __builtin_amdgcn_global_load_lds((const unsigned*)((const char*)(gbase) + (o0)), (PG8_LAS unsigned*)(lds + (bufoff) + ldsw), 16, 0, 0); \
        __builtin_amdgcn_global_load_lds((const unsigned*)((const char*)(gbase) + (o1)), (PG8_LAS unsigned*)(lds + (bufoff) + ldsw + 8192), 16, 0, 0); } while (0)
#define PG8_STAGE_B(bufoff, gbase) PG8_STAGE2(bufoff, gbase, voffB[0], voffB[1])
#define PG8_LDA(dst, b, h) do { if constexpr (ESZ == 2) { _Pragma("unroll") for (int m = 0; m < 4; ++m) _Pragma("unroll") for (int k = 0; k < 2; ++k) dst[m][k] = *(const PG8_LAS bf16x8*)(lds + PG8_SA(b, h) + aoff + m * 2048 + k * 1024); } \
        else { _Pragma("unroll") for (int m = 0; m < 4; ++m) { const i32x4 lo_ = *(const PG8_LAS i32x4*)(lds + PG8_SA(b, h) + aoff + m * 2048), hi_ = *(const PG8_LAS i32x4*)(lds + PG8_SA(b, h) + aoff + m * 2048 + 1024); dst##8[m] = __builtin_shufflevector(lo_, hi_, 0, 1, 2, 3, 4, 5, 6, 7); } } } while (0)
#define PG8_LDB(dst, b, h) do { if constexpr (ESZ == 2) { _Pragma("unroll") for (int n = 0; n < 2; ++n) _Pragma("unroll") for (int k = 0; k < 2; ++k) dst[n][k] = *(const PG8_LAS bf16x8*)(lds + PG8_SB(b, h) + boff + n * 2048 + k * 1024); } \
        else { _Pragma("unroll") for (int n = 0; n < 2; ++n) { const i32x4 lo_ = *(const PG8_LAS i32x4*)(lds + PG8_SB(b, h) + boff + n * 2048), hi_ = *(const PG8_LAS i32x4*)(lds + PG8_SB(b, h) + boff + n * 2048 + 1024); dst##8[n] = __builtin_shufflevector(lo_, hi_, 0, 1, 2, 3, 4, 5, 6, 7); } } } while (0)
#define PG8_MMA(ai, bj, At, Bt) do { __builtin_amdgcn_s_setprio(1); \
        if constexpr (ESZ == 2) { _Pragma("unroll") for (int m = 0; m < 4; ++m) _Pragma("unroll") for (int n = 0; n < 2; ++n) _Pragma("unroll") for (int k = 0; k < 2; ++k) \
            acc[ai][bj][m][n] = __builtin_amdgcn_mfma_f32_16x16x32_bf16(Bt[n][k], At[m][k], acc[ai][bj][m][n], 0, 0, 0); } \
        else {   \
            asm volatile("s_nop 3\n\t" \
                "v_mfma_f32_16x16x128_f8f6f4 %0, %8, %10, %0\n\t" "v_mfma_f32_16x16x128_f8f6f4 %1, %9, %10, %1\n\t" \
                "v_mfma_f32_16x16x128_f8f6f4 %2, %8, %11, %2\n\t" "v_mfma_f32_16x16x128_f8f6f4 %3, %9, %11, %3\n\t" \
                "v_mfma_f32_16x16x128_f8f6f4 %4, %8, %12, %4\n\t" "v_mfma_f32_16x16x128_f8f6f4 %5, %9, %12, %5\n\t" \
                "v_mfma_f32_16x16x128_f8f6f4 %6, %8, %13, %6\n\t" "v_mfma_f32_16x16x128_f8f6f4 %7, %9, %13, %7" \
                : "+v"(acc[ai][bj][0][0]), "+v"(acc[ai][bj][0][1]), "+v"(acc[ai][bj][1][0]), "+v"(acc[ai][bj][1][1]), "+v"(acc[ai][bj][2][0]), "+v"(acc[ai][bj][2][1]), "+v"(acc[ai][bj][3][0]), "+v"(acc[ai][bj][3][1]) \
                : "v"(Bt##8[0]), "v"(Bt##8[1]), "v"(At##8[0]), "v"(At##8[1]), "v"(At##8[2]), "v"(At##8[3])); } \
        __builtin_amdgcn_s_setprio(0); } while (0)
#define PG8_WAIT_V(n) asm volatile("s_waitcnt vmcnt(" #n ")" ::: "memory")
#define PG8_WAIT_L(n) asm volatile("s_waitcnt lgkmcnt(" #n ")" ::: "memory")
#define PG8_BAR __builtin_amdgcn_s_barrier()
#define PG8_SCHED __builtin_amdgcn_sched_barrier(0)
    Unit cur, nxt; int ui = 0;
    if (!S.next(0, cur)) return;
    f32x4 acc[2][2][4][2];
#pragma unroll
    for (int a = 0; a < 2; ++a)
#pragma unroll
        for (int b = 0; b < 2; ++b)
#pragma unroll
            for (int m = 0; m < 4; ++m)
#pragma unroll
                for (int n = 0; n < 2; ++n) acc[a][b][m][n] = (f32x4){0.f, 0.f, 0.f, 0.f};
    bf16x8 At[4][2], B0[2][2], B1[2][2]; i32x8 At8[4], B08[2], B18[2];
    const char* cA = S.a_ptr(cur); const char* cB = S.b_ptr(cur);
    unsigned gcur[2][2], gnxt[2][2];
#pragma unroll
    for (int h = 0; h < 2; ++h)
#pragma unroll
        for (int i = 0; i < 2; ++i) { if constexpr (GATHER) gcur[h][i] = S.a_rowoff(cur, h * HALF + rowA[i]) + colA[i]; else gcur[h][i] = voffA[i]; gnxt[h][i] = gcur[h][i]; }
    int rotc = S.krot(cur, nt), rotn = rotc;
#define PG8_KOFS(rot, j) ((size_t)(((j) + (rot)) >= nt ? ((j) + (rot) - nt) : ((j) + (rot))) * kstep)
    { const size_t k0 = PG8_KOFS(rotc, 0), k1 = PG8_KOFS(rotc, 1);
    PG8_STAGE_B(PG8_SB(0, 0), cB + k0); PG8_STAGE_B(PG8_SB(0, 1), cB + hstepB + k0); PG8_STAGE2(PG8_SA(0, 0), cA + k0, gcur[0][0], gcur[0][1]); PG8_STAGE2(PG8_SA(0, 1), cA + hstepA + k0, gcur[1][0], gcur[1][1]);
    if (wr == 1) PG8_BAR;
    PG8_WAIT_V(2); PG8_BAR;
    PG8_STAGE_B(PG8_SB(1, 0), cB + k1); PG8_STAGE2(PG8_SA(1, 0), cA + k1, gcur[0][0], gcur[0][1]); PG8_STAGE_B(PG8_SB(1, 1), cB + hstepB + k1);
    PG8_WAIT_V(6); PG8_BAR; }
    for (;;) {
        const bool has_next = S.next(ui + 1, nxt);
        const char* nA = has_next ? S.a_ptr(nxt) : cA; const char* nB = has_next ? S.b_ptr(nxt) : cB;
        rotn = has_next ? S.krot(nxt, nt) : rotc;
        const bool full = !HALFU || cur.nvalid > 128;
#pragma unroll 1
        for (int t = 0; t < nt; t += 2) {
            const bool last = (t == nt - 2);
            const bool fin = last && !has_next;
            const char* a1 = cA + PG8_KOFS(rotc, t + 1);
            const size_t k2 = last ? PG8_KOFS(rotn, 0) : PG8_KOFS(rotc, t + 2), k3 = last ? PG8_KOFS(rotn, 1) : PG8_KOFS(rotc, t + 3);
            const char* a2 = (last ? nA : cA) + k2; const char* b2 = (last ? nB : cB) + k2;
            const char* a3 = (last ? nA : cA) + k3; const char* b3 = (last ? nB : cB) + k3;
            unsigned o2[2][2];
#pragma unroll
            for (int h = 0; h < 2; ++h)
#pragma unroll
                for (int i = 0; i < 2; ++i) o2[h][i] = gcur[h][i];
            if constexpr (GATHER) {
                if (t == 0 && has_next) {
#pragma unroll
                    for (int h = 0; h < 2; ++h)
#pragma unroll
                        for (int i = 0; i < 2; ++i) gnxt[h][i] = S.a_rowoff(nxt, h * HALF + rowA[i]) + colA[i];
                }
                if (last && has_next) {
                    asm volatile("" : "+v"(gnxt[0][0]), "+v"(gnxt[0][1]), "+v"(gnxt[1][0]), "+v"(gnxt[1][1]));
#pragma unroll
                    for (int h = 0; h < 2; ++h)
#pragma unroll
                        for (int i = 0; i < 2; ++i) o2[h][i] = gnxt[h][i];
                }
            }
            PG8_LDB(B0, 0, 0); PG8_LDB(B1, 0, 1); PG8_SCHED; PG8_LDA(At, 0, 0); PG8_STAGE2(PG8_SA(1, 1), a1 + hstepA, gcur[1][0], gcur[1][1]);
            PG8_WAIT_V(8); PG8_WAIT_L(0); PG8_BAR; PG8_MMA(0, 0, At, B0); PG8_MMA(0, 1, At, B1); PG8_BAR; PG8_SCHED;
            if (full) { PG8_LDA(At, 0, 1); }
            if (!fin) { PG8_STAGE_B(PG8_SB(0, 0), b2); PG8_STAGE_B(PG8_SB(0, 1), b2 + hstepB); PG8_STAGE2(PG8_SA(0, 0), a2, o2[0][0], o2[0][1]); PG8_WAIT_V(8); }
            else { PG8_WAIT_V(2); }
            PG8_WAIT_L(0); PG8_BAR; if (full) { PG8_MMA(1, 0, At, B0); PG8_MMA(1, 1, At, B1); } PG8_BAR; PG8_SCHED;
            PG8_LDB(B0, 1, 0); PG8_LDB(B1, 1, 1); PG8_SCHED; PG8_LDA(At, 1, 0);
            if (!fin) { PG8_STAGE2(PG8_SA(0, 1), a2 + hstepA, o2[1][0], o2[1][1]); PG8_WAIT_V(8); } else { PG8_WAIT_V(0); }
            PG8_WAIT_L(0); PG8_BAR; PG8_MMA(0, 0, At, B0); PG8_MMA(0, 1, At, B1); PG8_BAR; PG8_SCHED;
            if (full) { PG8_LDA(At, 1, 1); }
            if (!fin) { PG8_STAGE_B(PG8_SB(1, 0), b3); PG8_STAGE_B(PG8_SB(1, 1), b3 + hstepB); PG8_STAGE2(PG8_SA(1, 0), a3, o2[0][0], o2[0][1]); PG8_WAIT_V(8); }
            PG8_WAIT_L(0); PG8_BAR; if (full) { PG8_MMA(1, 0, At, B0); PG8_MMA(1, 1, At, B1); } PG8_BAR; PG8_SCHED;
        }
        if (wr == 0) PG8_BAR;
        if constexpr (ESZ == 1) asm volatile("s_nop 15\n\ts_nop 15" ::: "memory");
        E(acc, cur, wr, wc, fr, fq);
        if (!has_next) break;
#pragma unroll
        for (int a = 0; a < 2; ++a)
#pragma unroll
            for (int b = 0; b < 2; ++b)
#pragma unroll
                for (int m = 0; m < 4; ++m)
#pragma unroll
                    for (int n = 0; n < 2; ++n) acc[a][b][m][n] = (f32x4){0.f, 0.f, 0.f, 0.f};
        cur = nxt; cA = nA; cB = nB; rotc = rotn; ++ui;
#pragma unroll
        for (int h = 0; h < 2; ++h)
#pragma unroll
            for (int i = 0; i < 2; ++i) gcur[h][i] = gnxt[h][i];
        if (wr == 1) PG8_BAR;
    }
    PG8_WAIT_V(0);
    PG8_BAR;
#undef PG8_KOFS
#undef PG8_SA
#undef PG8_SB
#undef PG8_STAGE2
#undef PG8_STAGE_B
#undef PG8_LDA
#undef PG8_LDB
#undef PG8_MMA
#undef PG8_WAIT_V
#undef PG8_WAIT_L
#undef PG8_BAR
#undef PG8_SCHED
}
}

constexpr int NWAVES = 8;
#ifndef MK_N_LAUNCHES
#define MK_N_LAUNCHES 1
#endif
#ifndef GATE_FP8
#define GATE_FP8 1
#endif
#ifndef PO_FP8
#define PO_FP8 1
#endif
#ifndef OUT_FP8
#define OUT_FP8 1
#endif
#ifndef GLU_FP8
#define GLU_FP8 1
#endif
#ifndef Z_FP8
#define Z_FP8 1
#endif
constexpr int NPH = 12;
constexpr int N_LAUNCHES = MK_N_LAUNCHES;

constexpr int BATCH = 4, SEQ = 4096, D = 2048, T = BATCH * SEQ;
constexpr int PW = 1024, SW = 1024, INW = PW + SW + 2 * D;
constexpr int NE = 32, TOPK = 4, FE = 2048;
constexpr int SG = 64, SP = 64, SH = 16, CL = 16, NCH = SEQ / CL;
constexpr int UGK = CL * SH + 2 * SP;
constexpr int LCAP = T;
constexpr int MAXBLK = 288;
constexpr float RMS_EPS = 1e-6f;

constexpr size_t MiB = 1u << 20;
constexpr size_t WS_CTL = 0, CTL_ZERO_BYTES = 32768;
constexpr size_t WS_MOD = 1 * MiB;
constexpr size_t WS_FMOD = WS_MOD + 196608, WS_AL = WS_MOD + 262144;
constexpr size_t WS_WIN = 2 * MiB, WS_POOLW = 26 * MiB, WS_WPO = 27 * MiB, WS_WGLU = 31 * MiB, WS_WOUT = 39 * MiB, WS_WEND = 47 * MiB, WS_TG = 55 * MiB;
constexpr size_t WS_W1 = 68 * MiB, WS_W2 = 580 * MiB;
constexpr size_t WS_XN = 836 * MiB, WS_UP = 900 * MiB, WS_UG = 932 * MiB, WS_SGP = 980 * MiB, WS_SGS = 1044 * MiB, WS_PL = 1108 * MiB, WS_PM = 1140 * MiB, WS_E = 1172 * MiB;
constexpr size_t WS_YPG = 1204 * MiB, WS_YS = 1268 * MiB, WS_MG = 1300 * MiB, WS_X1 = 1364 * MiB, WS_LTOK = 1492 * MiB, WS_LWT = 1494 * MiB, WS_TSLOT = 1496 * MiB;
constexpr size_t WS_ACT = 1498 * MiB, WS_YE = 1786 * MiB, WS_END = 2074 * MiB;
static_assert(WS_TG + (size_t)SG * 256 * UGK * 2 <= WS_W1 && WS_UG + (size_t)SG * 1024 * UGK * 2 <= WS_SGP && WS_ACT + (size_t)MAXBLK * 256 * FE * 2 <= WS_YE, "d_ws map");
constexpr int CW_TMO = 0, CW_CODE = 1, CW_CNT = 64, CW_BAR = 4096;

constexpr int RING_OFF = 0, RING_BYTES = 131072;
constexpr int LDSCTL_OFF = RING_BYTES, MISC_OFF = LDSCTL_OFF + 320;
constexpr int LDS_BYTES = 147456;

#define GAS __attribute__((address_space(1)))
#define LAS __attribute__((address_space(3)))
typedef unsigned short bf16;
typedef unsigned v4u __attribute__((ext_vector_type(4)));
typedef unsigned v2u __attribute__((ext_vector_type(2)));
typedef float f32x4 __attribute__((ext_vector_type(4)));
typedef float f32x16 __attribute__((ext_vector_type(16)));
typedef GAS unsigned gu32;
#define RLX_AGENT __ATOMIC_RELAXED, __HIP_MEMORY_SCOPE_AGENT
#define LDS_WAIT() asm volatile("s_waitcnt lgkmcnt(0)" ::: "memory")
#define VM_WAIT() asm volatile("s_waitcnt vmcnt(0)" ::: "memory")
using pg8::cvt_pk_bf16; using pg8::pk4_fp8; using pg8::pk4_u8; using pg8::pair16; using pg8::unpair16; using pg8::bf_lo; using pg8::bf_hi; using pg8::sigmoidf_; using pg8::gelu_tanh_;

#define XB_TMO      128
#define XB_XCNT(j)  (256  + 64 * (j))
#define XB_XSUB(j)  (1280 + 64 * (j))
#define XB_XGEN(j)  (2304 + 64 * (j))
#define XB_TOP      3328
#define XB_TOPGEN   3392
#define XCD_BAR_WORDS 3456
#define XB_SPIN_CAP (1u << 18)

__device__ __forceinline__ unsigned xb_ld(unsigned* p)              { return __hip_atomic_load(p, __ATOMIC_RELAXED, __HIP_MEMORY_SCOPE_AGENT); }
__device__ __forceinline__ unsigned xb_add(unsigned* p, unsigned v) { return __hip_atomic_fetch_add(p, v, __ATOMIC_RELAXED, __HIP_MEMORY_SCOPE_AGENT); }
__device__ __forceinline__ unsigned xb_xcc_id() { return (unsigned)__builtin_amdgcn_s_getreg((3 << 11) | 20) & 0xFu; }
#define XB_SPIN(cond, bar) do { unsigned _sp = 0; while (cond) { __builtin_amdgcn_s_sleep(1); \
    if ((++_sp & 255u) == 0u) { if (xb_ld(&(bar)[XB_TMO])) break; if (_sp > XB_SPIN_CAP) { atomicAdd(&(bar)[XB_TMO], 1u); break; } } } } while (0)

struct XcdBarrier { unsigned* bar; unsigned x; volatile LAS unsigned* st; };

__device__ __forceinline__ XcdBarrier xcd_barrier_post(unsigned* bar, volatile LAS unsigned* st) {
    XcdBarrier b; b.bar = bar; b.x = xb_xcc_id(); b.st = st;
    if (threadIdx.x == 0) (void)xb_add(&bar[XB_XCNT(b.x)], 1u);
    return b;
}
__device__ __forceinline__ void xcd_barrier_complete(unsigned* bar, unsigned x, unsigned& nloc, unsigned& nx) {
    const unsigned G = gridDim.x * gridDim.y * gridDim.z;
    unsigned sum, cnt, mine, sp = 0u;
    for (;;) {
        sum = 0u; cnt = 0u; mine = 0u;
#pragma unroll
        for (unsigned j = 0; j < 16; ++j) { const unsigned c = xb_ld(&bar[XB_XCNT(j)]); sum += c; cnt += (c > 0u) ? 1u : 0u; mine = (j == x) ? c : mine; }
        if (sum == G) break;
        __builtin_amdgcn_s_sleep(1);
        if ((++sp & 255u) == 0u) { if (xb_ld(&bar[XB_TMO])) break; if (sp > XB_SPIN_CAP) { atomicAdd(&bar[XB_TMO], 1u); break; } }
    }
    nloc = mine > 0u ? mine : 1u; nx = cnt > 0u ? cnt : 1u;
}
__device__ __forceinline__ void xcd_barrier(const XcdBarrier& b) {
    asm volatile("s_waitcnt vmcnt(0)" ::: "memory");
    __syncthreads();
    if (threadIdx.x == 0) {
        unsigned* bar = b.bar;
        __builtin_amdgcn_s_waitcnt(0);
        unsigned nloc = b.st[0], nx = b.st[1];
        if (nloc == 0u) { xcd_barrier_complete(bar, b.x, nloc, nx); b.st[0] = nloc; b.st[1] = nx; }
        const unsigned old = xb_add(&bar[XB_XSUB(b.x)], 1u);
        const unsigned gen = old / nloc;
        if (old + 1u == (gen + 1u) * nloc) {
            __builtin_amdgcn_fence(__ATOMIC_RELEASE, "agent");
            asm volatile("s_waitcnt vmcnt(0)" ::: "memory");
            const unsigned og = xb_add(&bar[XB_TOP], 1u);
            const unsigned tg = og / nx;
            if (og + 1u == (tg + 1u) * nx) xb_add(&bar[XB_TOPGEN], 1u);
            else XB_SPIN(xb_ld(&bar[XB_TOPGEN]) == tg, bar);
            __builtin_amdgcn_fence(__ATOMIC_ACQUIRE, "agent");
            xb_add(&bar[XB_XGEN(b.x)], 1u);
            asm volatile("s_waitcnt vmcnt(0)" ::: "memory");
        } else {
            XB_SPIN(xb_ld(&bar[XB_XGEN(b.x)]) == gen, bar);
            __builtin_amdgcn_fence(__ATOMIC_ACQUIRE, "agent");
            asm volatile("s_waitcnt vmcnt(0)" ::: "memory");
        }
    }
    __syncthreads();
}

using pg8::Unit;
struct SchedDense {
    const char* A; const char* Bt; size_t astep, bstep; int nM, nN, nwg, G, c;
    __device__ __forceinline__ void init(const void* A_, const void* Bt_, int M, int N, int lda, int ldb, int G_, int c_, int esz = 2) { A = (const char*)A_; Bt = (const char*)Bt_; astep = (size_t)256 * lda * esz; bstep = (size_t)256 * ldb * esz; nM = M / 256; nN = N / 256; nwg = nM * nN; G = G_; c = c_; }
    __device__ __forceinline__ bool next(int i, Unit& u) const {
        const long L = (long)i * G + c; if (L >= nwg) return false;
        int wgid = (int)L; { const int q = nwg / pg8::NXCD, r = nwg % pg8::NXCD, xcd = wgid % pg8::NXCD, off = wgid / pg8::NXCD; wgid = (xcd < r ? xcd * (q + 1) : r * (q + 1) + (xcd - r) * q) + off; }
        const int nig = pg8::WGM * nN, gid = wgid / nig, fm = gid * pg8::WGM, gsz = (nM - fm) < pg8::WGM ? (nM - fm) : pg8::WGM;
        u.pm = fm + ((wgid % nig) % gsz); u.pn = (wgid % nig) / gsz; u.e = 0; u.rb = 0; u.nvalid = 256; return true;
    }
    __device__ __forceinline__ const char* a_ptr(const Unit& u) const { return A + (size_t)u.pm * astep; }
    __device__ __forceinline__ const char* b_ptr(const Unit& u) const { return Bt + (size_t)u.pn * bstep; }
    __device__ __forceinline__ unsigned a_rowoff(const Unit&, int) const { return 0u; }
    __device__ __forceinline__ int krot(const Unit&, int) const { return 0; }
};
struct SchedGrouped {
    const char* A; const char* Bt; size_t astep, agstride, bgstride; int nPM, nunits, G, c;
    __device__ __forceinline__ void init(const void* A_, const void* Bt_, int lda, size_t agstride_, size_t bgstride_, int nPM_, int ngroups, int G_, int c_) { A = (const char*)A_; Bt = (const char*)Bt_; astep = (size_t)256 * lda * 2; agstride = agstride_; bgstride = bgstride_; nPM = nPM_; nunits = nPM_ * ngroups; G = G_; c = c_; }
    __device__ __forceinline__ bool next(int i, Unit& u) const { const int L = i * G + c; if (L >= nunits) return false; u.e = L / nPM; u.pm = L % nPM; u.pn = 0; u.rb = 0; u.nvalid = 256; return true; }
    __device__ __forceinline__ const char* a_ptr(const Unit& u) const { return A + (size_t)u.e * agstride + (size_t)u.pm * astep; }
    __device__ __forceinline__ const char* b_ptr(const Unit& u) const { return Bt + (size_t)u.e * bgstride; }
    __device__ __forceinline__ unsigned a_rowoff(const Unit&, int) const { return 0u; }
    __device__ __forceinline__ int krot(const Unit&, int) const { return 0; }
};
struct SchedMoe {
    const char* A; const char* Bt; size_t astep, bstep_e, bstep_n; int nN, G, c; volatile LAS unsigned* M; const int* ltok; bool gather;
    __device__ __forceinline__ bool next(int i, Unit& u) const {
        const int L = i * G + c; const int total = (int)M[176]; if (L >= total) return false;
        const int ln = threadIdx.x & 63; const int us1 = (int)M[33 + (ln & 31)];
        const int e = __builtin_popcountll(__ballot(ln < 32 && L >= us1));
        const int w = L - (int)M[32 + e], pb = (int)M[80 + e], nb = (int)M[80 + e + 1] - pb, cnt = (int)M[128 + e];
        int rb = w % nb, pn = w / nb;
        rb = __builtin_amdgcn_readfirstlane(rb); pn = __builtin_amdgcn_readfirstlane(pn);
        u.e = e; u.rb = rb; u.pn = pn; u.pm = __builtin_amdgcn_readfirstlane(pb + rb); const int nv = cnt - rb * 256; u.nvalid = __builtin_amdgcn_readfirstlane(nv < 256 ? nv : 256); return true;
    }
    __device__ __forceinline__ const char* a_ptr(const Unit& u) const { return gather ? A : A + (size_t)u.pm * astep; }
    __device__ __forceinline__ const char* b_ptr(const Unit& u) const { return Bt + (size_t)u.e * bstep_e + (size_t)u.pn * bstep_n; }
    __device__ __forceinline__ unsigned a_rowoff(const Unit& u, int r) const { const int idx = (r < u.nvalid) ? (u.rb * 256 + r) : 0; const int tok = ltok[(size_t)u.e * LCAP + idx]; return (unsigned)tok * (unsigned)D; }
    __device__ __forceinline__ int krot(const Unit& u, int nt) const { return (2 * u.rb + u.pn) % nt; }
};

using pg8::f32x2; using pg8::u32x4;
#define EPI_ARGS const f32x4 (&acc)[2][2][4][2], const Unit& u, int wr, int wc, int fr, int fq
struct EpiZ { static constexpr bool PERM = true; bf16 *UP, *UG, *SGP, *SGS; float asc;
    __device__ __forceinline__ void operator()(EPI_ARGS) const {
        const int pn = u.pn, region = pn < 4 ? 0 : (pn < 8 ? 1 : (pn < 16 ? 2 : 3));
        if (GATE_FP8 && region >= 2) {
            unsigned char* gb = (unsigned char*)(region == 2 ? SGP : SGS); const int cbase = (region == 2 ? pn - 8 : pn - 16) * 256;
#pragma unroll
            for (int ai = 0; ai < 2; ++ai)
#pragma unroll
                for (int bj = 0; bj < 2; ++bj)
#pragma unroll
                    for (int mp = 0; mp < 2; ++mp) { unsigned px[2], py[2];
#pragma unroll
                        for (int h = 0; h < 2; ++h) { const int m = 2 * mp + h; f32x4 v0 = acc[ai][bj][m][0] * asc, v1 = acc[ai][bj][m][1] * asc;
#pragma unroll
                            for (int j = 0; j < 4; ++j) { v0[j] = 255.0f * sigmoidf_(v0[j]); v1[j] = 255.0f * sigmoidf_(v1[j]); }
                            px[h] = pk4_u8(v0[0], v0[1], v0[2], v0[3]); py[h] = pk4_u8(v1[0], v1[1], v1[2], v1[3]); }
                        const u32x4 q = pair16(px[0], py[0], px[1], py[1]);
                        const int row = u.pm * 256 + ai * 128 + wr * 64 + (2 * mp + (fq & 1)) * 16 + fr;
                        *(u32x4*)(gb + (size_t)row * D + cbase + bj * 128 + wc * 32 + 8 * (fq & ~1)) = q; }
            return;
        }
#pragma unroll
        for (int ai = 0; ai < 2; ++ai)
#pragma unroll
            for (int m = 0; m < 4; ++m) { const int row = u.pm * 256 + ai * 128 + wr * 64 + m * 16 + fr;
#pragma unroll
                for (int bj = 0; bj < 2; ++bj) { const int lc = bj * 128 + wc * 32 + 8 * fq; f32x4 v0 = acc[ai][bj][m][0] * asc, v1 = acc[ai][bj][m][1] * asc;
                    if (region >= 2) {
#pragma unroll
                        for (int j = 0; j < 4; ++j) { v0[j] = sigmoidf_(v0[j]); v1[j] = sigmoidf_(v1[j]); } }
                    u32x4 w; w.x = cvt_pk_bf16(v0[0], v0[1]); w.y = cvt_pk_bf16(v0[2], v0[3]); w.z = cvt_pk_bf16(v1[0], v1[1]); w.w = cvt_pk_bf16(v1[2], v1[3]);
                    bf16* dst;
                    if (region == 0) dst = UP + (size_t)row * PW + pn * 256 + lc;
                    else if (region == 1) { const int j = (pn - 4) * 256 + lc, g = j >> 4, h0 = j & 15, b = row >> 12, tp = row & 4095, c = tp >> 4, s = tp & 15; dst = UG + ((size_t)(g * 1024 + b * 256 + c) * UGK + s * 16 + h0); }
                    else if (region == 2) dst = SGP + (size_t)row * D + (pn - 8) * 256 + lc;
                    else dst = SGS + (size_t)row * D + (pn - 16) * 256 + lc;
                    *(u32x4*)dst = w; } }
    }
};
struct EpiS1 { static constexpr bool PERM = false; float* E;
    __device__ __forceinline__ void operator()(EPI_ARGS) const {
#pragma unroll
        for (int ai = 0; ai < 2; ++ai)
#pragma unroll
            for (int m = 0; m < 4; ++m) { const int row = u.pm * 256 + ai * 128 + wr * 64 + m * 16 + fr; float* rp = E + ((size_t)u.e * 1024 + row) * 128 + wc * 32 + 4 * fq;
#pragma unroll
                for (int n = 0; n < 2; ++n) *(f32x4*)(rp + n * 16) = acc[ai][0][m][n]; }
    }
};
struct EpiPmix { static constexpr bool PERM = true; bf16* PM; const float* scale;
    __device__ __forceinline__ void operator()(EPI_ARGS) const {
#pragma unroll
        for (int bj = 0; bj < 2; ++bj) { const int col = u.e * 256 + bj * 128 + wc * 32 + 8 * fq; const f32x4 s0 = *(const f32x4*)(scale + col), s1 = *(const f32x4*)(scale + col + 4);
#pragma unroll
            for (int ai = 0; ai < 2; ++ai)
#pragma unroll
                for (int m = 0; m < 4; ++m) { const int row = u.pm * 256 + ai * 128 + wr * 64 + m * 16 + fr; const f32x4 v0 = acc[ai][bj][m][0] * s0, v1 = acc[ai][bj][m][1] * s1;
                    if (PO_FP8) { v2u w; w.x = pk4_fp8(v0[0], v0[1], v0[2], v0[3]); w.y = pk4_fp8(v1[0], v1[1], v1[2], v1[3]); *(v2u*)((unsigned char*)PM + (size_t)row * PW + col) = w; }
                    else { u32x4 w; w.x = cvt_pk_bf16(v0[0], v0[1]); w.y = cvt_pk_bf16(v0[2], v0[3]); w.z = cvt_pk_bf16(v1[0], v1[1]); w.w = cvt_pk_bf16(v1[2], v1[3]);
                    *(u32x4*)(PM + (size_t)row * PW + col) = w; } } }
    }
};
struct EpiS3 { static constexpr bool PERM = true; bf16* YS;
    __device__ __forceinline__ void operator()(EPI_ARGS) const {
#pragma unroll
        for (int ai = 0; ai < 2; ++ai)
#pragma unroll
            for (int bj = 0; bj < 2; ++bj) { const int lc = bj * 128 + wc * 32 + 8 * fq, t = lc >> 4, h0 = lc & 15;
#pragma unroll
                for (int mp = 0; mp < 2; ++mp) { unsigned px[2], py[2];
#pragma unroll
                    for (int h = 0; h < 2; ++h) { const int m = 2 * mp + h; f32x4 v0 = acc[ai][bj][m][0], v1 = acc[ai][bj][m][1];
#pragma unroll
                        for (int j = 0; j < 4; ++j) { v0[j] = gelu_tanh_(v0[j]); v1[j] = gelu_tanh_(v1[j]); }
                        if (GLU_FP8) { px[h] = pk4_fp8(v0[0], v0[1], v0[2], v0[3]); py[h] = pk4_fp8(v1[0], v1[1], v1[2], v1[3]); }
                        else { const int r = u.pm * 256 + ai * 128 + wr * 64 + m * 16 + fr, b = r >> 8, c = r & 255; u32x4 w; w.x = cvt_pk_bf16(v0[0], v0[1]); w.y = cvt_pk_bf16(v0[2], v0[3]); w.z = cvt_pk_bf16(v1[0], v1[1]); w.w = cvt_pk_bf16(v1[2], v1[3]);
                            *(u32x4*)(YS + (size_t)(b * SEQ + c * CL + t) * SW + u.e * 16 + h0) = w; } }
                    if (GLU_FP8) { const u32x4 q = pair16(px[0], py[0], px[1], py[1]);
                        const int r = u.pm * 256 + ai * 128 + wr * 64 + (2 * mp + (fq & 1)) * 16 + fr, b = r >> 8, c = r & 255;
                        *(u32x4*)((unsigned char*)YS + (size_t)(b * SEQ + c * CL + t) * SW + u.e * 16) = q; } } }
    }
};
#define EPI_ALD16(dst_, ptr_) asm volatile("global_load_dwordx4 %0, %1, off" : "=v"(dst_) : "v"(ptr_))
struct EpiYpool { static constexpr bool PERM = true; bf16* YPG; const bf16* SGP; float asc;
    __device__ __forceinline__ void operator()(EPI_ARGS) const {
        u32x4 glq[2][2][2];
        if (GATE_FP8) {
#pragma unroll
            for (int ai = 0; ai < 2; ++ai)
#pragma unroll
                for (int bj = 0; bj < 2; ++bj)
#pragma unroll
                    for (int mp = 0; mp < 2; ++mp) { const int rowq = u.pm * 256 + ai * 128 + wr * 64 + (2 * mp + (fq & 1)) * 16 + fr;
                        const unsigned char* gp = (const unsigned char*)SGP + (size_t)rowq * D + u.pn * 256 + bj * 128 + wc * 32 + 8 * (fq & ~1); EPI_ALD16(glq[ai][bj][mp], gp); }
            asm volatile("s_waitcnt vmcnt(0)" : "+v"(glq[0][0][0]), "+v"(glq[0][0][1]), "+v"(glq[0][1][0]), "+v"(glq[0][1][1]), "+v"(glq[1][0][0]), "+v"(glq[1][0][1]), "+v"(glq[1][1][0]), "+v"(glq[1][1][1])); }
#pragma unroll
        for (int ai = 0; ai < 2; ++ai)
#pragma unroll
            for (int bj = 0; bj < 2; ++bj) { const int colb = u.pn * 256 + bj * 128 + wc * 32;
#pragma unroll
                for (int mp = 0; mp < 2; ++mp) { unsigned gq[2][2] = {{0u, 0u}, {0u, 0u}};
                    if (GATE_FP8) unpair16(glq[ai][bj][mp], gq[0][0], gq[0][1], gq[1][0], gq[1][1]);
#pragma unroll
                    for (int h = 0; h < 2; ++h) { const int m = 2 * mp + h; const int row = u.pm * 256 + ai * 128 + wr * 64 + m * 16 + fr; const size_t off = (size_t)row * D + colb + 8 * fq;
                        float gg[8];
                        if (GATE_FP8) { const unsigned gx = gq[h][0], gy = gq[h][1]; const float k255 = 1.0f / 255.0f;
                            gg[0] = (float)(gx & 0xffu) * k255; gg[1] = (float)((gx >> 8) & 0xffu) * k255; gg[2] = (float)((gx >> 16) & 0xffu) * k255; gg[3] = (float)(gx >> 24) * k255;
                            gg[4] = (float)(gy & 0xffu) * k255; gg[5] = (float)((gy >> 8) & 0xffu) * k255; gg[6] = (float)((gy >> 16) & 0xffu) * k255; gg[7] = (float)(gy >> 24) * k255; }
                        else { const u32x4 g = *(const u32x4*)(SGP + off); gg[0] = bf_lo(g.x); gg[1] = bf_hi(g.x); gg[2] = bf_lo(g.y); gg[3] = bf_hi(g.y); gg[4] = bf_lo(g.z); gg[5] = bf_hi(g.z); gg[6] = bf_lo(g.w); gg[7] = bf_hi(g.w); }
                        const f32x4 v0 = acc[ai][bj][m][0] * asc, v1 = acc[ai][bj][m][1] * asc;
                        u32x4 w; w.x = cvt_pk_bf16(v0[0] * gg[0], v0[1] * gg[1]); w.y = cvt_pk_bf16(v0[2] * gg[2], v0[3] * gg[3]);
                        w.z = cvt_pk_bf16(v1[0] * gg[4], v1[1] * gg[5]); w.w = cvt_pk_bf16(v1[2] * gg[6], v1[3] * gg[7]);
                        *(u32x4*)(YPG + off) = w; } } }
    }
};
struct EpiGlu { static constexpr bool PERM = true; bf16* MG; const bf16 *YPG, *SGS; const float* bglu; float asc;
    __device__ __forceinline__ void operator()(EPI_ARGS) const {
        const int j0 = u.pn * 128 + wc * 32 + 8 * fq, j0q = u.pn * 128 + wc * 32 + 8 * (fq & ~1);
        f32x4 ba0, ba1, bb0, bb1; u32x4 glq[2][2], ypq[2][2][2];
        EPI_ALD16(ba0, bglu + j0); EPI_ALD16(ba1, bglu + j0 + 4); EPI_ALD16(bb0, bglu + D + j0); EPI_ALD16(bb1, bglu + D + j0 + 4);
#pragma unroll
        for (int ai = 0; ai < 2; ++ai)
#pragma unroll
            for (int mp = 0; mp < 2; ++mp) {
                if (GATE_FP8) { const int rowq = u.pm * 256 + ai * 128 + wr * 64 + (2 * mp + (fq & 1)) * 16 + fr;
                    const unsigned char* gp = (const unsigned char*)SGS + (size_t)rowq * D + j0q; EPI_ALD16(glq[ai][mp], gp); }
#pragma unroll
                for (int h = 0; h < 2; ++h) { const int row = u.pm * 256 + ai * 128 + wr * 64 + (2 * mp + h) * 16 + fr; const bf16* yq = YPG + (size_t)row * D + j0; EPI_ALD16(ypq[ai][mp][h], yq); } }
        asm volatile("s_waitcnt vmcnt(0)" : "+v"(ba0), "+v"(ba1), "+v"(bb0), "+v"(bb1), "+v"(ypq[0][0][0]), "+v"(ypq[0][0][1]), "+v"(ypq[0][1][0]), "+v"(ypq[0][1][1]), "+v"(ypq[1][0][0]), "+v"(ypq[1][0][1]), "+v"(ypq[1][1][0]), "+v"(ypq[1][1][1]));
        if (GATE_FP8) asm volatile("" : "+v"(glq[0][0]), "+v"(glq[0][1]), "+v"(glq[1][0]), "+v"(glq[1][1]));
#pragma unroll
        for (int ai = 0; ai < 2; ++ai)
#pragma unroll
            for (int mp = 0; mp < 2; ++mp) { unsigned px[2], py[2]; unsigned gq[2][2] = {{0u, 0u}, {0u, 0u}};
                if (GATE_FP8) unpair16(glq[ai][mp], gq[0][0], gq[0][1], gq[1][0], gq[1][1]);
#pragma unroll
                for (int h = 0; h < 2; ++h) { const int m = 2 * mp + h; const int row = u.pm * 256 + ai * 128 + wr * 64 + m * 16 + fr; const size_t off = (size_t)row * D + j0;
                    const u32x4 yp = ypq[ai][mp][h]; float gsf[8];
                    if (GATE_FP8) { v2u g8; g8.x = gq[h][0]; g8.y = gq[h][1]; const float k255 = 1.0f / 255.0f;
                        gsf[0] = (float)(g8.x & 0xffu) * k255; gsf[1] = (float)((g8.x >> 8) & 0xffu) * k255; gsf[2] = (float)((g8.x >> 16) & 0xffu) * k255; gsf[3] = (float)(g8.x >> 24) * k255;
                        gsf[4] = (float)(g8.y & 0xffu) * k255; gsf[5] = (float)((g8.y >> 8) & 0xffu) * k255; gsf[6] = (float)((g8.y >> 16) & 0xffu) * k255; gsf[7] = (float)(g8.y >> 24) * k255; }
                    else { const u32x4 gs = *(const u32x4*)(SGS + off); gsf[0] = bf_lo(gs.x); gsf[1] = bf_hi(gs.x); gsf[2] = bf_lo(gs.y); gsf[3] = bf_hi(gs.y); gsf[4] = bf_lo(gs.z); gsf[5] = bf_hi(gs.z); gsf[6] = bf_lo(gs.w); gsf[7] = bf_hi(gs.w); }
                    const f32x4 a0 = acc[ai][0][m][0] * asc + ba0, a1 = acc[ai][0][m][1] * asc + ba1, b0 = acc[ai][1][m][0] * asc + bb0, b1 = acc[ai][1][m][1] * asc + bb1;
                    float o[8];
#pragma unroll
                    for (int j = 0; j < 4; ++j) { o[j] = a0[j] * sigmoidf_(b0[j]); o[4 + j] = a1[j] * sigmoidf_(b1[j]); }
                    float mo[8] = {bf_lo(yp.x) + gsf[0] * o[0], bf_hi(yp.x) + gsf[1] * o[1], bf_lo(yp.y) + gsf[2] * o[2], bf_hi(yp.y) + gsf[3] * o[3],
                                   bf_lo(yp.z) + gsf[4] * o[4], bf_hi(yp.z) + gsf[5] * o[5], bf_lo(yp.w) + gsf[6] * o[6], bf_hi(yp.w) + gsf[7] * o[7]};
                    if (OUT_FP8) { px[h] = pk4_fp8(mo[0], mo[1], mo[2], mo[3]); py[h] = pk4_fp8(mo[4], mo[5], mo[6], mo[7]); }
                    else { u32x4 w; w.x = cvt_pk_bf16(mo[0], mo[1]); w.y = cvt_pk_bf16(mo[2], mo[3]); w.z = cvt_pk_bf16(mo[4], mo[5]); w.w = cvt_pk_bf16(mo[6], mo[7]); *(u32x4*)(MG + off) = w; } }
                if (OUT_FP8) { const u32x4 q = pair16(px[0], py[0], px[1], py[1]);
                    const int row = u.pm * 256 + ai * 128 + wr * 64 + (2 * mp + (fq & 1)) * 16 + fr; *(u32x4*)((unsigned char*)MG + (size_t)row * D + j0q) = q; } }
    }
};
struct EpiMix { static constexpr bool PERM = true; bf16* MX; float asc; const float* gtm;
    __device__ __forceinline__ void operator()(EPI_ARGS) const {
        const float* gb = gtm + (size_t)(u.pm >> 4) * 6 * D;
#pragma unroll
        for (int bj = 0; bj < 2; ++bj) { const int col = u.pn * 256 + bj * 128 + wc * 32 + 8 * fq; const f32x4 g0 = *(const f32x4*)(gb + col) * asc, g1 = *(const f32x4*)(gb + col + 4) * asc;
#pragma unroll
            for (int ai = 0; ai < 2; ++ai)
#pragma unroll
                for (int m = 0; m < 4; ++m) { const int row = u.pm * 256 + ai * 128 + wr * 64 + m * 16 + fr; const f32x4 v0 = acc[ai][bj][m][0] * g0, v1 = acc[ai][bj][m][1] * g1;
                    u32x4 w; w.x = cvt_pk_bf16(v0[0], v0[1]); w.y = cvt_pk_bf16(v0[2], v0[3]); w.z = cvt_pk_bf16(v1[0], v1[1]); w.w = cvt_pk_bf16(v1[2], v1[3]);
                    *(u32x4*)(MX + (size_t)row * D + col) = w; } }
    }
};
struct EpiMoe1 { static constexpr bool PERM = true; unsigned char* ACT; const float* b1;
    __device__ __forceinline__ void operator()(EPI_ARGS) const {
        const int j0 = u.pn * 128 + wc * 32 + 8 * fq; const float* bb = b1 + (size_t)u.e * 2 * FE;
        const f32x4 ba0 = *(const f32x4*)(bb + j0), ba1 = *(const f32x4*)(bb + j0 + 4), bl0 = *(const f32x4*)(bb + FE + j0), bl1 = *(const f32x4*)(bb + FE + j0 + 4);
        const int j0q = u.pn * 128 + wc * 32 + 8 * (fq & ~1);
#pragma unroll
        for (int ai = 0; ai < 2; ++ai)
#pragma unroll
            for (int mp = 0; mp < 2; ++mp) { unsigned px[2], py[2];
#pragma unroll
                for (int h = 0; h < 2; ++h) { const int m = 2 * mp + h;
                    const f32x4 a0 = acc[ai][0][m][0] * 0.03125f + ba0, a1 = acc[ai][0][m][1] * 0.03125f + ba1, l0 = acc[ai][1][m][0] * 0.03125f + bl0, l1 = acc[ai][1][m][1] * 0.03125f + bl1;
                    float o[8];
#pragma unroll
                    for (int j = 0; j < 4; ++j) { const float g0 = fminf(a0[j], 7.0f), g1 = fminf(a1[j], 7.0f), x0 = fminf(fmaxf(l0[j], -7.0f), 7.0f), x1 = fminf(fmaxf(l1[j], -7.0f), 7.0f);
                        o[j] = g0 * sigmoidf_(1.702f * g0) * (x0 + 1.0f); o[4 + j] = g1 * sigmoidf_(1.702f * g1) * (x1 + 1.0f); }
                    px[h] = pk4_fp8(o[0], o[1], o[2], o[3]); py[h] = pk4_fp8(o[4], o[5], o[6], o[7]); }
                const u32x4 q = pair16(px[0], py[0], px[1], py[1]);
                const int row = u.pm * 256 + ai * 128 + wr * 64 + (2 * mp + (fq & 1)) * 16 + fr;
                *(u32x4*)(ACT + (size_t)row * FE + j0q) = q; }
    }
};
struct EpiMoe2 { static constexpr bool PERM = true; unsigned char* YE; const float* b2; const float* lwt;
    __device__ __forceinline__ void operator()(EPI_ARGS) const {
        const float* bb = b2 + (size_t)u.e * D; const float* lw = lwt + (size_t)u.e * LCAP + u.rb * 256;
        float wg[2][4]; f32x4 cb[2][2];
#pragma unroll
        for (int ai = 0; ai < 2; ++ai)
#pragma unroll
            for (int m = 0; m < 4; ++m) { const float* p_ = lw + (ai * 128 + wr * 64 + m * 16 + fr); asm volatile("global_load_dword %0, %1, off" : "=v"(wg[ai][m]) : "v"(p_)); }
#pragma unroll
        for (int bj = 0; bj < 2; ++bj) { const float* p_ = bb + u.pn * 256 + bj * 128 + wc * 32 + 8 * fq; EPI_ALD16(cb[bj][0], p_); EPI_ALD16(cb[bj][1], p_ + 4); }
        asm volatile("s_waitcnt vmcnt(0)" : "+v"(wg[0][0]), "+v"(wg[0][1]), "+v"(wg[0][2]), "+v"(wg[0][3]), "+v"(wg[1][0]), "+v"(wg[1][1]), "+v"(wg[1][2]), "+v"(wg[1][3]), "+v"(cb[0][0]), "+v"(cb[0][1]), "+v"(cb[1][0]), "+v"(cb[1][1]));
#pragma unroll
        for (int ai = 0; ai < 2; ++ai)
#pragma unroll
            for (int m = 0; m < 4; ++m) { const int r = ai * 128 + wr * 64 + m * 16 + fr; wg[ai][m] = (r < u.nvalid) ? 16.0f * wg[ai][m] : 0.0f; }
#pragma unroll
        for (int bj = 0; bj < 2; ++bj) { const f32x4 c0 = cb[bj][0], c1 = cb[bj][1];
            const int colq = u.pn * 256 + bj * 128 + wc * 32 + 8 * (fq & ~1);
#pragma unroll
            for (int ai = 0; ai < 2; ++ai)
#pragma unroll
                for (int mp = 0; mp < 2; ++mp) { unsigned px[2], py[2];
#pragma unroll
                    for (int h = 0; h < 2; ++h) { const int m = 2 * mp + h; const f32x4 v0 = (acc[ai][bj][m][0] * 0.03125f + c0) * wg[ai][m], v1 = (acc[ai][bj][m][1] * 0.03125f + c1) * wg[ai][m];
                        px[h] = pk4_fp8(v0[0], v0[1], v0[2], v0[3]); py[h] = pk4_fp8(v1[0], v1[1], v1[2], v1[3]); }
                    const u32x4 q = pair16(px[0], py[0], px[1], py[1]);
                    const int r = ai * 128 + wr * 64 + (2 * mp + (fq & 1)) * 16 + fr;
                    *(u32x4*)(YE + ((size_t)u.pm * 256 + r) * D + colq) = q; } }
    }
};

__device__ __forceinline__ float wave_sum(float v) {
#pragma unroll
    for (int o = 1; o < 64; o <<= 1) v += __shfl_xor(v, o);
    return v;
}
__device__ __forceinline__ void tr_item(const float* __restrict__ W, int K, int N, bf16* WT, int item, int lane, int mode) {
    const int nblk = N >> 6, kb = item / nblk, nb = item - kb * nblk, k0 = kb * 64, n = nb * 64 + lane;
    int drow = n;
    if (mode) { const int half = N >> 1, hi = n >= half ? 1 : 0, nn = n - hi * half; drow = (nn >> 7) * 256 + hi * 128 + (nn & 127); }
    const float* src = W + (size_t)k0 * N + n;
    float v[64];
#pragma unroll
    for (int i = 0; i < 64; ++i) v[i] = src[(size_t)i * N];
    bf16* dst = WT + (size_t)drow * K + k0;
#pragma unroll
    for (int j = 0; j < 8; ++j) { v4u o; o.x = cvt_pk_bf16(v[8 * j], v[8 * j + 1]); o.y = cvt_pk_bf16(v[8 * j + 2], v[8 * j + 3]); o.z = cvt_pk_bf16(v[8 * j + 4], v[8 * j + 5]); o.w = cvt_pk_bf16(v[8 * j + 6], v[8 * j + 7]);
        *(v4u*)(dst + 8 * j) = o; }
}

template <int W> __device__ __forceinline__ void pool_item(const bf16* ub, unsigned voff, bf16* pl, int t0) {
    constexpr int NR = 15 + W;
    v4u R[NR];
#pragma unroll
    for (int i = 0; i < NR; ++i) { const bf16* p_ = ub + (size_t)i * PW; asm volatile("global_load_dwordx4 %0, %1, %2" : "=v"(R[i]) : "v"(voff), "s"(p_)); }
#pragma unroll
    for (int i0 = 0; i0 < NR; i0 += 8) {
        if (i0 == 0) asm volatile("s_waitcnt vmcnt(0)" : "+v"(R[0]), "+v"(R[1]), "+v"(R[2]), "+v"(R[3]), "+v"(R[4]), "+v"(R[5]), "+v"(R[6]), "+v"(R[7]));
        else if (i0 + 8 <= NR) asm volatile("" : "+v"(R[i0]), "+v"(R[i0 + 1]), "+v"(R[i0 + 2]), "+v"(R[i0 + 3]), "+v"(R[i0 + 4]), "+v"(R[i0 + 5]), "+v"(R[i0 + 6]), "+v"(R[i0 + 7]));
        else {
#pragma unroll
            for (int i = i0; i < NR; ++i) asm volatile("" : "+v"(R[i])); } }
#pragma unroll
    for (int i = 0; i < W - 1; ++i) { if (t0 - (W - 1) + i < 0) R[i] = (v4u){0u, 0u, 0u, 0u}; }
    float Sx[8] = {0.f, 0.f, 0.f, 0.f, 0.f, 0.f, 0.f, 0.f};
#pragma unroll
    for (int i = 0; i < W - 1; ++i) { Sx[0] += bf_lo(R[i].x); Sx[1] += bf_hi(R[i].x); Sx[2] += bf_lo(R[i].y); Sx[3] += bf_hi(R[i].y); Sx[4] += bf_lo(R[i].z); Sx[5] += bf_hi(R[i].z); Sx[6] += bf_lo(R[i].w); Sx[7] += bf_hi(R[i].w); }
#pragma unroll
    for (int tt = 0; tt < 16; ++tt) { const int tp = t0 + tt; const v4u q = R[tt + W - 1];
        const float uu[8] = {bf_lo(q.x), bf_hi(q.x), bf_lo(q.y), bf_hi(q.y), bf_lo(q.z), bf_hi(q.z), bf_lo(q.w), bf_hi(q.w)};
        const float rc = 1.0f / (float)((tp + 1) < W ? (tp + 1) : W); float o[8];
#pragma unroll
        for (int j = 0; j < 8; ++j) { Sx[j] += uu[j]; o[j] = Sx[j] * rc - uu[j]; }
        v4u ov; ov.x = cvt_pk_bf16(o[0], o[1]); ov.y = cvt_pk_bf16(o[2], o[3]); ov.z = cvt_pk_bf16(o[4], o[5]); ov.w = cvt_pk_bf16(o[6], o[7]);
        *(v4u*)(pl + (size_t)tp * PW) = ov;
        v4u q2 = R[tt];
        asm volatile("" : "+v"(q2.x), "+v"(q2.y), "+v"(q2.z), "+v"(q2.w));
        Sx[0] -= bf_lo(q2.x); Sx[1] -= bf_hi(q2.x); Sx[2] -= bf_lo(q2.y); Sx[3] -= bf_hi(q2.y); Sx[4] -= bf_lo(q2.z); Sx[5] -= bf_hi(q2.z); Sx[6] -= bf_lo(q2.w); Sx[7] -= bf_hi(q2.w); }
}

struct Args { const void* in[30]; float* out; unsigned char* ws; int ph_lo, ph_hi, li, pad; };

__global__ void __launch_bounds__(NWAVES * 64, 2) fwd_kernel(Args args) {
    extern __shared__ __attribute__((aligned(16))) unsigned char lds_raw[];
    LAS unsigned char* lds = (LAS unsigned char*)lds_raw;
    volatile LAS unsigned* MISC = (volatile LAS unsigned*)(lds + MISC_OFF);
    const int tid = threadIdx.x, lane = tid & 63, wave = __builtin_amdgcn_readfirstlane(tid >> 6);
    const int G = gridDim.x; const int bx = blockIdx.x; const int vcu = (G % 8 == 0) ? (bx % 8) * (G / 8) + bx / 8 : bx;
    gu32* ctl = (gu32*)(args.ws + WS_CTL);
#define KARG_PTR(off_) (*(void* const __attribute__((address_space(4)))*)(kp_ + (off_)))
#define PH_PTRS() const __attribute__((address_space(4))) char* kp_ = (const __attribute__((address_space(4))) char*)__builtin_amdgcn_kernarg_segment_ptr(); asm volatile("" : "+s"(kp_)); \
    unsigned char* ws = (unsigned char*)KARG_PTR(248); const float* x = (const float*)KARG_PTR(0); const float* cin = (const float*)KARG_PTR(8); const float* ada_w = (const float*)KARG_PTR(16); const float* ada_b = (const float*)KARG_PTR(24); const float* norm1_g = (const float*)KARG_PTR(32); const float* w_in = (const float*)KARG_PTR(40); const float* pool_w = (const float*)KARG_PTR(48); const float* pool_scale = (const float*)KARG_PTR(56); const float* w_pool_out = (const float*)KARG_PTR(64); const float* lam_re = (const float*)KARG_PTR(72); const float* lam_im = (const float*)KARG_PTR(80); const float* log_dt = (const float*)KARG_PTR(88); const float* sb_re = (const float*)KARG_PTR(96); const float* sb_im = (const float*)KARG_PTR(104); const float* sc_re = (const float*)KARG_PTR(112); const float* sc_im = (const float*)KARG_PTR(120); const float* ssm_d = (const float*)KARG_PTR(128); const float* w_glu = (const float*)KARG_PTR(136); const float* b_glu = (const float*)KARG_PTR(144); const float* w_out = (const float*)KARG_PTR(152); const float* norm2_g = (const float*)KARG_PTR(160); const float* w_router = (const float*)KARG_PTR(168); const float* b_router = (const float*)KARG_PTR(176); const float* w1 = (const float*)KARG_PTR(184); const float* b1 = (const float*)KARG_PTR(192); const float* w2 = (const float*)KARG_PTR(200); const float* b2 = (const float*)KARG_PTR(208); const float* fada_w = (const float*)KARG_PTR(216); const float* fada_b = (const float*)KARG_PTR(224); const float* fnorm_g = (const float*)KARG_PTR(232); float* out = (float*)KARG_PTR(240); float* MOD = (float*)(ws + WS_MOD); float* FMOD = (float*)(ws + WS_FMOD); float* AL = (float*)(ws + WS_AL); bf16* WinT = (bf16*)(ws + WS_WIN); bf16* PoolWT = (bf16*)(ws + WS_POOLW); bf16* WpoT = (bf16*)(ws + WS_WPO); bf16* WgluT = (bf16*)(ws + WS_WGLU); bf16* WoutT = (bf16*)(ws + WS_WOUT); bf16* WendT = (bf16*)(ws + WS_WEND); bf16* TG = (bf16*)(ws + WS_TG); unsigned char* W1T8 = ws + WS_W1; unsigned char* W2T8 = ws + WS_W2; bf16* XN = (bf16*)(ws + WS_XN); bf16* UP = (bf16*)(ws + WS_UP); bf16* UG = (bf16*)(ws + WS_UG); bf16* SGP = (bf16*)(ws + WS_SGP); bf16* SGS = (bf16*)(ws + WS_SGS); bf16* PL = (bf16*)(ws + WS_PL); bf16* PM = (bf16*)(ws + WS_PM); float* EB = (float*)(ws + WS_E); bf16* YPG = (bf16*)(ws + WS_YPG); bf16* YS = (bf16*)(ws + WS_YS); bf16* MG = (bf16*)(ws + WS_MG); bf16* MX = (bf16*)(ws + WS_X1); int* LTOK = (int*)(ws + WS_LTOK); float* LWT = (float*)(ws + WS_LWT); int* TSLOT = (int*)(ws + WS_TSLOT); unsigned char* ACT8 = ws + WS_ACT; unsigned char* YE = ws + WS_YE; unsigned char* XN8 = ws + WS_XN;
    for (int u = tid; u < (LDS_BYTES - LDSCTL_OFF) / 4; u += NWAVES * 64) ((LAS unsigned*)(lds + LDSCTL_OFF))[u] = 0u;
    __syncthreads();
    XcdBarrier bar; bar.bar = (unsigned*)(ctl + CW_BAR); bar.x = 0; bar.st = nullptr;
    if (N_LAUNCHES == 1) bar = xcd_barrier_post((unsigned*)(ctl + CW_BAR), MISC + 8);
#define GRID_BAR() do { if (N_LAUNCHES == 1) xcd_barrier(bar); } while (0)
    const int lo = args.ph_lo, hi = args.ph_hi;
#ifndef PHSEL
#define PHSEL -1
#endif
#define IN(k) (PHSEL < 0 ? (lo <= (k) && (k) < hi) : ((k) == PHSEL))
#define BOTH(k) (IN(k) && IN((k) + 1))
#ifndef DUPSEL
#define DUPSEL -1
#endif
#define REP(k) ((DUPSEL == (k)) ? 2 : 1)
    const int gw = vcu * NWAVES + wave, NGW = G * NWAVES;
#ifndef PROBE_PH
#define PROBE_PH -1
#endif
#ifndef PROBE_MODE
#define PROBE_MODE 0
#endif
#ifndef PROBE_N
#define PROBE_N 4
#endif
    unsigned long long pr_t0 = 0ull, pr_dt = 0ull;
#define PROBE_BEGIN(k) do { if (PROBE_PH == (k)) { __syncthreads(); pr_t0 = __builtin_amdgcn_s_memrealtime(); } } while (0)
#define PROBE_MID(k) do { if (PROBE_PH == (k) && PROBE_MODE == 0) { __syncthreads(); pr_dt = __builtin_amdgcn_s_memrealtime() - pr_t0; } } while (0)
#define PROBE_END(k) do { if (PROBE_PH == (k) && PROBE_MODE == 1) { pr_dt = __builtin_amdgcn_s_memrealtime() - pr_t0; } } while (0)

    if (IN(0)) for (int rep_ = 0; rep_ < REP(0); ++rep_) {
        PH_PTRS(); PROBE_BEGIN(0);
        LAS float* CA = (LAS float*)(lds + RING_OFF);
        LAS float* RED = (LAS float*)(lds + RING_OFF + 32768);
        { f32x4 cv[4];
#pragma unroll
          for (int j = 0; j < 4; ++j) cv[j] = *(const f32x4*)(cin + 4 * (tid + 512 * j));
#pragma unroll
          for (int j = 0; j < 4; ++j) { f32x4 o; o[0] = cv[j][0] * sigmoidf_(cv[j][0]); o[1] = cv[j][1] * sigmoidf_(cv[j][1]); o[2] = cv[j][2] * sigmoidf_(cv[j][2]); o[3] = cv[j][3] * sigmoidf_(cv[j][3]); *(LAS f32x4*)(CA + 4 * (tid + 512 * j)) = o; } }
        __syncthreads();
        for (int cb = vcu; cb < (6 * D + 2 * D) / 64; cb += G) {
            const int col0 = cb * 64; const float* W; int N, cc; const float* bias; float* dst; int dld;
            if (col0 < 6 * D) { W = ada_w; N = 6 * D; cc = col0; bias = ada_b; dst = MOD; dld = 6 * D; } else { W = fada_w; N = 2 * D; cc = col0 - 6 * D; bias = fada_b; dst = FMOD; dld = 2 * D; }
            const int c4 = lane & 15, kr = lane >> 4;
            f32x4 a0 = {0.f, 0.f, 0.f, 0.f}, a1 = a0, a2 = a0, a3 = a0;
            const float* rowp = W + (size_t)(256 * wave) * N + cc; const unsigned voff = (unsigned)(kr * N + 4 * c4) * 4u;
            f32x4 va[16], vb[16];
#define GV_LOAD(buf_, base_) do { _Pragma("unroll") for (int i_ = 0; i_ < 16; ++i_) { const float* p_ = rowp + (size_t)((base_) + i_) * 4 * N; asm volatile("global_load_dwordx4 %0, %1, %2 nt" : "=v"(buf_[i_]) : "v"(voff), "s"(p_)); } } while (0)
#define GV_WAIT(buf_, n_) do { asm volatile("s_waitcnt vmcnt(" #n_ ")" : "+v"(buf_[0]), "+v"(buf_[1]), "+v"(buf_[2]), "+v"(buf_[3]), "+v"(buf_[4]), "+v"(buf_[5]), "+v"(buf_[6]), "+v"(buf_[7])); \
                asm volatile("" : "+v"(buf_[8]), "+v"(buf_[9]), "+v"(buf_[10]), "+v"(buf_[11]), "+v"(buf_[12]), "+v"(buf_[13]), "+v"(buf_[14]), "+v"(buf_[15])); } while (0)
#define GV_FMA(buf_, base_) do { _Pragma("unroll") for (int i_ = 0; i_ < 16; ++i_) { const int k = 256 * wave + ((base_) + i_) * 4 + kr; const f32x4 v = buf_[i_]; \
                a0 += v * CA[k]; a1 += v * CA[D + k]; a2 += v * CA[2 * D + k]; a3 += v * CA[3 * D + k]; } } while (0)
#define GV_PIN() asm volatile("" : "+v"(a0), "+v"(a1), "+v"(a2), "+v"(a3))
            GV_LOAD(va, 0); GV_LOAD(vb, 16); GV_WAIT(va, 16); GV_FMA(va, 0); GV_PIN(); GV_LOAD(va, 32); GV_WAIT(vb, 16); GV_FMA(vb, 16); GV_PIN(); GV_LOAD(vb, 48); GV_WAIT(va, 16); GV_FMA(va, 32); GV_PIN(); GV_WAIT(vb, 0); GV_FMA(vb, 48);
#pragma unroll
            for (int j = 0; j < 4; ++j) { a0[j] += __shfl_xor(a0[j], 16); a0[j] += __shfl_xor(a0[j], 32); a1[j] += __shfl_xor(a1[j], 16); a1[j] += __shfl_xor(a1[j], 32);
                a2[j] += __shfl_xor(a2[j], 16); a2[j] += __shfl_xor(a2[j], 32); a3[j] += __shfl_xor(a3[j], 16); a3[j] += __shfl_xor(a3[j], 32); }
            if (kr == 0) {
#pragma unroll
                for (int j = 0; j < 4; ++j) { RED[(wave * 4 + 0) * 64 + 4 * c4 + j] = a0[j]; RED[(wave * 4 + 1) * 64 + 4 * c4 + j] = a1[j]; RED[(wave * 4 + 2) * 64 + 4 * c4 + j] = a2[j]; RED[(wave * 4 + 3) * 64 + 4 * c4 + j] = a3[j]; } }
            __syncthreads();
            if (tid < 256) { const int b = tid >> 6, c = tid & 63; float s = bias[cc + c];
#pragma unroll
                for (int w = 0; w < 8; ++w) s += RED[(w * 4 + b) * 64 + c];
                dst[(size_t)b * dld + cc + c] = s; }
            __syncthreads();
        }
        PROBE_MID(0); if (BOTH(0)) GRID_BAR(); PROBE_END(0);
    }

    if (IN(1)) for (int rep_ = 0; rep_ < REP(1); ++rep_) {
        PH_PTRS(); PROBE_BEGIN(1);
        {
            LAS float* AP = (LAS float*)(lds + RING_OFF);
            LAS float* BBm = (LAS float*)(lds + RING_OFF + 16384);
            LAS float* CCm = (LAS float*)(lds + RING_OFF + 32768);
            LAS float* MT = (LAS float*)(lds + RING_OFF + 49152);
            LAS float* FF = (LAS float*)(lds + RING_OFF + 53248);
            for (int it = vcu; it < SG * 4; it += G) {
                const int g = it >> 2, part = it & 3;
                if (tid < 64) { const int p = tid; const float dt = expf(log_dt[g]); const float lre = fminf(lam_re[g * SP + p], -1e-4f), lim = lam_im[g * SP + p];
                    const float mag = expf(lre * dt), ang = lim * dt; float sn, cs; sincosf(ang, &sn, &cs); const float abr = mag * cs, abi = mag * sn;
                    float pr = 1.0f, pi = 0.0f;
                    for (int k = 0; k <= 16; ++k) { AP[(k * 64 + p) * 2] = pr; AP[(k * 64 + p) * 2 + 1] = pi; const float nr2 = pr * abr - pi * abi, ni2 = pr * abi + pi * abr; pr = nr2; pi = ni2; }
                    const float den = lre * lre + lim * lim, nr = abr - 1.0f, ni = abi; FF[2 * p] = (nr * lre + ni * lim) / den; FF[2 * p + 1] = (ni * lre - nr * lim) / den;
                }
                __syncthreads();
                for (int idx = tid; idx < SP * SH; idx += NWAVES * 64) { const int p = idx >> 4, h = idx & 15; const float fr_ = FF[2 * p], fi_ = FF[2 * p + 1];
                    const float br = sb_re[((size_t)g * SP + p) * SH + h], bi = sb_im[((size_t)g * SP + p) * SH + h]; BBm[(p * 16 + h) * 2] = fr_ * br - fi_ * bi; BBm[(p * 16 + h) * 2 + 1] = fr_ * bi + fi_ * br;
                    const int h2 = idx >> 6, p2 = idx & 63; CCm[(h2 * 64 + p2) * 2] = sc_re[((size_t)g * SH + h2) * SP + p2]; CCm[(h2 * 64 + p2) * 2 + 1] = sc_im[((size_t)g * SH + h2) * SP + p2]; }
                if (part == 0 && tid < 64) { AL[(g * SP + tid) * 2] = AP[(16 * 64 + tid) * 2]; AL[(g * SP + tid) * 2 + 1] = AP[(16 * 64 + tid) * 2 + 1]; }
                __syncthreads();
                for (int idx = tid; idx < 1024; idx += NWAVES * 64) { const int k = idx >> 6, hq = (idx >> 4) & 3, h = idx & 15, hp = 4 * part + hq; float s = 0.f;
                    for (int p = 0; p < SP; ++p) { const float ar = AP[(k * 64 + p) * 2], ai = AP[(k * 64 + p) * 2 + 1], cr = CCm[(hp * 64 + p) * 2], ci = CCm[(hp * 64 + p) * 2 + 1];
                        const float car = cr * ar - ci * ai, cai = cr * ai + ci * ar; s += car * BBm[(p * 16 + h) * 2] - cai * BBm[(p * 16 + h) * 2 + 1]; }
                    if (k == 0 && h == hp) s += ssm_d[g * SH + hp];
                    MT[idx] = s; }
                __syncthreads();
                for (int vi = tid; vi < 64 * (UGK / 8); vi += NWAVES * 64) { const int nl = vi / (UGK / 8), kv = vi - nl * (UGK / 8), t = nl >> 2, hq = nl & 3, hp = 4 * part + hq, n = t * 16 + hp, k0 = kv * 8; float val[8];
#pragma unroll
                    for (int j = 0; j < 8; ++j) { const int k = k0 + j;
                        if (k < 256) { const int s2 = k >> 4, h = k & 15; val[j] = (s2 <= t) ? MT[((t - s2) << 6) + (hq << 4) + h] : 0.f; }
                        else { const int comp = k - 256, p = comp & 63; const float ar = AP[((t + 1) * 64 + p) * 2], ai = AP[((t + 1) * 64 + p) * 2 + 1], cr = CCm[(hp * 64 + p) * 2], ci = CCm[(hp * 64 + p) * 2 + 1];
                            val[j] = comp < 64 ? (cr * ar - ci * ai) : -(cr * ai + ci * ar); } }
                    v4u o; o.x = cvt_pk_bf16(val[0], val[1]); o.y = cvt_pk_bf16(val[2], val[3]); o.z = cvt_pk_bf16(val[4], val[5]); o.w = cvt_pk_bf16(val[6], val[7]);
                    *(v4u*)(TG + ((size_t)g * 256 + n) * UGK + k0) = o; }
                for (int vi = tid; vi < 64 * 32; vi += NWAVES * 64) { const int nl = vi >> 5, kv = vi & 31, n = part * 64 + nl, k0 = kv * 8; float val[8];
#pragma unroll
                    for (int j = 0; j < 8; ++j) { const int k = k0 + j, s2 = k >> 4, h = k & 15;
                        if (n < 128) { const int p = n & 63; const float ar = AP[((15 - s2) * 64 + p) * 2], ai = AP[((15 - s2) * 64 + p) * 2 + 1], br = BBm[(p * 16 + h) * 2], bi = BBm[(p * 16 + h) * 2 + 1];
                            val[j] = n < 64 ? (ar * br - ai * bi) : (ar * bi + ai * br); } else val[j] = 0.f; }
                    v4u o; o.x = cvt_pk_bf16(val[0], val[1]); o.y = cvt_pk_bf16(val[2], val[3]); o.z = cvt_pk_bf16(val[4], val[5]); o.w = cvt_pk_bf16(val[6], val[7]);
                    *(v4u*)(WendT + ((size_t)g * 256 + n) * 256 + k0) = o; }
                __syncthreads();
            }
        }
        {
            const int RPW = (T + NGW - 1) / NGW; int cb = -1; f32x4 Av[8], Bv[8];
            const unsigned nvo = 16u * lane;
#define N1_ROWS(i_, row_, row2_) const int row_ = gw * RPW + (i_); const int row2_ = ((i_) + 1 < RPW && row_ + 1 < T && ((row_ + 1) >> 12) == (row_ >> 12)) ? row_ + 1 : row_
#define N1_LD1(dst_, base_, off_) asm volatile("global_load_dwordx4 %0, %1, %2 offset:" #off_ : "=v"(dst_) : "v"(nvo), "s"(base_))
#define N1_LOAD(V_, W_, row_, row2_) do { const float* pa_ = x + (size_t)(row_) * D; const float* pb_ = pa_ + 1024; const float* qa_ = x + (size_t)(row2_) * D; const float* qb_ = qa_ + 1024; \
                N1_LD1(V_[0], pa_, 0); N1_LD1(V_[1], pa_, 1024); N1_LD1(V_[2], pa_, 2048); N1_LD1(V_[3], pa_, 3072); N1_LD1(V_[4], pb_, 0); N1_LD1(V_[5], pb_, 1024); N1_LD1(V_[6], pb_, 2048); N1_LD1(V_[7], pb_, 3072); \
                N1_LD1(W_[0], qa_, 0); N1_LD1(W_[1], qa_, 1024); N1_LD1(W_[2], qa_, 2048); N1_LD1(W_[3], qa_, 3072); N1_LD1(W_[4], qb_, 0); N1_LD1(W_[5], qb_, 1024); N1_LD1(W_[6], qb_, 2048); N1_LD1(W_[7], qb_, 3072); } while (0)
#define N1_TIE(V_, W_, cnt_) do { asm volatile("s_waitcnt vmcnt(" #cnt_ ")" : "+v"(V_[0]), "+v"(V_[1]), "+v"(V_[2]), "+v"(V_[3]), "+v"(V_[4]), "+v"(V_[5]), "+v"(V_[6]), "+v"(V_[7])); \
                asm volatile("" : "+v"(W_[0]), "+v"(W_[1]), "+v"(W_[2]), "+v"(W_[3]), "+v"(W_[4]), "+v"(W_[5]), "+v"(W_[6]), "+v"(W_[7])); } while (0)
#define N1_VECS(row_) do { const int b_ = (row_) >> 12; \
                if (b_ != cb) { cb = b_; const float* mb = MOD + (size_t)b_ * 6 * D; \
                    _Pragma("unroll") for (int j = 0; j < 8; ++j) { const int k = 4 * lane + 256 * j; const f32x4 g = *(const f32x4*)(norm1_g + k), sh = *(const f32x4*)(mb + k), sc = *(const f32x4*)(mb + D + k); Av[j] = g * (sc + 1.0f); Bv[j] = sh; } } } while (0)
#define N1_BODY(V_, W_, row_, row2_) do { \
                float ss = 0.f, ss2 = 0.f; \
                _Pragma("unroll") for (int j = 0; j < 8; ++j) { ss += V_[j][0] * V_[j][0] + V_[j][1] * V_[j][1] + V_[j][2] * V_[j][2] + V_[j][3] * V_[j][3]; ss2 += W_[j][0] * W_[j][0] + W_[j][1] * W_[j][1] + W_[j][2] * W_[j][2] + W_[j][3] * W_[j][3]; } \
                const float rstd = 1.0f / sqrtf(wave_sum(ss) * (1.0f / D) + RMS_EPS), rstd2 = 1.0f / sqrtf(wave_sum(ss2) * (1.0f / D) + RMS_EPS); \
                _Pragma("unroll") for (int j = 0; j < 8; ++j) { const int k = 4 * lane + 256 * j; const f32x4 h = V_[j] * rstd * Av[j] + Bv[j], h2 = W_[j] * rstd2 * Av[j] + Bv[j]; \
                    if (Z_FP8) { *(unsigned*)(XN8 + (size_t)(row_) * D + k) = pk4_fp8(h[0], h[1], h[2], h[3]); *(unsigned*)(XN8 + (size_t)(row2_) * D + k) = pk4_fp8(h2[0], h2[1], h2[2], h2[3]); } \
                    else { v2u o; o.x = cvt_pk_bf16(h[0], h[1]); o.y = cvt_pk_bf16(h[2], h[3]); *(v2u*)(XN + (size_t)(row_) * D + k) = o; o.x = cvt_pk_bf16(h2[0], h2[1]); o.y = cvt_pk_bf16(h2[2], h2[3]); *(v2u*)(XN + (size_t)(row2_) * D + k) = o; } } } while (0)
            if (RPW == 8 && gw * RPW + 7 < T) {
                f32x4 va[8], wa[8], vb[8], wb[8];
                const int r0 = gw * 8;
                N1_VECS(r0);
                N1_LOAD(va, wa, r0, r0 + 1); N1_LOAD(vb, wb, r0 + 2, r0 + 3);
                N1_TIE(va, wa, 16); N1_BODY(va, wa, r0, r0 + 1);
                N1_LOAD(va, wa, r0 + 4, r0 + 5);
                N1_TIE(vb, wb, 16); N1_BODY(vb, wb, r0 + 2, r0 + 3);
                N1_LOAD(vb, wb, r0 + 6, r0 + 7);
                N1_TIE(va, wa, 16); N1_BODY(va, wa, r0 + 4, r0 + 5);
                N1_TIE(vb, wb, 0); N1_BODY(vb, wb, r0 + 6, r0 + 7);
            } else {
                for (int i = 0; i < RPW; i += 2) {
                    N1_ROWS(i, row, row2); if (row >= T) break;
                    f32x4 v[8], w[8];
                    const float* xr = x + (size_t)row * D + 4 * lane; const float* xr2 = x + (size_t)row2 * D + 4 * lane;
#pragma unroll
                    for (int j = 0; j < 8; ++j) { v[j] = *(const f32x4*)(xr + 256 * j); w[j] = *(const f32x4*)(xr2 + 256 * j); }
                    N1_VECS(row); N1_BODY(v, w, row, row2);
                }
            }
#undef N1_ROWS
#undef N1_LD1
#undef N1_LOAD
#undef N1_TIE
#undef N1_BODY
#undef N1_VECS
        }
        {
            constexpr int T_IN = Z_FP8 ? 0 : (D / 64) * (INW / 256), T_PW = 4 * 4, T_PO = PO_FP8 ? 0 : (PW / 64) * (D / 256), T_GL = GLU_FP8 ? 0 : (SW / 64) * (2 * D / 256), T_OUT = OUT_FP8 ? 0 : (D / 64) * (D / 256);
            constexpr int NTILES = T_IN + T_PW + T_PO + T_GL + T_OUT;
            constexpr int TRB = 256 * 144;
#define TR_DECODE(it_, W_, WT_, K_, N_, mode_, k0_, n0_) do { int r_ = (it_); \
                if (r_ < T_IN) { W_ = w_in; WT_ = WinT; K_ = D; N_ = INW; mode_ = 0; } \
                else if ((r_ -= T_IN) < T_PW) { const int q_ = r_ >> 2; r_ &= 3; W_ = pool_w + (size_t)q_ * 65536; WT_ = PoolWT + (size_t)q_ * 65536; K_ = 256; N_ = 256; mode_ = 0; } \
                else if ((r_ -= T_PW) < T_PO) { W_ = w_pool_out; WT_ = WpoT; K_ = PW; N_ = D; mode_ = 0; } \
                else if ((r_ -= T_PO) < T_GL) { W_ = w_glu; WT_ = WgluT; K_ = SW; N_ = 2 * D; mode_ = 1; } \
                else { r_ -= T_GL; W_ = w_out; WT_ = WoutT; K_ = D; N_ = D; mode_ = 0; } \
                const int nblk_ = N_ >> 8; k0_ = (r_ / nblk_) * 64; n0_ = (r_ % nblk_) * 256; } while (0)
#define TR_LOAD(reg_, W_, N_, k0_, n0_) do { const float* p_ = W_ + (size_t)(k0_ + 8 * wave) * N_ + n0_ + 4 * lane; \
                _Pragma("unroll") for (int i_ = 0; i_ < 8; ++i_) reg_[i_] = __builtin_nontemporal_load((const f32x4*)(p_ + (size_t)i_ * N_)); } while (0)
#define TR_PUT(reg_, buf_) do { _Pragma("unroll") for (int j_ = 0; j_ < 4; ++j_) { v4u o_; o_.x = cvt_pk_bf16(reg_[0][j_], reg_[1][j_]); o_.y = cvt_pk_bf16(reg_[2][j_], reg_[3][j_]); \
                o_.z = cvt_pk_bf16(reg_[4][j_], reg_[5][j_]); o_.w = cvt_pk_bf16(reg_[6][j_], reg_[7][j_]); *(LAS v4u*)(lds + RING_OFF + (buf_) * TRB + (4 * lane + j_) * 144 + 16 * wave) = o_; } } while (0)
#define TR_FLUSH(buf_, WT_, K_, N_, mode_, k0_, n0_) do { _Pragma("unroll") for (int p_ = 0; p_ < 4; ++p_) { const int n_ = 64 * p_ + (tid >> 3), c_ = tid & 7; \
                const v4u q_ = *(const LAS v4u*)(lds + RING_OFF + (buf_) * TRB + n_ * 144 + 16 * c_); const int gn_ = n0_ + n_; int drow_ = gn_; \
                if (mode_) { const int half_ = N_ >> 1, hi_ = gn_ >= half_ ? 1 : 0, nn_ = gn_ - hi_ * half_; drow_ = (nn_ >> 7) * 256 + hi_ * 128 + (nn_ & 127); } \
                *(v4u*)(WT_ + (size_t)drow_ * K_ + k0_ + 8 * c_) = q_; } } while (0)
#define TR_BAR() do { LDS_WAIT(); __builtin_amdgcn_s_barrier(); asm volatile("" ::: "memory"); } while (0)
            int itA = vcu, itB = vcu + G;
            const float *WA = nullptr, *WB = nullptr; bf16 *TA = nullptr, *TB = nullptr; int KA = 0, NA = 0, mA = 0, kA = 0, nA = 0, KB = 0, NB = 0, mB = 0, kB = 0, nB = 0;
            f32x4 ra[8], rb[8];
            if (itA < NTILES) { TR_DECODE(itA, WA, TA, KA, NA, mA, kA, nA); TR_LOAD(ra, WA, NA, kA, nA); }
            if (itB < NTILES) { TR_DECODE(itB, WB, TB, KB, NB, mB, kB, nB); TR_LOAD(rb, WB, NB, kB, nB); }
            while (itA < NTILES) {
                TR_PUT(ra, 0);
                { bf16* dT = TA; const int dK = KA, dN = NA, dm = mA, dk = kA, dn = nA;
                  itA += 2 * G; if (itA < NTILES) { TR_DECODE(itA, WA, TA, KA, NA, mA, kA, nA); TR_LOAD(ra, WA, NA, kA, nA); }
                  TR_BAR();
                  TR_FLUSH(0, dT, dK, dN, dm, dk, dn); }
                if (itB >= NTILES) break;
                TR_PUT(rb, 1);
                { bf16* dT = TB; const int dK = KB, dN = NB, dm = mB, dk = kB, dn = nB;
                  itB += 2 * G; if (itB < NTILES) { TR_DECODE(itB, WB, TB, KB, NB, mB, kB, nB); TR_LOAD(rb, WB, NB, kB, nB); }
                  TR_BAR();
                  TR_FLUSH(1, dT, dK, dN, dm, dk, dn); }
            }
            __syncthreads();
            {
                constexpr int U_IN = Z_FP8 ? (D / 128) * (INW / 256) : 0, U_GL = GLU_FP8 ? (SW / 128) * (2 * D / 256) : 0, U_PO = PO_FP8 ? (PW / 128) * (D / 256) : 0, U_OUT = OUT_FP8 ? (D / 128) * (D / 256) : 0, U_W1E = (D / 128) * (2 * FE / 256), U_W2E = (FE / 128) * (D / 256), U_W1 = NE * U_W1E, U_TOT = U_IN + U_GL + U_PO + U_OUT + U_W1 + NE * U_W2E;
#define T8_DECODE(it_, W_, WT_, K_, N_, mode_, k0_, n0_) do { int r_ = (it_); \
                    if (r_ < U_IN) { W_ = w_in; WT_ = (unsigned char*)WinT; K_ = D; N_ = INW; mode_ = 0; } \
                    else if ((r_ -= U_IN) < U_GL) { W_ = w_glu; WT_ = (unsigned char*)WgluT; K_ = SW; N_ = 2 * D; mode_ = 1; } \
                    else if ((r_ -= U_GL) < U_PO) { W_ = w_pool_out; WT_ = (unsigned char*)WpoT; K_ = PW; N_ = D; mode_ = 0; } \
                    else if ((r_ -= U_PO) < U_OUT) { W_ = w_out; WT_ = (unsigned char*)WoutT; K_ = D; N_ = D; mode_ = 0; } \
                    else if ((r_ -= U_OUT) < U_W1) { const int e_ = r_ / U_W1E; r_ -= e_ * U_W1E; W_ = w1 + (size_t)e_ * D * 2 * FE; WT_ = W1T8 + (size_t)e_ * D * 2 * FE; K_ = D; N_ = 2 * FE; mode_ = 1; } \
                    else { r_ -= U_W1; const int e_ = r_ / U_W2E; r_ -= e_ * U_W2E; W_ = w2 + (size_t)e_ * FE * D; WT_ = W2T8 + (size_t)e_ * FE * D; K_ = FE; N_ = D; mode_ = 0; } \
                    const int nblk_ = N_ >> 8; k0_ = (r_ / nblk_) * 128; n0_ = (r_ % nblk_) * 256; } while (0)
#define T8_LOAD(reg_, W_, N_, k0_, n0_) do { const float* p_ = W_ + (size_t)(k0_ + 16 * wave) * N_ + n0_ + 4 * lane; \
                    _Pragma("unroll") for (int i_ = 0; i_ < 16; ++i_) reg_[i_] = __builtin_nontemporal_load((const f32x4*)(p_ + (size_t)i_ * N_)); } while (0)
#define T8_PUT(reg_, buf_) do { _Pragma("unroll") for (int j_ = 0; j_ < 4; ++j_) { v4u o_; o_.x = pk4_fp8(32.f * reg_[0][j_], 32.f * reg_[1][j_], 32.f * reg_[2][j_], 32.f * reg_[3][j_]); o_.y = pk4_fp8(32.f * reg_[4][j_], 32.f * reg_[5][j_], 32.f * reg_[6][j_], 32.f * reg_[7][j_]); \
                    o_.z = pk4_fp8(32.f * reg_[8][j_], 32.f * reg_[9][j_], 32.f * reg_[10][j_], 32.f * reg_[11][j_]); o_.w = pk4_fp8(32.f * reg_[12][j_], 32.f * reg_[13][j_], 32.f * reg_[14][j_], 32.f * reg_[15][j_]); \
                    *(LAS v4u*)(lds + RING_OFF + (buf_) * TRB + (4 * lane + j_) * 144 + 16 * wave) = o_; } } while (0)
#define T8_FLUSH(buf_, WT_, K_, N_, mode_, k0_, n0_) do { _Pragma("unroll") for (int p_ = 0; p_ < 4; ++p_) { const int n_ = 64 * p_ + (tid >> 3), c_ = tid & 7; \
                    const v4u q_ = *(const LAS v4u*)(lds + RING_OFF + (buf_) * TRB + n_ * 144 + 16 * c_); const int gn_ = n0_ + n_; int drow_ = gn_; \
                    if (mode_) { const int half_ = N_ >> 1, hi_ = gn_ >= half_ ? 1 : 0, nn_ = gn_ - hi_ * half_; drow_ = (nn_ >> 7) * 256 + hi_ * 128 + (nn_ & 127); } \
                    __builtin_nontemporal_store(q_, (v4u*)(WT_ + (size_t)drow_ * K_ + k0_ + 16 * c_)); } } while (0)
                int itA = vcu, itB = vcu + G;
                const float *WA = nullptr, *WB = nullptr; unsigned char *TA = nullptr, *TB = nullptr; int KA = 0, NA = 0, mA = 0, kA = 0, nA = 0, KB = 0, NB = 0, mB = 0, kB = 0, nB = 0;
                f32x4 ra[16], rb[16];
                if (itA < U_TOT) { T8_DECODE(itA, WA, TA, KA, NA, mA, kA, nA); T8_LOAD(ra, WA, NA, kA, nA); }
                if (itB < U_TOT) { T8_DECODE(itB, WB, TB, KB, NB, mB, kB, nB); T8_LOAD(rb, WB, NB, kB, nB); }
                while (itA < U_TOT) {
                    T8_PUT(ra, 0);
                    { unsigned char* dT = TA; const int dK = KA, dN = NA, dm = mA, dk = kA, dn = nA;
                      itA += 2 * G; if (itA < U_TOT) { T8_DECODE(itA, WA, TA, KA, NA, mA, kA, nA); T8_LOAD(ra, WA, NA, kA, nA); }
                      TR_BAR();
                      T8_FLUSH(0, dT, dK, dN, dm, dk, dn); }
                    if (itB >= U_TOT) break;
                    T8_PUT(rb, 1);
                    { unsigned char* dT = TB; const int dK = KB, dN = NB, dm = mB, dk = kB, dn = nB;
                      itB += 2 * G; if (itB < U_TOT) { T8_DECODE(itB, WB, TB, KB, NB, mB, kB, nB); T8_LOAD(rb, WB, NB, kB, nB); }
                      TR_BAR();
                      T8_FLUSH(1, dT, dK, dN, dm, dk, dn); }
                }
                __syncthreads();
#undef T8_DECODE
#undef T8_LOAD
#undef T8_PUT
#undef T8_FLUSH
            }
#undef TR_DECODE
#undef TR_LOAD
#undef TR_PUT
#undef TR_FLUSH
#undef TR_BAR
        }
        PROBE_MID(1); if (BOTH(1)) GRID_BAR(); PROBE_END(1);
    }

    if (IN(2)) {
        PH_PTRS(); PROBE_BEGIN(2);
        SchedDense S; S.init(Z_FP8 ? (const void*)XN8 : (const void*)XN, WinT, T, INW, D, D, G, bx, Z_FP8 ? 1 : 2);
        EpiZ E{UP, UG, SGP, SGS, Z_FP8 ? 0.03125f : 1.0f};
        pg8::gemm_phase<EpiZ, SchedDense, false, Z_FP8 ? 1 : 2>(lds + RING_OFF, D, D, D, S, E);
        if (DUPSEL == 2) { pg8::gemm_phase<EpiZ, SchedDense, false, Z_FP8 ? 1 : 2>(lds + RING_OFF, D, D, D, S, E); }
        PROBE_MID(2); if (BOTH(2)) GRID_BAR(); PROBE_END(2);
    }

    if (IN(3)) {
        PH_PTRS(); PROBE_BEGIN(3);
        for (int L = vcu; L < 4 * (T / 256); L += G) {
            const int gq = L / (T / 256), pm = L % (T / 256), b = pm >> 4, oct = lane & 31, th = lane >> 5, t0 = (pm & 15) * 256 + wave * 32 + th * 16;
            bf16* pl = PL + (size_t)b * SEQ * PW + gq * 256 + oct * 8; const unsigned voff = (unsigned)(th * 16 * PW + oct * 8) * 2u;
            const bf16* ub0 = UP + ((size_t)b * SEQ + (pm & 15) * 256 + wave * 32) * PW + gq * 256;
            if (gq == 0) pool_item<2>(ub0 - 1 * PW, voff, pl, t0); else if (gq == 1) pool_item<4>(ub0 - 3 * PW, voff, pl, t0); else if (gq == 2) pool_item<8>(ub0 - 7 * PW, voff, pl, t0); else pool_item<16>(ub0 - 15 * PW, voff, pl, t0);
        }
        VM_WAIT(); __syncthreads();
        { SchedGrouped S; S.init(PL, PoolWT, PW, (size_t)256 * 2, (size_t)256 * 256 * 2, T / 256, 4, G, vcu);
          EpiPmix E{PM, pool_scale};
          pg8::gemm_phase<EpiPmix, SchedGrouped, false>(lds + RING_OFF, PW, 256, 256, S, E); }
        { SchedGrouped S; S.init(UG, WendT, UGK, (size_t)1024 * UGK * 2, (size_t)256 * 256 * 2, 4, SG, G, vcu);
          EpiS1 E{EB};
          pg8::gemm_phase<EpiS1, SchedGrouped, false>(lds + RING_OFF, UGK, 256, 256, S, E); }
        PROBE_MID(3); if (BOTH(3)) GRID_BAR(); PROBE_END(3);
    }


    if (IN(5)) {
        PH_PTRS(); PROBE_BEGIN(5);
        {
            LAS float* SB = (LAS float*)(lds + RING_OFF);
            for (int L = vcu; L < SG * 4; L += G) {
                const int g = L >> 2, b = L & 3, p = lane; const float ar = AL[(g * SP + p) * 2], ai = AL[(g * SP + p) * 2 + 1];
                const size_t rb = (size_t)g * 1024 + b * 256 + 32 * wave;
                float er[32], ei[32], lr[32], li[32];
#pragma unroll
                for (int j = 0; j < 32; ++j) { er[j] = EB[(rb + j) * 128 + p]; ei[j] = EB[(rb + j) * 128 + 64 + p]; }
                float xr = 0.f, xi = 0.f;
#pragma unroll
                for (int j = 0; j < 32; ++j) { lr[j] = xr; li[j] = xi; const float nr = ar * xr - ai * xi + er[j], ni = ar * xi + ai * xr + ei[j]; xr = nr; xi = ni; }
                SB[(wave * 64 + p) * 2] = xr; SB[(wave * 64 + p) * 2 + 1] = xi;
                float qr = ar, qi = ai;
#pragma unroll
                for (int k = 0; k < 5; ++k) { const float t0 = qr * qr - qi * qi, t1 = 2.f * qr * qi; qr = t0; qi = t1; }
                __syncthreads();
                float cr = 0.f, ci = 0.f;
                for (int v = 0; v < wave; ++v) { const float sr = SB[(v * 64 + p) * 2], si = SB[(v * 64 + p) * 2 + 1]; const float nr = qr * cr - qi * ci + sr, ni = qr * ci + qi * cr + si; cr = nr; ci = ni; }
                float pr = 1.f, pi = 0.f;
#pragma unroll
                for (int j = 0; j < 32; ++j) { const float fr_ = lr[j] + pr * cr - pi * ci, fi_ = li[j] + pr * ci + pi * cr;
                    UG[(rb + j) * UGK + 256 + p] = (bf16)(cvt_pk_bf16(fr_, 0.f) & 0xffffu); UG[(rb + j) * UGK + 320 + p] = (bf16)(cvt_pk_bf16(fi_, 0.f) & 0xffffu);
                    const float t0 = pr * ar - pi * ai, t1 = pr * ai + pi * ar; pr = t0; pi = t1; }
                __syncthreads();
            }
        }
        VM_WAIT(); __syncthreads();
        { SchedGrouped S; S.init(UG, TG, UGK, (size_t)1024 * UGK * 2, (size_t)256 * UGK * 2, 4, SG, G, vcu);
          EpiS3 E{YS};
          pg8::gemm_phase<EpiS3, SchedGrouped, false>(lds + RING_OFF, UGK, UGK, UGK, S, E); }
        { SchedDense S; S.init(PM, WpoT, T, D, PW, PW, G, bx, PO_FP8 ? 1 : 2);
          EpiYpool E{YPG, SGP, PO_FP8 ? 0.03125f : 1.0f};
          pg8::gemm_phase<EpiYpool, SchedDense, false, PO_FP8 ? 1 : 2>(lds + RING_OFF, PW, PW, PW, S, E); }
        PROBE_MID(5); if (BOTH(5)) GRID_BAR(); PROBE_END(5);
    }

    if (IN(6)) {
        PH_PTRS(); PROBE_BEGIN(6);
        SchedDense S; S.init(YS, WgluT, T, 2 * D, SW, SW, G, bx, GLU_FP8 ? 1 : 2);
        EpiGlu E{MG, YPG, SGS, b_glu, GLU_FP8 ? 0.03125f : 1.0f};
        pg8::gemm_phase<EpiGlu, SchedDense, false, GLU_FP8 ? 1 : 2>(lds + RING_OFF, SW, SW, SW, S, E);
        PROBE_MID(6); if (BOTH(6)) GRID_BAR(); PROBE_END(6);
    }

    if (IN(7)) {
        PH_PTRS(); PROBE_BEGIN(7);
        SchedDense S; S.init(MG, WoutT, T, D, D, D, G, bx, OUT_FP8 ? 1 : 2);
        EpiMix E{MX, OUT_FP8 ? 0.03125f : 1.0f, MOD + 2 * D};
        pg8::gemm_phase<EpiMix, SchedDense, false, OUT_FP8 ? 1 : 2>(lds + RING_OFF, D, D, D, S, E);
        PROBE_MID(7); if (BOTH(7)) GRID_BAR(); PROBE_END(7);
    }

    if (IN(8)) for (int rep_ = 0; rep_ < REP(8); ++rep_) {
        PH_PTRS(); PROBE_BEGIN(8);
        LAS float* HT = (LAS float*)(lds + RING_OFF);
        LAS float* RED = (LAS float*)(lds + RING_OFF + 65792);
        LAS float* LG = (LAS float*)(lds + RING_OFF + 98560);
        LAS int* HIST = (LAS int*)(lds + RING_OFF + 102784);
        LAS int* BASE = (LAS int*)(lds + RING_OFF + 102912);
        LAS float* PVA = (LAS float*)(lds + RING_OFF + 104448);
        LAS float* PVS = PVA + D;
        const int TPW8 = (T / 32 + G - 1) / G; int cb8 = -1;
        for (int ti8 = 0; ti8 < TPW8; ++ti8) {
            const int tile = vcu * TPW8 + ti8; if (tile >= T / 32) break;
            const int R0 = tile * 32, b = R0 >> 12; const float* mb = MOD + (size_t)b * 6 * D;
            if (b != cb8) { cb8 = b; __syncthreads(); const int k = 4 * tid;
                const f32x4 g = *(const f32x4*)(norm2_g + k), sh = *(const f32x4*)(mb + 3 * D + k), sc = *(const f32x4*)(mb + 4 * D + k);
                *(LAS f32x4*)(PVA + k) = g * (sc + 1.0f); *(LAS f32x4*)(PVS + k) = sh; __syncthreads(); }
            f32x4 v[4][8]; float rstd[4], ssq[4] = {0.f, 0.f, 0.f, 0.f};
#pragma unroll
            for (int j = 0; j < 8; ++j) { const int k = 4 * lane + 256 * j;
#pragma unroll
                for (int rr = 0; rr < 4; ++rr) { const size_t off = (size_t)(R0 + 4 * wave + rr) * D + k; const v2u mq = *(const v2u*)(MX + off);
                    v[rr][j] = *(const f32x4*)(x + off) + (f32x4){bf_lo(mq.x), bf_hi(mq.x), bf_lo(mq.y), bf_hi(mq.y)};
                    ssq[rr] += v[rr][j][0] * v[rr][j][0] + v[rr][j][1] * v[rr][j][1] + v[rr][j][2] * v[rr][j][2] + v[rr][j][3] * v[rr][j][3]; } }
#pragma unroll
            for (int rr = 0; rr < 4; ++rr) rstd[rr] = 1.0f / sqrtf(wave_sum(ssq[rr]) * (1.0f / D) + RMS_EPS);
#pragma unroll
            for (int j = 0; j < 8; ++j) { const int k = 4 * lane + 256 * j; const f32x4 Aj = *(const LAS f32x4*)(PVA + k), sh = *(const LAS f32x4*)(PVS + k);
#pragma unroll
                for (int rr = 0; rr < 4; ++rr) { const int row = R0 + 4 * wave + rr; v[rr][j] = v[rr][j] * rstd[rr] * Aj + sh;
                    *(unsigned*)(XN8 + (size_t)row * D + k) = pk4_fp8(v[rr][j][0], v[rr][j][1], v[rr][j][2], v[rr][j][3]); } }
            if (tid < 32) HIST[tid] = 0;
            f32x16 lacc;
#pragma unroll
            for (int j = 0; j < 16; ++j) lacc[j] = 0.f;
#pragma unroll
            for (int q = 0; q < 4; ++q) {
                float bq[16];
                const float* wr0 = w_router + (size_t)(q * 512 + 64 * wave) * NE; const float* wr1 = wr0 + 16 * 2 * NE; const unsigned wvo = (unsigned)((lane >> 5) * NE + (lane & 31)) * 4u;
#define RB_LD(i_, off_, base_) asm volatile("global_load_dword %0, %1, %2 offset:" #off_ : "=v"(bq[i_]) : "v"(wvo), "s"(base_))
#define RB_LD16(base_) do { RB_LD(0, 0, base_); RB_LD(1, 256, base_); RB_LD(2, 512, base_); RB_LD(3, 768, base_); RB_LD(4, 1024, base_); RB_LD(5, 1280, base_); RB_LD(6, 1536, base_); RB_LD(7, 1792, base_); \
                    RB_LD(8, 2048, base_); RB_LD(9, 2304, base_); RB_LD(10, 2560, base_); RB_LD(11, 2816, base_); RB_LD(12, 3072, base_); RB_LD(13, 3328, base_); RB_LD(14, 3584, base_); RB_LD(15, 3840, base_); } while (0)
#define RB_WAIT() do { asm volatile("s_waitcnt vmcnt(0)" : "+v"(bq[0]), "+v"(bq[1]), "+v"(bq[2]), "+v"(bq[3]), "+v"(bq[4]), "+v"(bq[5]), "+v"(bq[6]), "+v"(bq[7])); \
                    asm volatile("" : "+v"(bq[8]), "+v"(bq[9]), "+v"(bq[10]), "+v"(bq[11]), "+v"(bq[12]), "+v"(bq[13]), "+v"(bq[14]), "+v"(bq[15])); } while (0)
                RB_LD16(wr0);
                __syncthreads();
#pragma unroll
                for (int rr = 0; rr < 4; ++rr)
#pragma unroll
                    for (int jj = 0; jj < 2; ++jj) { const int lk = 4 * lane + 256 * jj; LAS float* hp = HT + (4 * wave + rr) * 513 + lk; const f32x4 q4 = v[rr][2 * q + jj]; hp[0] = q4[0]; hp[1] = q4[1]; hp[2] = q4[2]; hp[3] = q4[3]; }
                __syncthreads();
                const LAS float* ap = HT + (lane & 31) * 513 + 64 * wave + (lane >> 5);
                RB_WAIT();
#pragma unroll
                for (int s = 0; s < 16; ++s) lacc = __builtin_amdgcn_mfma_f32_32x32x2f32(ap[2 * s], bq[s], lacc, 0, 0, 0);
                asm volatile("" : "+v"(lacc));
                RB_LD16(wr1); RB_WAIT();
#pragma unroll
                for (int s = 0; s < 16; ++s) lacc = __builtin_amdgcn_mfma_f32_32x32x2f32(ap[32 + 2 * s], bq[s], lacc, 0, 0, 0);
                asm volatile("" : "+v"(lacc));
            }
#pragma unroll
            for (int rg = 0; rg < 16; ++rg) { const int i = (rg & 3) + 8 * (rg >> 2) + 4 * (lane >> 5); RED[(wave * 32 + i) * 32 + (lane & 31)] = lacc[rg]; }
            __syncthreads();
#pragma unroll
            for (int pp = 0; pp < 2; ++pp) { const int p = tid + pp * 512, i = p >> 5, j = p & 31; float s = b_router[j];
#pragma unroll
                for (int w = 0; w < 8; ++w) s += RED[(w * 32 + i) * 32 + j];
                LG[i * 33 + j] = s; }
            __syncthreads();
            int ae[2], al[2]; float aw[2];
            { const int hw = tid >> 5, l32 = tid & 31;
#pragma unroll
              for (int it = 0; it < 2; ++it) { const int i = hw * 2 + it; float val = LG[i * 33 + l32]; float tv[4]; int ti[4];
#pragma unroll
                for (int k = 0; k < 4; ++k) { float bv = val; int bi = l32;
#pragma unroll
                    for (int off = 16; off >= 1; off >>= 1) { const float ov = __shfl_xor(bv, off); const int oi = __shfl_xor(bi, off); if (ov > bv || (ov == bv && oi < bi)) { bv = ov; bi = oi; } }
                    tv[k] = bv; ti[k] = bi; if (l32 == bi) val = -3.0e38f; }
                float den = 0.f, ex[4];
#pragma unroll
                for (int k = 0; k < 4; ++k) { ex[k] = expf(tv[k] - tv[0]); den += ex[k]; }
                const int ke = l32 & 3; ae[it] = ke == 0 ? ti[0] : (ke == 1 ? ti[1] : (ke == 2 ? ti[2] : ti[3])); aw[it] = (ke == 0 ? ex[0] : (ke == 1 ? ex[1] : (ke == 2 ? ex[2] : ex[3]))) / den;
                al[it] = (l32 < 4) ? atomicAdd((int*)&HIST[ae[it]], 1) : 0; } }
            __syncthreads();
            if (tid < 32) { const int c = HIST[tid]; BASE[tid] = c ? (int)__hip_atomic_fetch_add((unsigned*)(ctl + CW_CNT + tid), (unsigned)c, RLX_AGENT) : 0; }
            __syncthreads();
            if ((tid & 31) < 4) { const int hw = tid >> 5, k = tid & 3;
#pragma unroll
                for (int it = 0; it < 2; ++it) { const int tok = R0 + hw * 2 + it, e = ae[it], rank = BASE[e] + al[it]; LTOK[(size_t)e * LCAP + rank] = tok; LWT[(size_t)e * LCAP + rank] = aw[it]; TSLOT[tok * 4 + k] = e * LCAP + rank; } }
            __syncthreads();
        }
        PROBE_MID(8); if (BOTH(8)) GRID_BAR(); PROBE_END(8);
    }

#define MOE_TABLES(nN_) do { __syncthreads(); if (tid < 64) { const int e_ = tid & 31; const unsigned c_ = (tid < 32) ? __hip_atomic_load(ctl + CW_CNT + e_, RLX_AGENT) : 0u; const unsigned nb_ = (c_ + 255u) >> 8; \
        unsigned incl_ = nb_; _Pragma("unroll") for (int off_ = 1; off_ < 32; off_ <<= 1) { const unsigned t_ = __shfl_up(incl_, off_); if (e_ >= off_) incl_ += t_; } \
        if (tid < 32) { const unsigned excl_ = incl_ - nb_; MISC[32 + e_] = excl_ * (unsigned)(nN_); MISC[80 + e_] = excl_; MISC[128 + e_] = c_; \
            if (e_ == NE - 1) { MISC[32 + NE] = incl_ * (unsigned)(nN_); MISC[80 + NE] = incl_; MISC[176] = incl_ * (unsigned)(nN_); } } } __syncthreads(); } while (0)

    if (IN(9)) {
        PH_PTRS(); PROBE_BEGIN(9);
        MOE_TABLES(2 * FE / 256);
        SchedMoe S; S.A = (const char*)XN8; S.Bt = (const char*)W1T8; S.astep = 0; S.bstep_e = (size_t)2 * FE * D; S.bstep_n = (size_t)256 * D; S.nN = 2 * FE / 256; S.G = G; S.c = vcu; S.M = MISC; S.ltok = LTOK; S.gather = true;
        EpiMoe1 E{ACT8, b1};
        pg8::gemm_phase<EpiMoe1, SchedMoe, true, 1, true>(lds + RING_OFF, D, D, D, S, E);
        if (DUPSEL == 9) { pg8::gemm_phase<EpiMoe1, SchedMoe, true, 1, true>(lds + RING_OFF, D, D, D, S, E); }
        PROBE_MID(9); if (BOTH(9)) GRID_BAR(); PROBE_END(9);
    }

    if (IN(10)) {
        PH_PTRS(); PROBE_BEGIN(10);
        MOE_TABLES(D / 256);
        SchedMoe S; S.A = (const char*)ACT8; S.Bt = (const char*)W2T8; S.astep = (size_t)256 * FE; S.bstep_e = (size_t)D * FE; S.bstep_n = (size_t)256 * FE; S.nN = D / 256; S.G = G; S.c = vcu; S.M = MISC; S.ltok = LTOK; S.gather = false;
        EpiMoe2 E{YE, b2, LWT};
        pg8::gemm_phase<EpiMoe2, SchedMoe, false, 1, true>(lds + RING_OFF, FE, FE, FE, S, E);
        if (DUPSEL == 10) { pg8::gemm_phase<EpiMoe2, SchedMoe, false, 1, true>(lds + RING_OFF, FE, FE, FE, S, E); }
        PROBE_MID(10); if (BOTH(10)) GRID_BAR(); PROBE_END(10);
    }

    if (IN(11)) for (int rep_ = 0; rep_ < REP(11); ++rep_) {
        PH_PTRS(); PROBE_BEGIN(11);
        MOE_TABLES(1);
        {
            const int RPW = (T + NGW - 1) / NGW; int cb = -1;
            f32x4 Av[8], Bv[8], Gv[8];
            int sl[4];
            { const int r0 = gw * RPW < T ? gw * RPW : T - 1;
#pragma unroll
              for (int k = 0; k < 4; ++k) sl[k] = TSLOT[r0 * 4 + k]; }
            for (int i = 0; i < RPW; ++i) {
                const int row = gw * RPW + i; if (row >= T) break;
                const int b = row >> 12;
                if (b != cb) { cb = b; const float* mb = MOD + (size_t)b * 6 * D; const float* fb = FMOD + (size_t)b * 2 * D;
#pragma unroll
                    for (int j = 0; j < 8; ++j) { const int k = 8 * lane + 512 * (j >> 1) + 4 * (j & 1); const f32x4 g = *(const f32x4*)(fnorm_g + k), sh = *(const f32x4*)(fb + k), sc = *(const f32x4*)(fb + D + k);
                        Av[j] = g * (sc + 1.0f); Bv[j] = sh; Gv[j] = *(const f32x4*)(mb + 5 * D + k); } }
                size_t prow[4];
#pragma unroll
                for (int k = 0; k < 4; ++k) { const int sv = sl[k]; const int e = sv >> 14, rank = sv & (LCAP - 1); prow[k] = ((size_t)MISC[80 + e] * 256 + rank) * D; }
                { const int rn = (row + 1 < T) ? row + 1 : row;
#pragma unroll
                  for (int k = 0; k < 4; ++k) sl[k] = TSLOT[rn * 4 + k]; }
                f32x4 v[8]; float ss = 0.f;
#pragma unroll
                for (int j = 0; j < 4; ++j) { const int k = 8 * lane + 512 * j; float f[8] = {0.f, 0.f, 0.f, 0.f, 0.f, 0.f, 0.f, 0.f};
#pragma unroll
                    for (int kk = 0; kk < 4; ++kk) { const v2u y = *(const v2u*)(YE + prow[kk] + k); const pg8::f32x2 q0 = __builtin_amdgcn_cvt_pk_f32_fp8((int)y.x, false), q1 = __builtin_amdgcn_cvt_pk_f32_fp8((int)y.x, true), q2 = __builtin_amdgcn_cvt_pk_f32_fp8((int)y.y, false), q3 = __builtin_amdgcn_cvt_pk_f32_fp8((int)y.y, true);
                        f[0] += q0.x; f[1] += q0.y; f[2] += q1.x; f[3] += q1.y; f[4] += q2.x; f[5] += q2.y; f[6] += q3.x; f[7] += q3.y; }
                    const v4u mq = *(const v4u*)(MX + (size_t)row * D + k);
                    const f32x4 x0 = *(const f32x4*)(x + (size_t)row * D + k) + (f32x4){bf_lo(mq.x), bf_hi(mq.x), bf_lo(mq.y), bf_hi(mq.y)}, x1v = *(const f32x4*)(x + (size_t)row * D + k + 4) + (f32x4){bf_lo(mq.z), bf_hi(mq.z), bf_lo(mq.w), bf_hi(mq.w)};
                    v[2 * j] = x0 + Gv[2 * j] * ((f32x4){f[0], f[1], f[2], f[3]} * 0.0625f); v[2 * j + 1] = x1v + Gv[2 * j + 1] * ((f32x4){f[4], f[5], f[6], f[7]} * 0.0625f);
                    ss += v[2 * j][0] * v[2 * j][0] + v[2 * j][1] * v[2 * j][1] + v[2 * j][2] * v[2 * j][2] + v[2 * j][3] * v[2 * j][3];
                    ss += v[2 * j + 1][0] * v[2 * j + 1][0] + v[2 * j + 1][1] * v[2 * j + 1][1] + v[2 * j + 1][2] * v[2 * j + 1][2] + v[2 * j + 1][3] * v[2 * j + 1][3]; }
                const float rstd = 1.0f / sqrtf(wave_sum(ss) * (1.0f / D) + RMS_EPS);
#pragma unroll
                for (int j = 0; j < 8; ++j) { const int k = 8 * lane + 512 * (j >> 1) + 4 * (j & 1); *(f32x4*)(out + (size_t)row * D + k) = v[j] * rstd * Av[j] + Bv[j]; }
            }
        }
    }
    if (PROBE_PH == 11) { __syncthreads(); pr_dt = __builtin_amdgcn_s_memrealtime() - pr_t0; }
    if (PROBE_PH >= 0) { const unsigned long long te = __builtin_amdgcn_s_memrealtime(); while (__builtin_amdgcn_s_memrealtime() - te < (unsigned long long)PROBE_N * pr_dt) __builtin_amdgcn_s_sleep(8); }
#undef IN
#undef BOTH
}

extern "C" void kernel_launch(void* const* d_in, const int* in_sizes, int n_in, void* d_out, int out_size, void* d_ws, size_t ws_size, hipStream_t stream) {
    static int grid = 0;
    if (grid == 0) {
        if (n_in != 30 || out_size != T * D || ws_size < WS_END) { fprintf(stderr, "kernel_launch: unexpected shapes (n_in %d, out %d, ws %zu); nothing launched\n", n_in, out_size, ws_size); grid = -1; return; }
        int dev = 0, cus = 0, per_cu = 0;
        if (hipGetDevice(&dev) != hipSuccess || hipDeviceGetAttribute(&cus, hipDeviceAttributeMultiprocessorCount, dev) != hipSuccess) { grid = -1; return; }
        if (hipFuncSetAttribute((const void*)fwd_kernel, hipFuncAttributeMaxDynamicSharedMemorySize, LDS_BYTES) != hipSuccess) { fprintf(stderr, "kernel_launch: hipFuncSetAttribute failed\n"); grid = -1; return; }
        if (hipOccupancyMaxActiveBlocksPerMultiprocessor(&per_cu, (const void*)fwd_kernel, NWAVES * 64, LDS_BYTES) != hipSuccess || per_cu < 1)
            fprintf(stderr, "kernel_launch: note: occupancy query reports %d workgroups per CU\n", per_cu);
        (void)hipGetLastError();
        grid = cus;
    }
    if (grid < 0) return;
    if (hipMemsetAsync((char*)d_ws + WS_CTL, 0, CTL_ZERO_BYTES, stream) != hipSuccess) { fprintf(stderr, "kernel_launch: hipMemsetAsync failed\n"); return; }
    Args a{};
    for (int i = 0; i < 30; ++i) a.in[i] = d_in[i];
    a.out = (float*)d_out; a.ws = (unsigned char*)d_ws;
    for (int li = 0; li < N_LAUNCHES; ++li) {
        if (N_LAUNCHES == 1) { a.ph_lo = 0; a.ph_hi = NPH; } else { a.ph_lo = li; a.ph_hi = li + 1; }
        a.li = li; a.pad = 0;
        hipLaunchKernelGGL(fwd_kernel, dim3(grid), dim3(NWAVES * 64), LDS_BYTES, stream, a);
        const hipError_t le = hipPeekAtLastError();
        if (le != hipSuccess) { fprintf(stderr, "kernel_launch: launch %d failed: %s\n", li, hipGetErrorName(le)); break; }
    }
}
```

```cpp
#include <hip/hip_runtime.h>
#include <cstdio>
#include <cstdint>

namespace pg8 {
#define PG8_LAS __attribute__((address_space(3)))
typedef unsigned short bf16_t;
typedef short bf16x8 __attribute__((ext_vector_type(8)));
typedef float f32x4 __attribute__((ext_vector_type(4)));
typedef float f32x2 __attribute__((ext_vector_type(2)));
typedef unsigned u32x4 __attribute__((ext_vector_type(4)));
typedef int i32x4 __attribute__((ext_vector_type(4)));
typedef int i32x8 __attribute__((ext_vector_type(8)));
constexpr int BM = 256, BK = 64, HALF = 128, HTB = HALF * BK * 2, STAGE_BYTES = 8 * HTB, NXCD = 8, WGM = 8;

__host__ __device__ __forceinline__ int lds_byte(int r, int c) { const int st = (r >> 4) * 2 + (c >> 5), rr = r & 15, cc = c & 31, ob = rr * 64 + cc * 2; return st * 1024 + (ob ^ (((ob >> 9) & 1) << 5)); }
__host__ __device__ __forceinline__ void stage_rc(int b, int& R, int& C) { const int st = b / 1024, sb = b % 1024, swz = sb ^ (((sb >> 9) & 1) << 5); R = (st >> 1) * 16 + swz / 64; C = (st & 1) * 32 + (swz % 64) / 2; }
__host__ __device__ __forceinline__ int perm32(int rho) { const int n = rho >> 4, i = rho & 15; return 8 * (i >> 2) + 4 * n + (i & 3); }

struct Unit { int pm, pn, e, rb, nvalid; };

__device__ __forceinline__ unsigned cvt_pk_bf16(float lo, float hi) { unsigned r; asm volatile("v_cvt_pk_bf16_f32 %0, %1, %2" : "=v"(r) : "v"(lo), "v"(hi)); return r; }
__device__ __forceinline__ unsigned pk4_fp8(float a, float b, float c, float d) {
    a = __builtin_amdgcn_fmed3f(a, -448.f, 448.f); b = __builtin_amdgcn_fmed3f(b, -448.f, 448.f); c = __builtin_amdgcn_fmed3f(c, -448.f, 448.f); d = __builtin_amdgcn_fmed3f(d, -448.f, 448.f);
    int w = 0; w = __builtin_amdgcn_cvt_pk_fp8_f32(a, b, w, false); w = __builtin_amdgcn_cvt_pk_fp8_f32(c, d, w, true); return (unsigned)w; }
__device__ __forceinline__ unsigned pk4_u8(float a, float b, float c, float d) {
    unsigned w = 0; w = __builtin_amdgcn_cvt_pk_u8_f32(a, 0, w); w = __builtin_amdgcn_cvt_pk_u8_f32(b, 1, w); w = __builtin_amdgcn_cvt_pk_u8_f32(c, 2, w); w = __builtin_amdgcn_cvt_pk_u8_f32(d, 3, w); return w; }
__device__ __forceinline__ u32x4 pair16(unsigned ax, unsigned ay, unsigned bx, unsigned by) {
    const auto rx = __builtin_amdgcn_permlane16_swap(ax, bx, false, false); const auto ry = __builtin_amdgcn_permlane16_swap(ay, by, false, false);
    return (u32x4){rx[0], ry[0], rx[1], ry[1]};
}
__device__ __forceinline__ void unpair16(u32x4 q, unsigned& ax, unsigned& ay, unsigned& bx, unsigned& by) {
    const auto rx = __builtin_amdgcn_permlane16_swap(q.x, q.z, false, false); const auto ry = __builtin_amdgcn_permlane16_swap(q.y, q.w, false, false);
    ax = rx[0]; ay = ry[0]; bx = rx[1]; by = ry[1];
}
__device__ __forceinline__ float bf_lo(unsigned w) { return __uint_as_float(w << 16); }
__device__ __forceinline__ float bf_hi(unsigned w) { return __uint_as_float(w & 0xffff0000u); }
__device__ __forceinline__ float sigmoidf_(float x) { return __builtin_amdgcn_rcpf(1.0f + __builtin_amdgcn_exp2f(-1.44269504089f * x)); }
__device__ __forceinline__ float gelu_tanh_(float x) { const float u = 0.7978845608f * (x + 0.044715f * x * x * x); return x * __builtin_amdgcn_rcpf(1.0f + __builtin_amdgcn_exp2f(-2.88539008178f * u)); }

template <class Epi, class Sched, bool GATHER, int ESZ = 2, bool HALFU = false>
__device__ __forceinline__ void gemm_phase(PG8_LAS unsigned char* lds, const int lda, const int ldb, const int K, const Sched& S, const Epi& E) {
    const int tid = threadIdx.x, wid = __builtin_amdgcn_readfirstlane(tid >> 6), lane = tid & 63, wr = wid >> 2, wc = wid & 3, fr = lane & 15, fq = lane >> 4;
    const int nt = (K * ESZ) / (BK * 2);
    unsigned voffA[2], voffB[2], colA[2]; int rowA[2];
#pragma unroll
    for (int i = 0; i < 2; ++i) { int R, C; stage_rc(tid * 16 + i * 8192, R, C); const int Rb = Epi::PERM ? ((R & ~31) + perm32(R & 31)) : R;
        rowA[i] = R; colA[i] = (unsigned)C * 2u; voffA[i] = (unsigned)(R * lda * ESZ + C * 2); voffB[i] = (unsigned)(Rb * ldb * ESZ + C * 2); }
    const size_t kstep = (size_t)(BK * 2);
    const size_t hstepA = GATHER ? (size_t)0 : (size_t)HALF * lda * ESZ;
    const size_t hstepB = (size_t)HALF * ldb * ESZ;
    const unsigned ldsw = (unsigned)wid * 1024u;
    const int aoff = lds_byte(wr * 64 + fr, fq * 8), boff = lds_byte(wc * 32 + fr, fq * 8);
#define PG8_SA(b, h) (((b) * 2 + (h)) * HTB)
#define PG8_SB(b, h) ((4 + (b) * 2 + (h)) * HTB)
#define PG8_STAGE2(bufoff, gbase, o0, o1) do { \
        __builtin_amdgcn_global_load_lds((const unsigned*)((const char*)(gbase) + (o0)), (PG8_LAS unsigned*)(lds + (bufoff) + ldsw), 16, 0, 0); \
        __builtin_amdgcn_global_load_lds((const unsigned*)((const char*)(gbase) + (o1)), (PG8_LAS unsigned*)(lds + (bufoff) + ldsw + 8192), 16, 0, 0); } while (0)
#define PG8_STAGE_B(bufoff, gbase) PG8_STAGE2(bufoff, gbase, voffB[0], voffB[1])
#define PG8_LDA(dst, b, h) do { if constexpr (ESZ == 2) { _Pragma("unroll") for (int m = 0; m < 4; ++m) _Pragma("unroll") for (int k = 0; k < 2; ++k) dst[m][k] = *(const PG8_LAS bf16x8*)(lds + PG8_SA(b, h) + aoff + m * 2048 + k * 1024); } \
        else { _Pragma("unroll") for (int m = 0; m < 4; ++m) { const i32x4 lo_ = *(const PG8_LAS i32x4*)(lds + PG8_SA(b, h) + aoff + m * 2048), hi_ = *(const PG8_LAS i32x4*)(lds + PG8_SA(b, h) + aoff + m * 2048 + 1024); dst##8[m] = __builtin_shufflevector(lo_, hi_, 0, 1, 2, 3, 4, 5, 6, 7); } } } while (0)
#define PG8_LDB(dst, b, h) do { if constexpr (ESZ == 2) { _Pragma("unroll") for (int n = 0; n < 2; ++n) _Pragma("unroll") for (int k = 0; k < 2; ++k) dst[n][k] = *(const PG8_LAS bf16x8*)(lds + PG8_SB(b, h) + boff + n * 2048 + k * 1024); } \
        else { _Pragma("unroll") for (int n = 0; n < 2; ++n) { const i32x4 lo_ = *(const PG8_LAS i32x4*)(lds + PG8_SB(b, h) + boff + n * 2048), hi_ = *(const PG8_LAS i32x4*)(lds + PG8_SB(b, h) + boff + n * 2048 + 1024); dst##8[n] = __builtin_shufflevector(lo_, hi_, 0, 1, 2, 3, 4, 5, 6, 7); } } } while (0)
#define PG8_MMA(ai, bj, At, Bt) do { __builtin_amdgcn_s_setprio(1); \
        if constexpr (ESZ == 2) { _Pragma("unroll") for (int m = 0; m < 4; ++m) _Pragma("unroll") for (int n = 0; n < 2; ++n) _Pragma("unroll") for (int k = 0; k < 2; ++k) \
            acc[ai][bj][m][n] = __builtin_amdgcn_mfma_f32_16x16x32_bf16(Bt[n][k], At[m][k], acc[ai][bj][m][n], 0, 0, 0); } \
        else {   \
            asm volatile("s_nop 3\n\t" \
                "v_mfma_f32_16x16x128_f8f6f4 %0, %8, %10, %0\n\t" "v_mfma_f32_16x16x128_f8f6f4 %1, %9, %10, %1\n\t" \
                "v_mfma_f32_16x16x128_f8f6f4 %2, %8, %11, %2\n\t" "v_mfma_f32_16x16x128_f8f6f4 %3, %9, %11, %3\n\t" \
                "v_mfma_f32_16x16x128_f8f6f4 %4, %8, %12, %4\n\t" "v_mfma_f32_16x16x128_f8f6f4 %5, %9, %12, %5\n\t" \
                "v_mfma_f32_16x16x128_f8f6f4 %6, %8, %13, %6\n\t" "v_mfma_f32_16x16x128_f8f6f4 %7, %9, %13, %7" \
                : "+v"(acc[ai][bj][0][0]), "+v"(acc[ai][bj][0][1]), "+v"(acc[ai][bj][1][0]), "+v"(acc[ai][bj][1][1]), "+v"(acc[ai][bj][2][0]), "+v"(acc[ai][bj][2][1]), "+v"(acc[ai][bj][3][0]), "+v"(acc[ai][bj][3][1]) \
                : "v"(Bt##8[0]), "v"(Bt##8[1]), "v"(At##8[0]), "v"(At##8[1]), "v"(At##8[2]), "v"(At##8[3])); } \
        __builtin_amdgcn_s_setprio(0); } while (0)
#define PG8_WAIT_V(n) asm volatile("s_waitcnt vmcnt(" #n ")" ::: "memory")
#define PG8_WAIT_L(n) asm volatile("s_waitcnt lgkmcnt(" #n ")" ::: "memory")
#define PG8_BAR __builtin_amdgcn_s_barrier()
#define PG8_SCHED __builtin_amdgcn_sched_barrier(0)
    Unit cur, nxt; int ui = 0;
    if (!S.next(0, cur)) return;
    f32x4 acc[2][2][4][2];
#pragma unroll
    for (int a = 0; a < 2; ++a)
#pragma unroll
        for (int b = 0; b < 2; ++b)
#pragma unroll
            for (int m = 0; m < 4; ++m)
#pragma unroll
                for (int n = 0; n < 2; ++n) acc[a][b][m][n] = (f32x4){0.f, 0.f, 0.f, 0.f};
    bf16x8 At[4][2], B0[2][2], B1[2][2]; i32x8 At8[4], B08[2], B18[2];
    const char* cA = S.a_ptr(cur); const char* cB = S.b_ptr(cur);
    unsigned gcur[2][2], gnxt[2][2];
#pragma unroll
    for (int h = 0; h < 2; ++h)
#pragma unroll
        for (int i = 0; i < 2; ++i) { if constexpr (GATHER) gcur[h][i] = S.a_rowoff(cur, h * HALF + rowA[i]) + colA[i]; else gcur[h][i] = voffA[i]; gnxt[h][i] = gcur[h][i]; }
    int rotc = S.krot(cur, nt), rotn = rotc;
#define PG8_KOFS(rot, j) ((size_t)(((j) + (rot)) >= nt ? ((j) + (rot) - nt) : ((j) + (rot))) * kstep)
    { const size_t k0 = PG8_KOFS(rotc, 0), k1 = PG8_KOFS(rotc, 1);
    PG8_STAGE_B(PG8_SB(0, 0), cB + k0); PG8_STAGE_B(PG8_SB(0, 1), cB + hstepB + k0); PG8_STAGE2(PG8_SA(0, 0), cA + k0, gcur[0][0], gcur[0][1]); PG8_STAGE2(PG8_SA(0, 1), cA + hstepA + k0, gcur[1][0], gcur[1][1]);
    if (wr == 1) PG8_BAR;
    PG8_WAIT_V(2); PG8_BAR;
    PG8_STAGE_B(PG8_SB(1, 0), cB + k1); PG8_STAGE2(PG8_SA(1, 0), cA + k1, gcur[0][0], gcur[0][1]); PG8_STAGE_B(PG8_SB(1, 1), cB + hstepB + k1);
    PG8_WAIT_V(6); PG8_BAR; }
    for (;;) {
        const bool has_next = S.next(ui + 1, nxt);
        const char* nA = has_next ? S.a_ptr(nxt) : cA; const char* nB = has_next ? S.b_ptr(nxt) : cB;
        rotn = has_next ? S.krot(nxt, nt) : rotc;
        const bool full = !HALFU || cur.nvalid > 128;
#pragma unroll 1
        for (int t = 0; t < nt; t += 2) {
            const bool last = (t == nt - 2);
            const bool fin = last && !has_next;
            const char* a1 = cA + PG8_KOFS(rotc, t + 1);
            const size_t k2 = last ? PG8_KOFS(rotn, 0) : PG8_KOFS(rotc, t + 2), k3 = last ? PG8_KOFS(rotn, 1) : PG8_KOFS(rotc, t + 3);
            const char* a2 = (last ? nA : cA) + k2; const char* b2 = (last ? nB : cB) + k2;
            const char* a3 = (last ? nA : cA) + k3; const char* b3 = (last ? nB : cB) + k3;
            unsigned o2[2][2];
#pragma unroll
            for (int h = 0; h < 2; ++h)
#pragma unroll
                for (int i = 0; i < 2; ++i) o2[h][i] = gcur[h][i];
            if constexpr (GATHER) {
                if (t == 0 && has_next) {
#pragma unroll
                    for (int h = 0; h < 2; ++h)
#pragma unroll
                        for (int i = 0; i < 2; ++i) gnxt[h][i] = S.a_rowoff(nxt, h * HALF + rowA[i]) + colA[i];
                }
                if (last && has_next) {
                    asm volatile("" : "+v"(gnxt[0][0]), "+v"(gnxt[0][1]), "+v"(gnxt[1][0]), "+v"(gnxt[1][1]));
#pragma unroll
                    for (int h = 0; h < 2; ++h)
#pragma unroll
                        for (int i = 0; i < 2; ++i) o2[h][i] = gnxt[h][i];
                }
            }
            PG8_LDB(B0, 0, 0); PG8_LDB(B1, 0, 1); PG8_SCHED; PG8_LDA(At, 0, 0); PG8_STAGE2(PG8_SA(1, 1), a1 + hstepA, gcur[1][0], gcur[1][1]);
            PG8_WAIT_V(8); PG8_WAIT_L(0); PG8_BAR; PG8_MMA(0, 0, At, B0); PG8_MMA(0, 1, At, B1); PG8_BAR; PG8_SCHED;
            if (full) { PG8_LDA(At, 0, 1); }
            if (!fin) { PG8_STAGE_B(PG8_SB(0, 0), b2); PG8_STAGE_B(PG8_SB(0, 1), b2 + hstepB); PG8_STAGE2(PG8_SA(0, 0), a2, o2[0][0], o2[0][1]); PG8_WAIT_V(8); }
            else { PG8_WAIT_V(2); }
            PG8_WAIT_L(0); PG8_BAR; if (full) { PG8_MMA(1, 0, At, B0); PG8_MMA(1, 1, At, B1); } PG8_BAR; PG8_SCHED;
            PG8_LDB(B0, 1, 0); PG8_LDB(B1, 1, 1); PG8_SCHED; PG8_LDA(At, 1, 0);
            if (!fin) { PG8_STAGE2(PG8_SA(0, 1), a2 + hstepA, o2[1][0], o2[1][1]); PG8_WAIT_V(8); } else { PG8_WAIT_V(0); }
            PG8_WAIT_L(0); PG8_BAR; PG8_MMA(0, 0, At, B0); PG8_MMA(0, 1, At, B1); PG8_BAR; PG8_SCHED;
            if (full) { PG8_LDA(At, 1, 1); }
            if (!fin) { PG8_STAGE_B(PG8_SB(1, 0), b3); PG8_STAGE_B(PG8_SB(1, 1), b3 + hstepB); PG8_STAGE2(PG8_SA(1, 0), a3, o2[0][0], o2[0][1]); PG8_WAIT_V(8); }
            PG8_WAIT_L(0); PG8_BAR; if (full) { PG8_MMA(1, 0, At, B0); PG8_MMA(1, 1, At, B1); } PG8_BAR; PG8_SCHED;
        }
        if (wr == 0) PG8_BAR;
        if constexpr (ESZ == 1) asm volatile("s_nop 15\n\ts_nop 15" ::: "memory");
        E(acc, cur, wr, wc, fr, fq);
        if (!has_next) break;
#pragma unroll
        for (int a = 0; a < 2; ++a)
#pragma unroll
            for (int b = 0; b < 2; ++b)
#pragma unroll
                for (int m = 0; m < 4; ++m)
#pragma unroll
                    for (int n = 0; n < 2; ++n) acc[a][b][m][n] = (f32x4){0.f, 0.f, 0.f, 0.f};
        cur = nxt; cA = nA; cB = nB; rotc = rotn; ++ui;
#pragma unroll
        for (int h = 0; h < 2; ++h)
#pragma unroll
            for (int i = 0; i < 2; ++i) gcur[h][i] = gnxt[h][i];
        if (wr == 1) PG8_BAR;
    }
    PG8_WAIT_V(0);
    PG8_BAR;
#undef PG8_KOFS
#undef PG8_SA
#undef PG8_SB
#undef PG8_STAGE2
#undef PG8_STAGE_B
#undef PG8_LDA
#undef PG8_LDB
#undef PG8_MMA
#undef PG8_WAIT_V
#undef PG8_WAIT_L
#undef PG8_BAR
#undef PG8_SCHED
}
}

constexpr int NWAVES = 8;
#ifndef MK_N_LAUNCHES
#define MK_N_LAUNCHES 1
#endif
#ifndef GATE_FP8
#define GATE_FP8 1
#endif
#ifndef PO_FP8
#define PO_FP8 1
#endif
#ifndef OUT_FP8
#define OUT_FP8 1
#endif
#ifndef GLU_FP8
#define GLU_FP8 1
#endif
#ifndef Z_FP8
#define Z_FP8 1
#endif
constexpr int NPH = 12;
constexpr int N_LAUNCHES = MK_N_LAUNCHES;

constexpr int BATCH = 4, SEQ = 4096, D = 2048, T = BATCH * SEQ;
constexpr int PW = 1024, SW = 1024, INW = PW + SW + 2 * D;
constexpr int NE = 32, TOPK = 4, FE = 2048;
constexpr int SG = 64, SP = 64, SH = 16, CL = 16, NCH = SEQ / CL;
constexpr int UGK = CL * SH + 2 * SP;
constexpr int LCAP = T;
constexpr int MAXBLK = 288;
constexpr float RMS_EPS = 1e-6f;

constexpr size_t MiB = 1u << 20;
constexpr size_t WS_CTL = 0, CTL_ZERO_BYTES = 32768;
constexpr size_t WS_MOD = 1 * MiB;
constexpr size_t WS_FMOD = WS_MOD + 196608, WS_AL = WS_MOD + 262144;
constexpr size_t WS_WIN = 2 * MiB, WS_POOLW = 26 * MiB, WS_WPO = 27 * MiB, WS_WGLU = 31 * MiB, WS_WOUT = 39 * MiB, WS_WEND = 47 * MiB, WS_TG = 55 * MiB;
constexpr size_t WS_W1 = 68 * MiB, WS_W2 = 580 * MiB;
constexpr size_t WS_XN = 836 * MiB, WS_UP = 900 * MiB, WS_UG = 932 * MiB, WS_SGP = 980 * MiB, WS_SGS = 1044 * MiB, WS_PL = 1108 * MiB, WS_PM = 1140 * MiB, WS_E = 1172 * MiB;
constexpr size_t WS_YPG = 1204 * MiB, WS_YS = 1268 * MiB, WS_MG = 1300 * MiB, WS_X1 = 1364 * MiB, WS_LTOK = 1492 * MiB, WS_LWT = 1494 * MiB, WS_TSLOT = 1496 * MiB;
constexpr size_t WS_ACT = 1498 * MiB, WS_YE = 1786 * MiB, WS_END = 2074 * MiB;
static_assert(WS_TG + (size_t)SG * 256 * UGK * 2 <= WS_W1 && WS_UG + (size_t)SG * 1024 * UGK * 2 <= WS_SGP && WS_ACT + (size_t)MAXBLK * 256 * FE * 2 <= WS_YE, "d_ws map");
constexpr int CW_TMO = 0, CW_CODE = 1, CW_CNT = 64, CW_BAR = 4096;

constexpr int RING_OFF = 0, RING_BYTES = 131072;
constexpr int LDSCTL_OFF = RING_BYTES, MISC_OFF = LDSCTL_OFF + 320;
constexpr int LDS_BYTES = 147456;

#define GAS __attribute__((address_space(1)))
#define LAS __attribute__((address_space(3)))
typedef unsigned short bf16;
typedef unsigned v4u __attribute__((ext_vector_type(4)));
typedef unsigned v2u __attribute__((ext_vector_type(2)));
typedef float f32x4 __attribute__((ext_vector_type(4)));
typedef float f32x16 __attribute__((ext_vector_type(16)));
typedef GAS unsigned gu32;
#define RLX_AGENT __ATOMIC_RELAXED, __HIP_MEMORY_SCOPE_AGENT
#define LDS_WAIT() asm volatile("s_waitcnt lgkmcnt(0)" ::: "memory")
#define VM_WAIT() asm volatile("s_waitcnt vmcnt(0)" ::: "memory")
using pg8::cvt_pk_bf16; using pg8::pk4_fp8; using pg8::pk4_u8; using pg8::pair16; using pg8::unpair16; using pg8::bf_lo; using pg8::bf_hi; using pg8::sigmoidf_; using pg8::gelu_tanh_;

#define XB_TMO      128
#define XB_XCNT(j)  (256  + 64 * (j))
#define XB_XSUB(j)  (1280 + 64 * (j))
#define XB_XGEN(j)  (2304 + 64 * (j))
#define XB_TOP      3328
#define XB_TOPGEN   3392
#define XCD_BAR_WORDS 3456
#define XB_SPIN_CAP (1u << 18)

__device__ __forceinline__ unsigned xb_ld(unsigned* p)              { return __hip_atomic_load(p, __ATOMIC_RELAXED, __HIP_MEMORY_SCOPE_AGENT); }
__device__ __forceinline__ unsigned xb_add(unsigned* p, unsigned v) { return __hip_atomic_fetch_add(p, v, __ATOMIC_RELAXED, __HIP_MEMORY_SCOPE_AGENT); }
__device__ __forceinline__ unsigned xb_xcc_id() { return (unsigned)__builtin_amdgcn_s_getreg((3 << 11) | 20) & 0xFu; }
#define XB_SPIN(cond, bar) do { unsigned _sp = 0; while (cond) { __builtin_amdgcn_s_sleep(1); \
    if ((++_sp & 255u) == 0u) { if (xb_ld(&(bar)[XB_TMO])) break; if (_sp > XB_SPIN_CAP) { atomicAdd(&(bar)[XB_TMO], 1u); break; } } } } while (0)

struct XcdBarrier { unsigned* bar; unsigned x; volatile LAS unsigned* st; };

__device__ __forceinline__ XcdBarrier xcd_barrier_post(unsigned* bar, volatile LAS unsigned* st) {
    XcdBarrier b; b.bar = bar; b.x = xb_xcc_id(); b.st = st;
    if (threadIdx.x == 0) (void)xb_add(&bar[XB_XCNT(b.x)], 1u);
    return b;
}
__device__ __forceinline__ void xcd_barrier_complete(unsigned* bar, unsigned x, unsigned& nloc, unsigned& nx) {
    const unsigned G = gridDim.x * gridDim.y * gridDim.z;
    unsigned sum, cnt, mine, sp = 0u;
    for (;;) {
        sum = 0u; cnt = 0u; mine = 0u;
#pragma unroll
        for (unsigned j = 0; j < 16; ++j) { const unsigned c = xb_ld(&bar[XB_XCNT(j)]); sum += c; cnt += (c > 0u) ? 1u : 0u; mine = (j == x) ? c : mine; }
        if (sum == G) break;
        __builtin_amdgcn_s_sleep(1);
        if ((++sp & 255u) == 0u) { if (xb_ld(&bar[XB_TMO])) break; if (sp > XB_SPIN_CAP) { atomicAdd(&bar[XB_TMO], 1u); break; } }
    }
    nloc = mine > 0u ? mine : 1u; nx = cnt > 0u ? cnt : 1u;
}
__device__ __forceinline__ void xcd_barrier(const XcdBarrier& b) {
    asm volatile("s_waitcnt vmcnt(0)" ::: "memory");
    __syncthreads();
    if (threadIdx.x == 0) {
        unsigned* bar = b.bar;
        __builtin_amdgcn_s_waitcnt(0);
        unsigned nloc = b.st[0], nx = b.st[1];
        if (nloc == 0u) { xcd_barrier_complete(bar, b.x, nloc, nx); b.st[0] = nloc; b.st[1] = nx; }
        const unsigned old = xb_add(&bar[XB_XSUB(b.x)], 1u);
        const unsigned gen = old / nloc;
        if (old + 1u == (gen + 1u) * nloc) {
            __builtin_amdgcn_fence(__ATOMIC_RELEASE, "agent");
            asm volatile("s_waitcnt vmcnt(0)" ::: "memory");
            const unsigned og = xb_add(&bar[XB_TOP], 1u);
            const unsigned tg = og / nx;
            if (og + 1u == (tg + 1u) * nx) xb_add(&bar[XB_TOPGEN], 1u);
            else XB_SPIN(xb_ld(&bar[XB_TOPGEN]) == tg, bar);
            __builtin_amdgcn_fence(__ATOMIC_ACQUIRE, "agent");
            xb_add(&bar[XB_XGEN(b.x)], 1u);
            asm volatile("s_waitcnt vmcnt(0)" ::: "memory");
        } else {
            XB_SPIN(xb_ld(&bar[XB_XGEN(b.x)]) == gen, bar);
            __builtin_amdgcn_fence(__ATOMIC_ACQUIRE, "agent");
            asm volatile("s_waitcnt vmcnt(0)" ::: "memory");
        }
    }
    __syncthreads();
}

using pg8::Unit;
struct SchedDense {
    const char* A; const char* Bt; size_t astep, bstep; int nM, nN, nwg, G, c;
    __device__ __forceinline__ void init(const void* A_, const void* Bt_, int M, int N, int lda, int ldb, int G_, int c_, int esz = 2) { A = (const char*)A_; Bt = (const char*)Bt_; astep = (size_t)256 * lda * esz; bstep = (size_t)256 * ldb * esz; nM = M / 256; nN = N / 256; nwg = nM * nN; G = G_; c = c_; }
    __device__ __forceinline__ bool next(int i, Unit& u) const {
        const long L = (long)i * G + c; if (L >= nwg) return false;
        int wgid = (int)L; { const int q = nwg / pg8::NXCD, r = nwg % pg8::NXCD, xcd = wgid % pg8::NXCD, off = wgid / pg8::NXCD; wgid = (xcd < r ? xcd * (q + 1) : r * (q + 1) + (xcd - r) * q) + off; }
        const int nig = pg8::WGM * nN, gid = wgid / nig, fm = gid * pg8::WGM, gsz = (nM - fm) < pg8::WGM ? (nM - fm) : pg8::WGM;
        u.pm = fm + ((wgid % nig) % gsz); u.pn = (wgid % nig) / gsz; u.e = 0; u.rb = 0; u.nvalid = 256; return true;
    }
    __device__ __forceinline__ const char* a_ptr(const Unit& u) const { return A + (size_t)u.pm * astep; }
    __device__ __forceinline__ const char* b_ptr(const Unit& u) const { return Bt + (size_t)u.pn * bstep; }
    __device__ __forceinline__ unsigned a_rowoff(const Unit&, int) const { return 0u; }
    __device__ __forceinline__ int krot(const Unit&, int) const { return 0; }
};
struct SchedGrouped {
    const char* A; const char* Bt; size_t astep, agstride, bgstride; int nPM, nunits, G, c;
    __device__ __forceinline__ void init(const void* A_, const void* Bt_, int lda, size_t agstride_, size_t bgstride_, int nPM_, int ngroups, int G_, int c_) { A = (const char*)A_; Bt = (const char*)Bt_; astep = (size_t)256 * lda * 2; agstride = agstride_; bgstride = bgstride_; nPM = nPM_; nunits = nPM_ * ngroups; G = G_; c = c_; }
    __device__ __forceinline__ bool next(int i, Unit& u) const { const int L = i * G + c; if (L >= nunits) return false; u.e = L / nPM; u.pm = L % nPM; u.pn = 0; u.rb = 0; u.nvalid = 256; return true; }
    __device__ __forceinline__ const char* a_ptr(const Unit& u) const { return A + (size_t)u.e * agstride + (size_t)u.pm * astep; }
    __device__ __forceinline__ const char* b_ptr(const Unit& u) const { return Bt + (size_t)u.e * bgstride; }
    __device__ __forceinline__ unsigned a_rowoff(const Unit&, int) const { return 0u; }
    __device__ __forceinline__ int krot(const Unit&, int) const { return 0; }
};
struct SchedMoe {
    const char* A; const char* Bt; size_t astep, bstep_e, bstep_n; int nN, G, c; volatile LAS unsigned* M; const int* ltok; bool gather;
    __device__ __forceinline__ bool next(int i, Unit& u) const {
        const int L = i * G + c; const int total = (int)M[176]; if (L >= total) return false;
        const int ln = threadIdx.x & 63; const int us1 = (int)M[33 + (ln & 31)];
        const int e = __builtin_popcountll(__ballot(ln < 32 && L >= us1));
        const int w = L - (int)M[32 + e], pb = (int)M[80 + e], nb = (int)M[80 + e + 1] - pb, cnt = (int)M[128 + e];
        int rb = w % nb, pn = w / nb;
        rb = __builtin_amdgcn_readfirstlane(rb); pn = __builtin_amdgcn_readfirstlane(pn);
        u.e = e; u.rb = rb; u.pn = pn; u.pm = __builtin_amdgcn_readfirstlane(pb + rb); const int nv = cnt - rb * 256; u.nvalid = __builtin_amdgcn_readfirstlane(nv < 256 ? nv : 256); return true;
    }
    __device__ __forceinline__ const char* a_ptr(const Unit& u) const { return gather ? A : A + (size_t)u.pm * astep; }
    __device__ __forceinline__ const char* b_ptr(const Unit& u) const { return Bt + (size_t)u.e * bstep_e + (size_t)u.pn * bstep_n; }
    __device__ __forceinline__ unsigned a_rowoff(const Unit& u, int r) const { const int idx = (r < u.nvalid) ? (u.rb * 256 + r) : 0; const int tok = ltok[(size_t)u.e * LCAP + idx]; return (unsigned)tok * (unsigned)D; }
    __device__ __forceinline__ int krot(const Unit& u, int nt) const { return (2 * u.rb + u.pn) % nt; }
};

using pg8::f32x2; using pg8::u32x4;
#define EPI_ARGS const f32x4 (&acc)[2][2][4][2], const Unit& u, int wr, int wc, int fr, int fq
struct EpiZ { static constexpr bool PERM = true; bf16 *UP, *UG, *SGP, *SGS; float asc;
    __device__ __forceinline__ void operator()(EPI_ARGS) const {
        const int pn = u.pn, region = pn < 4 ? 0 : (pn < 8 ? 1 : (pn < 16 ? 2 : 3));
        if (GATE_FP8 && region >= 2) {
            unsigned char* gb = (unsigned char*)(region == 2 ? SGP : SGS); const int cbase = (region == 2 ? pn - 8 : pn - 16) * 256;
#pragma unroll
            for (int ai = 0; ai < 2; ++ai)
#pragma unroll
                for (int bj = 0; bj < 2; ++bj)
#pragma unroll
                    for (int mp = 0; mp < 2; ++mp) { unsigned px[2], py[2];
#pragma unroll
                        for (int h = 0; h < 2; ++h) { const int m = 2 * mp + h; f32x4 v0 = acc[ai][bj][m][0] * asc, v1 = acc[ai][bj][m][1] * asc;
#pragma unroll
                            for (int j = 0; j < 4; ++j) { v0[j] = 255.0f * sigmoidf_(v0[j]); v1[j] = 255.0f * sigmoidf_(v1[j]); }
                            px[h] = pk4_u8(v0[0], v0[1], v0[2], v0[3]); py[h] = pk4_u8(v1[0], v1[1], v1[2], v1[3]); }
                        const u32x4 q = pair16(px[0], py[0], px[1], py[1]);
                        const int row = u.pm * 256 + ai * 128 + wr * 64 + (2 * mp + (fq & 1)) * 16 + fr;
                        *(u32x4*)(gb + (size_t)row * D + cbase + bj * 128 + wc * 32 + 8 * (fq & ~1)) = q; }
            return;
        }
#pragma unroll
        for (int ai = 0; ai < 2; ++ai)
#pragma unroll
            for (int m = 0; m < 4; ++m) { const int row = u.pm * 256 + ai * 128 + wr * 64 + m * 16 + fr;
#pragma unroll
                for (int bj = 0; bj < 2; ++bj) { const int lc = bj * 128 + wc * 32 + 8 * fq; f32x4 v0 = acc[ai][bj][m][0] * asc, v1 = acc[ai][bj][m][1] * asc;
                    if (region >= 2) {
#pragma unroll
                        for (int j = 0; j < 4; ++j) { v0[j] = sigmoidf_(v0[j]); v1[j] = sigmoidf_(v1[j]); } }
                    u32x4 w; w.x = cvt_pk_bf16(v0[0], v0[1]); w.y = cvt_pk_bf16(v0[2], v0[3]); w.z = cvt_pk_bf16(v1[0], v1[1]); w.w = cvt_pk_bf16(v1[2], v1[3]);
                    bf16* dst;
                    if (region == 0) dst = UP + (size_t)row * PW + pn * 256 + lc;
                    else if (region == 1) { const int j = (pn - 4) * 256 + lc, g = j >> 4, h0 = j & 15, b = row >> 12, tp = row & 4095, c = tp >> 4, s = tp & 15; dst = UG + ((size_t)(g * 1024 + b * 256 + c) * UGK + s * 16 + h0); }
                    else if (region == 2) dst = SGP + (size_t)row * D + (pn - 8) * 256 + lc;
                    else dst = SGS + (size_t)row * D + (pn - 16) * 256 + lc;
                    *(u32x4*)dst = w; } }
    }
};
struct EpiS1 { static constexpr bool PERM = false; float* E;
    __device__ __forceinline__ void operator()(EPI_ARGS) const {
#pragma unroll
        for (int ai = 0; ai < 2; ++ai)
#pragma unroll
            for (int m = 0; m < 4; ++m) { const int row = u.pm * 256 + ai * 128 + wr * 64 + m * 16 + fr; float* rp = E + ((size_t)u.e * 1024 + row) * 128 + wc * 32 + 4 * fq;
#pragma unroll
                for (int n = 0; n < 2; ++n) *(f32x4*)(rp + n * 16) = acc[ai][0][m][n]; }
    }
};
struct EpiPmix { static constexpr bool PERM = true; bf16* PM; const float* scale;
    __device__ __forceinline__ void operator()(EPI_ARGS) const {
#pragma unroll
        for (int bj = 0; bj < 2; ++bj) { const int col = u.e * 256 + bj * 128 + wc * 32 + 8 * fq; const f32x4 s0 = *(const f32x4*)(scale + col), s1 = *(const f32x4*)(scale + col + 4);
#pragma unroll
            for (int ai = 0; ai < 2; ++ai)
#pragma unroll
                for (int m = 0; m < 4; ++m) { const int row = u.pm * 256 + ai * 128 + wr * 64 + m * 16 + fr; const f32x4 v0 = acc[ai][bj][m][0] * s0, v1 = acc[ai][bj][m][1] * s1;
                    if (PO_FP8) { v2u w; w.x = pk4_fp8(v0[0], v0[1], v0[2], v0[3]); w.y = pk4_fp8(v1[0], v1[1], v1[2], v1[3]); *(v2u*)((unsigned char*)PM + (size_t)row * PW + col) = w; }
                    else { u32x4 w; w.x = cvt_pk_bf16(v0[0], v0[1]); w.y = cvt_pk_bf16(v0[2], v0[3]); w.z = cvt_pk_bf16(v1[0], v1[1]); w.w = cvt_pk_bf16(v1[2], v1[3]);
                    *(u32x4*)(PM + (size_t)row * PW + col) = w; } } }
    }
};
struct EpiS3 { static constexpr bool PERM = true; bf16* YS;
    __device__ __forceinline__ void operator()(EPI_ARGS) const {
#pragma unroll
        for (int ai = 0; ai < 2; ++ai)
#pragma unroll
            for (int bj = 0; bj < 2; ++bj) { const int lc = bj * 128 + wc * 32 + 8 * fq, t = lc >> 4, h0 = lc & 15;
#pragma unroll
                for (int mp = 0; mp < 2; ++mp) { unsigned px[2], py[2];
#pragma unroll
                    for (int h = 0; h < 2; ++h) { const int m = 2 * mp + h; f32x4 v0 = acc[ai][bj][m][0], v1 = acc[ai][bj][m][1];
#pragma unroll
                        for (int j = 0; j < 4; ++j) { v0[j] = gelu_tanh_(v0[j]); v1[j] = gelu_tanh_(v1[j]); }
                        if (GLU_FP8) { px[h] = pk4_fp8(v0[0], v0[1], v0[2], v0[3]); py[h] = pk4_fp8(v1[0], v1[1], v1[2], v1[3]); }
                        else { const int r = u.pm * 256 + ai * 128 + wr * 64 + m * 16 + fr, b = r >> 8, c = r & 255; u32x4 w; w.x = cvt_pk_bf16(v0[0], v0[1]); w.y = cvt_pk_bf16(v0[2], v0[3]); w.z = cvt_pk_bf16(v1[0], v1[1]); w.w = cvt_pk_bf16(v1[2], v1[3]);
                            *(u32x4*)(YS + (size_t)(b * SEQ + c * CL + t) * SW + u.e * 16 + h0) = w; } }
                    if (GLU_FP8) { const u32x4 q = pair16(px[0], py[0], px[1], py[1]);
                        const int r = u.pm * 256 + ai * 128 + wr * 64 + (2 * mp + (fq & 1)) * 16 + fr, b = r >> 8, c = r & 255;
                        *(u32x4*)((unsigned char*)YS + (size_t)(b * SEQ + c * CL + t) * SW + u.e * 16) = q; } } }
    }
};
#define EPI_ALD16(dst_, ptr_) asm volatile("global_load_dwordx4 %0, %1, off" : "=v"(dst_) : "v"(ptr_))
struct EpiYpool { static constexpr bool PERM = true; bf16* YPG; const bf16* SGP; float asc;
    __device__ __forceinline__ void operator()(EPI_ARGS) const {
        u32x4 glq[2][2][2];
        if (GATE_FP8) {
#pragma unroll
            for (int ai = 0; ai < 2; ++ai)
#pragma unroll
                for (int bj = 0; bj < 2; ++bj)
#pragma unroll
                    for (int mp = 0; mp < 2; ++mp) { const int rowq = u.pm * 256 + ai * 128 + wr * 64 + (2 * mp + (fq & 1)) * 16 + fr;
                        const unsigned char* gp = (const unsigned char*)SGP + (size_t)rowq * D + u.pn * 256 + bj * 128 + wc * 32 + 8 * (fq & ~1); EPI_ALD16(glq[ai][bj][mp], gp); }
            asm volatile("s_waitcnt vmcnt(0)" : "+v"(glq[0][0][0]), "+v"(glq[0][0][1]), "+v"(glq[0][1][0]), "+v"(glq[0][1][1]), "+v"(glq[1][0][0]), "+v"(glq[1][0][1]), "+v"(glq[1][1][0]), "+v"(glq[1][1][1])); }
#pragma unroll
        for (int ai = 0; ai < 2; ++ai)
#pragma unroll
            for (int bj = 0; bj < 2; ++bj) { const int colb = u.pn * 256 + bj * 128 + wc * 32;
#pragma unroll
                for (int mp = 0; mp < 2; ++mp) { unsigned gq[2][2] = {{0u, 0u}, {0u, 0u}};
                    if (GATE_FP8) unpair16(glq[ai][bj][mp], gq[0][0], gq[0][1], gq[1][0], gq[1][1]);
#pragma unroll
                    for (int h = 0; h < 2; ++h) { const int m = 2 * mp + h; const int row = u.pm * 256 + ai * 128 + wr * 64 + m * 16 + fr; const size_t off = (size_t)row * D + colb + 8 * fq;
                        float gg[8];
                        if (GATE_FP8) { const unsigned gx = gq[h][0], gy = gq[h][1]; const float k255 = 1.0f / 255.0f;
                            gg[0] = (float)(gx & 0xffu) * k255; gg[1] = (float)((gx >> 8) & 0xffu) * k255; gg[2] = (float)((gx >> 16) & 0xffu) * k255; gg[3] = (float)(gx >> 24) * k255;
                            gg[4] = (float)(gy & 0xffu) * k255; gg[5] = (float)((gy >> 8) & 0xffu) * k255; gg[6] = (float)((gy >> 16) & 0xffu) * k255; gg[7] = (float)(gy >> 24) * k255; }
                        else { const u32x4 g = *(const u32x4*)(SGP + off); gg[0] = bf_lo(g.x); gg[1] = bf_hi(g.x); gg[2] = bf_lo(g.y); gg[3] = bf_hi(g.y); gg[4] = bf_lo(g.z); gg[5] = bf_hi(g.z); gg[6] = bf_lo(g.w); gg[7] = bf_hi(g.w); }
                        const f32x4 v0 = acc[ai][bj][m][0] * asc, v1 = acc[ai][bj][m][1] * asc;
                        u32x4 w; w.x = cvt_pk_bf16(v0[0] * gg[0], v0[1] * gg[1]); w.y = cvt_pk_bf16(v0[2] * gg[2], v0[3] * gg[3]);
                        w.z = cvt_pk_bf16(v1[0] * gg[4], v1[1] * gg[5]); w.w = cvt_pk_bf16(v1[2] * gg[6], v1[3] * gg[7]);
                        *(u32x4*)(YPG + off) = w; } } }
    }
};
struct EpiGlu { static constexpr bool PERM = true; bf16* MG; const bf16 *YPG, *SGS; const float* bglu; float asc;
    __device__ __forceinline__ void operator()(EPI_ARGS) const {
        const int j0 = u.pn * 128 + wc * 32 + 8 * fq, j0q = u.pn * 128 + wc * 32 + 8 * (fq & ~1);
        f32x4 ba0, ba1, bb0, bb1; u32x4 glq[2][2], ypq[2][2][2];
        EPI_ALD16(ba0, bglu + j0); EPI_ALD16(ba1, bglu + j0 + 4); EPI_ALD16(bb0, bglu + D + j0); EPI_ALD16(bb1, bglu + D + j0 + 4);
#pragma unroll
        for (int ai = 0; ai < 2; ++ai)
#pragma unroll
            for (int mp = 0; mp < 2; ++mp) {
                if (GATE_FP8) { const int rowq = u.pm * 256 + ai * 128 + wr * 64 + (2 * mp + (fq & 1)) * 16 + fr;
                    const unsigned char* gp = (const unsigned char*)SGS + (size_t)rowq * D + j0q; EPI_ALD16(glq[ai][mp], gp); }
#pragma unroll
                for (int h = 0; h < 2; ++h) { const int row = u.pm * 256 + ai * 128 + wr * 64 + (2 * mp + h) * 16 + fr; const bf16* yq = YPG + (size_t)row * D + j0; EPI_ALD16(ypq[ai][mp][h], yq); } }
        asm volatile("s_waitcnt vmcnt(0)" : "+v"(ba0), "+v"(ba1), "+v"(bb0), "+v"(bb1), "+v"(ypq[0][0][0]), "+v"(ypq[0][0][1]), "+v"(ypq[0][1][0]), "+v"(ypq[0][1][1]), "+v"(ypq[1][0][0]), "+v"(ypq[1][0][1]), "+v"(ypq[1][1][0]), "+v"(ypq[1][1][1]));
        if (GATE_FP8) asm volatile("" : "+v"(glq[0][0]), "+v"(glq[0][1]), "+v"(glq[1][0]), "+v"(glq[1][1]));
#pragma unroll
        for (int ai = 0; ai < 2; ++ai)
#pragma unroll
            for (int mp = 0; mp < 2; ++mp) { unsigned px[2], py[2]; unsigned gq[2][2] = {{0u, 0u}, {0u, 0u}};
                if (GATE_FP8) unpair16(glq[ai][mp], gq[0][0], gq[0][1], gq[1][0], gq[1][1]);
#pragma unroll
                for (int h = 0; h < 2; ++h) { const int m = 2 * mp + h; const int row = u.pm * 256 + ai * 128 + wr * 64 + m * 16 + fr; const size_t off = (size_t)row * D + j0;
                    const u32x4 yp = ypq[ai][mp][h]; float gsf[8];
                    if (GATE_FP8) { v2u g8; g8.x = gq[h][0]; g8.y = gq[h][1]; const float k255 = 1.0f / 255.0f;
                        gsf[0] = (float)(g8.x & 0xffu) * k255; gsf[1] = (float)((g8.x >> 8) & 0xffu) * k255; gsf[2] = (float)((g8.x >> 16) & 0xffu) * k255; gsf[3] = (float)(g8.x >> 24) * k255;
                        gsf[4] = (float)(g8.y & 0xffu) * k255; gsf[5] = (float)((g8.y >> 8) & 0xffu) * k255; gsf[6] = (float)((g8.y >> 16) & 0xffu) * k255; gsf[7] = (float)(g8.y >> 24) * k255; }
                    else { const u32x4 gs = *(const u32x4*)(SGS + off); gsf[0] = bf_lo(gs.x); gsf[1] = bf_hi(gs.x); gsf[2] = bf_lo(gs.y); gsf[3] = bf_hi(gs.y); gsf[4] = bf_lo(gs.z); gsf[5] = bf_hi(gs.z); gsf[6] = bf_lo(gs.w); gsf[7] = bf_hi(gs.w); }
                    const f32x4 a0 = acc[ai][0][m][0] * asc + ba0, a1 = acc[ai][0][m][1] * asc + ba1, b0 = acc[ai][1][m][0] * asc + bb0, b1 = acc[ai][1][m][1] * asc + bb1;
                    float o[8];
#pragma unroll
                    for (int j = 0; j < 4; ++j) { o[j] = a0[j] * sigmoidf_(b0[j]); o[4 + j] = a1[j] * sigmoidf_(b1[j]); }
                    float mo[8] = {bf_lo(yp.x) + gsf[0] * o[0], bf_hi(yp.x) + gsf[1] * o[1], bf_lo(yp.y) + gsf[2] * o[2], bf_hi(yp.y) + gsf[3] * o[3],
                                   bf_lo(yp.z) + gsf[4] * o[4], bf_hi(yp.z) + gsf[5] * o[5], bf_lo(yp.w) + gsf[6] * o[6], bf_hi(yp.w) + gsf[7] * o[7]};
                    if (OUT_FP8) { px[h] = pk4_fp8(mo[0], mo[1], mo[2], mo[3]); py[h] = pk4_fp8(mo[4], mo[5], mo[6], mo[7]); }
                    else { u32x4 w; w.x = cvt_pk_bf16(mo[0], mo[1]); w.y = cvt_pk_bf16(mo[2], mo[3]); w.z = cvt_pk_bf16(mo[4], mo[5]); w.w = cvt_pk_bf16(mo[6], mo[7]); *(u32x4*)(MG + off) = w; } }
                if (OUT_FP8) { const u32x4 q = pair16(px[0], py[0], px[1], py[1]);
                    const int row = u.pm * 256 + ai * 128 + wr * 64 + (2 * mp + (fq & 1)) * 16 + fr; *(u32x4*)((unsigned char*)MG + (size_t)row * D + j0q) = q; } }
    }
};
struct EpiMix { static constexpr bool PERM = true; bf16* X1; float asc; const float* gtm; const float* xin;
    __device__ __forceinline__ void operator()(EPI_ARGS) const {
        const float* gb = gtm + (size_t)(u.pm >> 4) * 6 * D;
        const float* xt = xin + (size_t)u.pm * 256 * D + u.pn * 256;
#pragma unroll
        for (int bj = 0; bj < 2; ++bj) { const int col = u.pn * 256 + bj * 128 + wc * 32 + 8 * fq; f32x4 g0, g1, xv[2][4][2];
            EPI_ALD16(g0, gb + col); EPI_ALD16(g1, gb + col + 4);
#pragma unroll
            for (int ai = 0; ai < 2; ++ai)
#pragma unroll
                for (int m = 0; m < 4; ++m) { const unsigned xo = (unsigned)((ai * 128 + wr * 64 + m * 16 + fr) * D + col - u.pn * 256) * 4u;
                    asm volatile("global_load_dwordx4 %0, %1, %2" : "=v"(xv[ai][m][0]) : "v"(xo), "s"(xt)); asm volatile("global_load_dwordx4 %0, %1, %2 offset:16" : "=v"(xv[ai][m][1]) : "v"(xo), "s"(xt)); }
            asm volatile("s_waitcnt vmcnt(0)" : "+v"(g0), "+v"(g1), "+v"(xv[0][0][0]), "+v"(xv[0][0][1]), "+v"(xv[0][1][0]), "+v"(xv[0][1][1]), "+v"(xv[0][2][0]), "+v"(xv[0][2][1]), "+v"(xv[0][3][0]), "+v"(xv[0][3][1]));
            asm volatile("" : "+v"(xv[1][0][0]), "+v"(xv[1][0][1]), "+v"(xv[1][1][0]), "+v"(xv[1][1][1]), "+v"(xv[1][2][0]), "+v"(xv[1][2][1]), "+v"(xv[1][3][0]), "+v"(xv[1][3][1]));
            g0 = g0 * asc; g1 = g1 * asc;
#pragma unroll
            for (int ai = 0; ai < 2; ++ai)
#pragma unroll
                for (int m = 0; m < 4; ++m) { const int row = u.pm * 256 + ai * 128 + wr * 64 + m * 16 + fr; const f32x4 v0 = xv[ai][m][0] + acc[ai][bj][m][0] * g0, v1 = xv[ai][m][1] + acc[ai][bj][m][1] * g1;
                    u32x4 w; w.x = cvt_pk_bf16(v0[0], v0[1]); w.y = cvt_pk_bf16(v0[2], v0[3]); w.z = cvt_pk_bf16(v1[0], v1[1]); w.w = cvt_pk_bf16(v1[2], v1[3]);
                    *(u32x4*)(X1 + (size_t)row * D + col) = w; } }
    }
};
struct EpiMoe1 { static constexpr bool PERM = true; unsigned char* ACT; const float* b1;
    __device__ __forceinline__ void operator()(EPI_ARGS) const {
        const int j0 = u.pn * 128 + wc * 32 + 8 * fq; const float* bb = b1 + (size_t)u.e * 2 * FE;
        const f32x4 ba0 = *(const f32x4*)(bb + j0), ba1 = *(const f32x4*)(bb + j0 + 4), bl0 = *(const f32x4*)(bb + FE + j0), bl1 = *(const f32x4*)(bb + FE + j0 + 4);
        const int j0q = u.pn * 128 + wc * 32 + 8 * (fq & ~1);
#pragma unroll
        for (int ai = 0; ai < 2; ++ai)
#pragma unroll
            for (int mp = 0; mp < 2; ++mp) { unsigned px[2], py[2];
#pragma unroll
                for (int h = 0; h < 2; ++h) { const int m = 2 * mp + h;
                    const f32x4 a0 = acc[ai][0][m][0] * 0.03125f + ba0, a1 = acc[ai][0][m][1] * 0.03125f + ba1, l0 = acc[ai][1][m][0] * 0.03125f + bl0, l1 = acc[ai][1][m][1] * 0.03125f + bl1;
                    float o[8];
#pragma unroll
                    for (int j = 0; j < 4; ++j) { const float g0 = fminf(a0[j], 7.0f), g1 = fminf(a1[j], 7.0f), x0 = fminf(fmaxf(l0[j], -7.0f), 7.0f), x1 = fminf(fmaxf(l1[j], -7.0f), 7.0f);
                        o[j] = g0 * sigmoidf_(1.702f * g0) * (x0 + 1.0f); o[4 + j] = g1 * sigmoidf_(1.702f * g1) * (x1 + 1.0f); }
                    px[h] = pk4_fp8(o[0], o[1], o[2], o[3]); py[h] = pk4_fp8(o[4], o[5], o[6], o[7]); }
                const u32x4 q = pair16(px[0], py[0], px[1], py[1]);
                const int row = u.pm * 256 + ai * 128 + wr * 64 + (2 * mp + (fq & 1)) * 16 + fr;
                *(u32x4*)(ACT + (size_t)row * FE + j0q) = q; }
    }
};
struct EpiMoe2 { static constexpr bool PERM = true; unsigned char* YE; const float* b2; const float* lwt;
    __device__ __forceinline__ void operator()(EPI_ARGS) const {
        const float* bb = b2 + (size_t)u.e * D; const float* lw = lwt + (size_t)u.e * LCAP + u.rb * 256;
        float wg[2][4]; f32x4 cb[2][2];
#pragma unroll
        for (int ai = 0; ai < 2; ++ai)
#pragma unroll
            for (int m = 0; m < 4; ++m) { const float* p_ = lw + (ai * 128 + wr * 64 + m * 16 + fr); asm volatile("global_load_dword %0, %1, off" : "=v"(wg[ai][m]) : "v"(p_)); }
#pragma unroll
        for (int bj = 0; bj < 2; ++bj) { const float* p_ = bb + u.pn * 256 + bj * 128 + wc * 32 + 8 * fq; EPI_ALD16(cb[bj][0], p_); EPI_ALD16(cb[bj][1], p_ + 4); }
        asm volatile("s_waitcnt vmcnt(0)" : "+v"(wg[0][0]), "+v"(wg[0][1]), "+v"(wg[0][2]), "+v"(wg[0][3]), "+v"(wg[1][0]), "+v"(wg[1][1]), "+v"(wg[1][2]), "+v"(wg[1][3]), "+v"(cb[0][0]), "+v"(cb[0][1]), "+v"(cb[1][0]), "+v"(cb[1][1]));
#pragma unroll
        for (int ai = 0; ai < 2; ++ai)
#pragma unroll
            for (int m = 0; m < 4; ++m) { const int r = ai * 128 + wr * 64 + m * 16 + fr; wg[ai][m] = (r < u.nvalid) ? 16.0f * wg[ai][m] : 0.0f; }
#pragma unroll
        for (int bj = 0; bj < 2; ++bj) { const f32x4 c0 = cb[bj][0], c1 = cb[bj][1];
            const int colq = u.pn * 256 + bj * 128 + wc * 32 + 8 * (fq & ~1);
#pragma unroll
            for (int ai = 0; ai < 2; ++ai)
#pragma unroll
                for (int mp = 0; mp < 2; ++mp) { unsigned px[2], py[2];
#pragma unroll
                    for (int h = 0; h < 2; ++h) { const int m = 2 * mp + h; const f32x4 v0 = (acc[ai][bj][m][0] * 0.03125f + c0) * wg[ai][m], v1 = (acc[ai][bj][m][1] * 0.03125f + c1) * wg[ai][m];
                        px[h] = pk4_fp8(v0[0], v0[1], v0[2], v0[3]); py[h] = pk4_fp8(v1[0], v1[1], v1[2], v1[3]); }
                    const u32x4 q = pair16(px[0], py[0], px[1], py[1]);
                    const int r = ai * 128 + wr * 64 + (2 * mp + (fq & 1)) * 16 + fr;
                    *(u32x4*)(YE + ((size_t)u.pm * 256 + r) * D + colq) = q; } }
    }
};

__device__ __forceinline__ float wave_sum(float v) {
#pragma unroll
    for (int o = 1; o < 64; o <<= 1) v += __shfl_xor(v, o);
    return v;
}
__device__ __forceinline__ void tr_item(const float* __restrict__ W, int K, int N, bf16* WT, int item, int lane, int mode) {
    const int nblk = N >> 6, kb = item / nblk, nb = item - kb * nblk, k0 = kb * 64, n = nb * 64 + lane;
    int drow = n;
    if (mode) { const int half = N >> 1, hi = n >= half ? 1 : 0, nn = n - hi * half; drow = (nn >> 7) * 256 + hi * 128 + (nn & 127); }
    const float* src = W + (size_t)k0 * N + n;
    float v[64];
#pragma unroll
    for (int i = 0; i < 64; ++i) v[i] = src[(size_t)i * N];
    bf16* dst = WT + (size_t)drow * K + k0;
#pragma unroll
    for (int j = 0; j < 8; ++j) { v4u o; o.x = cvt_pk_bf16(v[8 * j], v[8 * j + 1]); o.y = cvt_pk_bf16(v[8 * j + 2], v[8 * j + 3]); o.z = cvt_pk_bf16(v[8 * j + 4], v[8 * j + 5]); o.w = cvt_pk_bf16(v[8 * j + 6], v[8 * j + 7]);
        *(v4u*)(dst + 8 * j) = o; }
}

template <int W> __device__ __forceinline__ void pool_item(const bf16* ub, unsigned voff, bf16* pl, int t0) {
    constexpr int NR = 15 + W;
    v4u R[NR];
#pragma unroll
    for (int i = 0; i < NR; ++i) { const bf16* p_ = ub + (size_t)i * PW; asm volatile("global_load_dwordx4 %0, %1, %2" : "=v"(R[i]) : "v"(voff), "s"(p_)); }
#pragma unroll
    for (int i0 = 0; i0 < NR; i0 += 8) {
        if (i0 == 0) asm volatile("s_waitcnt vmcnt(0)" : "+v"(R[0]), "+v"(R[1]), "+v"(R[2]), "+v"(R[3]), "+v"(R[4]), "+v"(R[5]), "+v"(R[6]), "+v"(R[7]));
        else if (i0 + 8 <= NR) asm volatile("" : "+v"(R[i0]), "+v"(R[i0 + 1]), "+v"(R[i0 + 2]), "+v"(R[i0 + 3]), "+v"(R[i0 + 4]), "+v"(R[i0 + 5]), "+v"(R[i0 + 6]), "+v"(R[i0 + 7]));
        else {
#pragma unroll
            for (int i = i0; i < NR; ++i) asm volatile("" : "+v"(R[i])); } }
#pragma unroll
    for (int i = 0; i < W - 1; ++i) { if (t0 - (W - 1) + i < 0) R[i] = (v4u){0u, 0u, 0u, 0u}; }
    float Sx[8] = {0.f, 0.f, 0.f, 0.f, 0.f, 0.f, 0.f, 0.f};
#pragma unroll
    for (int i = 0; i < W - 1; ++i) { Sx[0] += bf_lo(R[i].x); Sx[1] += bf_hi(R[i].x); Sx[2] += bf_lo(R[i].y); Sx[3] += bf_hi(R[i].y); Sx[4] += bf_lo(R[i].z); Sx[5] += bf_hi(R[i].z); Sx[6] += bf_lo(R[i].w); Sx[7] += bf_hi(R[i].w); }
#pragma unroll
    for (int tt = 0; tt < 16; ++tt) { const int tp = t0 + tt; const v4u q = R[tt + W - 1];
        const float uu[8] = {bf_lo(q.x), bf_hi(q.x), bf_lo(q.y), bf_hi(q.y), bf_lo(q.z), bf_hi(q.z), bf_lo(q.w), bf_hi(q.w)};
        const float rc = 1.0f / (float)((tp + 1) < W ? (tp + 1) : W); float o[8];
#pragma unroll
        for (int j = 0; j < 8; ++j) { Sx[j] += uu[j]; o[j] = Sx[j] * rc - uu[j]; }
        v4u ov; ov.x = cvt_pk_bf16(o[0], o[1]); ov.y = cvt_pk_bf16(o[2], o[3]); ov.z = cvt_pk_bf16(o[4], o[5]); ov.w = cvt_pk_bf16(o[6], o[7]);
        *(v4u*)(pl + (size_t)tp * PW) = ov;
        v4u q2 = R[tt];
        asm volatile("" : "+v"(q2.x), "+v"(q2.y), "+v"(q2.z), "+v"(q2.w));
        Sx[0] -= bf_lo(q2.x); Sx[1] -= bf_hi(q2.x); Sx[2] -= bf_lo(q2.y); Sx[3] -= bf_hi(q2.y); Sx[4] -= bf_lo(q2.z); Sx[5] -= bf_hi(q2.z); Sx[6] -= bf_lo(q2.w); Sx[7] -= bf_hi(q2.w); }
}

struct Args { const void* in[30]; float* out; unsigned char* ws; int ph_lo, ph_hi, li, pad; };

__global__ void __launch_bounds__(NWAVES * 64, 2) fwd_kernel(Args args) {
    extern __shared__ __attribute__((aligned(16))) unsigned char lds_raw[];
    LAS unsigned char* lds = (LAS unsigned char*)lds_raw;
    volatile LAS unsigned* MISC = (volatile LAS unsigned*)(lds + MISC_OFF);
    const int tid = threadIdx.x, lane = tid & 63, wave = __builtin_amdgcn_readfirstlane(tid >> 6);
    const int G = gridDim.x; const int bx = blockIdx.x; const int vcu = (G % 8 == 0) ? (bx % 8) * (G / 8) + bx / 8 : bx;
    gu32* ctl = (gu32*)(args.ws + WS_CTL);
#define KARG_PTR(off_) (*(void* const __attribute__((address_space(4)))*)(kp_ + (off_)))
#define PH_PTRS() const __attribute__((address_space(4))) char* kp_ = (const __attribute__((address_space(4))) char*)__builtin_amdgcn_kernarg_segment_ptr(); asm volatile("" : "+s"(kp_)); \
    unsigned char* ws = (unsigned char*)KARG_PTR(248); const float* x = (const float*)KARG_PTR(0); const float* cin = (const float*)KARG_PTR(8); const float* ada_w = (const float*)KARG_PTR(16); const float* ada_b = (const float*)KARG_PTR(24); const float* norm1_g = (const float*)KARG_PTR(32); const float* w_in = (const float*)KARG_PTR(40); const float* pool_w = (const float*)KARG_PTR(48); const float* pool_scale = (const float*)KARG_PTR(56); const float* w_pool_out = (const float*)KARG_PTR(64); const float* lam_re = (const float*)KARG_PTR(72); const float* lam_im = (const float*)KARG_PTR(80); const float* log_dt = (const float*)KARG_PTR(88); const float* sb_re = (const float*)KARG_PTR(96); const float* sb_im = (const float*)KARG_PTR(104); const float* sc_re = (const float*)KARG_PTR(112); const float* sc_im = (const float*)KARG_PTR(120); const float* ssm_d = (const float*)KARG_PTR(128); const float* w_glu = (const float*)KARG_PTR(136); const float* b_glu = (const float*)KARG_PTR(144); const float* w_out = (const float*)KARG_PTR(152); const float* norm2_g = (const float*)KARG_PTR(160); const float* w_router = (const float*)KARG_PTR(168); const float* b_router = (const float*)KARG_PTR(176); const float* w1 = (const float*)KARG_PTR(184); const float* b1 = (const float*)KARG_PTR(192); const float* w2 = (const float*)KARG_PTR(200); const float* b2 = (const float*)KARG_PTR(208); const float* fada_w = (const float*)KARG_PTR(216); const float* fada_b = (const float*)KARG_PTR(224); const float* fnorm_g = (const float*)KARG_PTR(232); float* out = (float*)KARG_PTR(240); float* MOD = (float*)(ws + WS_MOD); float* FMOD = (float*)(ws + WS_FMOD); float* AL = (float*)(ws + WS_AL); float* MODP = (float*)(ws + WS_ACT); bf16* WinT = (bf16*)(ws + WS_WIN); bf16* PoolWT = (bf16*)(ws + WS_POOLW); bf16* WpoT = (bf16*)(ws + WS_WPO); bf16* WgluT = (bf16*)(ws + WS_WGLU); bf16* WoutT = (bf16*)(ws + WS_WOUT); bf16* WendT = (bf16*)(ws + WS_WEND); bf16* TG = (bf16*)(ws + WS_TG); unsigned char* W1T8 = ws + WS_W1; unsigned char* W2T8 = ws + WS_W2; bf16* XN = (bf16*)(ws + WS_XN); bf16* UP = (bf16*)(ws + WS_UP); bf16* UG = (bf16*)(ws + WS_UG); bf16* SGP = (bf16*)(ws + WS_SGP); bf16* SGS = (bf16*)(ws + WS_SGS); bf16* PL = (bf16*)(ws + WS_PL); bf16* PM = (bf16*)(ws + WS_PM); float* EB = (float*)(ws + WS_E); bf16* YPG = (bf16*)(ws + WS_YPG); bf16* YS = (bf16*)(ws + WS_YS); bf16* MG = (bf16*)(ws + WS_MG); bf16* X1B = (bf16*)(ws + WS_X1); int* LTOK = (int*)(ws + WS_LTOK); float* LWT = (float*)(ws + WS_LWT); int* TSLOT = (int*)(ws + WS_TSLOT); unsigned char* ACT8 = ws + WS_ACT; unsigned char* YE = ws + WS_YE; unsigned char* XN8 = ws + WS_XN;
    for (int u = tid; u < (LDS_BYTES - LDSCTL_OFF) / 4; u += NWAVES * 64) ((LAS unsigned*)(lds + LDSCTL_OFF))[u] = 0u;
    __syncthreads();
    XcdBarrier bar; bar.bar = (unsigned*)(ctl + CW_BAR); bar.x = 0; bar.st = nullptr;
    if (N_LAUNCHES == 1) bar = xcd_barrier_post((unsigned*)(ctl + CW_BAR), MISC + 8);
#define GRID_BAR() do { if (N_LAUNCHES == 1) xcd_barrier(bar); } while (0)
    const int lo = args.ph_lo, hi = args.ph_hi;
#ifndef PHSEL
#define PHSEL -1
#endif
#define IN(k) (PHSEL < 0 ? (lo <= (k) && (k) < hi) : ((k) == PHSEL))
#define BOTH(k) (IN(k) && IN((k) + 1))
#ifndef DUPSEL
#define DUPSEL -1
#endif
#define REP(k) ((DUPSEL == (k)) ? 2 : 1)
    const int gw = vcu * NWAVES + wave, NGW = G * NWAVES;
#ifndef PROBE_PH
#define PROBE_PH -1
#endif
#ifndef PROBE_MODE
#define PROBE_MODE 0
#endif
#ifndef PROBE_N
#define PROBE_N 4
#endif
    unsigned long long pr_t0 = 0ull, pr_dt = 0ull;
#define PROBE_BEGIN(k) do { if (PROBE_PH == (k)) { __syncthreads(); pr_t0 = __builtin_amdgcn_s_memrealtime(); } } while (0)
#define PROBE_MID(k) do { if (PROBE_PH == (k) && PROBE_MODE == 0) { __syncthreads(); pr_dt = __builtin_amdgcn_s_memrealtime() - pr_t0; } } while (0)
#define PROBE_END(k) do { if (PROBE_PH == (k) && PROBE_MODE == 1) { pr_dt = __builtin_amdgcn_s_memrealtime() - pr_t0; } } while (0)

#define T8_CONSTS constexpr int U_IN = Z_FP8 ? (D / 128) * (INW / 256) : 0, U_GL = GLU_FP8 ? (SW / 128) * (2 * D / 256) : 0, U_PO = PO_FP8 ? (PW / 128) * (D / 256) : 0, U_OUT = OUT_FP8 ? (D / 128) * (D / 256) : 0, U_W1E = (D / 128) * (2 * FE / 256), U_W2E = (FE / 128) * (D / 256), U_W1 = NE * U_W1E, U_TOT = U_IN + U_GL + U_PO + U_OUT + U_W1 + NE * U_W2E;
#ifndef T8_GS
#define T8_GS 16
#endif
#ifndef T8_NMOVE
#define T8_NMOVE 11008
#endif
    if (IN(0)) for (int rep_ = 0; rep_ < REP(0); ++rep_) {
        PH_PTRS(); PROBE_BEGIN(0);
        LAS float* CA = (LAS float*)(lds + RING_OFF);
        LAS float* RED = (LAS float*)(lds + RING_OFF + 32768);
        { f32x4 cv[4];
#pragma unroll
          for (int j = 0; j < 4; ++j) cv[j] = *(const f32x4*)(cin + 4 * (tid + 512 * j));
#pragma unroll
          for (int j = 0; j < 4; ++j) { f32x4 o; o[0] = cv[j][0] * sigmoidf_(cv[j][0]); o[1] = cv[j][1] * sigmoidf_(cv[j][1]); o[2] = cv[j][2] * sigmoidf_(cv[j][2]); o[3] = cv[j][3] * sigmoidf_(cv[j][3]); *(LAS f32x4*)(CA + 4 * (tid + 512 * j)) = o; } }
        __syncthreads();
        for (int it = vcu; it < 256; it += G) {
            const int cb = it & 63, kq = it >> 6, col0 = cb * 256; const float* W; int N, cc;
            if (col0 < 6 * D) { W = ada_w; N = 6 * D; cc = col0; } else { W = fada_w; N = 2 * D; cc = col0 - 6 * D; }
            const int k0 = 512 * kq + 64 * wave;
            f32x4 a0 = {0.f, 0.f, 0.f, 0.f}, a1 = a0, a2 = a0, a3 = a0;
            const float* rowp = W + (size_t)__builtin_amdgcn_readfirstlane(k0) * N + cc; const unsigned voff = 16u * lane;
            f32x4 va[16], vb[16];
#define GV_LOAD(buf_, base_) do { _Pragma("unroll") for (int i_ = 0; i_ < 16; ++i_) { const float* p_ = rowp + (size_t)((base_) + i_) * N; asm volatile("global_load_dwordx4 %0, %1, %2 nt" : "=v"(buf_[i_]) : "v"(voff), "s"(p_)); } } while (0)
#define GV_WAIT(buf_, n_) do { asm volatile("s_waitcnt vmcnt(" #n_ ")" : "+v"(buf_[0]), "+v"(buf_[1]), "+v"(buf_[2]), "+v"(buf_[3]), "+v"(buf_[4]), "+v"(buf_[5]), "+v"(buf_[6]), "+v"(buf_[7])); \
                asm volatile("" : "+v"(buf_[8]), "+v"(buf_[9]), "+v"(buf_[10]), "+v"(buf_[11]), "+v"(buf_[12]), "+v"(buf_[13]), "+v"(buf_[14]), "+v"(buf_[15])); } while (0)
#define GV_FMA(buf_, base_) do { _Pragma("unroll") for (int i_ = 0; i_ < 16; ++i_) { const int k = k0 + (base_) + i_; const f32x4 v = buf_[i_]; \
                a0 += v * CA[k]; a1 += v * CA[D + k]; a2 += v * CA[2 * D + k]; a3 += v * CA[3 * D + k]; } } while (0)
#define GV_PIN() asm volatile("" : "+v"(a0), "+v"(a1), "+v"(a2), "+v"(a3))
            GV_LOAD(va, 0); GV_LOAD(vb, 16); GV_WAIT(va, 16); GV_FMA(va, 0); GV_PIN(); GV_LOAD(va, 32); GV_WAIT(vb, 16); GV_FMA(vb, 16); GV_PIN(); GV_LOAD(vb, 48); GV_WAIT(va, 16); GV_FMA(va, 32); GV_PIN(); GV_WAIT(vb, 0); GV_FMA(vb, 48);
            *(LAS f32x4*)(RED + (wave * 4 + 0) * 256 + 4 * lane) = a0; *(LAS f32x4*)(RED + (wave * 4 + 1) * 256 + 4 * lane) = a1;
            *(LAS f32x4*)(RED + (wave * 4 + 2) * 256 + 4 * lane) = a2; *(LAS f32x4*)(RED + (wave * 4 + 3) * 256 + 4 * lane) = a3;
            __syncthreads();
#pragma unroll
            for (int h = 0; h < 2; ++h) { const int o = tid + 512 * h, b = o >> 8, c = o & 255; float sacc = 0.f;
#pragma unroll
                for (int w = 0; w < 8; ++w) sacc += RED[(w * 4 + b) * 256 + c];
                MODP[(size_t)(kq * 4 + b) * (8 * D) + col0 + c] = sacc; }
            __syncthreads();
        }
        PROBE_MID(0); if (BOTH(0)) GRID_BAR(); PROBE_END(0);
    }

    if (IN(1)) for (int rep_ = 0; rep_ < REP(1); ++rep_) {
        PH_PTRS(); PROBE_BEGIN(1);
        for (int o = vcu * 512 + tid; o < 4 * 8 * D; o += G * 512) { const int b = o >> 14, c = o & (8 * D - 1);
            const float sacc = (c < 6 * D ? ada_b[c] : fada_b[c - 6 * D]) + MODP[(size_t)(0 * 4 + b) * (8 * D) + c] + MODP[(size_t)(1 * 4 + b) * (8 * D) + c] + MODP[(size_t)(2 * 4 + b) * (8 * D) + c] + MODP[(size_t)(3 * 4 + b) * (8 * D) + c];
            if (c < 6 * D) MOD[(size_t)b * 6 * D + c] = sacc; else FMOD[(size_t)b * 2 * D + c - 6 * D] = sacc; }
        const bool tabFirst = (vcu & 1) == 0;
#pragma unroll
        for (int pass1 = 0; pass1 < 2; ++pass1) {
        if ((pass1 == 0) == tabFirst) {
        {
            LAS float* AP = (LAS float*)(lds + RING_OFF);
            LAS float* BBm = (LAS float*)(lds + RING_OFF + 16384);
            LAS float* CCm = (LAS float*)(lds + RING_OFF + 32768);
            LAS float* MT = (LAS float*)(lds + RING_OFF + 49152);
            LAS float* FF = (LAS float*)(lds + RING_OFF + 53248);
            for (int it = vcu; it < SG * 4; it += G) {
                const int g = it >> 2, part = it & 3;
                if (tid < 64) { const int p = tid; const float dt = expf(log_dt[g]); const float lre = fminf(lam_re[g * SP + p], -1e-4f), lim = lam_im[g * SP + p];
                    const float mag = expf(lre * dt), ang = lim * dt; float sn, cs; sincosf(ang, &sn, &cs); const float abr = mag * cs, abi = mag * sn;
                    float pr = 1.0f, pi = 0.0f;
                    for (int k = 0; k <= 16; ++k) { AP[(k * 64 + p) * 2] = pr; AP[(k * 64 + p) * 2 + 1] = pi; const float nr2 = pr * abr - pi * abi, ni2 = pr * abi + pi * abr; pr = nr2; pi = ni2; }
                    const float den = lre * lre + lim * lim, nr = abr - 1.0f, ni = abi; FF[2 * p] = (nr * lre + ni * lim) / den; FF[2 * p + 1] = (ni * lre - nr * lim) / den;
                }
                __syncthreads();
                for (int idx = tid; idx < SP * SH; idx += NWAVES * 64) { const int p = idx >> 4, h = idx & 15; const float fr_ = FF[2 * p], fi_ = FF[2 * p + 1];
                    const float br = sb_re[((size_t)g * SP + p) * SH + h], bi = sb_im[((size_t)g * SP + p) * SH + h]; BBm[(p * 16 + h) * 2] = fr_ * br - fi_ * bi; BBm[(p * 16 + h) * 2 + 1] = fr_ * bi + fi_ * br;
                    const int h2 = idx >> 6, p2 = idx & 63; CCm[(h2 * 64 + p2) * 2] = sc_re[((size_t)g * SH + h2) * SP + p2]; CCm[(h2 * 64 + p2) * 2 + 1] = sc_im[((size_t)g * SH + h2) * SP + p2]; }
                if (part == 0 && tid < 64) { AL[(g * SP + tid) * 2] = AP[(16 * 64 + tid) * 2]; AL[(g * SP + tid) * 2 + 1] = AP[(16 * 64 + tid) * 2 + 1]; }
                __syncthreads();
                for (int idx = tid; idx < 1024; idx += NWAVES * 64) { const int k = idx >> 6, hq = (idx >> 4) & 3, h = idx & 15, hp = 4 * part + hq; float s = 0.f;
                    for (int p = 0; p < SP; ++p) { const float ar = AP[(k * 64 + p) * 2], ai = AP[(k * 64 + p) * 2 + 1], cr = CCm[(hp * 64 + p) * 2], ci = CCm[(hp * 64 + p) * 2 + 1];
                        const float car = cr * ar - ci * ai, cai = cr * ai + ci * ar; s += car * BBm[(p * 16 + h) * 2] - cai * BBm[(p * 16 + h) * 2 + 1]; }
                    if (k == 0 && h == hp) s += ssm_d[g * SH + hp];
                    MT[idx] = s; }
                __syncthreads();
                for (int vi = tid; vi < 64 * (UGK / 8); vi += NWAVES * 64) { const int nl = vi / (UGK / 8), kv = vi - nl * (UGK / 8), t = nl >> 2, hq = nl & 3, hp = 4 * part + hq, n = t * 16 + hp, k0 = kv * 8; float val[8];
#pragma unroll
                    for (int j = 0; j < 8; ++j) { const int k = k0 + j;
                        if (k < 256) { const int s2 = k >> 4, h = k & 15; val[j] = (s2 <= t) ? MT[((t - s2) << 6) + (hq << 4) + h] : 0.f; }
                        else { const int comp = k - 256, p = comp & 63; const float ar = AP[((t + 1) * 64 + p) * 2], ai = AP[((t + 1) * 64 + p) * 2 + 1], cr = CCm[(hp * 64 + p) * 2], ci = CCm[(hp * 64 + p) * 2 + 1];
                            val[j] = comp < 64 ? (cr * ar - ci * ai) : -(cr * ai + ci * ar); } }
                    v4u o; o.x = cvt_pk_bf16(val[0], val[1]); o.y = cvt_pk_bf16(val[2], val[3]); o.z = cvt_pk_bf16(val[4], val[5]); o.w = cvt_pk_bf16(val[6], val[7]);
                    *(v4u*)(TG + ((size_t)g * 256 + n) * UGK + k0) = o; }
                for (int vi = tid; vi < 64 * 32; vi += NWAVES * 64) { const int nl = vi >> 5, kv = vi & 31, n = part * 64 + nl, k0 = kv * 8; float val[8];
#pragma unroll
                    for (int j = 0; j < 8; ++j) { const int k = k0 + j, s2 = k >> 4, h = k & 15;
                        if (n < 128) { const int p = n & 63; const float ar = AP[((15 - s2) * 64 + p) * 2], ai = AP[((15 - s2) * 64 + p) * 2 + 1], br = BBm[(p * 16 + h) * 2], bi = BBm[(p * 16 + h) * 2 + 1];
                            val[j] = n < 64 ? (ar * br - ai * bi) : (ar * bi + ai * br); } else val[j] = 0.f; }
                    v4u o; o.x = cvt_pk_bf16(val[0], val[1]); o.y = cvt_pk_bf16(val[2], val[3]); o.z = cvt_pk_bf16(val[4], val[5]); o.w = cvt_pk_bf16(val[6], val[7]);
                    *(v4u*)(WendT + ((size_t)g * 256 + n) * 256 + k0) = o; }
                __syncthreads();
            }
        }
        }
        if (pass1 == 0) {
        {
            const int RPW = (T + NGW - 1) / NGW; int cb = -1; f32x4 Av[8], Bv[8];
            const unsigned nvo = 16u * lane;
#define N1_ROWS(i_, row_, row2_) const int row_ = gw * RPW + (i_); const int row2_ = ((i_) + 1 < RPW && row_ + 1 < T && ((row_ + 1) >> 12) == (row_ >> 12)) ? row_ + 1 : row_
#define N1_LD1(dst_, base_, off_) asm volatile("global_load_dwordx4 %0, %1, %2 offset:" #off_ : "=v"(dst_) : "v"(nvo), "s"(base_))
#define N1_LOAD(V_, W_, row_, row2_) do { const float* pa_ = x + (size_t)(row_) * D; const float* pb_ = pa_ + 1024; const float* qa_ = x + (size_t)(row2_) * D; const float* qb_ = qa_ + 1024; \
                N1_LD1(V_[0], pa_, 0); N1_LD1(V_[1], pa_, 1024); N1_LD1(V_[2], pa_, 2048); N1_LD1(V_[3], pa_, 3072); N1_LD1(V_[4], pb_, 0); N1_LD1(V_[5], pb_, 1024); N1_LD1(V_[6], pb_, 2048); N1_LD1(V_[7], pb_, 3072); \
                N1_LD1(W_[0], qa_, 0); N1_LD1(W_[1], qa_, 1024); N1_LD1(W_[2], qa_, 2048); N1_LD1(W_[3], qa_, 3072); N1_LD1(W_[4], qb_, 0); N1_LD1(W_[5], qb_, 1024); N1_LD1(W_[6], qb_, 2048); N1_LD1(W_[7], qb_, 3072); } while (0)
#define N1_TIE(V_, W_, cnt_) do { asm volatile("s_waitcnt vmcnt(" #cnt_ ")" : "+v"(V_[0]), "+v"(V_[1]), "+v"(V_[2]), "+v"(V_[3]), "+v"(V_[4]), "+v"(V_[5]), "+v"(V_[6]), "+v"(V_[7])); \
                asm volatile("" : "+v"(W_[0]), "+v"(W_[1]), "+v"(W_[2]), "+v"(W_[3]), "+v"(W_[4]), "+v"(W_[5]), "+v"(W_[6]), "+v"(W_[7])); } while (0)
#define N1_VECS(row_) do { const int b_ = (row_) >> 12; \
                if (b_ != cb) { cb = b_; const float* mp = MODP + (size_t)b_ * (8 * D); constexpr size_t QS_ = (size_t)4 * 8 * D; \
                    _Pragma("unroll") for (int j = 0; j < 8; ++j) { const int k = 4 * lane + 256 * j; const f32x4 g = *(const f32x4*)(norm1_g + k); \
                        const f32x4 sh = *(const f32x4*)(ada_b + k) + *(const f32x4*)(mp + k) + *(const f32x4*)(mp + QS_ + k) + *(const f32x4*)(mp + 2 * QS_ + k) + *(const f32x4*)(mp + 3 * QS_ + k); \
                        const f32x4 sc = *(const f32x4*)(ada_b + D + k) + *(const f32x4*)(mp + D + k) + *(const f32x4*)(mp + QS_ + D + k) + *(const f32x4*)(mp + 2 * QS_ + D + k) + *(const f32x4*)(mp + 3 * QS_ + D + k); \
                        Av[j] = g * (sc + 1.0f); Bv[j] = sh; } } } while (0)
#define N1_BODY(V_, W_, row_, row2_) do { \
                float ss = 0.f, ss2 = 0.f; \
                _Pragma("unroll") for (int j = 0; j < 8; ++j) { ss += V_[j][0] * V_[j][0] + V_[j][1] * V_[j][1] + V_[j][2] * V_[j][2] + V_[j][3] * V_[j][3]; ss2 += W_[j][0] * W_[j][0] + W_[j][1] * W_[j][1] + W_[j][2] * W_[j][2] + W_[j][3] * W_[j][3]; } \
                const float rstd = 1.0f / sqrtf(wave_sum(ss) * (1.0f / D) + RMS_EPS), rstd2 = 1.0f / sqrtf(wave_sum(ss2) * (1.0f / D) + RMS_EPS); \
                _Pragma("unroll") for (int j = 0; j < 8; ++j) { const int k = 4 * lane + 256 * j; const f32x4 h = V_[j] * rstd * Av[j] + Bv[j], h2 = W_[j] * rstd2 * Av[j] + Bv[j]; \
                    if (Z_FP8) { *(unsigned*)(XN8 + (size_t)(row_) * D + k) = pk4_fp8(h[0], h[1], h[2], h[3]); *(unsigned*)(XN8 + (size_t)(row2_) * D + k) = pk4_fp8(h2[0], h2[1], h2[2], h2[3]); } \
                    else { v2u o; o.x = cvt_pk_bf16(h[0], h[1]); o.y = cvt_pk_bf16(h[2], h[3]); *(v2u*)(XN + (size_t)(row_) * D + k) = o; o.x = cvt_pk_bf16(h2[0], h2[1]); o.y = cvt_pk_bf16(h2[2], h2[3]); *(v2u*)(XN + (size_t)(row2_) * D + k) = o; } } } while (0)
            if (RPW == 8 && (vcu * NWAVES + NWAVES - 1) * 8 + 7 < T) {
                f32x4 va[8], wa[8], vb[8], wb[8];
                const int r0 = gw * 8;
                {
                    constexpr size_t QS = (size_t)4 * 8 * D; LAS float* NA = (LAS float*)(lds + RING_OFF); LAS float* NB = NA + D;
                    const int bW = (vcu * NWAVES * 8) >> 12; const int k = 4 * tid; const float* mp = MODP + (size_t)bW * (8 * D) + k; f32x4 g, bs, bc, ps[4], pc[4];
                    EPI_ALD16(g, norm1_g + k); EPI_ALD16(bs, ada_b + k); EPI_ALD16(bc, ada_b + D + k);
#pragma unroll
                    for (int q = 0; q < 4; ++q) { EPI_ALD16(ps[q], mp + q * QS); EPI_ALD16(pc[q], mp + q * QS + D); }
                    asm volatile("s_waitcnt vmcnt(0)" : "+v"(g), "+v"(bs), "+v"(bc), "+v"(ps[0]), "+v"(ps[1]), "+v"(ps[2]), "+v"(ps[3]), "+v"(pc[0]), "+v"(pc[1]), "+v"(pc[2]), "+v"(pc[3]));
                    const f32x4 sh = bs + ps[0] + ps[1] + ps[2] + ps[3], sc = bc + pc[0] + pc[1] + pc[2] + pc[3];
                    *(LAS f32x4*)(NA + k) = g * (sc + 1.0f); *(LAS f32x4*)(NB + k) = sh;
                    __syncthreads();
#pragma unroll
                    for (int j = 0; j < 8; ++j) { const int kk = 4 * lane + 256 * j; Av[j] = *(const LAS f32x4*)(NA + kk); Bv[j] = *(const LAS f32x4*)(NB + kk); }
                    __syncthreads(); cb = bW; }
                N1_LOAD(va, wa, r0, r0 + 1); N1_LOAD(vb, wb, r0 + 2, r0 + 3);
                N1_TIE(va, wa, 16); N1_BODY(va, wa, r0, r0 + 1);
                N1_LOAD(va, wa, r0 + 4, r0 + 5);
                N1_TIE(vb, wb, 16); N1_BODY(vb, wb, r0 + 2, r0 + 3);
                N1_LOAD(vb, wb, r0 + 6, r0 + 7);
                N1_TIE(va, wa, 16); N1_BODY(va, wa, r0 + 4, r0 + 5);
                N1_TIE(vb, wb, 0); N1_BODY(vb, wb, r0 + 6, r0 + 7);
            } else {
                for (int i = 0; i < RPW; i += 2) {
                    N1_ROWS(i, row, row2); if (row >= T) break;
                    f32x4 v[8], w[8];
                    const float* xr = x + (size_t)row * D + 4 * lane; const float* xr2 = x + (size_t)row2 * D + 4 * lane;
#pragma unroll
                    for (int j = 0; j < 8; ++j) { v[j] = *(const f32x4*)(xr + 256 * j); w[j] = *(const f32x4*)(xr2 + 256 * j); }
                    N1_VECS(row); N1_BODY(v, w, row, row2);
                }
            }
#undef N1_ROWS
#undef N1_LD1
#undef N1_LOAD
#undef N1_TIE
#undef N1_BODY
#undef N1_VECS
        }
        {
            constexpr int T_IN = Z_FP8 ? 0 : (D / 64) * (INW / 256), T_PW = 4 * 4, T_PO = PO_FP8 ? 0 : (PW / 64) * (D / 256), T_GL = GLU_FP8 ? 0 : (SW / 64) * (2 * D / 256), T_OUT = OUT_FP8 ? 0 : (D / 64) * (D / 256);
            constexpr int NTILES = T_IN + T_PW + T_PO + T_GL + T_OUT;
            constexpr int TRB = 256 * 144;
#define TR_DECODE(it_, W_, WT_, K_, N_, mode_, k0_, n0_) do { int r_ = (it_); \
                if (r_ < T_IN) { W_ = w_in; WT_ = WinT; K_ = D; N_ = INW; mode_ = 0; } \
                else if ((r_ -= T_IN) < T_PW) { const int q_ = r_ >> 2; r_ &= 3; W_ = pool_w + (size_t)q_ * 65536; WT_ = PoolWT + (size_t)q_ * 65536; K_ = 256; N_ = 256; mode_ = 0; } \
                else if ((r_ -= T_PW) < T_PO) { W_ = w_pool_out; WT_ = WpoT; K_ = PW; N_ = D; mode_ = 0; } \
                else if ((r_ -= T_PO) < T_GL) { W_ = w_glu; WT_ = WgluT; K_ = SW; N_ = 2 * D; mode_ = 1; } \
                else { r_ -= T_GL; W_ = w_out; WT_ = WoutT; K_ = D; N_ = D; mode_ = 0; } \
                const int nblk_ = N_ >> 8; k0_ = (r_ / nblk_) * 64; n0_ = (r_ % nblk_) * 256; } while (0)
#define TR_LOAD(reg_, W_, N_, k0_, n0_) do { const float* p_ = W_ + (size_t)(k0_ + 8 * wave) * N_ + n0_ + 4 * lane; \
                _Pragma("unroll") for (int i_ = 0; i_ < 8; ++i_) reg_[i_] = __builtin_nontemporal_load((const f32x4*)(p_ + (size_t)i_ * N_)); } while (0)
#define TR_PUT(reg_, buf_) do { _Pragma("unroll") for (int j_ = 0; j_ < 4; ++j_) { v4u o_; o_.x = cvt_pk_bf16(reg_[0][j_], reg_[1][j_]); o_.y = cvt_pk_bf16(reg_[2][j_], reg_[3][j_]); \
                o_.z = cvt_pk_bf16(reg_[4][j_], reg_[5][j_]); o_.w = cvt_pk_bf16(reg_[6][j_], reg_[7][j_]); *(LAS v4u*)(lds + RING_OFF + (buf_) * TRB + (4 * lane + j_) * 144 + 16 * wave) = o_; } } while (0)
#define TR_FLUSH(buf_, WT_, K_, N_, mode_, k0_, n0_) do { _Pragma("unroll") for (int p_ = 0; p_ < 4; ++p_) { const int n_ = 64 * p_ + (tid >> 3), c_ = tid & 7; \
                const v4u q_ = *(const LAS v4u*)(lds + RING_OFF + (buf_) * TRB + n_ * 144 + 16 * c_); const int gn_ = n0_ + n_; int drow_ = gn_; \
                if (mode_) { const int half_ = N_ >> 1, hi_ = gn_ >= half_ ? 1 : 0, nn_ = gn_ - hi_ * half_; drow_ = (nn_ >> 7) * 256 + hi_ * 128 + (nn_ & 127); } \
                *(v4u*)(WT_ + (size_t)drow_ * K_ + k0_ + 8 * c_) = q_; } } while (0)
#define TR_BAR() do { LDS_WAIT(); __builtin_amdgcn_s_barrier(); asm volatile("" ::: "memory"); } while (0)
            int itA = vcu, itB = vcu + G;
            const float *WA = nullptr, *WB = nullptr; bf16 *TA = nullptr, *TB = nullptr; int KA = 0, NA = 0, mA = 0, kA = 0, nA = 0, KB = 0, NB = 0, mB = 0, kB = 0, nB = 0;
            f32x4 ra[8], rb[8];
            if (itA < NTILES) { TR_DECODE(itA, WA, TA, KA, NA, mA, kA, nA); TR_LOAD(ra, WA, NA, kA, nA); }
            if (itB < NTILES) { TR_DECODE(itB, WB, TB, KB, NB, mB, kB, nB); TR_LOAD(rb, WB, NB, kB, nB); }
            while (itA < NTILES) {
                TR_PUT(ra, 0);
                { bf16* dT = TA; const int dK = KA, dN = NA, dm = mA, dk = kA, dn = nA;
                  itA += 2 * G; if (itA < NTILES) { TR_DECODE(itA, WA, TA, KA, NA, mA, kA, nA); TR_LOAD(ra, WA, NA, kA, nA); }
                  TR_BAR();
                  TR_FLUSH(0, dT, dK, dN, dm, dk, dn); }
                if (itB >= NTILES) break;
                TR_PUT(rb, 1);
                { bf16* dT = TB; const int dK = KB, dN = NB, dm = mB, dk = kB, dn = nB;
                  itB += 2 * G; if (itB < NTILES) { TR_DECODE(itB, WB, TB, KB, NB, mB, kB, nB); TR_LOAD(rb, WB, NB, kB, nB); }
                  TR_BAR();
                  TR_FLUSH(1, dT, dK, dN, dm, dk, dn); }
            }
            __syncthreads();
            {
                T8_CONSTS;
#define T8_DECODE(it_, W_, WT_, K_, N_, mode_, k0_, n0_) do { int r_ = (it_); \
                    if (r_ < U_IN) { W_ = w_in; WT_ = (unsigned char*)WinT; K_ = D; N_ = INW; mode_ = 0; } \
                    else if ((r_ -= U_IN) < U_GL) { W_ = w_glu; WT_ = (unsigned char*)WgluT; K_ = SW; N_ = 2 * D; mode_ = 1; } \
                    else if ((r_ -= U_GL) < U_PO) { W_ = w_pool_out; WT_ = (unsigned char*)WpoT; K_ = PW; N_ = D; mode_ = 0; } \
                    else if ((r_ -= U_PO) < U_OUT) { W_ = w_out; WT_ = (unsigned char*)WoutT; K_ = D; N_ = D; mode_ = 0; } \
                    else if ((r_ -= U_OUT) < U_W1) { const int e_ = r_ / U_W1E; r_ -= e_ * U_W1E; W_ = w1 + (size_t)e_ * D * 2 * FE; WT_ = W1T8 + (size_t)e_ * D * 2 * FE; K_ = D; N_ = 2 * FE; mode_ = 1; } \
                    else { r_ -= U_W1; const int e_ = r_ / U_W2E; r_ -= e_ * U_W2E; W_ = w2 + (size_t)e_ * FE * D; WT_ = W2T8 + (size_t)e_ * FE * D; K_ = FE; N_ = D; mode_ = 0; } \
                    const int nblk_ = N_ >> 8; k0_ = (r_ / nblk_) * 128; n0_ = (r_ % nblk_) * 256; } while (0)
#define T8_LOAD(reg_, W_, N_, k0_, n0_) do { const float* p_ = W_ + (size_t)(k0_ + 16 * wave) * N_ + n0_ + 4 * lane; \
                    _Pragma("unroll") for (int i_ = 0; i_ < 16; ++i_) reg_[i_] = __builtin_nontemporal_load((const f32x4*)(p_ + (size_t)i_ * N_)); } while (0)
#define T8_PUT(reg_, buf_) do { _Pragma("unroll") for (int j_ = 0; j_ < 4; ++j_) { v4u o_; o_.x = pk4_fp8(32.f * reg_[0][j_], 32.f * reg_[1][j_], 32.f * reg_[2][j_], 32.f * reg_[3][j_]); o_.y = pk4_fp8(32.f * reg_[4][j_], 32.f * reg_[5][j_], 32.f * reg_[6][j_], 32.f * reg_[7][j_]); \
                    o_.z = pk4_fp8(32.f * reg_[8][j_], 32.f * reg_[9][j_], 32.f * reg_[10][j_], 32.f * reg_[11][j_]); o_.w = pk4_fp8(32.f * reg_[12][j_], 32.f * reg_[13][j_], 32.f * reg_[14][j_], 32.f * reg_[15][j_]); \
                    *(LAS v4u*)(lds + RING_OFF + (buf_) * TRB + (4 * lane + j_) * 144 + 16 * wave) = o_; } } while (0)
#define T8_FLUSH(buf_, WT_, K_, N_, mode_, k0_, n0_) do { _Pragma("unroll") for (int p_ = 0; p_ < 4; ++p_) { const int n_ = 64 * p_ + (tid >> 3), c_ = tid & 7; \
                    const v4u q_ = *(const LAS v4u*)(lds + RING_OFF + (buf_) * TRB + n_ * 144 + 16 * c_); const int gn_ = n0_ + n_; int drow_ = gn_; \
                    if (mode_) { const int half_ = N_ >> 1, hi_ = gn_ >= half_ ? 1 : 0, nn_ = gn_ - hi_ * half_; drow_ = (nn_ >> 7) * 256 + hi_ * 128 + (nn_ & 127); } \
                    __builtin_nontemporal_store(q_, (v4u*)(WT_ + (size_t)drow_ * K_ + k0_ + 16 * c_)); } } while (0)
#define T8_RUN(first_, stride_, end_) do { int itA = (first_), itB = (first_) + (stride_); const int itS = 2 * (stride_), itE = (end_); \
                const float *WA = nullptr, *WB = nullptr; unsigned char *TA = nullptr, *TB = nullptr; int KA = 0, NA = 0, mA = 0, kA = 0, nA = 0, KB = 0, NB = 0, mB = 0, kB = 0, nB = 0; \
                f32x4 ra[16], rb[16]; \
                if (itA < itE) { T8_DECODE(itA, WA, TA, KA, NA, mA, kA, nA); T8_LOAD(ra, WA, NA, kA, nA); } \
                if (itB < itE) { T8_DECODE(itB, WB, TB, KB, NB, mB, kB, nB); T8_LOAD(rb, WB, NB, kB, nB); } \
                while (itA < itE) { \
                    T8_PUT(ra, 0); \
                    { unsigned char* dT = TA; const int dK = KA, dN = NA, dm = mA, dk = kA, dn = nA; \
                      itA += itS; if (itA < itE) { T8_DECODE(itA, WA, TA, KA, NA, mA, kA, nA); T8_LOAD(ra, WA, NA, kA, nA); } \
                      TR_BAR(); \
                      T8_FLUSH(0, dT, dK, dN, dm, dk, dn); } \
                    if (itB >= itE) break; \
                    T8_PUT(rb, 1); \
                    { unsigned char* dT = TB; const int dK = KB, dN = NB, dm = mB, dk = kB, dn = nB; \
                      itB += itS; if (itB < itE) { T8_DECODE(itB, WB, TB, KB, NB, mB, kB, nB); T8_LOAD(rb, WB, NB, kB, nB); } \
                      TR_BAR(); \
                      T8_FLUSH(1, dT, dK, dN, dm, dk, dn); } \
                } \
                __syncthreads(); } while (0)
                T8_RUN(vcu, G, (G == 256) ? U_TOT - T8_NMOVE : U_TOT);
            }
#undef TR_DECODE
#undef TR_LOAD
#undef TR_PUT
#undef TR_FLUSH
        }
        }
        }
        PROBE_MID(1); if (BOTH(1)) GRID_BAR(); PROBE_END(1);
    }

    if (IN(2)) {
        PH_PTRS(); PROBE_BEGIN(2);
        const bool split2 = (G == 256); const int xcd2 = bx & 7, slot2 = bx >> 3;
        if (!split2 || slot2 < T8_GS) {
        SchedDense S; S.init(Z_FP8 ? (const void*)XN8 : (const void*)XN, WinT, T, INW, D, D, split2 ? T8_GS * 8 : G, split2 ? slot2 * 8 + xcd2 : bx, Z_FP8 ? 1 : 2);
        EpiZ E{UP, UG, SGP, SGS, Z_FP8 ? 0.03125f : 1.0f};
        pg8::gemm_phase<EpiZ, SchedDense, false, Z_FP8 ? 1 : 2>(lds + RING_OFF, D, D, D, S, E);
        } else { constexpr int TRB = 256 * 144; T8_CONSTS; T8_RUN(U_TOT - T8_NMOVE + (slot2 - T8_GS) * 8 + xcd2, (32 - T8_GS) * 8, U_TOT); }
        PROBE_MID(2); if (BOTH(2)) GRID_BAR(); PROBE_END(2);
    }

#undef T8_DECODE
#undef T8_LOAD
#undef T8_PUT
#undef T8_FLUSH
#undef T8_RUN
#undef TR_BAR
    if (IN(3)) {
        PH_PTRS(); PROBE_BEGIN(3);
        for (int L = vcu; L < 4 * (T / 256); L += G) {
            const int gq = L / (T / 256), pm = L % (T / 256), b = pm >> 4, oct = lane & 31, th = lane >> 5, t0 = (pm & 15) * 256 + wave * 32 + th * 16;
            bf16* pl = PL + (size_t)b * SEQ * PW + gq * 256 + oct * 8; const unsigned voff = (unsigned)(th * 16 * PW + oct * 8) * 2u;
            const bf16* ub0 = UP + ((size_t)b * SEQ + (pm & 15) * 256 + wave * 32) * PW + gq * 256;
            if (gq == 0) pool_item<2>(ub0 - 1 * PW, voff, pl, t0); else if (gq == 1) pool_item<4>(ub0 - 3 * PW, voff, pl, t0); else if (gq == 2) pool_item<8>(ub0 - 7 * PW, voff, pl, t0); else pool_item<16>(ub0 - 15 * PW, voff, pl, t0);
        }
        VM_WAIT(); __syncthreads();
        { SchedGrouped S; S.init(PL, PoolWT, PW, (size_t)256 * 2, (size_t)256 * 256 * 2, T / 256, 4, G, vcu);
          EpiPmix E{PM, pool_scale};
          pg8::gemm_phase<EpiPmix, SchedGrouped, false>(lds + RING_OFF, PW, 256, 256, S, E); }
        { SchedGrouped S; S.init(UG, WendT, UGK, (size_t)1024 * UGK * 2, (size_t)256 * 256 * 2, 4, SG, G, vcu);
          EpiS1 E{EB};
          pg8::gemm_phase<EpiS1, SchedGrouped, false>(lds + RING_OFF, UGK, 256, 256, S, E); }
        PROBE_MID(3); if (BOTH(3)) GRID_BAR(); PROBE_END(3);
    }


    if (IN(5)) {
        PH_PTRS(); PROBE_BEGIN(5);
        {
            LAS float* SB = (LAS float*)(lds + RING_OFF);
            for (int L = vcu; L < SG * 4; L += G) {
                const int g = L >> 2, b = L & 3, p = lane; const float ar = AL[(g * SP + p) * 2], ai = AL[(g * SP + p) * 2 + 1];
                const size_t rb = (size_t)g * 1024 + b * 256 + 32 * wave;
                float er[32], ei[32], lr[32], li[32];
#pragma unroll
                for (int j = 0; j < 32; ++j) { er[j] = EB[(rb + j) * 128 + p]; ei[j] = EB[(rb + j) * 128 + 64 + p]; }
                float xr = 0.f, xi = 0.f;
#pragma unroll
                for (int j = 0; j < 32; ++j) { lr[j] = xr; li[j] = xi; const float nr = ar * xr - ai * xi + er[j], ni = ar * xi + ai * xr + ei[j]; xr = nr; xi = ni; }
                SB[(wave * 64 + p) * 2] = xr; SB[(wave * 64 + p) * 2 + 1] = xi;
                float qr = ar, qi = ai;
#pragma unroll
                for (int k = 0; k < 5; ++k) { const float t0 = qr * qr - qi * qi, t1 = 2.f * qr * qi; qr = t0; qi = t1; }
                __syncthreads();
                float cr = 0.f, ci = 0.f;
                for (int v = 0; v < wave; ++v) { const float sr = SB[(v * 64 + p) * 2], si = SB[(v * 64 + p) * 2 + 1]; const float nr = qr * cr - qi * ci + sr, ni = qr * ci + qi * cr + si; cr = nr; ci = ni; }
                float pr = 1.f, pi = 0.f;
#pragma unroll
                for (int j = 0; j < 32; ++j) { const float fr_ = lr[j] + pr * cr - pi * ci, fi_ = li[j] + pr * ci + pi * cr;
                    UG[(rb + j) * UGK + 256 + p] = (bf16)(cvt_pk_bf16(fr_, 0.f) & 0xffffu); UG[(rb + j) * UGK + 320 + p] = (bf16)(cvt_pk_bf16(fi_, 0.f) & 0xffffu);
                    const float t0 = pr * ar - pi * ai, t1 = pr * ai + pi * ar; pr = t0; pi = t1; }
                __syncthreads();
            }
        }
        VM_WAIT(); __syncthreads();
        { SchedGrouped S; S.init(UG, TG, UGK, (size_t)1024 * UGK * 2, (size_t)256 * UGK * 2, 4, SG, G, vcu);
          EpiS3 E{YS};
          pg8::gemm_phase<EpiS3, SchedGrouped, false>(lds + RING_OFF, UGK, UGK, UGK, S, E); }
        { SchedDense S; S.init(PM, WpoT, T, D, PW, PW, G, bx, PO_FP8 ? 1 : 2);
          EpiYpool E{YPG, SGP, PO_FP8 ? 0.03125f : 1.0f};
          pg8::gemm_phase<EpiYpool, SchedDense, false, PO_FP8 ? 1 : 2>(lds + RING_OFF, PW, PW, PW, S, E); }
        PROBE_MID(5); if (BOTH(5)) GRID_BAR(); PROBE_END(5);
    }

    if (IN(6)) {
        PH_PTRS(); PROBE_BEGIN(6);
        SchedDense S; S.init(YS, WgluT, T, 2 * D, SW, SW, G, bx, GLU_FP8 ? 1 : 2);
        EpiGlu E{MG, YPG, SGS, b_glu, GLU_FP8 ? 0.03125f : 1.0f};
        pg8::gemm_phase<EpiGlu, SchedDense, false, GLU_FP8 ? 1 : 2>(lds + RING_OFF, SW, SW, SW, S, E);
        PROBE_MID(6); if (BOTH(6)) GRID_BAR(); PROBE_END(6);
    }

    if (IN(7)) {
        PH_PTRS(); PROBE_BEGIN(7);
        SchedDense S; S.init(MG, WoutT, T, D, D, D, G, bx, OUT_FP8 ? 1 : 2);
        EpiMix E{X1B, OUT_FP8 ? 0.03125f : 1.0f, MOD + 2 * D, x};
        pg8::gemm_phase<EpiMix, SchedDense, false, OUT_FP8 ? 1 : 2>(lds + RING_OFF, D, D, D, S, E);
        PROBE_MID(7); if (BOTH(7)) GRID_BAR(); PROBE_END(7);
    }

    if (IN(8)) for (int rep_ = 0; rep_ < REP(8); ++rep_) {
        PH_PTRS(); PROBE_BEGIN(8);
        LAS float* HT = (LAS float*)(lds + RING_OFF);
        LAS float* RED = (LAS float*)(lds + RING_OFF + 65792);
        LAS float* LG = (LAS float*)(lds + RING_OFF + 98560);
        LAS int* HIST = (LAS int*)(lds + RING_OFF + 102784);
        LAS int* BASE = (LAS int*)(lds + RING_OFF + 102912);
        LAS float* PVA = (LAS float*)(lds + RING_OFF + 104448);
        LAS float* PVS = PVA + D;
        const int TPW8 = (T / 32 + G - 1) / G; int cb8 = -1;
        for (int ti8 = 0; ti8 < TPW8; ++ti8) {
            const int tile = vcu * TPW8 + ti8; if (tile >= T / 32) break;
            const int R0 = tile * 32, b = R0 >> 12; const float* mb = MOD + (size_t)b * 6 * D;
            if (b != cb8) { cb8 = b; __syncthreads(); const int k = 4 * tid;
                const f32x4 g = *(const f32x4*)(norm2_g + k), sh = *(const f32x4*)(mb + 3 * D + k), sc = *(const f32x4*)(mb + 4 * D + k);
                *(LAS f32x4*)(PVA + k) = g * (sc + 1.0f); *(LAS f32x4*)(PVS + k) = sh; __syncthreads(); }
            f32x4 v[4][8]; float rstd[4], ssq[4] = {0.f, 0.f, 0.f, 0.f};
#pragma unroll
            for (int j = 0; j < 8; ++j) { const int k = 4 * lane + 256 * j;
#pragma unroll
                for (int rr = 0; rr < 4; ++rr) { const size_t off = (size_t)(R0 + 4 * wave + rr) * D + k; const v2u mq = *(const v2u*)(X1B + off);
                    v[rr][j] = (f32x4){bf_lo(mq.x), bf_hi(mq.x), bf_lo(mq.y), bf_hi(mq.y)};
                    ssq[rr] += v[rr][j][0] * v[rr][j][0] + v[rr][j][1] * v[rr][j][1] + v[rr][j][2] * v[rr][j][2] + v[rr][j][3] * v[rr][j][3]; } }
#pragma unroll
            for (int rr = 0; rr < 4; ++rr) rstd[rr] = 1.0f / sqrtf(wave_sum(ssq[rr]) * (1.0f / D) + RMS_EPS);
#pragma unroll
            for (int j = 0; j < 8; ++j) { const int k = 4 * lane + 256 * j; const f32x4 Aj = *(const LAS f32x4*)(PVA + k), sh = *(const LAS f32x4*)(PVS + k);
#pragma unroll
                for (int rr = 0; rr < 4; ++rr) { const int row = R0 + 4 * wave + rr; v[rr][j] = v[rr][j] * rstd[rr] * Aj + sh;
                    *(unsigned*)(XN8 + (size_t)row * D + k) = pk4_fp8(v[rr][j][0], v[rr][j][1], v[rr][j][2], v[rr][j][3]); } }
            if (tid < 32) HIST[tid] = 0;
            f32x16 lacc;
#pragma unroll
            for (int j = 0; j < 16; ++j) lacc[j] = 0.f;
#pragma unroll
            for (int q = 0; q < 4; ++q) {
                float bq[16];
                const float* wr0 = w_router + (size_t)(q * 512 + 64 * wave) * NE; const float* wr1 = wr0 + 16 * 2 * NE; const unsigned wvo = (unsigned)((lane >> 5) * NE + (lane & 31)) * 4u;
#define RB_LD(i_, off_, base_) asm volatile("global_load_dword %0, %1, %2 offset:" #off_ : "=v"(bq[i_]) : "v"(wvo), "s"(base_))
#define RB_LD16(base_) do { RB_LD(0, 0, base_); RB_LD(1, 256, base_); RB_LD(2, 512, base_); RB_LD(3, 768, base_); RB_LD(4, 1024, base_); RB_LD(5, 1280, base_); RB_LD(6, 1536, base_); RB_LD(7, 1792, base_); \
                    RB_LD(8, 2048, base_); RB_LD(9, 2304, base_); RB_LD(10, 2560, base_); RB_LD(11, 2816, base_); RB_LD(12, 3072, base_); RB_LD(13, 3328, base_); RB_LD(14, 3584, base_); RB_LD(15, 3840, base_); } while (0)
#define RB_WAIT() do { asm volatile("s_waitcnt vmcnt(0)" : "+v"(bq[0]), "+v"(bq[1]), "+v"(bq[2]), "+v"(bq[3]), "+v"(bq[4]), "+v"(bq[5]), "+v"(bq[6]), "+v"(bq[7])); \
                    asm volatile("" : "+v"(bq[8]), "+v"(bq[9]), "+v"(bq[10]), "+v"(bq[11]), "+v"(bq[12]), "+v"(bq[13]), "+v"(bq[14]), "+v"(bq[15])); } while (0)
                RB_LD16(wr0);
                __syncthreads();
#pragma unroll
                for (int rr = 0; rr < 4; ++rr)
#pragma unroll
                    for (int jj = 0; jj < 2; ++jj) { const int lk = 4 * lane + 256 * jj; LAS float* hp = HT + (4 * wave + rr) * 513 + lk; const f32x4 q4 = v[rr][2 * q + jj]; hp[0] = q4[0]; hp[1] = q4[1]; hp[2] = q4[2]; hp[3] = q4[3]; }
                __syncthreads();
                const LAS float* ap = HT + (lane & 31) * 513 + 64 * wave + (lane >> 5);
                RB_WAIT();
                float bq2[16];
#define RB_LD2(i_, off_) asm volatile("global_load_dword %0, %1, %2 offset:" #off_ : "=v"(bq2[i_]) : "v"(wvo), "s"(wr1))
                RB_LD2(0, 0); RB_LD2(1, 256); RB_LD2(2, 512); RB_LD2(3, 768); RB_LD2(4, 1024); RB_LD2(5, 1280); RB_LD2(6, 1536); RB_LD2(7, 1792);
                RB_LD2(8, 2048); RB_LD2(9, 2304); RB_LD2(10, 2560); RB_LD2(11, 2816); RB_LD2(12, 3072); RB_LD2(13, 3328); RB_LD2(14, 3584); RB_LD2(15, 3840);
#pragma unroll
                for (int s = 0; s < 16; ++s) lacc = __builtin_amdgcn_mfma_f32_32x32x2f32(ap[2 * s], bq[s], lacc, 0, 0, 0);
                asm volatile("" : "+v"(lacc));
                asm volatile("s_waitcnt vmcnt(0)" : "+v"(bq2[0]), "+v"(bq2[1]), "+v"(bq2[2]), "+v"(bq2[3]), "+v"(bq2[4]), "+v"(bq2[5]), "+v"(bq2[6]), "+v"(bq2[7]));
                asm volatile("" : "+v"(bq2[8]), "+v"(bq2[9]), "+v"(bq2[10]), "+v"(bq2[11]), "+v"(bq2[12]), "+v"(bq2[13]), "+v"(bq2[14]), "+v"(bq2[15]));
#pragma unroll
                for (int s = 0; s < 16; ++s) lacc = __builtin_amdgcn_mfma_f32_32x32x2f32(ap[32 + 2 * s], bq2[s], lacc, 0, 0, 0);
                asm volatile("" : "+v"(lacc));
            }
#pragma unroll
            for (int rg = 0; rg < 16; ++rg) { const int i = (rg & 3) + 8 * (rg >> 2) + 4 * (lane >> 5); RED[(wave * 32 + i) * 32 + (lane & 31)] = lacc[rg]; }
            __syncthreads();
#pragma unroll
            for (int pp = 0; pp < 2; ++pp) { const int p = tid + pp * 512, i = p >> 5, j = p & 31; float s = b_router[j];
#pragma unroll
                for (int w = 0; w < 8; ++w) s += RED[(w * 32 + i) * 32 + j];
                LG[i * 33 + j] = s; }
            __syncthreads();
            int ae[2], al[2]; float aw[2];
            { const int hw = tid >> 5, l32 = tid & 31;
#pragma unroll
              for (int it = 0; it < 2; ++it) { const int i = hw * 2 + it; float val = LG[i * 33 + l32]; float tv[4]; int ti[4];
#pragma unroll
                for (int k = 0; k < 4; ++k) { float bv = val; int bi = l32;
#pragma unroll
                    for (int off = 16; off >= 1; off >>= 1) { const float ov = __shfl_xor(bv, off); const int oi = __shfl_xor(bi, off); if (ov > bv || (ov == bv && oi < bi)) { bv = ov; bi = oi; } }
                    tv[k] = bv; ti[k] = bi; if (l32 == bi) val = -3.0e38f; }
                float den = 0.f, ex[4];
#pragma unroll
                for (int k = 0; k < 4; ++k) { ex[k] = expf(tv[k] - tv[0]); den += ex[k]; }
                const int ke = l32 & 3; ae[it] = ke == 0 ? ti[0] : (ke == 1 ? ti[1] : (ke == 2 ? ti[2] : ti[3])); aw[it] = (ke == 0 ? ex[0] : (ke == 1 ? ex[1] : (ke == 2 ? ex[2] : ex[3]))) / den;
                al[it] = (l32 < 4) ? atomicAdd((int*)&HIST[ae[it]], 1) : 0; } }
            __syncthreads();
            if (tid < 32) { const int c = HIST[tid]; BASE[tid] = c ? (int)__hip_atomic_fetch_add((unsigned*)(ctl + CW_CNT + tid), (unsigned)c, RLX_AGENT) : 0; }
            __syncthreads();
            if ((tid & 31) < 4) { const int hw = tid >> 5, k = tid & 3;
#pragma unroll
                for (int it = 0; it < 2; ++it) { const int tok = R0 + hw * 2 + it, e = ae[it], rank = BASE[e] + al[it]; LTOK[(size_t)e * LCAP + rank] = tok; LWT[(size_t)e * LCAP + rank] = aw[it]; TSLOT[tok * 4 + k] = e * LCAP + rank; } }
            __syncthreads();
        }
        PROBE_MID(8); if (BOTH(8)) GRID_BAR(); PROBE_END(8);
    }

#define MOE_TABLES(nN_) do { __syncthreads(); if (tid < 64) { const int e_ = tid & 31; const unsigned c_ = (tid < 32) ? __hip_atomic_load(ctl + CW_CNT + e_, RLX_AGENT) : 0u; const unsigned nb_ = (c_ + 255u) >> 8; \
        unsigned incl_ = nb_; _Pragma("unroll") for (int off_ = 1; off_ < 32; off_ <<= 1) { const unsigned t_ = __shfl_up(incl_, off_); if (e_ >= off_) incl_ += t_; } \
        if (tid < 32) { const unsigned excl_ = incl_ - nb_; MISC[32 + e_] = excl_ * (unsigned)(nN_); MISC[80 + e_] = excl_; MISC[128 + e_] = c_; \
            if (e_ == NE - 1) { MISC[32 + NE] = incl_ * (unsigned)(nN_); MISC[80 + NE] = incl_; MISC[176] = incl_ * (unsigned)(nN_); } } } __syncthreads(); } while (0)

    if (IN(9)) {
        PH_PTRS(); PROBE_BEGIN(9);
        MOE_TABLES(2 * FE / 256);
        SchedMoe S; S.A = (const char*)XN8; S.Bt = (const char*)W1T8; S.astep = 0; S.bstep_e = (size_t)2 * FE * D; S.bstep_n = (size_t)256 * D; S.nN = 2 * FE / 256; S.G = G; S.c = vcu; S.M = MISC; S.ltok = LTOK; S.gather = true;
        EpiMoe1 E{ACT8, b1};
        pg8::gemm_phase<EpiMoe1, SchedMoe, true, 1, true>(lds + RING_OFF, D, D, D, S, E);
        if (DUPSEL == 9) { pg8::gemm_phase<EpiMoe1, SchedMoe, true, 1, true>(lds + RING_OFF, D, D, D, S, E); }
        PROBE_MID(9); if (BOTH(9)) GRID_BAR(); PROBE_END(9);
    }

    if (IN(10)) {
        PH_PTRS(); PROBE_BEGIN(10);
        MOE_TABLES(D / 256);
        SchedMoe S; S.A = (const char*)ACT8; S.Bt = (const char*)W2T8; S.astep = (size_t)256 * FE; S.bstep_e = (size_t)D * FE; S.bstep_n = (size_t)256 * FE; S.nN = D / 256; S.G = G; S.c = vcu; S.M = MISC; S.ltok = LTOK; S.gather = false;
        EpiMoe2 E{YE, b2, LWT};
        pg8::gemm_phase<EpiMoe2, SchedMoe, false, 1, true>(lds + RING_OFF, FE, FE, FE, S, E);
        if (DUPSEL == 10) { pg8::gemm_phase<EpiMoe2, SchedMoe, false, 1, true>(lds + RING_OFF, FE, FE, FE, S, E); }
        PROBE_MID(10); if (BOTH(10)) GRID_BAR(); PROBE_END(10);
    }

    if (IN(11)) for (int rep_ = 0; rep_ < REP(11); ++rep_) {
        PH_PTRS(); PROBE_BEGIN(11);
        MOE_TABLES(1);
        {
            const int RPW = (T + NGW - 1) / NGW; int cb = -1;
            f32x4 Av[8], Bv[8], Gv[8];
            int sl[4];
            { const int r0 = gw * RPW < T ? gw * RPW : T - 1;
#pragma unroll
              for (int k = 0; k < 4; ++k) sl[k] = TSLOT[r0 * 4 + k]; }
            for (int i = 0; i < RPW; ++i) {
                const int row = gw * RPW + i; if (row >= T) break;
                const int b = row >> 12;
                if (b != cb) { cb = b; const float* mb = MOD + (size_t)b * 6 * D; const float* fb = FMOD + (size_t)b * 2 * D;
#pragma unroll
                    for (int j = 0; j < 8; ++j) { const int k = 8 * lane + 512 * (j >> 1) + 4 * (j & 1); const f32x4 g = *(const f32x4*)(fnorm_g + k), sh = *(const f32x4*)(fb + k), sc = *(const f32x4*)(fb + D + k);
                        Av[j] = g * (sc + 1.0f); Bv[j] = sh; Gv[j] = *(const f32x4*)(mb + 5 * D + k); } }
                size_t prow[4];
#pragma unroll
                for (int k = 0; k < 4; ++k) { const int sv = sl[k]; const int e = sv >> 14, rank = sv & (LCAP - 1); prow[k] = ((size_t)MISC[80 + e] * 256 + rank) * D; }
                { const int rn = (row + 1 < T) ? row + 1 : row;
#pragma unroll
                  for (int k = 0; k < 4; ++k) sl[k] = TSLOT[rn * 4 + k]; }
                f32x4 v[8]; float ss = 0.f;
#pragma unroll
                for (int j = 0; j < 4; ++j) { const int k = 8 * lane + 512 * j; float f[8] = {0.f, 0.f, 0.f, 0.f, 0.f, 0.f, 0.f, 0.f};
#pragma unroll
                    for (int kk = 0; kk < 4; ++kk) { const v2u y = *(const v2u*)(YE + prow[kk] + k); const pg8::f32x2 q0 = __builtin_amdgcn_cvt_pk_f32_fp8((int)y.x, false), q1 = __builtin_amdgcn_cvt_pk_f32_fp8((int)y.x, true), q2 = __builtin_amdgcn_cvt_pk_f32_fp8((int)y.y, false), q3 = __builtin_amdgcn_cvt_pk_f32_fp8((int)y.y, true);
                        f[0] += q0.x; f[1] += q0.y; f[2] += q1.x; f[3] += q1.y; f[4] += q2.x; f[5] += q2.y; f[6] += q3.x; f[7] += q3.y; }
                    const v4u mq = *(const v4u*)(X1B + (size_t)row * D + k);
                    const f32x4 x0 = (f32x4){bf_lo(mq.x), bf_hi(mq.x), bf_lo(mq.y), bf_hi(mq.y)}, x1v = (f32x4){bf_lo(mq.z), bf_hi(mq.z), bf_lo(mq.w), bf_hi(mq.w)};
                    v[2 * j] = x0 + Gv[2 * j] * ((f32x4){f[0], f[1], f[2], f[3]} * 0.0625f); v[2 * j + 1] = x1v + Gv[2 * j + 1] * ((f32x4){f[4], f[5], f[6], f[7]} * 0.0625f);
                    ss += v[2 * j][0] * v[2 * j][0] + v[2 * j][1] * v[2 * j][1] + v[2 * j][2] * v[2 * j][2] + v[2 * j][3] * v[2 * j][3];
                    ss += v[2 * j + 1][0] * v[2 * j + 1][0] + v[2 * j + 1][1] * v[2 * j + 1][1] + v[2 * j + 1][2] * v[2 * j + 1][2] + v[2 * j + 1][3] * v[2 * j + 1][3]; }
                const float rstd = 1.0f / sqrtf(wave_sum(ss) * (1.0f / D) + RMS_EPS);
#pragma unroll
                for (int j = 0; j < 8; ++j) { const int k = 8 * lane + 512 * (j >> 1) + 4 * (j & 1); *(f32x4*)(out + (size_t)row * D + k) = v[j] * rstd * Av[j] + Bv[j]; }
            }
        }
    }
    if (PROBE_PH == 11) { __syncthreads(); pr_dt = __builtin_amdgcn_s_memrealtime() - pr_t0; }
    if (PROBE_PH >= 0) { const unsigned long long te = __builtin_amdgcn_s_memrealtime(); while (__builtin_amdgcn_s_memrealtime() - te < (unsigned long long)PROBE_N * pr_dt) __builtin_amdgcn_s_sleep(8); }
#undef IN
#undef BOTH
}

extern "C" void kernel_launch(void* const* d_in, const int* in_sizes, int n_in, void* d_out, int out_size, void* d_ws, size_t ws_size, hipStream_t stream) {
    static int grid = 0;
    if (grid == 0) {
        if (n_in != 30 || out_size != T * D || ws_size < WS_END) { fprintf(stderr, "kernel_launch: unexpected shapes (n_in %d, out %d, ws %zu); nothing launched\n", n_in, out_size, ws_size); grid = -1; return; }
        int dev = 0, cus = 0, per_cu = 0;
        if (hipGetDevice(&dev) != hipSuccess || hipDeviceGetAttribute(&cus, hipDeviceAttributeMultiprocessorCount, dev) != hipSuccess) { grid = -1; return; }
        if (hipFuncSetAttribute((const void*)fwd_kernel, hipFuncAttributeMaxDynamicSharedMemorySize, LDS_BYTES) != hipSuccess) { fprintf(stderr, "kernel_launch: hipFuncSetAttribute failed\n"); grid = -1; return; }
        if (hipOccupancyMaxActiveBlocksPerMultiprocessor(&per_cu, (const void*)fwd_kernel, NWAVES * 64, LDS_BYTES) != hipSuccess || per_cu < 1)
            fprintf(stderr, "kernel_launch: note: occupancy query reports %d workgroups per CU\n", per_cu);
        (void)hipGetLastError();
        grid = cus;
    }
    if (grid < 0) return;
    if (hipMemsetAsync((char*)d_ws + WS_CTL, 0, CTL_ZERO_BYTES, stream) != hipSuccess) { fprintf(stderr, "kernel_launch: hipMemsetAsync failed\n"); return; }
    Args a{};
    for (int i = 0; i < 30; ++i) a.in[i] = d_in[i];
    a.out = (float*)d_out; a.ws = (unsigned char*)d_ws;
    for (int li = 0; li < N_LAUNCHES; ++li) {
        if (N_LAUNCHES == 1) { a.ph_lo = 0; a.ph_hi = NPH; } else { a.ph_lo = li; a.ph_hi = li + 1; }
        a.li = li; a.pad = 0;
        hipLaunchKernelGGL(fwd_kernel, dim3(grid), dim3(NWAVES * 64), LDS_BYTES, stream, a);
        const hipError_t le = hipPeekAtLastError();
        if (le != hipSuccess) { fprintf(stderr, "kernel_launch: launch %d failed: %s\n", li, hipGetErrorName(le)); break; }
    }
}
```
